# Optimizing an MI355X kernel written in HIP

```python
import math
import jax
import jax.numpy as jnp
from jax import lax
import numpy as np

D_MODEL = 1024
BATCH = 8
SEQ = 4096
DEPTH = 1

D_MIX = D_MODEL
DA_HEADS = 4
DA_HEAD_DIM = 64
DA_VAL_DIM = 2 * DA_HEAD_DIM
DA_QK = DA_HEADS * 2 * DA_HEAD_DIM
DA_WIDTH = DA_HEADS * DA_VAL_DIM
ML_HEADS = 4
ML_HEAD_DIM = (D_MIX - DA_WIDTH) // ML_HEADS
ML_WIDTH = ML_HEADS * ML_HEAD_DIM
ML_CONV = 4
ML_CHUNK = 64
IN_SPLITS = (DA_QK, DA_QK, DA_WIDTH, ML_WIDTH, ML_WIDTH, ML_WIDTH, ML_WIDTH, ML_HEADS, ML_HEADS)
N_IN = sum(IN_SPLITS)
MEM_LEN = 256
X_HEADS = 4
X_HEAD_DIM = D_MODEL // X_HEADS
N_GROUPS = 4
EXPERTS_PER_GROUP = 8
N_EXPERTS = N_GROUPS * EXPERTS_PER_GROUP
TOP_K = 2
D_EXPERT = 512
MOE_BLOCK = 128
Q_BLOCK = 128
ROPE_THETA = 10000.0
EPS = 1e-6

kernel_name = 'hybrid_diffattn_mlstm_hmoe_layer'


def rms_norm(x, g):
    xf = x.astype(jnp.float32)
    y = xf * lax.rsqrt(jnp.mean(xf * xf, axis=-1, keepdims=True) + EPS)
    return (y * g.astype(jnp.float32)).astype(x.dtype)


def rotary(t, pos):
    d = t.shape[-1]
    inv_freq = ROPE_THETA ** (-jnp.arange(0, d, 2, dtype=jnp.float32) / d)
    ang = pos.astype(jnp.float32)[:, None] * inv_freq[None, :]
    cos = jnp.cos(ang).astype(t.dtype)
    sin = jnp.sin(ang).astype(t.dtype)
    t1, t2 = t[..., : d // 2], t[..., d // 2:]
    return jnp.concatenate([t1 * cos - t2 * sin, t2 * cos + t1 * sin], axis=-1)


def diff_attention(q, k, v, lam, subln_g, lam_init):
    bsz, seq = q.shape[0], q.shape[1]
    pos = jnp.arange(seq)
    q = rotary(q.transpose(0, 2, 3, 1, 4), pos) * (DA_HEAD_DIM ** -0.5)
    k = rotary(k.transpose(0, 2, 3, 1, 4), pos)
    v = v.transpose(0, 2, 1, 3)
    n_blk = seq // Q_BLOCK
    q_blocks = q.reshape(bsz, DA_HEADS, 2, n_blk, Q_BLOCK, DA_HEAD_DIM).transpose(3, 0, 1, 2, 4, 5)
    k_pos = jnp.arange(seq)

    def one_block(args):
        q_blk, start = args
        s = jnp.einsum('bhmqd,bhmkd->bhmqk', q_blk, k).astype(jnp.float32)
        q_pos = start + jnp.arange(Q_BLOCK)
        causal = k_pos[None, :] <= q_pos[:, None]
        p = jax.nn.softmax(jnp.where(causal, s, -jnp.inf), axis=-1)
        a = p[:, :, 0] - lam * p[:, :, 1]
        return jnp.einsum('bhqk,bhkd->bhqd', a.astype(v.dtype), v)

    o = lax.map(one_block, (q_blocks, jnp.arange(n_blk) * Q_BLOCK))
    o = o.transpose(1, 0, 3, 2, 4).reshape(bsz, seq, DA_HEADS, DA_VAL_DIM)
    o = rms_norm(o, subln_g) * (1.0 - lam_init)
    return o.reshape(bsz, seq, DA_WIDTH)


def causal_depthwise_conv(u, w, b):
    c = u.shape[-1]
    y = lax.conv_general_dilated(u, w.astype(u.dtype), window_strides=(1,),
                                 padding=[(ML_CONV - 1, 0)],
                                 dimension_numbers=('NWC', 'WIO', 'NWC'),
                                 feature_group_count=c)
    return y + b.astype(u.dtype)


def mlstm_chunkwise(q, k, v, o_pre, i_pre, f_pre, norm_g):
    f32 = jnp.float32
    bsz, seq = q.shape[0], q.shape[1]
    n_ch = seq // ML_CHUNK

    def heads(t):
        return t.astype(f32).reshape(bsz, n_ch, ML_CHUNK, ML_HEADS, ML_HEAD_DIM).transpose(1, 0, 3, 2, 4)

    def gates(t):
        return t.astype(f32).reshape(bsz, n_ch, ML_CHUNK, ML_HEADS).transpose(1, 0, 3, 2)

    qc, kc, vc = heads(q), heads(k) * (ML_HEAD_DIM ** -0.5), heads(v)
    ic = gates(i_pre)
    lfc = jax.nn.log_sigmoid(gates(f_pre))
    tri = jnp.tril(jnp.ones((ML_CHUNK, ML_CHUNK), dtype=bool))

    def step(carry, xs):
        c_mat, n_vec, m_prev = carry
        qj, ks, vs, ig, lf = xs
        a = jnp.cumsum(lf, axis=-1)
        log_d = jnp.where(tri, a[..., :, None] - a[..., None, :] + ig[..., None, :], -jnp.inf)
        log_inter = a + m_prev[..., None]
        m_row = jnp.maximum(log_inter, jnp.max(log_d, axis=-1))
        w_intra = jnp.exp(log_d - m_row[..., None])
        w_inter = jnp.exp(log_inter - m_row)
        s = jnp.einsum('bhjd,bhsd->bhjs', qj, ks) * w_intra
        num = (w_inter[..., None] * jnp.einsum('bhjd,bhde->bhje', qj, c_mat)
               + jnp.einsum('bhjs,bhse->bhje', s, vs))
        den = w_inter * jnp.einsum('bhjd,bhd->bhj', qj, n_vec) + jnp.sum(s, axis=-1)
        h = num / jnp.maximum(jnp.abs(den), jnp.exp(-m_row))[..., None]
        g = a[..., -1]
        log_w = g[..., None] - a + ig
        m_new = jnp.maximum(g + m_prev, jnp.max(log_w, axis=-1))
        w_state = jnp.exp(log_w - m_new[..., None])
        decay = jnp.exp(g + m_prev - m_new)
        c_new = decay[..., None, None] * c_mat + jnp.einsum('bhs,bhsd,bhse->bhde', w_state, ks, vs)
        n_new = decay[..., None] * n_vec + jnp.einsum('bhs,bhsd->bhd', w_state, ks)
        return (c_new, n_new, m_new), h

    init = (jnp.zeros((bsz, ML_HEADS, ML_HEAD_DIM, ML_HEAD_DIM), f32),
            jnp.zeros((bsz, ML_HEADS, ML_HEAD_DIM), f32),
            jnp.zeros((bsz, ML_HEADS), f32))
    _, h = lax.scan(step, init, (qc, kc, vc, ic, lfc))
    h = h.transpose(1, 0, 3, 2, 4).reshape(bsz, seq, ML_HEADS, ML_HEAD_DIM)
    mu = jnp.mean(h, axis=-1, keepdims=True)
    var = jnp.mean(jnp.square(h - mu), axis=-1, keepdims=True)
    hn = (h - mu) * lax.rsqrt(var + EPS) * norm_g.astype(f32).reshape(ML_HEADS, ML_HEAD_DIM)
    o = jax.nn.sigmoid(o_pre.astype(f32)).reshape(bsz, seq, ML_HEADS, ML_HEAD_DIM)
    return (o * hn).reshape(bsz, seq, ML_WIDTH).astype(q.dtype)


def hybrid_mixer(h, w_in, w_out, da_lambda, da_subln_g, lam_init, ml_conv_w, ml_conv_b, ml_gate_b, ml_norm_g):
    bsz, seq = h.shape[0], h.shape[1]
    proj = h @ w_in
    dq, dk, dv, mq, mk, mv, mo, mi, mf = jnp.split(proj, np.cumsum(IN_SPLITS)[:-1].tolist(), axis=-1)
    lv = da_lambda.astype(jnp.float32)
    lam = jnp.exp(jnp.sum(lv[0] * lv[1])) - jnp.exp(jnp.sum(lv[2] * lv[3])) + lam_init
    y_da = diff_attention(dq.reshape(bsz, seq, DA_HEADS, 2, DA_HEAD_DIM),
                          dk.reshape(bsz, seq, DA_HEADS, 2, DA_HEAD_DIM),
                          dv.reshape(bsz, seq, DA_HEADS, DA_VAL_DIM), lam, da_subln_g, lam_init)
    qk = jax.nn.silu(causal_depthwise_conv(jnp.concatenate([mq, mk], axis=-1), ml_conv_w, ml_conv_b))
    mq_c, mk_c = jnp.split(qk, 2, axis=-1)
    y_ml = mlstm_chunkwise(mq_c, mk_c, mv, mo,
                           mi + ml_gate_b[0].astype(mi.dtype), mf + ml_gate_b[1].astype(mf.dtype), ml_norm_g)
    return jnp.concatenate([y_da, y_ml], axis=-1) @ w_out


def cross_attention(h, mem_n, wq, wk, wv, wo):
    bsz, seq = h.shape[0], h.shape[1]
    m_len = mem_n.shape[1]
    q = (h @ wq).reshape(bsz, seq, X_HEADS, X_HEAD_DIM)
    k = (mem_n @ wk).reshape(bsz, m_len, X_HEADS, X_HEAD_DIM)
    v = (mem_n @ wv).reshape(bsz, m_len, X_HEADS, X_HEAD_DIM)
    s = jnp.einsum('bqhd,bkhd->bhqk', q, k).astype(jnp.float32) * (X_HEAD_DIM ** -0.5)
    p = jax.nn.softmax(s, axis=-1)
    o = jnp.einsum('bhqk,bkhd->bqhd', p.astype(v.dtype), v).reshape(bsz, seq, D_MODEL)
    return o @ wo


def hierarchical_moe(h, w_rg, b_rg, w_re, b_re, w1, w3, w2):
    f32 = jnp.float32
    bsz, seq, d = h.shape
    n_tok = bsz * seq
    xt = h.reshape(n_tok, d)
    g_prob = jax.nn.softmax((xt @ w_rg).astype(f32) + b_rg.astype(f32), axis=-1)
    g_idx = jnp.argmax(g_prob, axis=-1).astype(jnp.int32)
    g_w = jnp.take_along_axis(g_prob, g_idx[:, None], axis=-1)[:, 0]
    e_logits = ((xt @ w_re).astype(f32) + b_re.astype(f32)).reshape(n_tok, N_GROUPS, EXPERTS_PER_GROUP)
    e_logits = jnp.take_along_axis(e_logits, g_idx[:, None, None], axis=1)[:, 0]
    top_p, top_i = lax.top_k(jax.nn.softmax(e_logits, axis=-1), TOP_K)
    comb = g_w[:, None] * top_p / jnp.sum(top_p, axis=-1, keepdims=True)
    expert = g_idx[:, None] * EXPERTS_PER_GROUP + top_i.astype(jnp.int32)
    n_asg = n_tok * TOP_K
    flat_e = expert.reshape(-1)
    flat_tok = jnp.repeat(jnp.arange(n_tok, dtype=jnp.int32), TOP_K)
    flat_w = comb.reshape(-1)
    order = jnp.argsort(flat_e)
    sorted_e, sorted_tok, sorted_w = flat_e[order], flat_tok[order], flat_w[order]
    counts = jnp.bincount(flat_e, length=N_EXPERTS).astype(jnp.int32)
    padded = (counts + MOE_BLOCK - 1) // MOE_BLOCK * MOE_BLOCK
    starts = jnp.cumsum(counts) - counts
    pad_ends = jnp.cumsum(padded)
    pad_starts = pad_ends - padded
    dest = pad_starts[sorted_e] + jnp.arange(n_asg, dtype=jnp.int32) - starts[sorted_e]
    n_blocks = -(-n_asg // MOE_BLOCK) + N_EXPERTS
    n_rows = n_blocks * MOE_BLOCK
    buf_tok = jnp.full((n_rows,), n_tok, jnp.int32).at[dest].set(sorted_tok)
    buf_w = jnp.zeros((n_rows,), f32).at[dest].set(sorted_w)
    block_e = jnp.clip(jnp.searchsorted(pad_ends, jnp.arange(n_blocks, dtype=jnp.int32) * MOE_BLOCK, side='right'),
                       0, N_EXPERTS - 1).astype(jnp.int32)
    xpad = jnp.concatenate([xt, jnp.zeros((1, d), xt.dtype)], axis=0)
    xb = xpad[buf_tok].reshape(n_blocks, MOE_BLOCK, d)

    def run_block(args):
        x_blk, e = args
        return (jax.nn.silu(x_blk @ w1[e]) * (x_blk @ w3[e])) @ w2[e]

    yb = lax.map(run_block, (xb, block_e)).reshape(n_rows, d)
    yb = yb * buf_w[:, None].astype(yb.dtype)
    out = jnp.zeros((n_tok + 1, d), yb.dtype).at[buf_tok].add(yb)[:n_tok]
    return out.reshape(bsz, seq, d)


def setup_inputs(seed: int = 0) -> dict:
    key = jax.random.key(seed)
    ks = jax.random.split(key, 32)
    f32 = jnp.float32
    L = DEPTH

    def nrm(k, shape, scale):
        return jax.random.normal(k, shape, f32) * scale

    def gain(k, shape):
        return 1.0 + 0.02 * jax.random.normal(k, shape, f32)

    f_bias = jnp.linspace(3.0, 6.0, ML_HEADS, dtype=f32)
    ml_gate_b = jnp.stack([nrm(ks[9], (L, ML_HEADS), 0.1),
                           f_bias[None, :] + nrm(ks[10], (L, ML_HEADS), 0.1)], axis=1)
    return {
        'x': nrm(ks[0], (BATCH, SEQ, D_MODEL), 1.0),
        'mem': nrm(ks[1], (BATCH, MEM_LEN, D_MODEL), 1.0),
        'norm_mix_g': gain(ks[2], (L, D_MODEL)),
        'w_in': nrm(ks[3], (L, D_MODEL, N_IN), D_MODEL ** -0.5),
        'w_out': nrm(ks[4], (L, D_MIX, D_MODEL), D_MIX ** -0.5),
        'da_lambda': nrm(ks[5], (L, 4, DA_HEAD_DIM), 0.1),
        'da_subln_g': gain(ks[6], (L, DA_VAL_DIM)),
        'ml_conv_w': nrm(ks[7], (L, ML_CONV, 1, 2 * ML_WIDTH), ML_CONV ** -0.5),
        'ml_conv_b': nrm(ks[8], (L, 2 * ML_WIDTH), 0.02),
        'ml_gate_b': ml_gate_b,
        'ml_norm_g': gain(ks[11], (L, ML_WIDTH)),
        'norm_x_g': gain(ks[12], (L, D_MODEL)),
        'norm_mem_g': gain(ks[13], (L, D_MODEL)),
        'w_xq': nrm(ks[14], (L, D_MODEL, D_MODEL), D_MODEL ** -0.5),
        'w_xk': nrm(ks[15], (L, D_MODEL, D_MODEL), D_MODEL ** -0.5),
        'w_xv': nrm(ks[16], (L, D_MODEL, D_MODEL), D_MODEL ** -0.5),
        'w_xo': nrm(ks[17], (L, D_MODEL, D_MODEL), D_MODEL ** -0.5),
        'norm_ffn_g': gain(ks[18], (L, D_MODEL)),
        'w_router_group': nrm(ks[19], (L, D_MODEL, N_GROUPS), D_MODEL ** -0.5),
        'b_router_group': nrm(ks[20], (L, N_GROUPS), 0.01),
        'w_router_expert': nrm(ks[21], (L, D_MODEL, N_EXPERTS), D_MODEL ** -0.5),
        'b_router_expert': nrm(ks[22], (L, N_EXPERTS), 0.01),
        'w1': nrm(ks[23], (L, N_EXPERTS, D_MODEL, D_EXPERT), D_MODEL ** -0.5),
        'w3': nrm(ks[24], (L, N_EXPERTS, D_MODEL, D_EXPERT), D_MODEL ** -0.5),
        'w2': nrm(ks[25], (L, N_EXPERTS, D_EXPERT, D_MODEL), D_EXPERT ** -0.5),
        'norm_final_g': gain(ks[26], (D_MODEL,)),
    }


def reference(x, mem, norm_mix_g, w_in, w_out, da_lambda, da_subln_g, ml_conv_w, ml_conv_b, ml_gate_b,
              ml_norm_g, norm_x_g, norm_mem_g, w_xq, w_xk, w_xv, w_xo, norm_ffn_g, w_router_group,
              b_router_group, w_router_expert, b_router_expert, w1, w3, w2, norm_final_g):
    for l in range(DEPTH):
        lam_init = 0.8 - 0.6 * math.exp(-0.3 * l)
        x = x + hybrid_mixer(rms_norm(x, norm_mix_g[l]), w_in[l], w_out[l], da_lambda[l], da_subln_g[l],
                             lam_init, ml_conv_w[l], ml_conv_b[l], ml_gate_b[l], ml_norm_g[l])
        x = x + cross_attention(rms_norm(x, norm_x_g[l]), rms_norm(mem, norm_mem_g[l]),
                                w_xq[l], w_xk[l], w_xv[l], w_xo[l])
        x = x + hierarchical_moe(rms_norm(x, norm_ffn_g[l]), w_router_group[l], b_router_group[l],
                                 w_router_expert[l], b_router_expert[l], w1[l], w3[l], w2[l])
    return rms_norm(x, norm_final_g)
```

```cpp
#include <hip/hip_runtime.h>
#include <cstdio>
#include <cstdint>
__device__ __forceinline__ int lane_now() { int l; asm volatile("v_mbcnt_lo_u32_b32 %0, -1, 0\n\tv_mbcnt_hi_u32_b32 %0, -1, %0" : "=v"(l)); return l; }
namespace pg8 {
#define PG8_LAS __attribute__((address_space(3)))
typedef unsigned short bf16_t;
typedef short bf16x8 __attribute__((ext_vector_type(8)));
typedef float f32x4 __attribute__((ext_vector_type(4)));
typedef unsigned u32x4 __attribute__((ext_vector_type(4)));
constexpr int BM = 256, BK = 64, HALF = 128, HTB = HALF * BK * 2  , STAGE_BYTES = 8 * HTB, NXCD = 8, WGM = 8;

__host__ __device__ __forceinline__ int lds_byte(int r, int c) { const int st = (r >> 4) * 2 + (c >> 5), rr = r & 15, cc = c & 31, ob = rr * 64 + cc * 2; return st * 1024 + (ob ^ (((ob >> 9) & 1) << 5)); }
__host__ __device__ __forceinline__ void stage_rc(int b, int& R, int& C) { const int st = b / 1024, sb = b % 1024, swz = sb ^ (((sb >> 9) & 1) << 5); R = (st >> 1) * 16 + swz / 64; C = (st & 1) * 32 + (swz % 64) / 2; }
__host__ __device__ __forceinline__ int perm32(int rho) { const int n = rho >> 4, i = rho & 15; return 8 * (i >> 2) + 4 * n + (i & 3); }

struct Unit { int pm, pn, e; };
struct Gemm { const bf16_t* A; const bf16_t* Bt; int M, N, K; };

struct StaticOrder {
    int nM, nN, nwg, G, c;
    __host__ __device__ void init(int M, int N, int G_, int c_) { nM = M / BM; nN = N / BM; nwg = nM * nN; G = G_; c = c_; }
    __host__ __device__ bool next(int i, Unit& u) const {
        const long L = (long)i * G + c; if (L >= nwg) return false;
        int wgid = (int)L; { const int q = nwg / NXCD, r = nwg % NXCD, xcd = wgid % NXCD, off = wgid / NXCD; wgid = (xcd < r ? xcd * (q + 1) : r * (q + 1) + (xcd - r) * q) + off; }
        const int nig = WGM * nN, gid = wgid / nig, fm = gid * WGM, gsz = (nM - fm) < WGM ? (nM - fm) : WGM;
        u.pm = fm + ((wgid % nig) % gsz); u.pn = (wgid % nig) / gsz; u.e = 0; return true;
    }
    __device__ __forceinline__ const char* aptr(const Gemm& g, const Unit& u, size_t tstep) const { return (const char*)g.A + (size_t)u.pm * tstep; }
    __device__ __forceinline__ const char* bptr(const Gemm& g, const Unit& u, size_t tstep) const { return (const char*)g.Bt + (size_t)u.pn * tstep; }
    __device__ __forceinline__ void avoff(const Unit&, int, const int (&R)[2], const int (&C)[2], int K, unsigned (&vo)[2][2]) const {
#pragma unroll
        for (int h = 0; h < 2; ++h)
#pragma unroll
            for (int i = 0; i < 2; ++i) vo[h][i] = (unsigned)((h * HALF + R[i]) * K + C[i]) * 2u; }
};

__device__ __forceinline__ unsigned cvt_pk_bf16(float lo, float hi) { unsigned r; asm volatile("v_cvt_pk_bf16_f32 %0, %1, %2" : "=v"(r) : "v"(lo), "v"(hi)); return r; }
typedef float f32x2 __attribute__((ext_vector_type(2)));
__device__ __forceinline__ f32x2 gelu_pk(f32x2 v) {
    const f32x2 av = __builtin_elementwise_abs(v), d = av * 0.2316418882f + 1.0f;
    f32x2 t; t.x = __builtin_amdgcn_rcpf(d.x); t.y = __builtin_amdgcn_rcpf(d.y);
    f32x2 q = t * 0.5307027145f + (-0.7265760135f); q = q * t + 0.7107068705f; q = q * t + (-0.142248368f); q = q * t + 0.127414796f; q = q * t;
    const f32x2 s = (v * v) * (-0.72134752044f);
    f32x2 e; e.x = __builtin_amdgcn_exp2f(s.x); e.y = __builtin_amdgcn_exp2f(s.y);
    const f32x2 m = v * (q * e), r = v - m;
    f32x2 o; o.x = v.x < 0.f ? m.x : r.x; o.y = v.y < 0.f ? m.y : r.y; return o;
}

template <int ACT  > struct EpiBf16 {
    static constexpr bool PERM = true, AFTER_DRAIN = false; static_assert(ACT == 0 || ACT == 1, "EpiBf16: ACT is 0 (none) or 1 (gelu_pk)");
    bf16_t* O; int ldc; const float* bias; int split_cols; size_t split_stride; float scale0;
    __device__ __forceinline__ void operator()(const f32x4 (&acc)[2][2][4][2], const Unit& u, int wr, int wc, int fr, int fq) const {
        const int row0 = u.pm * BM + wr * 64 + fr; int colt = u.pn * BM; bf16_t* base = O;
        float sc = 1.f; if (split_cols) { const int t = colt / split_cols; base += (size_t)t * split_stride; colt -= t * split_cols; if (t == 0) sc = scale0; }
        const int col0 = colt + wc * 32 + 8 * fq, bcol0 = u.pn * BM + wc * 32 + 8 * fq;
        f32x4 bv[2][2];
#pragma unroll
        for (int bj = 0; bj < 2; ++bj)
#pragma unroll
            for (int n = 0; n < 2; ++n) bv[bj][n] = bias ? *(const f32x4*)(bias + bcol0 + bj * HALF + 4 * n) : (f32x4){0.f, 0.f, 0.f, 0.f};
#pragma unroll
        for (int ai = 0; ai < 2; ++ai)
#pragma unroll
            for (int m = 0; m < 4; ++m) { bf16_t* rowp = base + (size_t)(row0 + ai * HALF + m * 16) * ldc + col0;
#pragma unroll
                for (int bj = 0; bj < 2; ++bj) { f32x4 v0 = acc[ai][bj][m][0] + bv[bj][0], v1 = acc[ai][bj][m][1] + bv[bj][1];
                    if (ACT == 1) { f32x2 a = gelu_pk((f32x2){v0[0], v0[1]}), b = gelu_pk((f32x2){v0[2], v0[3]}), c = gelu_pk((f32x2){v1[0], v1[1]}), d = gelu_pk((f32x2){v1[2], v1[3]});
                        v0 = (f32x4){a.x, a.y, b.x, b.y}; v1 = (f32x4){c.x, c.y, d.x, d.y}; }
                    v0 = v0 * sc; v1 = v1 * sc; u32x4 w; w.x = cvt_pk_bf16(v0[0], v0[1]); w.y = cvt_pk_bf16(v0[2], v0[3]); w.z = cvt_pk_bf16(v1[0], v1[1]); w.w = cvt_pk_bf16(v1[2], v1[3]);
                    *(u32x4*)(rowp + bj * HALF) = w; } }
    }
};
typedef unsigned u32x2 __attribute__((ext_vector_type(2)));
__device__ __forceinline__ u32x2 pack4(const f32x4 v) { u32x2 w; w.x = cvt_pk_bf16(v[0], v[1]); w.y = cvt_pk_bf16(v[2], v[3]); return w; }

struct EpiProj {
    static constexpr bool PERM = false, AFTER_DRAIN = false;
    bf16_t* O; int ldc; const float* rope; float qscale;
    __device__ __forceinline__ void operator()(const f32x4 (&acc)[2][2][4][2], const Unit& u, int wr, int wc, int fr, int fq) const {
        const int row0 = u.pm * BM + wr * 64 + fr;
        if (u.pn < 4) {
            const float sc = (u.pn < 2) ? qscale : 1.0f; const int fi = 16 * (wc & 1) + 4 * fq;
#pragma unroll
            for (int ai = 0; ai < 2; ++ai)
#pragma unroll
                for (int m = 0; m < 4; ++m) { const int r = row0 + ai * HALF + m * 16; const int pos = r & 4095;
                    const f32x4 cs = *(const f32x4*)(rope + pos * 32 + fi), sn = *(const f32x4*)(rope + 4096 * 32 + pos * 32 + fi);
#pragma unroll
                    for (int bj = 0; bj < 2; ++bj) { const f32x4 t1 = acc[ai][bj][m][0], t2 = acc[ai][bj][m][1];
                        const f32x4 o1 = (t1 * cs - t2 * sn) * sc, o2 = (t2 * cs + t1 * sn) * sc;
                        bf16_t* p = O + (size_t)r * ldc + u.pn * BM + bj * HALF + 64 * (wc >> 1) + fi;
                        *(u32x2*)p = pack4(o1); *(u32x2*)(p + 32) = pack4(o2); } }
        } else {
            const int col0 = u.pn * BM + wc * 32 + 4 * fq;
#pragma unroll
            for (int ai = 0; ai < 2; ++ai)
#pragma unroll
                for (int m = 0; m < 4; ++m) { bf16_t* rowp = O + (size_t)(row0 + ai * HALF + m * 16) * ldc + col0;
#pragma unroll
                    for (int bj = 0; bj < 2; ++bj)
#pragma unroll
                        for (int n = 0; n < 2; ++n) *(u32x2*)(rowp + bj * HALF + n * 16) = pack4(acc[ai][bj][m][n]); }
        }
    }
};
template <bool WITH_XB> struct EpiResid {
    static constexpr bool PERM = false, AFTER_DRAIN = false;
    const float* base; float* out; bf16_t* xb; float* rowss; int ldc;
    __device__ __forceinline__ void operator()(const f32x4 (&acc)[2][2][4][2], const Unit& u, int wr, int wc, int fr, int fq) const {
        const int row0 = u.pm * BM + wr * 64 + fr, col0 = u.pn * BM + wc * 32 + 4 * fq;
#pragma unroll
        for (int ai = 0; ai < 2; ++ai)
#pragma unroll
            for (int m = 0; m < 4; ++m) { const int r = row0 + ai * HALF + m * 16; const size_t off = (size_t)r * ldc + col0; float ss = 0.f;
#pragma unroll
                for (int bj = 0; bj < 2; ++bj)
#pragma unroll
                    for (int n = 0; n < 2; ++n) { const f32x4 o = *(const f32x4*)(base + off + bj * HALF + n * 16) + acc[ai][bj][m][n];
                        *(f32x4*)(out + off + bj * HALF + n * 16) = o;
                        if (WITH_XB) { *(u32x2*)(xb + off + bj * HALF + n * 16) = pack4(o); ss += (o[0] * o[0] + o[1] * o[1]) + (o[2] * o[2] + o[3] * o[3]); } }
                if (WITH_XB) { ss += __shfl_xor(ss, 16); ss += __shfl_xor(ss, 32); if (fq == 0) atomicAdd(rowss + r, ss); } }
    }
};
struct EpiRowScale {
    static constexpr bool PERM = true, AFTER_DRAIN = false;
    bf16_t* O; int ldc; const float* rowss; float eps, scale;
    __device__ __forceinline__ void operator()(const f32x4 (&acc)[2][2][4][2], const Unit& u, int wr, int wc, int fr, int fq) const {
        const int row0 = u.pm * BM + wr * 64 + fr, col0 = u.pn * BM + wc * 32 + 8 * fq;
#pragma unroll
        for (int ai = 0; ai < 2; ++ai)
#pragma unroll
            for (int m = 0; m < 4; ++m) { const int r = row0 + ai * HALF + m * 16; const float sc = scale / sqrtf(rowss[r] * (1.0f / 1024.0f) + eps); bf16_t* rowp = O + (size_t)r * ldc + col0;
#pragma unroll
                for (int bj = 0; bj < 2; ++bj) { const f32x4 v0 = acc[ai][bj][m][0] * sc, v1 = acc[ai][bj][m][1] * sc;
                    u32x4 w; w.x = cvt_pk_bf16(v0[0], v0[1]); w.y = cvt_pk_bf16(v0[2], v0[3]); w.z = cvt_pk_bf16(v1[0], v1[1]); w.w = cvt_pk_bf16(v1[2], v1[3]);
                    *(u32x4*)(rowp + bj * HALF) = w; } }
    }
};
struct EpiSwiGLU {
    static constexpr bool PERM = false, AFTER_DRAIN = false;
    bf16_t* O; int ldc;
    __device__ __forceinline__ void operator()(const f32x4 (&acc)[2][2][4][2], const Unit& u, int wr, int wc, int fr, int fq) const {
        const int row0 = u.pm * BM + wr * 64 + fr, col0 = u.pn * HALF + wc * 32 + 4 * fq;
#pragma unroll
        for (int ai = 0; ai < 2; ++ai)
#pragma unroll
            for (int m = 0; m < 4; ++m) { bf16_t* rowp = O + (size_t)(row0 + ai * HALF + m * 16) * ldc + col0;
#pragma unroll
                for (int n = 0; n < 2; ++n) { const f32x4 a = acc[ai][0][m][n], b = acc[ai][1][m][n]; f32x4 o;
#pragma unroll
                    for (int j = 0; j < 4; ++j) o[j] = a[j] * b[j] * __builtin_amdgcn_rcpf(1.0f + __builtin_amdgcn_exp2f(-1.4426950408889634f * a[j]));
                    *(u32x2*)(rowp + n * 16) = pack4(o); } }
    }
};
template <bool GATHER> struct ExpertOrder {
    int G, c, ntiles; const PG8_LAS int* TS; const PG8_LAS int* TOK; size_t estride;
    __device__ __forceinline__ bool next(int i, Unit& u) const {
        const int L = i * G + c; if (L >= 4 * ntiles) return false;
        const int rt = L >> 2; int e = 0;
        for (int k = 1; k < 32; ++k) e += (TS[k] <= rt) ? 1 : 0;
        u.pm = rt; u.pn = L & 3; u.e = e; return true;
    }
    __device__ __forceinline__ const char* aptr(const Gemm& g, const Unit& u, size_t tstep) const { return GATHER ? (const char*)g.A : (const char*)g.A + (size_t)u.pm * tstep; }
    __device__ __forceinline__ const char* bptr(const Gemm& g, const Unit& u, size_t tstep) const { return (const char*)g.Bt + (size_t)u.e * estride + (size_t)u.pn * tstep; }
    __device__ __forceinline__ void avoff(const Unit&, int ui, const int (&R)[2], const int (&C)[2], int K, unsigned (&vo)[2][2]) const {
#pragma unroll
        for (int h = 0; h < 2; ++h)
#pragma unroll
            for (int i = 0; i < 2; ++i) { const int row = GATHER ? TOK[ui * 256 + h * HALF + R[i]] : (h * HALF + R[i]); vo[h][i] = (unsigned)(row * K + C[i]) * 2u; } }
};
template <class Epi, class Sched, bool ALIGN_EPI = false, bool SP2 = false>
__device__ __forceinline__ void gemm_phase(PG8_LAS unsigned char* lds, const Gemm g, const Sched& S, const Epi& E, const int wv) {
    const int wid = wv, lane = lane_now(), tid = wid * 64 + lane, wr = wid >> 2, wc = wid & 3, fr = lane & 15, fq = lane >> 4;
    const int K = g.K, nt = K / BK;
    int R_[2], C_[2]; unsigned voffB[2];
#pragma unroll
    for (int i = 0; i < 2; ++i) { int R, C; stage_rc(tid * 16 + i * 8192, R, C); R_[i] = R; C_[i] = C; const int Rb = Epi::PERM ? ((R & ~31) + perm32(R & 31)) : R;
        voffB[i] = (unsigned)(Rb * K + C) * 2u; }
    const size_t kstep = (size_t)(BK * 2);
    const size_t hstep = (size_t)HALF * K * 2;
    const size_t tstep = 2 * hstep;
    const unsigned ldsw = (unsigned)wid * 1024u;
    const int aoff = lds_byte(wr * 64 + fr, fq * 8), boff = lds_byte(wc * 32 + fr, fq * 8);
#define PG8_SA(b, h) (((b) * 2 + (h)) * HTB)
#define PG8_SB(b, h) ((4 + (b) * 2 + (h)) * HTB)
#define PG8_STAGE(bufoff, gbase, voff) do { _Pragma("unroll") for (int _i = 0; _i < 2; ++_i) \
        __builtin_amdgcn_global_load_lds((const unsigned*)((const char*)(gbase) + (voff)[_i]), (PG8_LAS unsigned*)(lds + (bufoff) + ldsw + _i * 8192), 16, 0, 0); } while (0)
#define PG8_LDA(dst, b, h) do { _Pragma("unroll") for (int m = 0; m < 4; ++m) _Pragma("unroll") for (int k = 0; k < 2; ++k) dst[m][k] = *(const PG8_LAS bf16x8*)(lds + PG8_SA(b, h) + aoff + m * 2048 + k * 1024); } while (0)
#define PG8_LDB(dst, b, h) do { _Pragma("unroll") for (int n = 0; n < 2; ++n) _Pragma("unroll") for (int k = 0; k < 2; ++k) dst[n][k] = *(const PG8_LAS bf16x8*)(lds + PG8_SB(b, h) + boff + n * 2048 + k * 1024); } while (0)
#define PG8_MMA(ai, bj, At, Bt) do { __builtin_amdgcn_s_setprio(1); _Pragma("unroll") for (int m = 0; m < 4; ++m) _Pragma("unroll") for (int n = 0; n < 2; ++n) _Pragma("unroll") for (int k = 0; k < 2; ++k) \
        acc[ai][bj][m][n] = __builtin_amdgcn_mfma_f32_16x16x32_bf16(Bt[n][k], At[m][k], acc[ai][bj][m][n], 0, 0, 0); __builtin_amdgcn_s_setprio(0); } while (0)
#define PG8_WAIT_V(n) asm volatile("s_waitcnt vmcnt(" #n ")" ::: "memory")
#define PG8_WAIT_L(n) asm volatile("s_waitcnt lgkmcnt(" #n ")" ::: "memory")
#define PG8_BAR __builtin_amdgcn_s_barrier()
#define PG8_SCHED __builtin_amdgcn_sched_barrier(0)
    Unit cur, nxt; int ui = 0;
    if (!S.next(0, cur)) return;
    f32x4 acc[2][2][4][2];
#pragma unroll
    for (int a = 0; a < 2; ++a)
#pragma unroll
        for (int b = 0; b < 2; ++b)
#pragma unroll
            for (int m = 0; m < 4; ++m)
#pragma unroll
                for (int n = 0; n < 2; ++n) acc[a][b][m][n] = (f32x4){0.f, 0.f, 0.f, 0.f};
    bf16x8 At[4][2], B0[2][2], B1[2][2];
    const char* cA = S.aptr(g, cur, tstep); const char* cB = S.bptr(g, cur, tstep);
    unsigned voA[2][2], voN[2][2];
    S.avoff(cur, 0, R_, C_, K, voA);
    if constexpr (SP2) {
        PG8_STAGE(PG8_SB(0, 0), cB, voffB); PG8_STAGE(PG8_SB(0, 1), cB + hstep, voffB); PG8_STAGE(PG8_SA(0, 0), cA, voA[0]); PG8_STAGE(PG8_SA(0, 1), cA, voA[1]);
        if (wr == 1) PG8_BAR;
        PG8_WAIT_V(2); PG8_BAR;
        PG8_STAGE(PG8_SB(1, 0), cB + kstep, voffB); PG8_STAGE(PG8_SA(1, 0), cA + kstep, voA[0]); PG8_STAGE(PG8_SB(1, 1), cB + hstep + kstep, voffB);
        PG8_WAIT_V(6); PG8_BAR;
    } else {
        PG8_STAGE(PG8_SB(0, 0), cB, voffB); PG8_STAGE(PG8_SA(0, 0), cA, voA[0]); PG8_STAGE(PG8_SB(0, 1), cB + hstep, voffB); PG8_STAGE(PG8_SA(0, 1), cA, voA[1]);
        if (wr == 1) PG8_BAR;
        PG8_WAIT_V(4); PG8_BAR;
        PG8_STAGE(PG8_SB(1, 0), cB + kstep, voffB); PG8_STAGE(PG8_SA(1, 0), cA + kstep, voA[0]); PG8_STAGE(PG8_SB(1, 1), cB + hstep + kstep, voffB);
        PG8_WAIT_V(6); PG8_BAR;
    }
    for (;;) {
        const bool has_next = S.next(ui + 1, nxt);
        const char* nA = has_next ? S.aptr(g, nxt, tstep) : cA; const char* nB = has_next ? S.bptr(g, nxt, tstep) : cB;
        if (has_next) S.avoff(nxt, ui + 1, R_, C_, K, voN); else {
#pragma unroll
            for (int h = 0; h < 2; ++h)
#pragma unroll
                for (int i = 0; i < 2; ++i) voN[h][i] = voA[h][i]; }
        for (int t = 0; t < nt; t += 2) {
            const bool last = (t == nt - 2);
            const char* a1 = cA + (size_t)(t + 1) * kstep;
            const char* a2 = last ? nA : cA + (size_t)(t + 2) * kstep; const char* b2 = last ? nB : cB + (size_t)(t + 2) * kstep;
            const char* a3 = a2 + kstep; const char* b3 = b2 + kstep;
            unsigned v2[2][2];
#pragma unroll
            for (int h = 0; h < 2; ++h)
#pragma unroll
                for (int i = 0; i < 2; ++i) v2[h][i] = last ? voN[h][i] : voA[h][i];
            if constexpr (SP2) {
            PG8_LDB(B0, 0, 0); PG8_LDB(B1, 0, 1); PG8_SCHED; PG8_LDA(At, 0, 0); PG8_STAGE(PG8_SA(1, 1), a1, voA[1]);
            PG8_WAIT_V(8); PG8_WAIT_L(0); PG8_BAR; PG8_MMA(0, 0, At, B0); PG8_MMA(0, 1, At, B1); PG8_BAR; PG8_SCHED;
            PG8_LDA(At, 0, 1); PG8_STAGE(PG8_SB(0, 0), b2, voffB); PG8_STAGE(PG8_SB(0, 1), b2 + hstep, voffB); PG8_STAGE(PG8_SA(0, 0), a2, v2[0]);
            PG8_WAIT_V(8); PG8_WAIT_L(0); PG8_BAR; PG8_MMA(1, 0, At, B0); PG8_MMA(1, 1, At, B1); PG8_BAR; PG8_SCHED;
            PG8_LDB(B0, 1, 0); PG8_LDB(B1, 1, 1); PG8_SCHED; PG8_LDA(At, 1, 0); PG8_STAGE(PG8_SA(0, 1), a2, v2[1]);
            PG8_WAIT_V(8); PG8_WAIT_L(0); PG8_BAR; PG8_MMA(0, 0, At, B0); PG8_MMA(0, 1, At, B1); PG8_BAR; PG8_SCHED;
            PG8_LDA(At, 1, 1); PG8_STAGE(PG8_SB(1, 0), b3, voffB); PG8_STAGE(PG8_SB(1, 1), b3 + hstep, voffB); PG8_STAGE(PG8_SA(1, 0), a3, v2[0]);
            PG8_WAIT_V(8); PG8_WAIT_L(0); PG8_BAR; PG8_MMA(1, 0, At, B0); PG8_MMA(1, 1, At, B1); PG8_BAR; PG8_SCHED;
            } else {
            PG8_LDB(B0, 0, 0); PG8_SCHED; PG8_LDA(At, 0, 0); PG8_STAGE(PG8_SA(1, 1), a1, voA[1]);
            PG8_WAIT_L(8); PG8_BAR; PG8_WAIT_L(0); PG8_MMA(0, 0, At, B0); PG8_BAR; PG8_SCHED;
            PG8_LDB(B1, 0, 1); PG8_STAGE(PG8_SB(0, 0), b2, voffB);
            PG8_BAR; PG8_WAIT_L(0); PG8_MMA(0, 1, At, B1); PG8_BAR;
            PG8_LDA(At, 0, 1); PG8_STAGE(PG8_SA(0, 0), a2, v2[0]);
            PG8_BAR; PG8_WAIT_L(0); PG8_MMA(1, 0, At, B0); PG8_BAR; PG8_SCHED;
            PG8_STAGE(PG8_SB(0, 1), b2 + hstep, voffB);
            PG8_WAIT_V(6); PG8_BAR; PG8_MMA(1, 1, At, B1); PG8_BAR;
            PG8_LDB(B0, 1, 0); PG8_SCHED; PG8_LDA(At, 1, 0); PG8_STAGE(PG8_SA(0, 1), a2, v2[1]);
            PG8_WAIT_L(8); PG8_BAR; PG8_WAIT_L(0); PG8_MMA(0, 0, At, B0); PG8_BAR; PG8_SCHED;
            PG8_LDB(B1, 1, 1); PG8_STAGE(PG8_SB(1, 0), b3, voffB);
            PG8_BAR; PG8_WAIT_L(0); PG8_MMA(0, 1, At, B1); PG8_BAR;
            PG8_LDA(At, 1, 1); PG8_STAGE(PG8_SA(1, 0), a3, v2[0]);
            PG8_BAR; PG8_WAIT_L(0); PG8_MMA(1, 0, At, B0); PG8_BAR; PG8_SCHED;
            PG8_STAGE(PG8_SB(1, 1), b3 + hstep, voffB);
            PG8_WAIT_V(6); PG8_BAR; PG8_MMA(1, 1, At, B1); PG8_BAR;
            }
        }
        if constexpr (ALIGN_EPI) { if (wr == 0) PG8_BAR; }
        if constexpr (!Epi::AFTER_DRAIN) { E(acc, cur, wr, wc, fr, fq); }
        if (!has_next) break;
#pragma unroll
        for (int a = 0; a < 2; ++a)
#pragma unroll
            for (int b = 0; b < 2; ++b)
#pragma unroll
                for (int m = 0; m < 4; ++m)
#pragma unroll
                    for (int n = 0; n < 2; ++n) acc[a][b][m][n] = (f32x4){0.f, 0.f, 0.f, 0.f};
        cur = nxt; cA = nA; cB = nB; ++ui;
#pragma unroll
        for (int h = 0; h < 2; ++h)
#pragma unroll
            for (int i = 0; i < 2; ++i) voA[h][i] = voN[h][i];
        if constexpr (ALIGN_EPI) { if (wr == 1) PG8_BAR; }
    }
    PG8_WAIT_V(0);
    if constexpr (!ALIGN_EPI) { if (wr == 0) PG8_BAR; }
    PG8_BAR;
    if constexpr (Epi::AFTER_DRAIN) { E.fused(acc, cur, wr, wc, fr, fq, lds, wid, lane); }
#undef PG8_SA
#undef PG8_SB
#undef PG8_STAGE
#undef PG8_LDA
#undef PG8_LDB
#undef PG8_MMA
#undef PG8_WAIT_V
#undef PG8_WAIT_L
#undef PG8_BAR
#undef PG8_SCHED
}
}

#ifndef PG8_SP2
#define PG8_SP2 true
#endif
#ifndef PG8_ALIGN
#define PG8_ALIGN true
#endif
#include <hip/hip_bf16.h>
#include <cmath>
namespace attn_body {
using bf16=__hip_bfloat16;
using bf16x8=__attribute__((ext_vector_type(8)))short;
using s16x4=__attribute__((ext_vector_type(4)))short;
using f32x16=__attribute__((ext_vector_type(16)))float;
using u32x4=__attribute__((ext_vector_type(4)))unsigned;
constexpr int BATCH=8,NHEAD=16,SEQ=4096,D=64,PQ=3584,PO=1024;
constexpr int NW=8,QBLK=32,QB=QBLK*NW,KVBLK=64,NQB=SEQ/QB;
constexpr int ATTN_UNIT_ROWS=QB;
__device__ __forceinline__ int crow(int r,int hi){return (r&3)+8*(r>>2)+4*hi;}
#define SBAR() __builtin_amdgcn_sched_barrier(0)
__device__ __forceinline__ void cmask(f32x16&p0,f32x16&p1,int jb,int qrel,int hi){
  const float NEG=-INFINITY; int kb=64*jb+4*hi;
  #pragma unroll
  for(int r=0;r<16;++r){int kv=kb+(r&3)+8*(r>>2); if(kv>qrel)p0[r]=NEG; if(kv+32>qrel)p1[r]=NEG;}
}

constexpr int NSLOT=3, SLOTB=8192;
constexpr int LDS_K=0, LDS_V=NSLOT*SLOTB, LDS_WS=2*NSLOT*SLOTB, LDS_OST=LDS_WS+NW*64*4, LDS_BYTES=LDS_OST+NW*4096;
constexpr float C2=0.125f*1.4426950408889634f;
__device__ __forceinline__ void glds16(const void*gsrc,unsigned lds_dst){unsigned keep;
  asm volatile("s_mov_b32 %0, m0\n\ts_mov_b32 m0, %2\n\ts_nop 0\n\tglobal_load_lds_dwordx4 %1, off\n\ts_mov_b32 m0, %0":"=&s"(keep):"v"(gsrc),"s"(lds_dst):"memory");}
__device__ __forceinline__ float max3f(float a,float b,float c){float r;asm("v_max3_f32 %0, %1, %2, %3":"=v"(r):"v"(a),"v"(b),"v"(c));return r;}
__device__ __forceinline__ float max2f(float a,float b){float r;asm("v_max_f32_e32 %0, %1, %2":"=v"(r):"v"(a),"v"(b));return r;}
__device__ __forceinline__ float fadd_s(float a,float b){float r;asm("v_add_f32_e32 %0, %1, %2":"=v"(r):"v"(a),"v"(b));return r;}
__device__ __forceinline__ float fsub_s(float a,float b){float r;asm("v_sub_f32_e32 %0, %1, %2":"=v"(r):"v"(a),"v"(b));return r;}
typedef float f32x2_t __attribute__((ext_vector_type(2))); typedef __bf16 bf16x2_t __attribute__((ext_vector_type(2)));
__device__ __forceinline__ unsigned cvtpk_s(float lo,float hi){f32x2_t v={lo,hi};bf16x2_t b=__builtin_convertvector(v,bf16x2_t);return __builtin_bit_cast(unsigned,b);}
#define WAIT_BAR(N) asm volatile("s_waitcnt vmcnt(" #N ") lgkmcnt(0)\n\ts_barrier":::"memory")

__device__ __forceinline__ void qkt(f32x16&p0,f32x16&p1,const char*Kslot,const bf16x8*qr,const f32x16&negm,int r32,int hi){
  const char*kb=Kslot+hi*1024+r32*16;
  #pragma unroll
  for(int d0=0;d0<4;++d0){
    const bf16x8 b0=*reinterpret_cast<const bf16x8*>(kb+d0*2048);
    const bf16x8 b1=*reinterpret_cast<const bf16x8*>(kb+d0*2048+512);
    if(d0==0){p0=__builtin_amdgcn_mfma_f32_32x32x16_bf16(b0,qr[0],negm,0,0,0);p1=__builtin_amdgcn_mfma_f32_32x32x16_bf16(b1,qr[0],negm,0,0,0);}
    else{p0=__builtin_amdgcn_mfma_f32_32x32x16_bf16(b0,qr[d0],p0,0,0,0);p1=__builtin_amdgcn_mfma_f32_32x32x16_bf16(b1,qr[d0],p1,0,0,0);}}
}
typedef __attribute__((address_space(3))) const char* lds_cptr;
typedef short v4i16_t __attribute__((ext_vector_type(4)));
__device__ __forceinline__ void kload8(bf16x8*kf,lds_cptr kp){
  kf[0]=*(const __attribute__((address_space(3))) bf16x8*)(kp);      kf[1]=*(const __attribute__((address_space(3))) bf16x8*)(kp+512);
  kf[2]=*(const __attribute__((address_space(3))) bf16x8*)(kp+2048); kf[3]=*(const __attribute__((address_space(3))) bf16x8*)(kp+2560);
  kf[4]=*(const __attribute__((address_space(3))) bf16x8*)(kp+4096); kf[5]=*(const __attribute__((address_space(3))) bf16x8*)(kp+4608);
  kf[6]=*(const __attribute__((address_space(3))) bf16x8*)(kp+6144); kf[7]=*(const __attribute__((address_space(3))) bf16x8*)(kp+6656);
}
__device__ __forceinline__ void kload2(bf16x8*kf,lds_cptr kp,int j){ kf[2*j]=*(const __attribute__((address_space(3))) bf16x8*)(kp+j*2048); kf[2*j+1]=*(const __attribute__((address_space(3))) bf16x8*)(kp+j*2048+512); }
__device__ __forceinline__ s16x4 vtr(lds_cptr p){ return __builtin_bit_cast(s16x4,__builtin_amdgcn_ds_read_tr16_b64_v4i16((__attribute__((address_space(3))) v4i16_t*)p)); }
__device__ __forceinline__ float rowmax(const f32x16&p0,const f32x16&p1){
  float a=max3f(p0[0],p0[1],p1[0]),b=max3f(p0[2],p0[3],p1[1]);a=max3f(a,p1[2],p1[3]);
  #pragma unroll
  for(int r=4;r<16;r+=4){a=max3f(a,p0[r],p0[r+1]);b=max3f(b,p0[r+2],p0[r+3]);a=max3f(a,p1[r],p1[r+1]);b=max3f(b,p1[r+2],p1[r+3]);}
  const float m=max2f(a,b);
  auto rr=__builtin_amdgcn_permlane32_swap(__float_as_uint(m),__float_as_uint(m),false,false);
  return max2f(__uint_as_float(rr[0]),__uint_as_float(rr[1]));
}
__device__ __forceinline__ void pv(f32x16*o,int vb,bf16x8 pa0,bf16x8 pa1,bf16x8 pa2,bf16x8 pa3){
  #pragma unroll
  for(int d0=0;d0<2;++d0){s16x4 lo[4],hi[4];
    #pragma unroll
    for(int ks=0;ks<4;++ks){
      asm volatile("ds_read_b64_tr_b16 %0,%1 offset:%c2":"=&v"(lo[ks]):"v"(vb),"i"(d0*4096+ks*1024):"memory");
      asm volatile("ds_read_b64_tr_b16 %0,%1 offset:%c2":"=&v"(hi[ks]):"v"(vb),"i"(d0*4096+ks*1024+512):"memory");}
    asm volatile("s_waitcnt lgkmcnt(0)":::"memory");SBAR();
    #define PK(k) (bf16x8){lo[k][0],lo[k][1],lo[k][2],lo[k][3],hi[k][0],hi[k][1],hi[k][2],hi[k][3]}
    o[d0]=__builtin_amdgcn_mfma_f32_32x32x16_bf16(pa0,PK(0),o[d0],0,0,0);
    o[d0]=__builtin_amdgcn_mfma_f32_32x32x16_bf16(pa1,PK(1),o[d0],0,0,0);
    o[d0]=__builtin_amdgcn_mfma_f32_32x32x16_bf16(pa2,PK(2),o[d0],0,0,0);
    o[d0]=__builtin_amdgcn_mfma_f32_32x32x16_bf16(pa3,PK(3),o[d0],0,0,0);
    #undef PK
  }
}

#ifndef ATTN_STORE16
#define ATTN_STORE16(p,v) (*(u32x4*)(p)=(v))
#endif
template<int THRL> __device__ __forceinline__ void attn_unit(int b,int qb,const bf16*Q,const bf16*__restrict__ K,const bf16*__restrict__ V,bf16*O,char*shm,const int wv){
  const int lane=lane_now(),r32=lane&31,hi=lane>>5; const int wid=wv;
  const long rowbase=(long)b*SEQ; const int q0=qb*QB;
  const bf16*Qw=Q+(rowbase+q0+wid*QBLK)*PQ;
  const bf16*Kh=K+rowbase*PQ,*Vh=V+rowbase*PQ;
  const unsigned lds0=(unsigned)(uintptr_t)shm;
  float*wsf=(float*)(shm+LDS_WS)+wid*64;
  const bf16*ksrc=Kh+(long)lane*PQ+wid*8;
  const bf16*vsrc=Vh+(long)(16*(wid&3)+(lane>>2))*PQ+(wid>>2)*32+(lane&3)*8;
  const unsigned kdst=lds0+LDS_K+wid*1024, vdst=lds0+LDS_V+wid*1024;
  #define DMA_K(t,slot) glds16(ksrc+(long)(t)*KVBLK*PQ,(unsigned)__builtin_amdgcn_readfirstlane(kdst+(slot)))
  #define DMA_V(t,slot) glds16(vsrc+(long)(t)*KVBLK*PQ,(unsigned)__builtin_amdgcn_readfirstlane(vdst+(slot)))
  const int vb0=(int)(lds0+LDS_V)+((lane>>4)&1)*32+(lane&3)*8+(4*hi+((lane&15)>>2))*64;
  const char*Kbase=shm+LDS_K; bf16x8 kf[8];
  const lds_cptr shm3=(lds_cptr)shm; const lds_cptr kp0=shm3+LDS_K+hi*1024+r32*16; const lds_cptr vp0=shm3+LDS_V+((lane>>4)&1)*32+(lane&3)*8+(4*hi+((lane&15)>>2))*64;
  const int NT=(q0+QB)/KVBLK;
  DMA_K(0,0);DMA_V(0,0);DMA_K(1,SLOTB);
  bf16x8 qr[4];
  #pragma unroll
  for(int d0=0;d0<4;++d0)qr[d0]=*reinterpret_cast<const bf16x8*>(&Qw[(long)r32*PQ+d0*16+hi*8]);
  float mhat=0.f,l_reg=0.f;f32x16 o[2];o[0]=f32x16{};o[1]=f32x16{};f32x16 negm=f32x16{};asm volatile("":"+v"(negm));
  const int qrel=wid*QBLK+r32;
  #define CMASK(P0,P1,t) do{int jb_=(t)-(NT-4); if(jb_>=0)cmask(P0,P1,jb_,qrel,hi);}while(0)
  bool resc=false;
  #define START(P0,P1) do{ const float rm=rowmax(P0,P1); resc=false; \
    { const float dl=rm; mhat=fadd_s(mhat,dl); \
      _Pragma("unroll") for(int r=0;r<16;++r){P0[r]=fsub_s(P0[r],dl);P1[r]=fsub_s(P1[r],dl);} \
      _Pragma("unroll") for(int r=0;r<16;++r)negm[r]=-mhat; asm volatile("":"+v"(negm)); } \
    _Pragma("unroll") for(int r=0;r<16;++r)P0[r]=__builtin_amdgcn_exp2f(P0[r]); }while(0)
  #define RESC() do{ if(resc){ asm volatile("s_waitcnt lgkmcnt(0)":::"memory"); \
      _Pragma("unroll") for(int d_=0;d_<2;++d_) _Pragma("unroll") for(int r=0;r<16;++r)o[d_][r]*=wsf[crow(r,hi)]; } }while(0)
  f32x16 pA0,pA1,pB0,pB1;
  int sl_prev=0,sl_cur=0,sl_next=SLOTB;
  #define ROT() do{sl_prev=sl_cur;sl_cur=sl_next;sl_next=(sl_next==(NSLOT-1)*SLOTB)?0:sl_next+SLOTB;}while(0)
  DMA_K(2,2*SLOTB);
  WAIT_BAR(3);
  qkt(pA0,pA1,Kbase,qr,negm,r32,hi);asm volatile("s_nop 15\n\ts_nop 7":"+v"(pA0),"+v"(pA1));CMASK(pA0,pA1,0);
  START(pA0,pA1);
  _Pragma("unroll") for(int r=0;r<16;++r)pA1[r]=__builtin_amdgcn_exp2f(pA1[r]);
  WAIT_BAR(0);
  DMA_K(3,0);DMA_V(1,SLOTB);
  ROT();
  kload8(kf,kp0+sl_cur);
  WAIT_BAR(2);
  s16x4 vlo[8],vhi[8]; u32x4 pw0,pw1,pw2,pw3;
  #define PKW(P,B) cvtpk_s(P[B],P[B+1])
  #define PAF(k) __builtin_bit_cast(bf16x8,pw##k)
  #define VFR(i) (bf16x8){vlo[i][0],vlo[i][1],vlo[i][2],vlo[i][3],vhi[i][0],vhi[i][1],vhi[i][2],vhi[i][3]}
  #define PIN(x) asm volatile("":"+v"(x))
  #define MX3(a,b,c) __builtin_fmaxf(__builtin_fmaxf((a),(b)),(c))
  #define GAPA(MF,A0,A1,A2,A3,W0,W1,PW) do{ MF; sacc+=A0; sacc+=A1; sacc+=A2; sacc+=A3; PIN(sacc); W0; W1; PIN(PW); SBAR(); }while(0)
  #define EX(v) __builtin_amdgcn_exp2f(v)
  #define GAPB(MF,X,B) do{ MF; X[B]=EX(X[B]); X[B+1]=EX(X[B+1]); X[B+2]=EX(X[B+2]); X[B+3]=EX(X[B+3]); PIN(X); SBAR(); }while(0)
  #define VRD(i) do{ vlo[i]=vtr(vp_+(((i)>>2)*4096+((i)&3)*1024)); vhi[i]=vtr(vp_+(((i)>>2)*4096+((i)&3)*1024+512)); }while(0)
  #define KRD(G,j) do{ if(G){ kload2(kf,kp0+sl_next,j); SBAR(); } }while(0)
  #define STEP(C0,C1,P0,P1,t,GK,GV,GL) do{ SBAR(); \
    const lds_cptr vp_=vp0+sl_prev; \
    VRD(0); SBAR(); float sacc=(P0[0]+P0[1]); \
    GAPA(C0=__builtin_amdgcn_mfma_f32_32x32x16_bf16(kf[0],qr[0],negm,0,0,0), P0[2],P0[3],P0[4],P0[5],     pw0[0]=PKW(P0,0), pw0[1]=PKW(P0,2), pw0); \
    VRD(4); SBAR(); GAPA(C1=__builtin_amdgcn_mfma_f32_32x32x16_bf16(kf[1],qr[0],negm,0,0,0), P0[6],P0[7],P0[8],P0[9],     pw0[2]=PKW(P0,4), pw0[3]=PKW(P0,6), pw0); \
    VRD(1); SBAR(); GAPA(C0=__builtin_amdgcn_mfma_f32_32x32x16_bf16(kf[2],qr[1],C0,0,0,0),   P0[10],P0[11],P0[12],P0[13], pw1[0]=PKW(P0,8), pw1[1]=PKW(P0,10), pw1); \
    VRD(5); SBAR(); GAPA(C1=__builtin_amdgcn_mfma_f32_32x32x16_bf16(kf[3],qr[1],C1,0,0,0),   P0[14],P0[15],P1[0],P1[1],   pw1[2]=PKW(P0,12),pw1[3]=PKW(P0,14), pw1); \
    VRD(2); SBAR(); GAPA(C0=__builtin_amdgcn_mfma_f32_32x32x16_bf16(kf[4],qr[2],C0,0,0,0),   P1[2],P1[3],P1[4],P1[5],     pw2[0]=PKW(P1,0), pw2[1]=PKW(P1,2), pw2); \
    VRD(6); SBAR(); GAPA(C1=__builtin_amdgcn_mfma_f32_32x32x16_bf16(kf[5],qr[2],C1,0,0,0),   P1[6],P1[7],P1[8],P1[9],     pw2[2]=PKW(P1,4), pw2[3]=PKW(P1,6), pw2); \
    VRD(3); SBAR(); GAPA(C0=__builtin_amdgcn_mfma_f32_32x32x16_bf16(kf[6],qr[3],C0,0,0,0),   P1[10],P1[11],P1[12],P1[13], pw3[0]=PKW(P1,8), pw3[1]=PKW(P1,10), pw3); \
    VRD(7); SBAR(); GAPA(C1=__builtin_amdgcn_mfma_f32_32x32x16_bf16(kf[7],qr[3],C1,0,0,0),   P1[14],P1[15],0.f,0.f,       pw3[2]=PKW(P1,12),pw3[3]=PKW(P1,14), pw3); \
    l_reg+=sacc; \
    if(GK){DMA_K((t)+3,sl_cur);} if(GV){DMA_V((t)+1,sl_next);} \
    CMASK(C0,C1,t); \
    { float a=MX3(C0[0],C0[1],C1[0]),b=MX3(C0[2],C0[3],C1[1]); a=MX3(a,C1[2],C1[3]); \
      _Pragma("unroll") for(int r=4;r<16;r+=4){a=MX3(a,C0[r],C0[r+1]);b=MX3(b,C0[r+2],C0[r+3]);a=MX3(a,C1[r],C1[r+1]);b=MX3(b,C1[r+2],C1[r+3]);} \
      float rm=__builtin_fmaxf(a,b); { auto rr=__builtin_amdgcn_permlane32_swap(__float_as_uint(rm),__float_as_uint(rm),false,false); rm=__builtin_fmaxf(__uint_as_float(rr[0]),__uint_as_float(rr[1])); } \
      resc=false; \
      if(__builtin_expect(__any(rm>(float)THRL),0)){ const float dl=__builtin_fmaxf(rm,0.f); mhat+=dl; \
        _Pragma("unroll") for(int r=0;r<16;++r){C0[r]-=dl;C1[r]-=dl;} \
        _Pragma("unroll") for(int r=0;r<16;++r)negm[r]=-mhat; asm volatile("":"+v"(negm)); \
        const float f=__builtin_amdgcn_exp2f(-dl); l_reg*=f; if(hi==0)wsf[r32]=f; resc=true; } } \
    SBAR(); \
    GAPB(o[0]=__builtin_amdgcn_mfma_f32_32x32x16_bf16(PAF(0),VFR(0),o[0],0,0,0), C0,0); \
    GAPB(o[1]=__builtin_amdgcn_mfma_f32_32x32x16_bf16(PAF(0),VFR(4),o[1],0,0,0), C0,4); \
    KRD(GL,0); GAPB(o[0]=__builtin_amdgcn_mfma_f32_32x32x16_bf16(PAF(1),VFR(1),o[0],0,0,0), C0,8); \
    KRD(GL,1); GAPB(o[1]=__builtin_amdgcn_mfma_f32_32x32x16_bf16(PAF(1),VFR(5),o[1],0,0,0), C0,12); \
    KRD(GL,2); GAPB(o[0]=__builtin_amdgcn_mfma_f32_32x32x16_bf16(PAF(2),VFR(2),o[0],0,0,0), C1,0); \
    KRD(GL,3); GAPB(o[1]=__builtin_amdgcn_mfma_f32_32x32x16_bf16(PAF(2),VFR(6),o[1],0,0,0), C1,4); \
    GAPB(o[0]=__builtin_amdgcn_mfma_f32_32x32x16_bf16(PAF(3),VFR(3),o[0],0,0,0), C1,8); \
    GAPB(o[1]=__builtin_amdgcn_mfma_f32_32x32x16_bf16(PAF(3),VFR(7),o[1],0,0,0), C1,12); \
    }while(0)
  int t=1;
  #undef CMASK
  #define CMASK(P0,P1,t) do{}while(0)
  for(;t+5<NT;t+=2){
    STEP(pB0,pB1,pA0,pA1,t,true,true,true);     WAIT_BAR(2); RESC(); ROT();
    STEP(pA0,pA1,pB0,pB1,t+1,true,true,true);   WAIT_BAR(2); RESC(); ROT();
  }
  #undef CMASK
  #define CMASK(P0,P1,t) do{int jb_=(t)-(NT-4); if(jb_>=0)cmask(P0,P1,jb_,qrel,hi);}while(0)
  #define ENDW(tt) do{ if((tt)+3<NT){WAIT_BAR(2);} else if((tt)+2<NT){WAIT_BAR(1);} else {WAIT_BAR(0);} }while(0)
  for(;t+1<NT;t+=2){
    STEP(pB0,pB1,pA0,pA1,t,(t+3<NT),(t+1<NT),(t+1<NT));       ENDW(t);   RESC(); ROT();
    STEP(pA0,pA1,pB0,pB1,t+1,(t+4<NT),(t+2<NT),(t+2<NT));     ENDW(t+1); RESC(); ROT();
  }
  STEP(pB0,pB1,pA0,pA1,NT-1,false,false,false); RESC();
  { float sacc=pB0[0]+pB0[1]; _Pragma("unroll") for(int r=2;r<16;++r)sacc+=pB0[r]; _Pragma("unroll") for(int r=0;r<16;++r)sacc+=pB1[r]; l_reg+=sacc;
    pw0=(u32x4){PKW(pB0,0),PKW(pB0,2),PKW(pB0,4),PKW(pB0,6)};pw1=(u32x4){PKW(pB0,8),PKW(pB0,10),PKW(pB0,12),PKW(pB0,14)};pw2=(u32x4){PKW(pB1,0),PKW(pB1,2),PKW(pB1,4),PKW(pB1,6)};pw3=(u32x4){PKW(pB1,8),PKW(pB1,10),PKW(pB1,12),PKW(pB1,14)};
    SBAR(); pv(o,vb0+sl_cur,PAF(0),PAF(1),PAF(2),PAF(3)); }
  #undef PKW
  #undef PAF
  #undef VFR
  #undef PIN
  #undef MX3
  #undef GAPA
  #undef GAPB
  #undef EX
  #undef VRD
  #undef KRD
  #undef STEP
  #undef ENDW
  {auto rr=__builtin_amdgcn_permlane32_swap(__float_as_uint(l_reg),__float_as_uint(l_reg),false,false);l_reg=__uint_as_float(rr[0])+__uint_as_float(rr[1]);}
  if(hi==0)wsf[32+r32]=l_reg;asm volatile("s_waitcnt lgkmcnt(0)":::"memory");
  float rli[16];
  #pragma unroll
  for(int r=0;r<16;++r)rli[r]=__builtin_amdgcn_rcpf(wsf[32+crow(r,hi)]);
  bf16*Ow=O+(rowbase+q0+wid*QBLK)*PO;
  { bf16*stg=(bf16*)(shm+LDS_OST)+wid*2048;
    #pragma unroll
    for(int r=0;r<16;++r){const int orow=crow(r,hi);
      #pragma unroll
      for(int d0=0;d0<2;++d0)stg[orow*64+d0*32+r32]=__float2bfloat16(o[d0][r]*rli[r]);}
    asm volatile("s_waitcnt lgkmcnt(0)":::"memory");
    #pragma unroll
    for(int i=0;i<4;++i){const int row=i*8+(lane>>3),ch=lane&7; const u32x4 v=*(const u32x4*)(stg+row*64+ch*8); ATTN_STORE16(Ow+(long)row*PO+ch*8,v);} }
  asm volatile("s_waitcnt lgkmcnt(0)\n\ts_barrier":::"memory");
  #undef DMA_K
  #undef DMA_V
  #undef CMASK
  #undef START
  #undef RESC
  #undef ROT
}
constexpr int ATTN_LDS_BYTES=LDS_BYTES;
struct AttnTensors { const bf16* Q; const bf16* K; const bf16* V; bf16* O; };
struct AttnUnit { int b; int vh; int qb; };
struct StaticOrder {
  int vcu, G;
  __device__ __forceinline__ StaticOrder(int grid,int vcu_):vcu(vcu_),G(grid){}
  __device__ __forceinline__ bool next(int i,AttnUnit&u)const{
    if(G==256){ if(i>=8)return false; const int s=vcu&1,bv=vcu>>1,k=i>>1; u.b=bv>>4; u.vh=bv&15; u.qb=(i&1)?(4*k+3-s):(4*k+s); return true; }
    const int L=i*G+vcu; if(L>=BATCH*NHEAD*NQB)return false; u.b=L/(NHEAD*NQB); u.vh=(L/NQB)%NHEAD; u.qb=L%NQB; return true; }
};
template<class Sched,int THRL=8> __device__ __forceinline__ void attn_phase(char*lds,const AttnTensors&T,const Sched&S,const int wv){
  AttnUnit u;
  for(int i=0;S.next(i,u);++i){ const int h=u.vh>>2,m=(u.vh>>1)&1,vhalf=u.vh&1;
    attn_unit<THRL>(u.b,u.qb,T.Q+(h*2+m)*64,T.K+(h*2+m)*64,T.V+h*128+vhalf*64,T.O+m*512+h*128+vhalf*64,lds,wv); }
}
#undef SBAR
#undef WAIT_BAR
}

constexpr int NWAVES = 8;
#ifndef MK_N_LAUNCHES
#define MK_N_LAUNCHES 1
#endif
constexpr int NPHASE = 13;
constexpr int N_LAUNCHES = MK_N_LAUNCHES;

constexpr int BATCH = 8, SEQ = 4096, D = 1024, M = BATCH * SEQ;
constexpr int NPROJ = 3584;
constexpr int C_DQ = 0, C_DK = 512, C_DV = 1024, C_MQ = 1536, C_MK = 2048, C_MV = 2560, C_MO = 3072;
constexpr int MEMLEN = 256, MROWS = BATCH * MEMLEN;
constexpr int NEXP = 32, DEXP = 512, MAXROWS = 73728;
constexpr int NCH = 64, CHL = 64, DVX = 144;
constexpr int CS_UNIT = DVX * 128;
constexpr float EPS = 1e-6f;
constexpr float LAM_INIT = 0.2f;
constexpr float XSCALE = 0.0625f * 1.4426950408889634f;

constexpr size_t MiB = 1u << 20;
constexpr size_t WS_CTL = 0, CTL_ZERO_BYTES = 1 * MiB;
constexpr size_t WS_GATE = 2 * MiB, WS_ROPE = 3 * MiB, WS_ACUM = 4 * MiB, WS_USUB = 4 * MiB + 512 * 1024, WS_SC = 5 * MiB;
constexpr size_t WS_TOKL = 6 * MiB, WS_ASG = 10 * MiB, WS_MEMN = 12 * MiB, WS_MKV = 16 * MiB;
constexpr size_t WS_WIN = 24 * MiB, WS_WOUT = 31 * MiB, WS_WXQ = 33 * MiB, WS_WKV = 35 * MiB, WS_WXO = 39 * MiB, WS_W13 = 41 * MiB, WS_W2 = 105 * MiB;
constexpr size_t WS_PROJ = 140 * MiB;
constexpr size_t WS_XB = 140 * MiB, WS_XQ = 204 * MiB, WS_XO = 268 * MiB;
constexpr size_t WS_H3 = 140 * MiB, WS_ACT = 204 * MiB, WS_YE = 276 * MiB;
constexpr size_t WS_OA = 364 * MiB;
constexpr size_t WS_END = 428 * MiB;
static_assert(WS_YE + (size_t)MAXROWS * 1024 * 2 <= WS_END && WS_ACT + (size_t)MAXROWS * 512 * 2 <= WS_YE && WS_PROJ + (size_t)M * NPROJ * 2 <= WS_OA, "d_ws map");
constexpr int CW_TMO = 0, CW_CODE = 1, CW_CNT = 1024, CW_ROWSS = 16384, CW_BAR = 65536;
constexpr int RING_OFF = 0, RING_BYTES = 131072;
constexpr int XT_TS = 131072, XT_TOK = 131072 + 256;
constexpr int LDSCTL_OFF = 158720, MISC_OFF = LDSCTL_OFF + 320;
constexpr int LDS_BYTES = 159744;
static_assert(MISC_OFF + 128 <= LDS_BYTES, "LDS map");

#define GAS __attribute__((address_space(1)))
#define LAS __attribute__((address_space(3)))
typedef unsigned short bf16;
typedef unsigned v4u __attribute__((ext_vector_type(4)));
typedef float f32x4 __attribute__((ext_vector_type(4)));
typedef short bf16x8 __attribute__((ext_vector_type(8)));
typedef GAS unsigned gu32;
typedef GAS unsigned long long gu64;
#define RLX_AGENT __ATOMIC_RELAXED, __HIP_MEMORY_SCOPE_AGENT
#define LDS_WAIT() asm volatile("s_waitcnt lgkmcnt(0)" ::: "memory")
#define VM_WAIT() asm volatile("s_waitcnt vmcnt(0)" ::: "memory")
__device__ __forceinline__ unsigned long long rt() { return __builtin_amdgcn_s_memrealtime(); }
__device__ __forceinline__ unsigned f2bf(float f) { unsigned u = __builtin_bit_cast(unsigned, f); return (u + 0x7fffu + ((u >> 16) & 1u)) >> 16; }
__device__ __forceinline__ unsigned pk2(float lo, float hi) { return f2bf(lo) | (f2bf(hi) << 16); }

#define XB_TMO      128
#define XB_XCNT(j)  (256  + 64 * (j))
#define XB_XSUB(j)  (1280 + 64 * (j))
#define XB_XGEN(j)  (2304 + 64 * (j))
#define XB_TOP      3328
#define XB_TOPGEN   3392
#define XCD_BAR_WORDS 3456
#define XB_SPIN_CAP (1u << 18)

__device__ __forceinline__ unsigned xb_ld(unsigned* p)              { return __hip_atomic_load(p, __ATOMIC_RELAXED, __HIP_MEMORY_SCOPE_AGENT); }
__device__ __forceinline__ unsigned xb_add(unsigned* p, unsigned v) { return __hip_atomic_fetch_add(p, v, __ATOMIC_RELAXED, __HIP_MEMORY_SCOPE_AGENT); }
__device__ __forceinline__ unsigned xb_xcc_id() { return (unsigned)__builtin_amdgcn_s_getreg((3 << 11) | 20) & 0xFu; }
#define XB_SPIN(cond, bar) do { unsigned _sp = 0; while (cond) { __builtin_amdgcn_s_sleep(1); \
    if ((++_sp & 255u) == 0u) { if (xb_ld(&(bar)[XB_TMO])) break; if (_sp > XB_SPIN_CAP) { atomicAdd(&(bar)[XB_TMO], 1u); break; } } } } while (0)

struct XcdBarrier {
    unsigned* bar; unsigned x;
    volatile LAS unsigned* st;
};

__device__ __forceinline__ XcdBarrier xcd_barrier_post(unsigned* bar, volatile LAS unsigned* st) {
    XcdBarrier b; b.bar = bar; b.x = xb_xcc_id(); b.st = st;
    if (threadIdx.x == 0) (void)xb_add(&bar[XB_XCNT(b.x)], 1u);
    return b;
}
__device__ __forceinline__ void xcd_barrier_complete(unsigned* bar, unsigned x, unsigned& nloc, unsigned& nx) {
    const unsigned G = gridDim.x * gridDim.y * gridDim.z;
    unsigned sum, cnt, mine, sp = 0u;
    for (;;) {
        sum = 0u; cnt = 0u; mine = 0u;
#pragma unroll
        for (unsigned j = 0; j < 16; ++j) { const unsigned c = xb_ld(&bar[XB_XCNT(j)]); sum += c; cnt += (c > 0u) ? 1u : 0u; mine = (j == x) ? c : mine; }
        if (sum == G) break;
        __builtin_amdgcn_s_sleep(1);
        if ((++sp & 255u) == 0u) { if (xb_ld(&bar[XB_TMO])) break; if (sp > XB_SPIN_CAP) { atomicAdd(&bar[XB_TMO], 1u); break; } }
    }
    nloc = mine > 0u ? mine : 1u; nx = cnt > 0u ? cnt : 1u;
}

__device__ __forceinline__ void xcd_barrier(const XcdBarrier& b, const int wv) {
    asm volatile("s_waitcnt vmcnt(0)" ::: "memory");
    __syncthreads();
    if (wv == 0 && lane_now() == 0) {
        unsigned* bar = b.bar;
        __builtin_amdgcn_s_waitcnt(0);
        unsigned nloc = b.st[0], nx = b.st[1];
        if (nloc == 0u) { xcd_barrier_complete(bar, b.x, nloc, nx); b.st[0] = nloc; b.st[1] = nx; }
        const unsigned old = xb_add(&bar[XB_XSUB(b.x)], 1u);
        const unsigned gen = old / nloc;
        if (old + 1u == (gen + 1u) * nloc) {
            __builtin_amdgcn_fence(__ATOMIC_RELEASE, "agent");
            asm volatile("s_waitcnt vmcnt(0)" ::: "memory");
            const unsigned og = xb_add(&bar[XB_TOP], 1u);
            const unsigned tg = og / nx;
            if (og + 1u == (tg + 1u) * nx) xb_add(&bar[XB_TOPGEN], 1u);
            else XB_SPIN(xb_ld(&bar[XB_TOPGEN]) == tg, bar);
            __builtin_amdgcn_fence(__ATOMIC_ACQUIRE, "agent");
            xb_add(&bar[XB_XGEN(b.x)], 1u);
            asm volatile("s_waitcnt vmcnt(0)" ::: "memory");
        } else {
            XB_SPIN(xb_ld(&bar[XB_XGEN(b.x)]) == gen, bar);
            __builtin_amdgcn_fence(__ATOMIC_ACQUIRE, "agent");
            asm volatile("s_waitcnt vmcnt(0)" ::: "memory");
        }
    }
    __syncthreads();
}


typedef unsigned u32x2 __attribute__((ext_vector_type(2))); typedef unsigned u32x4 __attribute__((ext_vector_type(4)));
struct Frame {
    LAS unsigned char* lds;
    volatile LAS unsigned* MISC;
    gu32* ctl;
    int wave;
    int vcu, G;
    const float* in[26]; float* out; unsigned char* ws;
};
__device__ __forceinline__ float wave_sum(float v) {
#pragma unroll
    for (int o = 1; o < 64; o <<= 1) v += __shfl_xor(v, o);
    return v;
}
__device__ __forceinline__ float wave_max(float v) {
#pragma unroll
    for (int o = 1; o < 64; o <<= 1) v = fmaxf(v, __shfl_xor(v, o));
    return v;
}
__device__ __forceinline__ float bf2f(unsigned short b) { return __uint_as_float((unsigned)b << 16); }
__device__ __forceinline__ float bflo(unsigned w) { return __uint_as_float(w << 16); }
__device__ __forceinline__ float bfhi(unsigned w) { return __uint_as_float(w & 0xffff0000u); }
__device__ __forceinline__ float dot4(f32x4 a, f32x4 b) { return (a.x * b.x + a.y * b.y) + (a.z * b.z + a.w * b.w); }
#define WG_SYNC() __syncthreads()

struct RowMap { int mode, off;
    __device__ __forceinline__ int operator()(int n) const {
        if (mode == 1) return (n < 1024) ? ((n & ~0x30) | ((n & 0x10) << 1) | ((n & 0x20) >> 1)) : n;
        if (mode == 2) return ((n >> 7) << 8) + off + (n & 127);
        return off + n; } };
__device__ __forceinline__ void p0_transpose_item(const float* W, int K, int ldw, int nblk, bf16* WT, const RowMap rm, const float* kscale, LAS float* scr, int item, int lane) {
    const int kb = item / nblk, nb = item % nblk, k0 = 64 * kb, n0 = 32 * nb;
#pragma unroll 8
    for (int i = 0; i < 32; ++i) { const int kk = 2 * i + (lane >> 5); float v = W[(size_t)(k0 + kk) * ldw + n0 + (lane & 31)]; if (kscale) v *= kscale[k0 + kk]; scr[kk * 33 + (lane & 31)] = v; }
    LDS_WAIT(); asm volatile("" ::: "memory");
    const int c = lane & 7;
#pragma unroll
    for (int j = 0; j < 4; ++j) { const int n = (lane >> 3) + 8 * j; const LAS float* s = scr + (8 * c) * 33 + n;
        v4u o; o.x = pk2(s[0 * 33], s[1 * 33]); o.y = pk2(s[2 * 33], s[3 * 33]); o.z = pk2(s[4 * 33], s[5 * 33]); o.w = pk2(s[6 * 33], s[7 * 33]);
        *(GAS v4u*)(WT + (size_t)rm(n0 + n) * K + k0 + 8 * c) = o; }
    LDS_WAIT(); asm volatile("" ::: "memory");
}
__device__ __forceinline__ void rms_row(Frame& F, const float* xrow, const float* g, bf16* orow, const LAS float* gw, float* gate_out, const float* gate_b) {
    const int lane = lane_now(), wave = F.wave, tid = wave * 64 + lane; (void)tid; (void)lane; (void)wave;
    const GAS f32x4* xr = (const GAS f32x4*)xrow + lane; const GAS f32x4* gr = (const GAS f32x4*)g + lane;
    f32x4 v[4]; float s = 0.f;
#pragma unroll
    for (int j = 0; j < 4; ++j) { v[j] = xr[64 * j]; s += dot4(v[j], v[j]); }
    const float rstd = 1.f / sqrtf(wave_sum(s) * (1.f / D) + EPS);
    GAS unsigned long long* o8 = (GAS unsigned long long*)orow + lane;
#pragma unroll
    for (int j = 0; j < 4; ++j) { v[j] = v[j] * rstd * gr[64 * j]; o8[64 * j] = (unsigned long long)pk2(v[j].x, v[j].y) | ((unsigned long long)pk2(v[j].z, v[j].w) << 32); }
    if (gw) {
        float mine = 0.f;
#pragma unroll
        for (int q = 0; q < 8; ++q) { float a = 0.f;
#pragma unroll
            for (int j = 0; j < 4; ++j) a += dot4(v[j], *(const LAS f32x4*)(gw + q * 1024 + 256 * j + 4 * lane));
            a = wave_sum(a); mine = (lane == q) ? a : mine; }
        if (lane < 8) gate_out[lane] = mine + gate_b[lane];
    }
}
__device__ __forceinline__ void sincos_acc(float ang, float& sn, float& cs) {
    const double a = (double)ang; const double q = rint(a * 0.63661977236758134308); const double z = a - q * 1.57079632679489661923;
    const double z2 = z * z;
    const double sp = z * (1.0 + z2 * (-1.0 / 6 + z2 * (1.0 / 120 + z2 * (-1.0 / 5040 + z2 * (1.0 / 362880 + z2 * (-1.0 / 39916800 + z2 * (1.0 / 6227020800.0)))))));
    const double cp = 1.0 + z2 * (-0.5 + z2 * (1.0 / 24 + z2 * (-1.0 / 720 + z2 * (1.0 / 40320 + z2 * (-1.0 / 3628800 + z2 * (1.0 / 479001600.0 + z2 * (-1.0 / 87178291200.0)))))));
    const int qi = ((int)(long long)q) & 3;
    const double s_ = (qi == 0) ? sp : (qi == 1) ? cp : (qi == 2) ? -sp : -cp;
    const double c_ = (qi == 0) ? cp : (qi == 1) ? -sp : (qi == 2) ? -cp : sp;
    sn = (float)s_; cs = (float)c_;
}
__device__ __forceinline__ void p0_prologue(Frame& F) {
    const int lane = lane_now(), wave = F.wave, tid = wave * 64 + lane; (void)tid; (void)lane; (void)wave;
    const int gw = F.vcu * NWAVES + wave, NGW = F.G * NWAVES;
    LAS float* scr = (LAS float*)(F.lds + wave * 8704);
    LAS float* gwt = (LAS float*)(F.lds + 69632);
    for (int i = tid; i < 8192; i += NWAVES * 64) { const int k = i >> 3, q = i & 7; gwt[q * 1024 + k] = F.in[3][(size_t)k * 3592 + 3584 + q]; }
    WG_SYNC();
    bf16* wsb = (bf16*)F.ws;
    constexpr int I_IN = 16 * 112, I_SQ = 16 * 32, I_E = 32 * 256;
    constexpr int NITEMS = I_IN + 5 * I_SQ + 3 * I_E;
    for (int it = gw; it < NITEMS; it += NGW) {
        int r = it;
        if (r < I_IN) { p0_transpose_item(F.in[3], D, 3592, 112, (bf16*)(F.ws + WS_WIN), RowMap{1, 0}, nullptr, scr, r, lane); continue; } r -= I_IN;
        if (r < I_SQ) { p0_transpose_item(F.in[4], D, D, 32, (bf16*)(F.ws + WS_WOUT), RowMap{0, 0}, nullptr, scr, r, lane); continue; } r -= I_SQ;
        if (r < I_SQ) { p0_transpose_item(F.in[13], D, D, 32, (bf16*)(F.ws + WS_WXQ), RowMap{0, 0}, F.in[11], scr, r, lane); continue; } r -= I_SQ;
        if (r < I_SQ) { p0_transpose_item(F.in[14], D, D, 32, (bf16*)(F.ws + WS_WKV), RowMap{0, 0}, nullptr, scr, r, lane); continue; } r -= I_SQ;
        if (r < I_SQ) { p0_transpose_item(F.in[15], D, D, 32, (bf16*)(F.ws + WS_WKV), RowMap{0, 1024}, nullptr, scr, r, lane); continue; } r -= I_SQ;
        if (r < I_SQ) { p0_transpose_item(F.in[16], D, D, 32, (bf16*)(F.ws + WS_WXO), RowMap{0, 0}, nullptr, scr, r, lane); continue; } r -= I_SQ;
        if (r < I_E) { const int e = r >> 8; p0_transpose_item(F.in[22] + (size_t)e * D * DEXP, D, DEXP, 16, (bf16*)(F.ws + WS_W13) + (size_t)e * D * D, RowMap{2, 0}, nullptr, scr, r & 255, lane); continue; } r -= I_E;
        if (r < I_E) { const int e = r >> 8; p0_transpose_item(F.in[23] + (size_t)e * D * DEXP, D, DEXP, 16, (bf16*)(F.ws + WS_W13) + (size_t)e * D * D, RowMap{2, 128}, nullptr, scr, r & 255, lane); continue; } r -= I_E;
        { const int e = r >> 8; p0_transpose_item(F.in[24] + (size_t)e * DEXP * D, DEXP, D, 32, (bf16*)(F.ws + WS_W2) + (size_t)e * D * DEXP, RowMap{0, 0}, nullptr, scr, r & 255, lane); }
    }
    (void)wsb;
    for (int m = gw; m < M; m += NGW) rms_row(F, F.in[0] + (size_t)m * D, F.in[2], (bf16*)F.out + (size_t)m * D, gwt, (float*)(F.ws + WS_GATE) + (size_t)m * 8, F.in[9]);
    for (int m = gw; m < MROWS; m += NGW) rms_row(F, F.in[1] + (size_t)m * D, F.in[12], (bf16*)(F.ws + WS_MEMN) + (size_t)m * D, nullptr, nullptr, nullptr);
    float* rope = (float*)(F.ws + WS_ROPE);
    for (int i = F.vcu * (NWAVES * 64) + tid; i < SEQ * 32; i += F.G * NWAVES * 64) { const int pos = i >> 5, fi = i & 31;
        const float invf = (float)exp2(-(double)fi * (13.287712379549449 / 32.0));
        const float ang = (float)pos * invf; float sn, cs; sincos_acc(ang, sn, cs); rope[i] = cs; rope[SEQ * 32 + i] = sn; }
}

__device__ __forceinline__ void gate_scan(Frame& F, int bh) {
    const int lane = lane_now(), wave = F.wave, tid = wave * 64 + lane; (void)tid; (void)lane; (void)wave;
    const int b = bh >> 2, h = bh & 3; const float* gate = (const float*)(F.ws + WS_GATE);
    float* acum = (float*)(F.ws + WS_ACUM) + (size_t)bh * SEQ; float* usub = (float*)(F.ws + WS_USUB) + (size_t)bh * SEQ; float* sc = (float*)(F.ws + WS_SC) + (size_t)bh * NCH * 4;
    float mprev = 0.f;
    for (int j = 0; j < NCH; ++j) { const int t = j * CHL + lane; const size_t row = (size_t)b * SEQ + t;
        const float gi = gate[row * 8 + h], gf = gate[row * 8 + 4 + h];
        float a = fminf(gf, 0.f) - log1pf(expf(-fabsf(gf)));
#pragma unroll
        for (int o = 1; o < 64; o <<= 1) { const float t_ = __shfl_up(a, o); if (lane >= o) a += t_; }
        const float g = __shfl(a, 63); const float u = gi - a;
        const float bm = wave_max(g + u); const float mnew = fmaxf(g + mprev, bm);
        acum[t] = a; usub[t] = u;
        if (lane == 0) { sc[j * 4 + 0] = mprev; sc[j * 4 + 1] = mnew; sc[j * 4 + 2] = g; sc[j * 4 + 3] = expf(g + mprev - mnew); }
        mprev = mnew; }
}

__device__ __forceinline__ void conv_silu8(Frame& F, const bf16* proj, int b, int t, int col, int ch0, float (&y)[8]) {
    const int lane = lane_now(), wave = F.wave, tid = wave * 64 + lane; (void)tid; (void)lane; (void)wave;
    const float* cw = F.in[7]; const float* cb = F.in[8];
#pragma unroll
    for (int e = 0; e < 8; ++e) y[e] = cb[ch0 + e];
#pragma unroll
    for (int tau = 0; tau < 4; ++tau) { const int tt = t - 3 + tau;
        if (tt >= 0) { const v4u w = *(const GAS v4u*)(proj + ((size_t)b * SEQ + tt) * NPROJ + col); const float* cwt = cw + tau * 1024 + ch0;
            y[0] += cwt[0] * bflo(w.x); y[1] += cwt[1] * bfhi(w.x); y[2] += cwt[2] * bflo(w.y); y[3] += cwt[3] * bfhi(w.y);
            y[4] += cwt[4] * bflo(w.z); y[5] += cwt[5] * bfhi(w.z); y[6] += cwt[6] * bflo(w.w); y[7] += cwt[7] * bfhi(w.w); } }
#pragma unroll
    for (int e = 0; e < 8; ++e) y[e] = y[e] / (1.f + expf(-y[e]));
}
constexpr int TS64 = 144;
constexpr int TS128 = 272;
__device__ __forceinline__ void stage_vt(Frame& F, const bf16* proj, int b, int t0, int h, LAS unsigned char* VT) {
    const int lane = lane_now(), wave = F.wave, tid = wave * 64 + lane; (void)tid; (void)lane; (void)wave;
#pragma unroll
    for (int i = 0; i < 2; ++i) { const int id = tid + 512 * i, s = id & 63, c8 = id >> 6;
        const v4u w = *(const GAS v4u*)(proj + ((size_t)b * SEQ + t0 + s) * NPROJ + C_MV + h * 128 + c8 * 8);
        LAS unsigned short* p = (LAS unsigned short*)(VT + (c8 * 8) * TS64) + s;
        p[0 * (TS64 / 2)] = (unsigned short)w.x; p[1 * (TS64 / 2)] = (unsigned short)(w.x >> 16); p[2 * (TS64 / 2)] = (unsigned short)w.y; p[3 * (TS64 / 2)] = (unsigned short)(w.y >> 16);
        p[4 * (TS64 / 2)] = (unsigned short)w.z; p[5 * (TS64 / 2)] = (unsigned short)(w.z >> 16); p[6 * (TS64 / 2)] = (unsigned short)w.w; p[7 * (TS64 / 2)] = (unsigned short)(w.w >> 16); }
#pragma unroll
    for (int i = 0; i < 2; ++i) { const int id = tid + 512 * i, s = id & 63, r = 128 + (id >> 6); ((LAS unsigned short*)(VT + r * TS64))[s] = (r == 128) ? (unsigned short)0x3F80 : (unsigned short)0; }
}

__device__ __forceinline__ void m1_unit(Frame& F, int bh, int j) {
    const int lane = lane_now(), wave = F.wave, tid = wave * 64 + lane; (void)tid; (void)lane; (void)wave;
    const int b = bh >> 2, h = bh & 3, t0 = j * CHL; const bf16* proj = (const bf16*)(F.ws + WS_PROJ);
    LAS unsigned char* KWT = F.lds; LAS unsigned char* VT = F.lds + 128 * TS64;
    const float* sc = (const float*)(F.ws + WS_SC) + ((size_t)bh * NCH + j) * 4; const float mnew = sc[1], g = sc[2];
    const float* usub = (const float*)(F.ws + WS_USUB) + (size_t)bh * SEQ + t0;
#pragma unroll
    for (int i = 0; i < 2; ++i) { const int id = tid + 512 * i, s = id & 63, c8 = id >> 6; float y[8];
        conv_silu8(F, proj, b, t0 + s, C_MK + h * 128 + c8 * 8, 512 + h * 128 + c8 * 8, y);
        const float w = 0.08838834764831845f * expf(g + usub[s] - mnew);
        LAS unsigned short* p = (LAS unsigned short*)(KWT + (c8 * 8) * TS64) + s;
#pragma unroll
        for (int e = 0; e < 8; ++e) p[e * (TS64 / 2)] = (unsigned short)f2bf(y[e] * w); }
    stage_vt(F, proj, b, t0, h, VT);
    WG_SYNC();
    const int r16 = lane & 15, q = lane >> 4, w = wave;
    bf16x8 xa[2];
#pragma unroll
    for (int ks = 0; ks < 2; ++ks) xa[ks] = *(const LAS bf16x8*)(KWT + (16 * w + r16) * TS64 + ks * 64 + q * 16);
    bf16* dst = (bf16*)F.out + ((size_t)bh * NCH + j) * CS_UNIT;
#pragma unroll
    for (int nt = 0; nt < 9; ++nt) { f32x4 acc = {0.f, 0.f, 0.f, 0.f};
#pragma unroll
        for (int ks = 0; ks < 2; ++ks) { const bf16x8 yb = *(const LAS bf16x8*)(VT + (16 * nt + r16) * TS64 + ks * 64 + q * 16); acc = __builtin_amdgcn_mfma_f32_16x16x32_bf16(xa[ks], yb, acc, 0, 0, 0); }
        u32x2 o; o.x = pk2(acc[0], acc[1]); o.y = pk2(acc[2], acc[3]);
        *(GAS u32x2*)(dst + (size_t)(16 * nt + r16) * 128 + 16 * w + 4 * q) = o; }
    WG_SYNC();
}

__device__ __forceinline__ void p3_scan_combine(Frame& F) {
    const int lane = lane_now(), wave = F.wave, tid = wave * 64 + lane; (void)tid; (void)lane; (void)wave;
    const int gt = F.vcu * (NWAVES * 64) + tid;
    if (gt < 32 * (CS_UNIT / 8)) { const int bh = gt / (CS_UNIT / 8), e8 = gt % (CS_UNIT / 8);
        GAS v4u* p = (GAS v4u*)((bf16*)F.out + (size_t)bh * NCH * CS_UNIT) + e8; const float* sc = (const float*)(F.ws + WS_SC) + (size_t)bh * NCH * 4;
        float run[8];
#pragma unroll
        for (int e = 0; e < 8; ++e) run[e] = 0.f;
        for (int j0 = 0; j0 < NCH; j0 += 8) { v4u x[8];
#pragma unroll
            for (int jj = 0; jj < 8; ++jj) x[jj] = p[(size_t)(j0 + jj) * (CS_UNIT / 8)];
#pragma unroll
            for (int jj = 0; jj < 8; ++jj) { const float dec = sc[(j0 + jj) * 4 + 3]; v4u o;
                o.x = pk2(run[0], run[1]); o.y = pk2(run[2], run[3]); o.z = pk2(run[4], run[5]); o.w = pk2(run[6], run[7]);
                p[(size_t)(j0 + jj) * (CS_UNIT / 8)] = o;
                run[0] = dec * run[0] + bflo(x[jj].x); run[1] = dec * run[1] + bfhi(x[jj].x); run[2] = dec * run[2] + bflo(x[jj].y); run[3] = dec * run[3] + bfhi(x[jj].y);
                run[4] = dec * run[4] + bflo(x[jj].z); run[5] = dec * run[5] + bfhi(x[jj].z); run[6] = dec * run[6] + bflo(x[jj].w); run[7] = dec * run[7] + bfhi(x[jj].w); } } }
    const float* lv = F.in[5];
    const float lam = expf(wave_sum(lv[lane] * lv[64 + lane])) - expf(wave_sum(lv[128 + lane] * lv[192 + lane])) + LAM_INIT;
    const int gw = F.vcu * NWAVES + wave, NGW = F.G * NWAVES; bf16* oa = (bf16*)(F.ws + WS_OA);
    float gs[8];
#pragma unroll
    for (int e = 0; e < 8; ++e) gs[e] = F.in[6][((lane * 8) & 127) + e] * (1.0f - LAM_INIT);
    for (int m = gw; m < M; m += NGW) { GAS v4u* r = (GAS v4u*)(oa + (size_t)m * 1024) + lane; const v4u a = r[0], c = r[64];
        float y[8]; y[0] = bflo(a.x) - lam * bflo(c.x); y[1] = bfhi(a.x) - lam * bfhi(c.x); y[2] = bflo(a.y) - lam * bflo(c.y); y[3] = bfhi(a.y) - lam * bfhi(c.y);
        y[4] = bflo(a.z) - lam * bflo(c.z); y[5] = bfhi(a.z) - lam * bfhi(c.z); y[6] = bflo(a.w) - lam * bflo(c.w); y[7] = bfhi(a.w) - lam * bfhi(c.w);
        float ss = 0.f;
#pragma unroll
        for (int e = 0; e < 8; ++e) ss += y[e] * y[e];
        ss += __shfl_xor(ss, 1); ss += __shfl_xor(ss, 2); ss += __shfl_xor(ss, 4); ss += __shfl_xor(ss, 8);
        const float rs = 1.f / sqrtf(ss * (1.f / 128.f) + EPS); v4u o;
        o.x = pk2(y[0] * rs * gs[0], y[1] * rs * gs[1]); o.y = pk2(y[2] * rs * gs[2], y[3] * rs * gs[3]); o.z = pk2(y[4] * rs * gs[4], y[5] * rs * gs[5]); o.w = pk2(y[6] * rs * gs[6], y[7] * rs * gs[7]);
        r[0] = o; }
}

__device__ __forceinline__ void m3_unit(Frame& F, int bh, int j) {
    const int lane = lane_now(), wave = F.wave, tid = wave * 64 + lane; (void)tid; (void)lane; (void)wave;
    const int b = bh >> 2, h = bh & 3, t0 = j * CHL; const bf16* proj = (const bf16*)(F.ws + WS_PROJ);
    LAS unsigned char* Qs = F.lds; LAS unsigned char* Ks = F.lds + 64 * TS128; LAS unsigned char* VT = F.lds + 128 * TS128; LAS unsigned char* CT = VT + DVX * TS64;
    LAS unsigned char* SD = CT + DVX * TS128; LAS float* sv = (LAS float*)(SD + 64 * TS64);
    LAS float* HB = (LAS float*)F.lds;
    static_assert(128 * TS128 + DVX * TS64 + DVX * TS128 + 64 * TS64 + 5 * 64 * 4 <= RING_BYTES && 64 * 132 * 4 <= 128 * TS128, "m3 LDS");
    const float* sc = (const float*)(F.ws + WS_SC) + ((size_t)bh * NCH + j) * 4; const float mprev = sc[0];
#pragma unroll
    for (int i = 0; i < 2; ++i) { const int id = tid + 512 * i, s = id & 63, c8 = id >> 6; float y[8]; v4u o;
        conv_silu8(F, proj, b, t0 + s, C_MQ + h * 128 + c8 * 8, h * 128 + c8 * 8, y);
        o.x = pk2(y[0], y[1]); o.y = pk2(y[2], y[3]); o.z = pk2(y[4], y[5]); o.w = pk2(y[6], y[7]); *(LAS v4u*)(Qs + s * TS128 + c8 * 16) = o;
        conv_silu8(F, proj, b, t0 + s, C_MK + h * 128 + c8 * 8, 512 + h * 128 + c8 * 8, y);
        const float ksc = 0.08838834764831845f;
        o.x = pk2(y[0] * ksc, y[1] * ksc); o.y = pk2(y[2] * ksc, y[3] * ksc); o.z = pk2(y[4] * ksc, y[5] * ksc); o.w = pk2(y[6] * ksc, y[7] * ksc); *(LAS v4u*)(Ks + s * TS128 + c8 * 16) = o; }
    stage_vt(F, proj, b, t0, h, VT);
    { const GAS v4u* src = (const GAS v4u*)((const bf16*)F.out + ((size_t)bh * NCH + j) * CS_UNIT);
        for (int id = tid; id < DVX * 16; id += NWAVES * 64) { const int r = id >> 4, c = id & 15; *(LAS v4u*)(CT + r * TS128 + c * 16) = src[id]; } }
    if (wave == 0) { const float u = ((const float*)(F.ws + WS_USUB))[(size_t)bh * SEQ + t0 + lane]; const float a = ((const float*)(F.ws + WS_ACUM))[(size_t)bh * SEQ + t0 + lane];
        float cm = u;
#pragma unroll
        for (int o = 1; o < 64; o <<= 1) { const float t_ = __shfl_up(cm, o); if (lane >= o) cm = fmaxf(cm, t_); }
        const float um = fmaxf(mprev, cm);
        sv[lane] = u; sv[64 + lane] = um; sv[128 + lane] = expf(mprev - um); sv[192 + lane] = expf(-(a + um)); }
    WG_SYNC();
    const int r16 = lane & 15, q = lane >> 4, tt = wave & 3, hf = wave >> 2;
    bf16x8 qf[4];
#pragma unroll
    for (int ks = 0; ks < 4; ++ks) qf[ks] = *(const LAS bf16x8*)(Qs + (16 * tt + r16) * TS128 + ks * 64 + q * 16);
    { const int t = 16 * tt + r16; const float umt = sv[64 + t];
#pragma unroll
        for (int k = 0; k < 2; ++k) { const int st = 2 * hf + k; f32x4 acc = {0.f, 0.f, 0.f, 0.f};
#pragma unroll
            for (int ks = 0; ks < 4; ++ks) { const bf16x8 kf = *(const LAS bf16x8*)(Ks + (16 * st + r16) * TS128 + ks * 64 + q * 16); acc = __builtin_amdgcn_mfma_f32_16x16x32_bf16(kf, qf[ks], acc, 0, 0, 0); }
            float o[4];
#pragma unroll
            for (int i = 0; i < 4; ++i) { const int s = 16 * st + 4 * q + i; o[i] = (s <= t) ? acc[i] * expf(sv[s] - umt) : 0.f; }
            u32x2 w; w.x = pk2(o[0], o[1]); w.y = pk2(o[2], o[3]); *(LAS u32x2*)(SD + t * TS64 + (16 * st + 4 * q) * 2) = w; } }
    const int mt0 = hf ? 5 : 0, nmt = hf ? 4 : 5;
    f32x4 acc[5];
#pragma unroll
    for (int k = 0; k < 5; ++k) { acc[k] = (f32x4){0.f, 0.f, 0.f, 0.f};
        if (k < nmt) {
#pragma unroll
            for (int ks = 0; ks < 4; ++ks) { const bf16x8 cf = *(const LAS bf16x8*)(CT + (16 * (mt0 + k) + r16) * TS128 + ks * 64 + q * 16); acc[k] = __builtin_amdgcn_mfma_f32_16x16x32_bf16(cf, qf[ks], acc[k], 0, 0, 0); } } }
    WG_SYNC();
    { const int t = 16 * tt + r16; const float wi = sv[128 + t];
        bf16x8 sf[2];
#pragma unroll
        for (int ks = 0; ks < 2; ++ks) sf[ks] = *(const LAS bf16x8*)(SD + t * TS64 + ks * 64 + q * 16);
#pragma unroll
        for (int k = 0; k < 5; ++k) if (k < nmt) { acc[k] = acc[k] * wi;
#pragma unroll
            for (int ks = 0; ks < 2; ++ks) { const bf16x8 vf = *(const LAS bf16x8*)(VT + (16 * (mt0 + k) + r16) * TS64 + ks * 64 + q * 16); acc[k] = __builtin_amdgcn_mfma_f32_16x16x32_bf16(vf, sf[ks], acc[k], 0, 0, 0); } }
        if (hf == 1 && q == 0) sv[256 + t] = acc[3][0]; }
    WG_SYNC();
    { const int t = 16 * tt + r16; const float dn = fmaxf(fabsf(sv[256 + t]), sv[192 + t]); const float inv = 1.f / dn;
#pragma unroll
        for (int k = 0; k < 5; ++k) if (k < nmt && mt0 + k < 8) *(LAS f32x4*)(HB + t * 132 + 16 * (mt0 + k) + 4 * q) = acc[k] * inv; }
    WG_SYNC();
    { const float g0 = F.in[10][h * 128 + 2 * lane], g1 = F.in[10][h * 128 + 2 * lane + 1]; bf16* Y = (bf16*)(F.ws + WS_OA);
#pragma unroll
        for (int rr = 0; rr < 8; ++rr) { const int t = 8 * wave + rr; const size_t row = (size_t)b * SEQ + t0 + t;
            const float x0 = HB[t * 132 + 2 * lane], x1 = HB[t * 132 + 2 * lane + 1];
            const float mu = wave_sum(x0 + x1) * (1.f / 128.f); const float d0 = x0 - mu, d1 = x1 - mu;
            const float var = wave_sum(d0 * d0 + d1 * d1) * (1.f / 128.f); const float rs = 1.f / sqrtf(var + EPS);
            const unsigned ow = *(const GAS unsigned*)(proj + row * NPROJ + C_MO + h * 128 + 2 * lane);
            const float o0 = 1.f / (1.f + expf(-bflo(ow))), o1 = 1.f / (1.f + expf(-bfhi(ow)));
            *(GAS unsigned*)(Y + row * 1024 + 512 + h * 128 + 2 * lane) = pk2(o0 * d0 * rs * g0, o1 * d1 * rs * g1); } }
    WG_SYNC();
}

constexpr int XK_STRIDE = 528;
__device__ __forceinline__ void xattn_unit(Frame& F, int rt, int h) {
    const int lane = lane_now(), wave = F.wave, tid = wave * 64 + lane; (void)tid; (void)lane; (void)wave;
    const bf16* XQ = (const bf16*)(F.ws + WS_XQ); const bf16* MKV = (const bf16*)(F.ws + WS_MKV); bf16* XO = (bf16*)(F.ws + WS_XO);
    LAS unsigned char* Ks = F.lds; LAS unsigned char* VT = F.lds + 64 * XK_STRIDE;
    static_assert(64 * XK_STRIDE + 256 * TS64 <= RING_BYTES, "xattn LDS");
    const int r16 = lane & 15, q = lane >> 4; const int row = rt * 128 + wave * 16 + r16; const int b = (rt * 128) / SEQ;
    bf16x8 qf[8];
#pragma unroll
    for (int ks = 0; ks < 8; ++ks) qf[ks] = *(const GAS bf16x8*)(XQ + (size_t)row * D + h * 256 + ks * 32 + q * 8);
    f32x4 o[16];
#pragma unroll
    for (int i = 0; i < 16; ++i) o[i] = (f32x4){0.f, 0.f, 0.f, 0.f};
    float mx = -INFINITY, l = 0.f;
    for (int kt = 0; kt < 4; ++kt) {
#pragma unroll
        for (int i = 0; i < 4; ++i) { const int id = tid + 512 * i, key = id >> 5, c = id & 31;
            *(LAS v4u*)(Ks + key * XK_STRIDE + c * 16) = *(const GAS v4u*)(MKV + (size_t)(b * MEMLEN + kt * 64 + key) * 2048 + h * 256 + c * 8); }
#pragma unroll
        for (int i = 0; i < 4; ++i) { const int id = tid + 512 * i, key = id & 63, c8 = id >> 6;
            const v4u w = *(const GAS v4u*)(MKV + (size_t)(b * MEMLEN + kt * 64 + key) * 2048 + 1024 + h * 256 + c8 * 8);
            LAS unsigned short* p = (LAS unsigned short*)(VT + (c8 * 8) * TS64) + key;
            p[0 * (TS64 / 2)] = (unsigned short)w.x; p[1 * (TS64 / 2)] = (unsigned short)(w.x >> 16); p[2 * (TS64 / 2)] = (unsigned short)w.y; p[3 * (TS64 / 2)] = (unsigned short)(w.y >> 16);
            p[4 * (TS64 / 2)] = (unsigned short)w.z; p[5 * (TS64 / 2)] = (unsigned short)(w.z >> 16); p[6 * (TS64 / 2)] = (unsigned short)w.w; p[7 * (TS64 / 2)] = (unsigned short)(w.w >> 16); }
        WG_SYNC();
        f32x4 s[4];
#pragma unroll
        for (int nt = 0; nt < 4; ++nt) { s[nt] = (f32x4){0.f, 0.f, 0.f, 0.f};
#pragma unroll
            for (int ks = 0; ks < 8; ++ks) { const bf16x8 kf = *(const LAS bf16x8*)(Ks + (16 * nt + r16) * XK_STRIDE + ks * 64 + q * 16); s[nt] = __builtin_amdgcn_mfma_f32_16x16x32_bf16(kf, qf[ks], s[nt], 0, 0, 0); } }
        float tm = -INFINITY;
#pragma unroll
        for (int nt = 0; nt < 4; ++nt) tm = fmaxf(tm, fmaxf(fmaxf(s[nt][0], s[nt][1]), fmaxf(s[nt][2], s[nt][3])));
        tm = fmaxf(tm, __shfl_xor(tm, 16)); tm = fmaxf(tm, __shfl_xor(tm, 32));
        const float mn = fmaxf(mx, tm); const float alpha = __builtin_amdgcn_exp2f(mx - mn); mx = mn;
        float ps = 0.f;
#pragma unroll
        for (int nt = 0; nt < 4; ++nt)
#pragma unroll
            for (int i = 0; i < 4; ++i) { s[nt][i] = __builtin_amdgcn_exp2f(s[nt][i] - mn); ps += s[nt][i]; }
        l = l * alpha + ps;
#pragma unroll
        for (int i = 0; i < 16; ++i) o[i] = o[i] * alpha;
        bf16x8 pf[2];
#pragma unroll
        for (int ks = 0; ks < 2; ++ks) { u32x4 w; w.x = pk2(s[2 * ks][0], s[2 * ks][1]); w.y = pk2(s[2 * ks][2], s[2 * ks][3]); w.z = pk2(s[2 * ks + 1][0], s[2 * ks + 1][1]); w.w = pk2(s[2 * ks + 1][2], s[2 * ks + 1][3]);
            pf[ks] = __builtin_bit_cast(bf16x8, w); }
#pragma unroll
        for (int mt = 0; mt < 16; ++mt)
#pragma unroll
            for (int ks = 0; ks < 2; ++ks) { const LAS unsigned char* vp = VT + (16 * mt + r16) * TS64 + (32 * ks + 4 * q) * 2;
                const u32x2 lo = *(const LAS u32x2*)vp, hi = *(const LAS u32x2*)(vp + 32); u32x4 w; w.x = lo.x; w.y = lo.y; w.z = hi.x; w.w = hi.y;
                o[mt] = __builtin_amdgcn_mfma_f32_16x16x32_bf16(__builtin_bit_cast(bf16x8, w), pf[ks], o[mt], 0, 0, 0); }
        WG_SYNC();
    }
    l += __shfl_xor(l, 16); l += __shfl_xor(l, 32);
    const float inv = 1.f / l;
#pragma unroll
    for (int mt = 0; mt < 16; ++mt) { u32x2 w; w.x = pk2(o[mt][0] * inv, o[mt][1] * inv); w.y = pk2(o[mt][2] * inv, o[mt][3] * inv);
        *(GAS u32x2*)(XO + (size_t)row * D + h * 256 + 16 * mt + 4 * q) = w; }
}

__device__ __forceinline__ void p9_router(Frame& F) {
    const int lane = lane_now(), wave = F.wave, tid = wave * 64 + lane; (void)tid; (void)lane; (void)wave;
    LAS float* WL = (LAS float*)F.lds;
    LAS int* CH = (LAS int*)(F.lds + 147456);
    LAS int* LCNT = (LAS int*)(F.lds + 151552); LAS int* LBASE = (LAS int*)(F.lds + 151680);
    const float* gf = F.in[17];
    for (int i = tid; i < 36 * 1024; i += NWAVES * 64) { const int k = i / 36, n = i % 36; const float w = (n < 4) ? F.in[18][k * 4 + n] : F.in[20][k * 32 + (n - 4)]; WL[n * 1024 + k] = w * gf[k]; }
    if (tid < 32) LCNT[tid] = 0;
    WG_SYNC();
    const float* x2 = F.out; bf16* H3 = (bf16*)(F.ws + WS_H3);
    const int rpb = (M + F.G - 1) / F.G;
    const int r0 = F.vcu * rpb; const int r1 = (r0 + rpb < M) ? r0 + rpb : M;
    for (int m = r0 + wave; m < r1; m += NWAVES) {
        const GAS f32x4* xr = (const GAS f32x4*)(x2 + (size_t)m * D) + lane; const GAS f32x4* gr = (const GAS f32x4*)gf + lane;
        f32x4 v[4]; float s = 0.f;
#pragma unroll
        for (int j = 0; j < 4; ++j) { v[j] = xr[64 * j]; s += dot4(v[j], v[j]); }
        const float rstd = 1.f / sqrtf(wave_sum(s) * (1.f / D) + EPS);
        GAS unsigned long long* o8 = (GAS unsigned long long*)(H3 + (size_t)m * D) + lane;
#pragma unroll
        for (int j = 0; j < 4; ++j) { v[j] = v[j] * rstd; const f32x4 hv = v[j] * gr[64 * j]; o8[64 * j] = (unsigned long long)pk2(hv.x, hv.y) | ((unsigned long long)pk2(hv.z, hv.w) << 32); }
        float gl[4];
#pragma unroll
        for (int n = 0; n < 4; ++n) { float a = 0.f;
#pragma unroll
            for (int j = 0; j < 4; ++j) a += dot4(v[j], *(const LAS f32x4*)(WL + n * 1024 + 256 * j + 4 * lane));
            gl[n] = wave_sum(a) + F.in[19][n]; }
        int gi = 0; float gm = gl[0];
#pragma unroll
        for (int n = 1; n < 4; ++n) if (gl[n] > gm) { gm = gl[n]; gi = n; }
        float gs = 0.f;
#pragma unroll
        for (int n = 0; n < 4; ++n) gs += expf(gl[n] - gm);
        const float g_w = 1.f / gs;
        float el[8];
#pragma unroll
        for (int n = 0; n < 8; ++n) { float a = 0.f; const LAS float* wp = WL + (4 + gi * 8 + n) * 1024 + 4 * lane;
#pragma unroll
            for (int j = 0; j < 4; ++j) a += dot4(v[j], *(const LAS f32x4*)(wp + 256 * j));
            el[n] = wave_sum(a) + F.in[21][gi * 8 + n]; }
        int i0 = 0; float m0 = el[0];
#pragma unroll
        for (int n = 1; n < 8; ++n) if (el[n] > m0) { m0 = el[n]; i0 = n; }
        int i1 = -1; float m1 = -INFINITY;
#pragma unroll
        for (int n = 0; n < 8; ++n) if (n != i0 && el[n] > m1) { m1 = el[n]; i1 = n; }
        const float p1r = expf(m1 - m0); const float w0 = g_w / (1.f + p1r), w1 = g_w * p1r / (1.f + p1r);
        if (lane == 0) { const int e0 = gi * 8 + i0, e1 = gi * 8 + i1; const int lr0 = atomicAdd((int*)&LCNT[e0], 1), lr1 = atomicAdd((int*)&LCNT[e1], 1);
            LAS int* c = CH + (m - r0) * 8; c[0] = e0; c[1] = e1; c[2] = lr0; c[3] = lr1; c[4] = __float_as_int(w0); c[5] = __float_as_int(w1); }
    }
    WG_SYNC();
    if (tid < 32) LBASE[tid] = (int)atomicAdd((unsigned*)(F.ctl + CW_CNT + tid), (unsigned)LCNT[tid]);
    WG_SYNC();
    int* tokl = (int*)(F.ws + WS_TOKL); int* asg = (int*)(F.ws + WS_ASG);
    for (int r = tid; r < r1 - r0; r += NWAVES * 64) { const LAS int* c = CH + r * 8; const int m = r0 + r;
        const int e0 = c[0], e1 = c[1], k0 = LBASE[e0] + c[2], k1 = LBASE[e1] + c[3];
        tokl[(size_t)e0 * M + k0] = m; tokl[(size_t)e1 * M + k1] = m;
        asg[m * 8 + 0] = e0; asg[m * 8 + 1] = k0; asg[m * 8 + 2] = e1; asg[m * 8 + 3] = k1; asg[m * 8 + 4] = c[4]; asg[m * 8 + 5] = c[5]; }
}

template <bool GATHER> __device__ __forceinline__ int expert_tables(Frame& F) {
    const int lane = lane_now(), wave = F.wave, tid = wave * 64 + lane; (void)tid; (void)lane; (void)wave;
    LAS int* TS = (LAS int*)(F.lds + XT_TS); LAS int* TOK = (LAS int*)(F.lds + XT_TOK);
    if (tid == 0) { int acc = 0; for (int e = 0; e < 32; ++e) { TS[e] = acc; acc += ((int)F.ctl[CW_CNT + e] + 255) >> 8; } TS[32] = acc; }
    WG_SYNC();
    const int ntiles = TS[32];
    if (GATHER) { const int* tokl = (const int*)(F.ws + WS_TOKL);
        for (int ui = 0; ui < 5; ++ui) { const int L = ui * F.G + (int)blockIdx.x; if (L >= 4 * ntiles) break;
            const int rt = L >> 2; int e = 0; for (int k = 1; k < 32; ++k) e += (TS[k] <= rt) ? 1 : 0;
            const int cnt = (int)F.ctl[CW_CNT + e];
            if (tid < 256) { const int rank = (rt - TS[e]) * 256 + tid; TOK[ui * 256 + tid] = (rank < cnt) ? tokl[(size_t)e * M + rank] : 0; } }
        WG_SYNC(); }
    return ntiles;
}

__device__ __forceinline__ void p12_final(Frame& F) {
    const int lane = lane_now(), wave = F.wave, tid = wave * 64 + lane; (void)tid; (void)lane; (void)wave;
    LAS int* TS = (LAS int*)(F.lds + XT_TS);
    if (tid == 0) { int acc = 0; for (int e = 0; e < 32; ++e) { TS[e] = acc; acc += ((int)F.ctl[CW_CNT + e] + 255) >> 8; } TS[32] = acc; }
    WG_SYNC();
    const int gw = F.vcu * NWAVES + wave, NGW = F.G * NWAVES; const int* asg = (const int*)(F.ws + WS_ASG); const bf16* YE = (const bf16*)(F.ws + WS_YE);
    for (int m = gw; m < M; m += NGW) {
        const int e0 = asg[m * 8 + 0], k0 = asg[m * 8 + 1], e1 = asg[m * 8 + 2], k1 = asg[m * 8 + 3]; const float w0 = __int_as_float(asg[m * 8 + 4]), w1 = __int_as_float(asg[m * 8 + 5]);
        const size_t p0 = (size_t)TS[e0] * 256 + k0, p1 = (size_t)TS[e1] * 256 + k1;
        GAS f32x4* xr = (GAS f32x4*)(F.out + (size_t)m * D) + lane; const GAS u32x2* y0 = (const GAS u32x2*)(YE + p0 * D) + lane; const GAS u32x2* y1 = (const GAS u32x2*)(YE + p1 * D) + lane;
        const GAS f32x4* gr = (const GAS f32x4*)F.in[25] + lane;
        f32x4 v[4]; float s = 0.f;
#pragma unroll
        for (int j = 0; j < 4; ++j) { const u32x2 a = y0[64 * j], c = y1[64 * j]; f32x4 x = xr[64 * j];
            x.x += w0 * bflo(a.x) + w1 * bflo(c.x); x.y += w0 * bfhi(a.x) + w1 * bfhi(c.x); x.z += w0 * bflo(a.y) + w1 * bflo(c.y); x.w += w0 * bfhi(a.y) + w1 * bfhi(c.y);
            v[j] = x; s += dot4(x, x); }
        const float rstd = 1.f / sqrtf(wave_sum(s) * (1.f / D) + EPS);
#pragma unroll
        for (int j = 0; j < 4; ++j) xr[64 * j] = v[j] * rstd * gr[64 * j];
    }
}

struct Args { const float* in[26]; float* out; unsigned char* ws; int ph_lo, ph_hi, li, pad; };
__global__ void __launch_bounds__(NWAVES * 64, 2) mk_fwd(Args args) {
    extern __shared__ __attribute__((aligned(16))) unsigned char lds[];
    Frame F;
    F.lds = (LAS unsigned char*)lds;
    F.MISC = (volatile LAS unsigned*)(F.lds + MISC_OFF);
    F.wave = __builtin_amdgcn_readfirstlane((int)threadIdx.x >> 6);
    F.G = gridDim.x; { const int bx = blockIdx.x; F.vcu = (F.G % 8 == 0) ? (bx % 8) * (F.G / 8) + bx / 8 : bx; }
    unsigned char* ws = args.ws; F.ws = ws; F.out = args.out;
    F.ctl = (gu32*)(ws + WS_CTL);
#pragma unroll
    for (int i = 0; i < 26; ++i) F.in[i] = args.in[i];
    for (int u = (int)threadIdx.x; u < (LDS_BYTES - LDSCTL_OFF) / 4; u += NWAVES * 64) ((LAS unsigned*)(F.lds + LDSCTL_OFF))[u] = 0u;
    __syncthreads();
    XcdBarrier bar; bar.bar = (unsigned*)(F.ctl + CW_BAR) + args.li * XCD_BAR_WORDS; bar.x = 0; bar.st = nullptr;
    if (N_LAUNCHES != NPHASE) bar = xcd_barrier_post((unsigned*)(F.ctl + CW_BAR) + args.li * XCD_BAR_WORDS, F.MISC + 8);
#define GRID_BAR(seam) do { if (N_LAUNCHES == NPHASE) { if (F.wave == 0 && lane_now() == 0) __hip_atomic_store(F.ctl + CW_TMO, 0xBADBA0u | (unsigned)(seam), RLX_AGENT); } else { xcd_barrier(bar, F.wave); } } while (0)
    const int lo = args.ph_lo, hi = args.ph_hi;
#ifndef PHASE_MASK
#define PHASE_MASK 0x1FFF
#endif
#define IN(k) (((PHASE_MASK >> (k)) & 1) && lo <= (k) && (k) < hi)
#define BOTH(k) (IN(k) && IN((k) + 1))
    bf16* Hb = (bf16*)F.out;
    bf16* PROJ = (bf16*)(ws + WS_PROJ);

    if (IN(0)) { p0_prologue(F); if (BOTH(0)) GRID_BAR(0); }

    if (IN(1)) {
        if (blockIdx.x < 32 && F.wave == 0) gate_scan(F, (int)blockIdx.x);
        { pg8::Gemm g{Hb, (const bf16*)(ws + WS_WIN), M, NPROJ, D}; pg8::StaticOrder S; S.init(M, NPROJ, F.G, (int)blockIdx.x);
          pg8::EpiProj E{PROJ, NPROJ, (const float*)(ws + WS_ROPE), attn_body::C2};
          pg8::gemm_phase<pg8::EpiProj, pg8::StaticOrder, PG8_ALIGN, PG8_SP2>(F.lds + RING_OFF, g, S, E, F.wave); }
        { pg8::Gemm g{(const bf16*)(ws + WS_MEMN), (const bf16*)(ws + WS_WKV), MROWS, 2048, D}; pg8::StaticOrder S; S.init(MROWS, 2048, F.G, (int)blockIdx.x);
          pg8::EpiBf16<0> E{(bf16*)(ws + WS_MKV), 2048, nullptr, 0, 0, 1.f};
          pg8::gemm_phase<pg8::EpiBf16<0>, pg8::StaticOrder, PG8_ALIGN, PG8_SP2>(F.lds + RING_OFF, g, S, E, F.wave); }
        if (BOTH(1)) GRID_BAR(1);
    }

    if (IN(2)) {
        for (int u = F.vcu; u < 32 * NCH; u += F.G) m1_unit(F, u >> 6, u & 63);
        const attn_body::AttnTensors AT{(const attn_body::bf16*)(PROJ + C_DQ), (const attn_body::bf16*)(PROJ + C_DK), (const attn_body::bf16*)(PROJ + C_DV), (attn_body::bf16*)(ws + WS_OA)};
        const attn_body::StaticOrder S((int)F.G, F.vcu);
        attn_body::attn_phase<attn_body::StaticOrder>((char*)lds + RING_OFF, AT, S, F.wave);
        if (BOTH(2)) GRID_BAR(2);
    }

    if (IN(3)) { p3_scan_combine(F); if (BOTH(3)) GRID_BAR(3); }

    if (IN(4)) { for (int u = F.vcu; u < 32 * NCH; u += F.G) m3_unit(F, u >> 6, u & 63); if (BOTH(4)) GRID_BAR(4); }

    if (IN(5)) {
        pg8::Gemm g{(const bf16*)(ws + WS_OA), (const bf16*)(ws + WS_WOUT), M, D, D}; pg8::StaticOrder S; S.init(M, D, F.G, (int)blockIdx.x);
        pg8::EpiResid<true> E{F.in[0], F.out, (bf16*)(ws + WS_XB), (float*)(F.ctl + CW_ROWSS), D};
        pg8::gemm_phase<pg8::EpiResid<true>, pg8::StaticOrder, PG8_ALIGN, PG8_SP2>(F.lds + RING_OFF, g, S, E, F.wave);
        if (BOTH(5)) GRID_BAR(5);
    }

    if (IN(6)) {
        pg8::Gemm g{(const bf16*)(ws + WS_XB), (const bf16*)(ws + WS_WXQ), M, D, D}; pg8::StaticOrder S; S.init(M, D, F.G, (int)blockIdx.x);
        pg8::EpiRowScale E{(bf16*)(ws + WS_XQ), D, (const float*)(F.ctl + CW_ROWSS), EPS, XSCALE};
        pg8::gemm_phase<pg8::EpiRowScale, pg8::StaticOrder, PG8_ALIGN, PG8_SP2>(F.lds + RING_OFF, g, S, E, F.wave);
        if (BOTH(6)) GRID_BAR(6);
    }

    if (IN(7)) { for (int u = F.vcu; u < (M / 128) * 4; u += F.G) xattn_unit(F, u >> 2, u & 3); if (BOTH(7)) GRID_BAR(7); }

    if (IN(8)) {
        pg8::Gemm g{(const bf16*)(ws + WS_XO), (const bf16*)(ws + WS_WXO), M, D, D}; pg8::StaticOrder S; S.init(M, D, F.G, (int)blockIdx.x);
        pg8::EpiResid<false> E{F.out, F.out, nullptr, nullptr, D};
        pg8::gemm_phase<pg8::EpiResid<false>, pg8::StaticOrder, PG8_ALIGN, PG8_SP2>(F.lds + RING_OFF, g, S, E, F.wave);
        if (BOTH(8)) GRID_BAR(8);
    }

    if (IN(9)) { p9_router(F); if (BOTH(9)) GRID_BAR(9); }

    if (IN(10)) {
        const int ntiles = expert_tables<true>(F);
        pg8::Gemm g{(const bf16*)(ws + WS_H3), (const bf16*)(ws + WS_W13), M, D, D};
        pg8::ExpertOrder<true> S{F.G, (int)blockIdx.x, ntiles, (const LAS int*)(F.lds + XT_TS), (const LAS int*)(F.lds + XT_TOK), (size_t)D * D * 2};
        pg8::EpiSwiGLU E{(bf16*)(ws + WS_ACT), DEXP};
        pg8::gemm_phase<pg8::EpiSwiGLU, pg8::ExpertOrder<true>, PG8_ALIGN, PG8_SP2>(F.lds + RING_OFF, g, S, E, F.wave);
        if (BOTH(10)) GRID_BAR(10);
    }

    if (IN(11)) {
        const int ntiles = expert_tables<false>(F);
        pg8::Gemm g{(const bf16*)(ws + WS_ACT), (const bf16*)(ws + WS_W2), MAXROWS, D, DEXP};
        pg8::ExpertOrder<false> S{F.G, (int)blockIdx.x, ntiles, (const LAS int*)(F.lds + XT_TS), (const LAS int*)(F.lds + XT_TOK), (size_t)D * DEXP * 2};
        pg8::EpiBf16<0> E{(bf16*)(ws + WS_YE), D, nullptr, 0, 0, 1.f};
        pg8::gemm_phase<pg8::EpiBf16<0>, pg8::ExpertOrder<false>, PG8_ALIGN, PG8_SP2>(F.lds + RING_OFF, g, S, E, F.wave);
        if (BOTH(11)) GRID_BAR(11);
    }

    if (IN(12)) { p12_final(F); }
#undef IN
#undef BOTH
}

extern "C" void kernel_launch(void* const* d_in, const int* in_sizes, int n_in, void* d_out, int out_size, void* d_ws, size_t ws_size, hipStream_t stream) {
    static int grid = 0;
    if (grid == 0) {
        if (n_in != 26 || in_sizes[0] != M * D || out_size != M * D || ws_size < WS_END) { fprintf(stderr, "kernel_launch: unexpected shapes (n_in %d, in0 %d, out %d, ws %zu); nothing launched\n", n_in, n_in > 0 ? in_sizes[0] : -1, out_size, ws_size); grid = -1; return; }
        int dev = 0, cus = 0, per_cu = 0;
        if (hipGetDevice(&dev) != hipSuccess || hipDeviceGetAttribute(&cus, hipDeviceAttributeMultiprocessorCount, dev) != hipSuccess) { grid = -1; return; }
        if (hipFuncSetAttribute((const void*)mk_fwd, hipFuncAttributeMaxDynamicSharedMemorySize, LDS_BYTES) != hipSuccess) { fprintf(stderr, "kernel_launch: hipFuncSetAttribute failed\n"); grid = -1; return; }
        if (hipOccupancyMaxActiveBlocksPerMultiprocessor(&per_cu, (const void*)mk_fwd, NWAVES * 64, LDS_BYTES) != hipSuccess || per_cu < 1) { fprintf(stderr, "kernel_launch: occupancy query reports %d workgroups per CU\n", per_cu); }
        (void)hipGetLastError();
        grid = cus;
    }
    if (grid < 0) return;
    if (hipMemsetAsync((char*)d_ws + WS_CTL, 0, CTL_ZERO_BYTES, stream) != hipSuccess) return;
    Args a{};
    for (int i = 0; i < 26; ++i) a.in[i] = (const float*)d_in[i];
    a.out = (float*)d_out; a.ws = (unsigned char*)d_ws;
    for (int li = 0; li < N_LAUNCHES; ++li) {
        a.ph_lo = (N_LAUNCHES == NPHASE) ? li : 0; a.ph_hi = (N_LAUNCHES == NPHASE) ? li + 1 : NPHASE; a.li = (N_LAUNCHES == NPHASE) ? 0 : li; a.pad = 0;
        hipLaunchKernelGGL(mk_fwd, dim3(grid), dim3(NWAVES * 64), LDS_BYTES, stream, a);
        if (hipPeekAtLastError() != hipSuccess) break;
    }
}
```

```cpp
#include <hip/hip_runtime.h>
#include <cstdio>
#include <cstdint>
__device__ __forceinline__ int lane_now() { int l; asm volatile("v_mbcnt_lo_u32_b32 %0, -1, 0\n\tv_mbcnt_hi_u32_b32 %0, -1, %0" : "=v"(l)); return l; }
namespace pg8 {
#define PG8_LAS __attribute__((address_space(3)))
typedef unsigned short bf16_t;
typedef short bf16x8 __attribute__((ext_vector_type(8)));
typedef float f32x4 __attribute__((ext_vector_type(4)));
typedef unsigned u32x4 __attribute__((ext_vector_type(4)));
constexpr int BM = 256, BK = 64, HALF = 128, HTB = HALF * BK * 2  , STAGE_BYTES = 8 * HTB, NXCD = 8, WGM = 8;

__host__ __device__ __forceinline__ int lds_byte(int r, int c) { const int st = (r >> 4) * 2 + (c >> 5), rr = r & 15, cc = c & 31, ob = rr * 64 + cc * 2; return st * 1024 + (ob ^ (((ob >> 9) & 1) << 5)); }
__host__ __device__ __forceinline__ void stage_rc(int b, int& R, int& C) { const int st = b / 1024, sb = b % 1024, swz = sb ^ (((sb >> 9) & 1) << 5); R = (st >> 1) * 16 + swz / 64; C = (st & 1) * 32 + (swz % 64) / 2; }
__host__ __device__ __forceinline__ int perm32(int rho) { const int n = rho >> 4, i = rho & 15; return 8 * (i >> 2) + 4 * n + (i & 3); }

struct Unit { int pm, pn, e, ui; int nt = 0; };
struct Gemm { const bf16_t* A; const bf16_t* Bt; int M, N, K; int kext = 0; };

struct StaticOrder {
    int nM, nN, nwg, G, c;
    __host__ __device__ __forceinline__ void init(int M, int N, int G_, int c_) { nM = M / BM; nN = N / BM; nwg = nM * nN; G = G_; c = c_; }
    __host__ __device__ __forceinline__ bool next(int i, Unit& u) const { const long L = (long)i * G + c; if (L >= nwg) return false; at((int)L, u); u.ui = i; return true; }
    __host__ __device__ __forceinline__ void at(int L, Unit& u) const {
        int wgid = L; { const int q = nwg / NXCD, r = nwg % NXCD, xcd = wgid % NXCD, off = wgid / NXCD; wgid = (xcd < r ? xcd * (q + 1) : r * (q + 1) + (xcd - r) * q) + off; }
        const int nig = WGM * nN, gid = wgid / nig, fm = gid * WGM, gsz = (nM - fm) < WGM ? (nM - fm) : WGM;
        u.pm = fm + ((wgid % nig) % gsz); u.pn = (wgid % nig) / gsz; u.e = 0; u.ui = 0;
    }
    __device__ __forceinline__ const char* aptr(const Gemm& g, const Unit& u, size_t tstep) const { return (const char*)g.A + (size_t)u.pm * tstep; }
    __device__ __forceinline__ const char* bptr(const Gemm& g, const Unit& u, size_t tstep) const { return (const char*)g.Bt + (size_t)u.pn * tstep; }
    __device__ __forceinline__ void avoff(const Unit&, int, const int (&R)[2], const int (&C)[2], int K, unsigned (&vo)[2][2]) const {
#pragma unroll
        for (int h = 0; h < 2; ++h)
#pragma unroll
            for (int i = 0; i < 2; ++i) vo[h][i] = (unsigned)((h * HALF + R[i]) * K + C[i]) * 2u; }
};

__device__ __forceinline__ unsigned cvt_pk_bf16(float lo, float hi) { unsigned r; asm volatile("v_cvt_pk_bf16_f32 %0, %1, %2" : "=v"(r) : "v"(lo), "v"(hi)); return r; }
typedef float f32x2 __attribute__((ext_vector_type(2)));
__device__ __forceinline__ f32x2 gelu_pk(f32x2 v) {
    const f32x2 av = __builtin_elementwise_abs(v), d = av * 0.2316418882f + 1.0f;
    f32x2 t; t.x = __builtin_amdgcn_rcpf(d.x); t.y = __builtin_amdgcn_rcpf(d.y);
    f32x2 q = t * 0.5307027145f + (-0.7265760135f); q = q * t + 0.7107068705f; q = q * t + (-0.142248368f); q = q * t + 0.127414796f; q = q * t;
    const f32x2 s = (v * v) * (-0.72134752044f);
    f32x2 e; e.x = __builtin_amdgcn_exp2f(s.x); e.y = __builtin_amdgcn_exp2f(s.y);
    const f32x2 m = v * (q * e), r = v - m;
    f32x2 o; o.x = v.x < 0.f ? m.x : r.x; o.y = v.y < 0.f ? m.y : r.y; return o;
}

template <int ACT  > struct EpiBf16 {
    static constexpr bool PERM = true, AFTER_DRAIN = false; static_assert(ACT == 0 || ACT == 1, "EpiBf16: ACT is 0 (none) or 1 (gelu_pk)");
    bf16_t* O; int ldc; const float* bias; int split_cols; size_t split_stride; float scale0;
    __device__ __forceinline__ void operator()(const f32x4 (&acc)[2][2][4][2], const Unit& u, int wr, int wc, int fr, int fq) const {
        const int row0 = u.pm * BM + wr * 64 + fr; int colt = u.pn * BM; bf16_t* base = O;
        float sc = 1.f; if (split_cols) { const int t = colt / split_cols; base += (size_t)t * split_stride; colt -= t * split_cols; if (t == 0) sc = scale0; }
        const int col0 = colt + wc * 32 + 8 * fq, bcol0 = u.pn * BM + wc * 32 + 8 * fq;
        f32x4 bv[2][2];
#pragma unroll
        for (int bj = 0; bj < 2; ++bj)
#pragma unroll
            for (int n = 0; n < 2; ++n) bv[bj][n] = bias ? *(const f32x4*)(bias + bcol0 + bj * HALF + 4 * n) : (f32x4){0.f, 0.f, 0.f, 0.f};
#pragma unroll
        for (int ai = 0; ai < 2; ++ai)
#pragma unroll
            for (int m = 0; m < 4; ++m) { bf16_t* rowp = base + (size_t)(row0 + ai * HALF + m * 16) * ldc + col0;
#pragma unroll
                for (int bj = 0; bj < 2; ++bj) { f32x4 v0 = acc[ai][bj][m][0] + bv[bj][0], v1 = acc[ai][bj][m][1] + bv[bj][1];
                    if (ACT == 1) { f32x2 a = gelu_pk((f32x2){v0[0], v0[1]}), b = gelu_pk((f32x2){v0[2], v0[3]}), c = gelu_pk((f32x2){v1[0], v1[1]}), d = gelu_pk((f32x2){v1[2], v1[3]});
                        v0 = (f32x4){a.x, a.y, b.x, b.y}; v1 = (f32x4){c.x, c.y, d.x, d.y}; }
                    v0 = v0 * sc; v1 = v1 * sc; u32x4 w; w.x = cvt_pk_bf16(v0[0], v0[1]); w.y = cvt_pk_bf16(v0[2], v0[3]); w.z = cvt_pk_bf16(v1[0], v1[1]); w.w = cvt_pk_bf16(v1[2], v1[3]);
                    *(u32x4*)(rowp + bj * HALF) = w; } }
    }
};
typedef unsigned u32x2 __attribute__((ext_vector_type(2)));
__device__ __forceinline__ u32x2 pack4(const f32x4 v) { u32x2 w; w.x = cvt_pk_bf16(v[0], v[1]); w.y = cvt_pk_bf16(v[2], v[3]); return w; }

struct EpiProj {
    static constexpr bool PERM = true, AFTER_DRAIN = false;
    bf16_t* O; int ldc; const float* rope; float qscale;
    __device__ __forceinline__ void operator()(const f32x4 (&acc)[2][2][4][2], const Unit& u, int wr, int wc, int fr, int fq) const {
        const int row0 = u.pm * BM + wr * 64 + fr;
        if (u.pn < 4) {
            const float sc = (u.pn < 2) ? qscale : 1.0f;
#pragma unroll
            for (int ai = 0; ai < 2; ++ai)
#pragma unroll
                for (int m = 0; m < 4; ++m) { const int r = row0 + ai * HALF + m * 16; const int pos = r & 4095; const float* rp = rope + pos * 32 + 8 * fq;
                    const f32x4 c0 = *(const f32x4*)rp, c1 = *(const f32x4*)(rp + 4), s0 = *(const f32x4*)(rp + 4096 * 32), s1 = *(const f32x4*)(rp + 4096 * 32 + 4);
                    const f32x4 a0 = acc[ai][0][m][0], a1 = acc[ai][0][m][1], b0 = acc[ai][1][m][0], b1 = acc[ai][1][m][1];
                    const f32x4 x0 = (a0 * c0 - b0 * s0) * sc, x1 = (a1 * c1 - b1 * s1) * sc, y0 = (b0 * c0 + a0 * s0) * sc, y1 = (b1 * c1 + a1 * s1) * sc;
                    bf16_t* p = O + (size_t)r * ldc + u.pn * BM + 64 * wc + 8 * fq; u32x4 w;
                    w.x = cvt_pk_bf16(x0[0], x0[1]); w.y = cvt_pk_bf16(x0[2], x0[3]); w.z = cvt_pk_bf16(x1[0], x1[1]); w.w = cvt_pk_bf16(x1[2], x1[3]); *(u32x4*)p = w;
                    w.x = cvt_pk_bf16(y0[0], y0[1]); w.y = cvt_pk_bf16(y0[2], y0[3]); w.z = cvt_pk_bf16(y1[0], y1[1]); w.w = cvt_pk_bf16(y1[2], y1[3]); *(u32x4*)(p + 32) = w; }
        } else {
            const int col0 = u.pn * BM + wc * 32 + 8 * fq;
#pragma unroll
            for (int ai = 0; ai < 2; ++ai)
#pragma unroll
                for (int m = 0; m < 4; ++m) { bf16_t* rowp = O + (size_t)(row0 + ai * HALF + m * 16) * ldc + col0;
#pragma unroll
                    for (int bj = 0; bj < 2; ++bj) { const f32x4 v0 = acc[ai][bj][m][0], v1 = acc[ai][bj][m][1];
                        u32x4 w; w.x = cvt_pk_bf16(v0[0], v0[1]); w.y = cvt_pk_bf16(v0[2], v0[3]); w.z = cvt_pk_bf16(v1[0], v1[1]); w.w = cvt_pk_bf16(v1[2], v1[3]);
                        *(u32x4*)(rowp + bj * HALF) = w; } }
        }
    }
};
template <bool BASE_F32, bool WITH_SS> struct EpiResid {
    static constexpr bool PERM = true, AFTER_DRAIN = false;
    const float* basef; const bf16_t* baseb; bf16_t* xb; float* rowss; int ldc;
    __device__ __forceinline__ void operator()(const f32x4 (&acc)[2][2][4][2], const Unit& u, int wr, int wc, int fr, int fq) const {
        const int row0 = u.pm * BM + wr * 64 + fr, col0 = u.pn * BM + wc * 32 + 8 * fq;
#pragma unroll
        for (int ai = 0; ai < 2; ++ai)
#pragma unroll
            for (int m = 0; m < 4; ++m) { const int r = row0 + ai * HALF + m * 16; const size_t off = (size_t)r * ldc + col0; float ss = 0.f;
#pragma unroll
                for (int bj = 0; bj < 2; ++bj) { f32x4 o0, o1;
                    if (BASE_F32) { o0 = __builtin_nontemporal_load((const f32x4*)(basef + off + bj * HALF)); o1 = __builtin_nontemporal_load((const f32x4*)(basef + off + bj * HALF + 4)); }
                    else { const u32x4 w = *(const u32x4*)(baseb + off + bj * HALF);
                        o0 = (f32x4){__uint_as_float(w.x << 16), __uint_as_float(w.x & 0xffff0000u), __uint_as_float(w.y << 16), __uint_as_float(w.y & 0xffff0000u)};
                        o1 = (f32x4){__uint_as_float(w.z << 16), __uint_as_float(w.z & 0xffff0000u), __uint_as_float(w.w << 16), __uint_as_float(w.w & 0xffff0000u)}; }
                    o0 = o0 + acc[ai][bj][m][0]; o1 = o1 + acc[ai][bj][m][1];
                    u32x4 w; w.x = cvt_pk_bf16(o0[0], o0[1]); w.y = cvt_pk_bf16(o0[2], o0[3]); w.z = cvt_pk_bf16(o1[0], o1[1]); w.w = cvt_pk_bf16(o1[2], o1[3]);
                    *(u32x4*)(xb + off + bj * HALF) = w;
                    if (WITH_SS) ss += ((o0[0] * o0[0] + o0[1] * o0[1]) + (o0[2] * o0[2] + o0[3] * o0[3])) + ((o1[0] * o1[0] + o1[1] * o1[1]) + (o1[2] * o1[2] + o1[3] * o1[3])); }
                if (WITH_SS) { ss += __shfl_xor(ss, 16); ss += __shfl_xor(ss, 32); if (fq == 0) atomicAdd(rowss + r, ss); } }
    }
};
struct EpiRowScale {
    static constexpr bool PERM = true, AFTER_DRAIN = false;
    bf16_t* O; int ldc; const float* rowss; float eps, scale;
    __device__ __forceinline__ void operator()(const f32x4 (&acc)[2][2][4][2], const Unit& u, int wr, int wc, int fr, int fq) const {
        const int row0 = u.pm * BM + wr * 64 + fr, col0 = u.pn * BM + wc * 32 + 8 * fq;
#pragma unroll
        for (int ai = 0; ai < 2; ++ai)
#pragma unroll
            for (int m = 0; m < 4; ++m) { const int r = row0 + ai * HALF + m * 16; const float sc = scale / sqrtf(rowss[r] * (1.0f / 1024.0f) + eps); bf16_t* rowp = O + (size_t)r * ldc + col0;
#pragma unroll
                for (int bj = 0; bj < 2; ++bj) { const f32x4 v0 = acc[ai][bj][m][0] * sc, v1 = acc[ai][bj][m][1] * sc;
                    u32x4 w; w.x = cvt_pk_bf16(v0[0], v0[1]); w.y = cvt_pk_bf16(v0[2], v0[3]); w.z = cvt_pk_bf16(v1[0], v1[1]); w.w = cvt_pk_bf16(v1[2], v1[3]);
                    *(u32x4*)(rowp + bj * HALF) = w; } }
    }
};
struct EpiSwiGLU {
    static constexpr bool PERM = true, AFTER_DRAIN = false;
    bf16_t* O; int ldc; const PG8_LAS float* RS;
    __device__ __forceinline__ void operator()(const f32x4 (&acc)[2][2][4][2], const Unit& u, int wr, int wc, int fr, int fq) const {
        const int row0 = u.pm * BM + wr * 64 + fr, col0 = u.pn * HALF + wc * 32 + 8 * fq;
#pragma unroll
        for (int ai = 0; ai < 2; ++ai)
#pragma unroll
            for (int m = 0; m < 4; ++m) { bf16_t* rowp = O + (size_t)(row0 + ai * HALF + m * 16) * ldc + col0; const float rs = RS[u.ui * 256 + wr * 64 + fr + ai * HALF + m * 16]; u32x4 w;
#pragma unroll
                for (int n = 0; n < 2; ++n) { const f32x4 a = acc[ai][0][m][n] * rs, b = acc[ai][1][m][n] * rs; f32x4 o;
#pragma unroll
                    for (int j = 0; j < 4; ++j) o[j] = a[j] * b[j] * __builtin_amdgcn_rcpf(1.0f + __builtin_amdgcn_exp2f(-1.4426950408889634f * a[j]));
                    const u32x2 p = pack4(o); if (n == 0) { w.x = p.x; w.y = p.y; } else { w.z = p.x; w.w = p.y; } }
                *(u32x4*)rowp = w; }
    }
};
struct EpiNull { static constexpr bool PERM = true, AFTER_DRAIN = false; float* sink;
    __device__ __forceinline__ void operator()(const f32x4 (&acc)[2][2][4][2], const Unit& u, int wr, int wc, int fr, int fq) const { float s = 0.f;
#pragma unroll
        for (int ai = 0; ai < 2; ++ai)
#pragma unroll
            for (int bj = 0; bj < 2; ++bj)
#pragma unroll
                for (int m = 0; m < 4; ++m)
#pragma unroll
                    for (int n = 0; n < 2; ++n) s += acc[ai][bj][m][n][0] + acc[ai][bj][m][n][1] + acc[ai][bj][m][n][2] + acc[ai][bj][m][n][3];
        if (s == 1.2345e-30f) *sink = s; } };
struct EpiNull2 { static constexpr bool PERM = true, AFTER_DRAIN = false; bf16_t* O; int ldc;
    __device__ __forceinline__ void operator()(const f32x4 (&acc)[2][2][4][2], const Unit& u, int wr, int wc, int fr, int fq) const {
        const int row0 = u.pm * BM + wr * 64 + fr, col0 = u.pn * BM + wc * 32 + 8 * fq;
#pragma unroll
        for (int ai = 0; ai < 2; ++ai)
#pragma unroll
            for (int m = 0; m < 4; ++m) { const int r = row0 + ai * HALF + m * 16; const float sc = 0.5f; const size_t off = (((size_t)r * ldc + col0) * 2 & 8191) + (size_t)blockIdx.x * 8192;
#pragma unroll
                for (int bj = 0; bj < 2; ++bj) { const f32x4 v0 = acc[ai][bj][m][0] * sc, v1 = acc[ai][bj][m][1] * sc;
                    u32x4 w; w.x = cvt_pk_bf16(v0[0], v0[1]); w.y = cvt_pk_bf16(v0[2], v0[3]); w.z = cvt_pk_bf16(v1[0], v1[1]); w.w = cvt_pk_bf16(v1[2], v1[3]);
                    *(u32x4*)((char*)O + ((off + bj * 256) & ~15)) = w; } }
    } };

struct BatchBOrder : StaticOrder { size_t bstride; int tpb;
    __device__ __forceinline__ const char* bptr(const Gemm& g, const Unit& u, size_t tstep) const { return (const char*)g.Bt + (size_t)(u.pm / tpb) * bstride + (size_t)u.pn * tstep; } };
struct FoldOrder { int G, c; const bf16_t* MK; const bf16_t* MV; const bf16_t* WXQN; const bf16_t* WXOT;
    __device__ __forceinline__ bool next(int i, Unit& u) const { const int L = i * G + c; if (L >= 256) return false;
        const int ty = L >> 7, l = L & 127, b = l >> 4, h = (l >> 2) & 3, j = l & 3; u.e = ty; u.ui = i;
        u.pm = ty == 0 ? b * 4 + h : 32 + b * 4 + j; u.pn = ty == 0 ? j : h; return true; }
    __device__ __forceinline__ const char* aptr(const Gemm&, const Unit& u, size_t) const {
        return u.e == 0 ? (const char*)(MK + ((size_t)(u.pm >> 2) * 256 * 1024 + (u.pm & 3) * 256)) : (const char*)(WXOT + ((size_t)((u.pm - 32) & 3) * 256 * 1024 + u.pn * 256)); }
    __device__ __forceinline__ const char* bptr(const Gemm&, const Unit& u, size_t) const {
        return u.e == 0 ? (const char*)(WXQN + ((size_t)u.pn * 256 * 1024 + (u.pm & 3) * 256)) : (const char*)(MV + ((size_t)((u.pm - 32) >> 2) * 256 * 1024 + u.pn * 256)); }
    __device__ __forceinline__ void avoff(const Unit&, int, const int (&R)[2], const int (&C)[2], int K, unsigned (&vo)[2][2]) const {
#pragma unroll
        for (int h = 0; h < 2; ++h)
#pragma unroll
            for (int i = 0; i < 2; ++i) vo[h][i] = (unsigned)((h * HALF + R[i]) * K + C[i]) * 2u; }
};
struct OutFoldOrder { StaticOrder main; FoldOrder fold; int G, c;
    __device__ __forceinline__ bool next(int i, Unit& u) const { const int P = i * G + c; if (P >= main.nwg + 256) return false;
        const bool mn = P < main.nwg; Unit t; main.at(mn ? P : 0, t);
        const int L = P - main.nwg, ty = L >> 7, l = L & 127, b = l >> 4, h = (l >> 2) & 3, j = l & 3;
        const int fpm = ty == 0 ? b * 4 + h : 32 + b * 4 + j, fpn = ty == 0 ? j : h;
        u.pm = mn ? t.pm : fpm; u.pn = mn ? t.pn : fpn; u.e = mn ? 2 : ty; u.ui = i; u.nt = mn ? 16 : 4; return true; }
    __device__ __forceinline__ const char* aptr(const Gemm& g, const Unit& u, size_t tstep) const { return u.e == 2 ? main.aptr(g, u, tstep) : fold.aptr(g, u, tstep); }
    __device__ __forceinline__ const char* bptr(const Gemm& g, const Unit& u, size_t tstep) const { return u.e == 2 ? main.bptr(g, u, tstep) : fold.bptr(g, u, tstep); }
    __device__ __forceinline__ void avoff(const Unit& u, int ui, const int (&R)[2], const int (&C)[2], int K, unsigned (&vo)[2][2]) const { main.avoff(u, ui, R, C, K, vo); }
};
struct EpiResidFold { static constexpr bool PERM = true, AFTER_DRAIN = false; EpiResid<true, true> R; EpiBf16<0> B;
    __device__ __forceinline__ void operator()(const f32x4 (&acc)[2][2][4][2], const Unit& u, int wr, int wc, int fr, int fq) const { if (u.e == 2) R(acc, u, wr, wc, fr, fq); else B(acc, u, wr, wc, fr, fq); } };
struct EpiSoftmaxP {
    static constexpr bool PERM = true, AFTER_DRAIN = false;
    bf16_t* O; int ldc; const float* rowss; float eps, scale; PG8_LAS float* ex;
    __device__ __forceinline__ void operator()(f32x4 (&acc)[2][2][4][2], const Unit& u, int wr, int wc, int fr, int fq) const {
        const int rl0 = wr * 64 + fr, row0 = u.pm * BM + rl0, col0 = u.pn * BM + wc * 32 + 8 * fq;
        float mw[2][4];
#pragma unroll
        for (int ai = 0; ai < 2; ++ai)
#pragma unroll
            for (int m = 0; m < 4; ++m) { const int rl = rl0 + ai * HALF + m * 16; const float sc = scale / sqrtf(rowss[u.pm * BM + rl] * (1.0f / 1024.0f) + eps);
                float mx = -INFINITY;
#pragma unroll
                for (int bj = 0; bj < 2; ++bj)
#pragma unroll
                    for (int n = 0; n < 2; ++n) { const f32x4 t = acc[ai][bj][m][n] * sc; acc[ai][bj][m][n] = t; mx = fmaxf(mx, fmaxf(fmaxf(t[0], t[1]), fmaxf(t[2], t[3]))); }
                { auto r = __builtin_amdgcn_permlane16_swap(__float_as_uint(mx), __float_as_uint(mx), false, false); mx = fmaxf(__uint_as_float(r[0]), __uint_as_float(r[1])); }
                { auto r = __builtin_amdgcn_permlane32_swap(__float_as_uint(mx), __float_as_uint(mx), false, false); mx = fmaxf(__uint_as_float(r[0]), __uint_as_float(r[1])); }
                float s = 0.f;
#pragma unroll
                for (int bj = 0; bj < 2; ++bj)
#pragma unroll
                    for (int n = 0; n < 2; ++n) { f32x4 t = acc[ai][bj][m][n];
#pragma unroll
                        for (int j = 0; j < 4; ++j) t[j] = __builtin_amdgcn_exp2f(t[j] - mx);
                        acc[ai][bj][m][n] = t; s += (t[0] + t[1]) + (t[2] + t[3]); }
                { auto r = __builtin_amdgcn_permlane16_swap(__float_as_uint(s), __float_as_uint(s), false, false); s = __uint_as_float(r[0]) + __uint_as_float(r[1]); }
                { auto r = __builtin_amdgcn_permlane32_swap(__float_as_uint(s), __float_as_uint(s), false, false); s = __uint_as_float(r[0]) + __uint_as_float(r[1]); }
                if (fq == 0) { f32x2 ms; ms.x = mx; ms.y = s; *(PG8_LAS f32x2*)(ex + (rl * 4 + wc) * 2) = ms; }
                mw[ai][m] = mx; }
        asm volatile("s_waitcnt lgkmcnt(0)" ::: "memory"); __builtin_amdgcn_s_barrier();
#pragma unroll
        for (int ai = 0; ai < 2; ++ai)
#pragma unroll
            for (int m = 0; m < 4; ++m) { const int rl = rl0 + ai * HALF + m * 16; const PG8_LAS f32x4* e4 = (const PG8_LAS f32x4*)(ex + rl * 8); const f32x4 a = e4[0], b = e4[1];
                const float Mx = fmaxf(fmaxf(a[0], a[2]), fmaxf(b[0], b[2]));
                const float L = (a[1] * __builtin_amdgcn_exp2f(a[0] - Mx) + a[3] * __builtin_amdgcn_exp2f(a[2] - Mx)) + (b[1] * __builtin_amdgcn_exp2f(b[0] - Mx) + b[3] * __builtin_amdgcn_exp2f(b[2] - Mx));
                const float f = __builtin_amdgcn_exp2f(mw[ai][m] - Mx) * __builtin_amdgcn_rcpf(L);
                bf16_t* rowp = O + (size_t)(row0 + ai * HALF + m * 16) * ldc + col0;
#pragma unroll
                for (int bj = 0; bj < 2; ++bj) { const f32x4 v0 = acc[ai][bj][m][0] * f, v1 = acc[ai][bj][m][1] * f;
                    u32x4 w; w.x = cvt_pk_bf16(v0[0], v0[1]); w.y = cvt_pk_bf16(v0[2], v0[3]); w.z = cvt_pk_bf16(v1[0], v1[1]); w.w = cvt_pk_bf16(v1[2], v1[3]);
                    *(u32x4*)(rowp + bj * HALF) = w; } }
    }
};
__host__ __device__ __forceinline__ int expert_unit_id(int L, int nwg) { const int q = nwg / NXCD, r = nwg % NXCD, xcd = L % NXCD, off = L / NXCD; return (xcd < r ? xcd * (q + 1) : r * (q + 1) + (xcd - r) * q) + off; }
template <bool GATHER> struct ExpertOrder {
    int G, c, ntiles; const PG8_LAS int* TS; const PG8_LAS int* TOK; size_t estride;
    __device__ __forceinline__ bool next(int i, Unit& u) const {
        const int L = i * G + c; if (L >= 4 * ntiles) return false;
        const int id = expert_unit_id(L, 4 * ntiles); const int rt = id >> 2; int e = 0;
        for (int k = 1; k < 32; ++k) e += (TS[k] <= rt) ? 1 : 0;
        u.pm = rt; u.pn = id & 3; u.e = e; u.ui = i; return true;
    }
    __device__ __forceinline__ const char* aptr(const Gemm& g, const Unit& u, size_t tstep) const { return GATHER ? (const char*)g.A : (const char*)g.A + (size_t)u.pm * tstep; }
    __device__ __forceinline__ const char* bptr(const Gemm& g, const Unit& u, size_t tstep) const { return (const char*)g.Bt + (size_t)u.e * estride + (size_t)u.pn * tstep; }
    __device__ __forceinline__ void avoff(const Unit&, int ui, const int (&R)[2], const int (&C)[2], int K, unsigned (&vo)[2][2]) const {
#pragma unroll
        for (int h = 0; h < 2; ++h)
#pragma unroll
            for (int i = 0; i < 2; ++i) { const int row = GATHER ? TOK[ui * 256 + h * HALF + R[i]] : (h * HALF + R[i]); vo[h][i] = (unsigned)(row * K + C[i]) * 2u; } }
};
template <class Epi, class Sched, bool ALIGN_EPI = false, bool SP2 = false>
__device__ __forceinline__ void gemm_phase(PG8_LAS unsigned char* lds, const Gemm g, const Sched& S, const Epi& E, const int wv) {
    const int wid = wv, lane = lane_now(), tid = wid * 64 + lane, wr = wid >> 2, wc = wid & 3, fr = lane & 15, fq = lane >> 4;
    const int K = g.K, nt = (g.kext ? g.kext : K) / BK;
    int R_[2], C_[2]; unsigned voffB[2];
#pragma unroll
    for (int i = 0; i < 2; ++i) { int R, C; stage_rc(tid * 16 + i * 8192, R, C); R_[i] = R; C_[i] = C; const int Rb = Epi::PERM ? ((R & ~31) + perm32(R & 31)) : R;
        voffB[i] = (unsigned)(Rb * K + C) * 2u; }
    const size_t kstep = (size_t)(BK * 2);
    const size_t hstep = (size_t)HALF * K * 2;
    const size_t tstep = 2 * hstep;
    const unsigned ldsw = (unsigned)wid * 1024u;
    const int aoff = lds_byte(wr * 64 + fr, fq * 8), boff = lds_byte(wc * 32 + fr, fq * 8);
#define PG8_SA(b, h) (((b) * 2 + (h)) * HTB)
#define PG8_SB(b, h) ((4 + (b) * 2 + (h)) * HTB)
#define PG8_STAGE(bufoff, gbase, voff) do { _Pragma("unroll") for (int _i = 0; _i < 2; ++_i) \
        __builtin_amdgcn_global_load_lds((const unsigned*)((const char*)(gbase) + (voff)[_i]), (PG8_LAS unsigned*)(lds + (bufoff) + ldsw + _i * 8192), 16, 0, 0); } while (0)
#define PG8_LDA(dst, b, h) do { _Pragma("unroll") for (int m = 0; m < 4; ++m) _Pragma("unroll") for (int k = 0; k < 2; ++k) dst[m][k] = *(const PG8_LAS bf16x8*)(lds + PG8_SA(b, h) + aoff + m * 2048 + k * 1024); } while (0)
#define PG8_LDB(dst, b, h) do { _Pragma("unroll") for (int n = 0; n < 2; ++n) _Pragma("unroll") for (int k = 0; k < 2; ++k) dst[n][k] = *(const PG8_LAS bf16x8*)(lds + PG8_SB(b, h) + boff + n * 2048 + k * 1024); } while (0)
#define PG8_MMA(ai, bj, At, Bt) do { __builtin_amdgcn_s_setprio(1); _Pragma("unroll") for (int m = 0; m < 4; ++m) _Pragma("unroll") for (int n = 0; n < 2; ++n) _Pragma("unroll") for (int k = 0; k < 2; ++k) \
        acc[ai][bj][m][n] = __builtin_amdgcn_mfma_f32_16x16x32_bf16(Bt[n][k], At[m][k], acc[ai][bj][m][n], 0, 0, 0); __builtin_amdgcn_s_setprio(0); } while (0)
#define PG8_WAIT_V(n) asm volatile("s_waitcnt vmcnt(" #n ")" ::: "memory")
#define PG8_WAIT_L(n) asm volatile("s_waitcnt lgkmcnt(" #n ")" ::: "memory")
#define PG8_BAR __builtin_amdgcn_s_barrier()
#define PG8_SCHED __builtin_amdgcn_sched_barrier(0)
    Unit cur, nxt; int ui = 0;
    if (!S.next(0, cur)) return;
    f32x4 acc[2][2][4][2];
#pragma unroll
    for (int a = 0; a < 2; ++a)
#pragma unroll
        for (int b = 0; b < 2; ++b)
#pragma unroll
            for (int m = 0; m < 4; ++m)
#pragma unroll
                for (int n = 0; n < 2; ++n) acc[a][b][m][n] = (f32x4){0.f, 0.f, 0.f, 0.f};
    bf16x8 At[4][2], B0[2][2], B1[2][2];
    const char* cA = S.aptr(g, cur, tstep); const char* cB = S.bptr(g, cur, tstep);
    unsigned voA[2][2], voN[2][2];
    S.avoff(cur, 0, R_, C_, K, voA);
    if constexpr (SP2) {
        PG8_STAGE(PG8_SB(0, 0), cB, voffB); PG8_STAGE(PG8_SB(0, 1), cB + hstep, voffB); PG8_STAGE(PG8_SA(0, 0), cA, voA[0]); PG8_STAGE(PG8_SA(0, 1), cA, voA[1]);
        if (wr == 1) PG8_BAR;
        PG8_WAIT_V(2); PG8_BAR;
        PG8_STAGE(PG8_SB(1, 0), cB + kstep, voffB); PG8_STAGE(PG8_SA(1, 0), cA + kstep, voA[0]); PG8_STAGE(PG8_SB(1, 1), cB + hstep + kstep, voffB);
        PG8_WAIT_V(6); PG8_BAR;
    } else {
        PG8_STAGE(PG8_SB(0, 0), cB, voffB); PG8_STAGE(PG8_SA(0, 0), cA, voA[0]); PG8_STAGE(PG8_SB(0, 1), cB + hstep, voffB); PG8_STAGE(PG8_SA(0, 1), cA, voA[1]);
        if (wr == 1) PG8_BAR;
        PG8_WAIT_V(4); PG8_BAR;
        PG8_STAGE(PG8_SB(1, 0), cB + kstep, voffB); PG8_STAGE(PG8_SA(1, 0), cA + kstep, voA[0]); PG8_STAGE(PG8_SB(1, 1), cB + hstep + kstep, voffB);
        PG8_WAIT_V(6); PG8_BAR;
    }
    for (;;) {
        const bool has_next = S.next(ui + 1, nxt);
        const char* nA = has_next ? S.aptr(g, nxt, tstep) : cA; const char* nB = has_next ? S.bptr(g, nxt, tstep) : cB;
        if (has_next) S.avoff(nxt, ui + 1, R_, C_, K, voN); else {
#pragma unroll
            for (int h = 0; h < 2; ++h)
#pragma unroll
                for (int i = 0; i < 2; ++i) voN[h][i] = voA[h][i]; }
        const int unt = cur.nt ? cur.nt : nt;
        for (int t = 0; t < unt; t += 2) {
            const bool last = (t == unt - 2);
            const char* a1 = cA + (size_t)(t + 1) * kstep;
            const char* a2 = last ? nA : cA + (size_t)(t + 2) * kstep; const char* b2 = last ? nB : cB + (size_t)(t + 2) * kstep;
            const char* a3 = a2 + kstep; const char* b3 = b2 + kstep;
            unsigned v2[2][2];
#pragma unroll
            for (int h = 0; h < 2; ++h)
#pragma unroll
                for (int i = 0; i < 2; ++i) v2[h][i] = last ? voN[h][i] : voA[h][i];
            if constexpr (SP2) {
            PG8_LDB(B0, 0, 0); PG8_LDB(B1, 0, 1); PG8_SCHED; PG8_LDA(At, 0, 0); PG8_STAGE(PG8_SA(1, 1), a1, voA[1]);
            PG8_WAIT_V(8); PG8_WAIT_L(0); PG8_BAR; PG8_MMA(0, 0, At, B0); PG8_MMA(0, 1, At, B1); PG8_BAR; PG8_SCHED;
            PG8_LDA(At, 0, 1); PG8_STAGE(PG8_SB(0, 0), b2, voffB); PG8_STAGE(PG8_SB(0, 1), b2 + hstep, voffB); PG8_STAGE(PG8_SA(0, 0), a2, v2[0]);
            PG8_WAIT_V(8); PG8_WAIT_L(0); PG8_BAR; PG8_MMA(1, 0, At, B0); PG8_MMA(1, 1, At, B1); PG8_BAR; PG8_SCHED;
            PG8_LDB(B0, 1, 0); PG8_LDB(B1, 1, 1); PG8_SCHED; PG8_LDA(At, 1, 0); PG8_STAGE(PG8_SA(0, 1), a2, v2[1]);
            PG8_WAIT_V(8); PG8_WAIT_L(0); PG8_BAR; PG8_MMA(0, 0, At, B0); PG8_MMA(0, 1, At, B1); PG8_BAR; PG8_SCHED;
            PG8_LDA(At, 1, 1); PG8_STAGE(PG8_SB(1, 0), b3, voffB); PG8_STAGE(PG8_SB(1, 1), b3 + hstep, voffB); PG8_STAGE(PG8_SA(1, 0), a3, v2[0]);
            PG8_WAIT_V(8); PG8_WAIT_L(0); PG8_BAR; PG8_MMA(1, 0, At, B0); PG8_MMA(1, 1, At, B1); PG8_BAR; PG8_SCHED;
            } else {
            PG8_LDB(B0, 0, 0); PG8_SCHED; PG8_LDA(At, 0, 0); PG8_STAGE(PG8_SA(1, 1), a1, voA[1]);
            PG8_WAIT_L(8); PG8_BAR; PG8_WAIT_L(0); PG8_MMA(0, 0, At, B0); PG8_BAR; PG8_SCHED;
            PG8_LDB(B1, 0, 1); PG8_STAGE(PG8_SB(0, 0), b2, voffB);
            PG8_BAR; PG8_WAIT_L(0); PG8_MMA(0, 1, At, B1); PG8_BAR;
            PG8_LDA(At, 0, 1); PG8_STAGE(PG8_SA(0, 0), a2, v2[0]);
            PG8_BAR; PG8_WAIT_L(0); PG8_MMA(1, 0, At, B0); PG8_BAR; PG8_SCHED;
            PG8_STAGE(PG8_SB(0, 1), b2 + hstep, voffB);
            PG8_WAIT_V(6); PG8_BAR; PG8_MMA(1, 1, At, B1); PG8_BAR;
            PG8_LDB(B0, 1, 0); PG8_SCHED; PG8_LDA(At, 1, 0); PG8_STAGE(PG8_SA(0, 1), a2, v2[1]);
            PG8_WAIT_L(8); PG8_BAR; PG8_WAIT_L(0); PG8_MMA(0, 0, At, B0); PG8_BAR; PG8_SCHED;
            PG8_LDB(B1, 1, 1); PG8_STAGE(PG8_SB(1, 0), b3, voffB);
            PG8_BAR; PG8_WAIT_L(0); PG8_MMA(0, 1, At, B1); PG8_BAR;
            PG8_LDA(At, 1, 1); PG8_STAGE(PG8_SA(1, 0), a3, v2[0]);
            PG8_BAR; PG8_WAIT_L(0); PG8_MMA(1, 0, At, B0); PG8_BAR; PG8_SCHED;
            PG8_STAGE(PG8_SB(1, 1), b3 + hstep, voffB);
            PG8_WAIT_V(6); PG8_BAR; PG8_MMA(1, 1, At, B1); PG8_BAR;
            }
        }
        if constexpr (ALIGN_EPI) { if (wr == 0) PG8_BAR; }
        if constexpr (!Epi::AFTER_DRAIN) { E(acc, cur, wr, wc, fr, fq); }
        if (!has_next) break;
#pragma unroll
        for (int a = 0; a < 2; ++a)
#pragma unroll
            for (int b = 0; b < 2; ++b)
#pragma unroll
                for (int m = 0; m < 4; ++m)
#pragma unroll
                    for (int n = 0; n < 2; ++n) acc[a][b][m][n] = (f32x4){0.f, 0.f, 0.f, 0.f};
        cur = nxt; cA = nA; cB = nB; ++ui;
#pragma unroll
        for (int h = 0; h < 2; ++h)
#pragma unroll
            for (int i = 0; i < 2; ++i) voA[h][i] = voN[h][i];
        if constexpr (ALIGN_EPI) { if (wr == 1) PG8_BAR; }
    }
    PG8_WAIT_V(0);
    if constexpr (!ALIGN_EPI) { if (wr == 0) PG8_BAR; }
    PG8_BAR;
    if constexpr (Epi::AFTER_DRAIN) { E.fused(acc, cur, wr, wc, fr, fq, lds, wid, lane); }
#undef PG8_SA
#undef PG8_SB
#undef PG8_STAGE
#undef PG8_LDA
#undef PG8_LDB
#undef PG8_MMA
#undef PG8_WAIT_V
#undef PG8_WAIT_L
#undef PG8_BAR
#undef PG8_SCHED
}
}

#ifndef PG8_SP2
#define PG8_SP2 true
#endif
#ifndef PG8_ALIGN
#define PG8_ALIGN true
#endif
#include <hip/hip_bf16.h>
#include <cmath>
namespace attn_body {
using bf16=__hip_bfloat16;
using bf16x8=__attribute__((ext_vector_type(8)))short;
using s16x4=__attribute__((ext_vector_type(4)))short;
using f32x16=__attribute__((ext_vector_type(16)))float;
using u32x4=__attribute__((ext_vector_type(4)))unsigned;
constexpr int BATCH=8,NHEAD=8,SEQ=4096,D=64,PQ=3072,PO=1024;
constexpr int NW=8,QBLK=32,QB=QBLK*NW,KVBLK=64,NQB=SEQ/QB;
constexpr int ATTN_UNIT_ROWS=QB;
__device__ __forceinline__ int crow(int r,int hi){return (r&3)+8*(r>>2)+4*hi;}
#define SBAR() __builtin_amdgcn_sched_barrier(0)
__device__ __forceinline__ void cmask(f32x16&p0,f32x16&p1,int jb,int qrel,int hi){
  const float NEG=-INFINITY; int kb=64*jb+4*hi;
  #pragma unroll
  for(int r=0;r<16;++r){int kv=kb+(r&3)+8*(r>>2); if(kv>qrel)p0[r]=NEG; if(kv+32>qrel)p1[r]=NEG;}
}

constexpr int NSLOT=3, SLOTB=8192, VSLOTB=2*SLOTB;
constexpr int LDS_K=0, LDS_V=NSLOT*SLOTB, LDS_WS=LDS_V+NSLOT*VSLOTB, LDS_OST=LDS_WS+NW*64*4, LDS_BYTES=LDS_OST+NW*4096;
constexpr float C2=0.125f*1.4426950408889634f;
__device__ __forceinline__ void glds16(const void*gsrc,unsigned lds_dst){unsigned keep;
  asm volatile("s_mov_b32 %0, m0\n\ts_mov_b32 m0, %2\n\ts_nop 0\n\tglobal_load_lds_dwordx4 %1, off\n\ts_mov_b32 m0, %0":"=&s"(keep):"v"(gsrc),"s"(lds_dst):"memory");}
__device__ __forceinline__ float max3f(float a,float b,float c){float r;asm("v_max3_f32 %0, %1, %2, %3":"=v"(r):"v"(a),"v"(b),"v"(c));return r;}
__device__ __forceinline__ float max2f(float a,float b){float r;asm("v_max_f32_e32 %0, %1, %2":"=v"(r):"v"(a),"v"(b));return r;}
__device__ __forceinline__ float fadd_s(float a,float b){float r;asm("v_add_f32_e32 %0, %1, %2":"=v"(r):"v"(a),"v"(b));return r;}
__device__ __forceinline__ float fsub_s(float a,float b){float r;asm("v_sub_f32_e32 %0, %1, %2":"=v"(r):"v"(a),"v"(b));return r;}
typedef float f32x2_t __attribute__((ext_vector_type(2))); typedef __bf16 bf16x2_t __attribute__((ext_vector_type(2)));
__device__ __forceinline__ unsigned cvtpk_s(float lo,float hi){f32x2_t v={lo,hi};bf16x2_t b=__builtin_convertvector(v,bf16x2_t);return __builtin_bit_cast(unsigned,b);}
#define WAIT_BAR(N) asm volatile("s_waitcnt vmcnt(" #N ") lgkmcnt(0)\n\ts_barrier":::"memory")

__device__ __forceinline__ void qkt(f32x16&p0,f32x16&p1,const char*Kslot,const bf16x8*qr,const f32x16&negm,int r32,int hi){
  const char*kb=Kslot+hi*1024+r32*16;
  #pragma unroll
  for(int d0=0;d0<4;++d0){
    const bf16x8 b0=*reinterpret_cast<const bf16x8*>(kb+d0*2048);
    const bf16x8 b1=*reinterpret_cast<const bf16x8*>(kb+d0*2048+512);
    if(d0==0){p0=__builtin_amdgcn_mfma_f32_32x32x16_bf16(b0,qr[0],negm,0,0,0);p1=__builtin_amdgcn_mfma_f32_32x32x16_bf16(b1,qr[0],negm,0,0,0);}
    else{p0=__builtin_amdgcn_mfma_f32_32x32x16_bf16(b0,qr[d0],p0,0,0,0);p1=__builtin_amdgcn_mfma_f32_32x32x16_bf16(b1,qr[d0],p1,0,0,0);}}
}
typedef __attribute__((address_space(3))) const char* lds_cptr;
typedef short v4i16_t __attribute__((ext_vector_type(4)));
__device__ __forceinline__ void kload8(bf16x8*kf,lds_cptr kp){
  kf[0]=*(const __attribute__((address_space(3))) bf16x8*)(kp);      kf[1]=*(const __attribute__((address_space(3))) bf16x8*)(kp+512);
  kf[2]=*(const __attribute__((address_space(3))) bf16x8*)(kp+2048); kf[3]=*(const __attribute__((address_space(3))) bf16x8*)(kp+2560);
  kf[4]=*(const __attribute__((address_space(3))) bf16x8*)(kp+4096); kf[5]=*(const __attribute__((address_space(3))) bf16x8*)(kp+4608);
  kf[6]=*(const __attribute__((address_space(3))) bf16x8*)(kp+6144); kf[7]=*(const __attribute__((address_space(3))) bf16x8*)(kp+6656);
}
__device__ __forceinline__ void kload2(bf16x8*kf,lds_cptr kp,int j){ kf[2*j]=*(const __attribute__((address_space(3))) bf16x8*)(kp+j*2048); kf[2*j+1]=*(const __attribute__((address_space(3))) bf16x8*)(kp+j*2048+512); }
__device__ __forceinline__ s16x4 vtr(lds_cptr p){ return __builtin_bit_cast(s16x4,__builtin_amdgcn_ds_read_tr16_b64_v4i16((__attribute__((address_space(3))) v4i16_t*)p)); }
__device__ __forceinline__ float rowmax(const f32x16&p0,const f32x16&p1){
  float a=max3f(p0[0],p0[1],p1[0]),b=max3f(p0[2],p0[3],p1[1]);a=max3f(a,p1[2],p1[3]);
  #pragma unroll
  for(int r=4;r<16;r+=4){a=max3f(a,p0[r],p0[r+1]);b=max3f(b,p0[r+2],p0[r+3]);a=max3f(a,p1[r],p1[r+1]);b=max3f(b,p1[r+2],p1[r+3]);}
  const float m=max2f(a,b);
  auto rr=__builtin_amdgcn_permlane32_swap(__float_as_uint(m),__float_as_uint(m),false,false);
  return max2f(__uint_as_float(rr[0]),__uint_as_float(rr[1]));
}
__device__ __forceinline__ void pv(f32x16*o,int vb,bf16x8 pa0,bf16x8 pa1,bf16x8 pa2,bf16x8 pa3){
  #pragma unroll
  for(int d0=0;d0<2;++d0){s16x4 lo[4],hi[4];
    #pragma unroll
    for(int ks=0;ks<4;++ks){
      asm volatile("ds_read_b64_tr_b16 %0,%1 offset:%c2":"=&v"(lo[ks]):"v"(vb),"i"(d0*4096+ks*1024):"memory");
      asm volatile("ds_read_b64_tr_b16 %0,%1 offset:%c2":"=&v"(hi[ks]):"v"(vb),"i"(d0*4096+ks*1024+512):"memory");}
    asm volatile("s_waitcnt lgkmcnt(0)":::"memory");SBAR();
    #define PK(k) (bf16x8){lo[k][0],lo[k][1],lo[k][2],lo[k][3],hi[k][0],hi[k][1],hi[k][2],hi[k][3]}
    o[d0]=__builtin_amdgcn_mfma_f32_32x32x16_bf16(pa0,PK(0),o[d0],0,0,0);
    o[d0]=__builtin_amdgcn_mfma_f32_32x32x16_bf16(pa1,PK(1),o[d0],0,0,0);
    o[d0]=__builtin_amdgcn_mfma_f32_32x32x16_bf16(pa2,PK(2),o[d0],0,0,0);
    o[d0]=__builtin_amdgcn_mfma_f32_32x32x16_bf16(pa3,PK(3),o[d0],0,0,0);
    #undef PK
  }
}

__device__ __forceinline__ void pv_pipe(f32x16*o,int vb,bf16x8 pa0,bf16x8 pa1,bf16x8 pa2,bf16x8 pa3){
  s16x4 lo0[4],hi0[4],lo1[4],hi1[4];
  #pragma unroll
  for(int ks=0;ks<4;++ks){
    asm volatile("ds_read_b64_tr_b16 %0,%1 offset:%c2":"=&v"(lo0[ks]):"v"(vb),"i"(ks*1024):"memory");
    asm volatile("ds_read_b64_tr_b16 %0,%1 offset:%c2":"=&v"(hi0[ks]):"v"(vb),"i"(ks*1024+512):"memory");}
  #pragma unroll
  for(int ks=0;ks<4;++ks){
    asm volatile("ds_read_b64_tr_b16 %0,%1 offset:%c2":"=&v"(lo1[ks]):"v"(vb),"i"(4096+ks*1024):"memory");
    asm volatile("ds_read_b64_tr_b16 %0,%1 offset:%c2":"=&v"(hi1[ks]):"v"(vb),"i"(4096+ks*1024+512):"memory");}
  #define PK0(k) (bf16x8){lo0[k][0],lo0[k][1],lo0[k][2],lo0[k][3],hi0[k][0],hi0[k][1],hi0[k][2],hi0[k][3]}
  #define PK1(k) (bf16x8){lo1[k][0],lo1[k][1],lo1[k][2],lo1[k][3],hi1[k][0],hi1[k][1],hi1[k][2],hi1[k][3]}
  asm volatile("s_waitcnt lgkmcnt(8)":::"memory");SBAR();
  o[0]=__builtin_amdgcn_mfma_f32_32x32x16_bf16(pa0,PK0(0),o[0],0,0,0);
  o[0]=__builtin_amdgcn_mfma_f32_32x32x16_bf16(pa1,PK0(1),o[0],0,0,0);
  asm volatile("s_waitcnt lgkmcnt(0)":::"memory");SBAR();
  o[1]=__builtin_amdgcn_mfma_f32_32x32x16_bf16(pa0,PK1(0),o[1],0,0,0);
  o[0]=__builtin_amdgcn_mfma_f32_32x32x16_bf16(pa2,PK0(2),o[0],0,0,0);
  o[1]=__builtin_amdgcn_mfma_f32_32x32x16_bf16(pa1,PK1(1),o[1],0,0,0);
  o[0]=__builtin_amdgcn_mfma_f32_32x32x16_bf16(pa3,PK0(3),o[0],0,0,0);
  o[1]=__builtin_amdgcn_mfma_f32_32x32x16_bf16(pa2,PK1(2),o[1],0,0,0);
  o[1]=__builtin_amdgcn_mfma_f32_32x32x16_bf16(pa3,PK1(3),o[1],0,0,0);
  #undef PK0
  #undef PK1
}
#ifndef ATTN_STORE16
#define ATTN_STORE16(p,v) (*(u32x4*)(p)=(v))
#endif
template<int THRL,int MODE> __device__ __forceinline__ void attn_unit(int b,int qb,const bf16*Q,const bf16*__restrict__ K,const bf16*__restrict__ V,bf16*O,char*shm,const int wv,const float lam,const float oscale,const float eps,const float*sg){
  const int lane=lane_now(),r32=lane&31,hi=lane>>5; const int wid=wv;
  const long rowbase=(long)b*SEQ; const int q0=qb*QB;
  const bf16*Qw=Q+(rowbase+q0+wid*QBLK)*PQ;
  const bf16*Kh=K+rowbase*PQ,*Vh=V+rowbase*PQ;
  const unsigned lds0=(unsigned)(uintptr_t)shm;
  float*wsf=(float*)(shm+LDS_WS)+wid*64;
  const bf16*ksrc=Kh+(long)lane*PQ+wid*8;
  const bf16*vsrc=Vh+(long)(16*(wid&3)+(lane>>2))*PQ+(wid>>2)*32+(lane&3)*8;
  const unsigned kdst=lds0+LDS_K+wid*1024, vdst=lds0+LDS_V+wid*1024;
  #define DMA_K(t,slot) glds16(ksrc+(long)(t)*KVBLK*PQ,(unsigned)__builtin_amdgcn_readfirstlane(kdst+(slot)))
  #define DMA_V(t,slot) do{ glds16(vsrc+(long)(t)*KVBLK*PQ,(unsigned)__builtin_amdgcn_readfirstlane(vdst+2*(slot))); glds16(vsrc+64+(long)(t)*KVBLK*PQ,(unsigned)__builtin_amdgcn_readfirstlane(vdst+2*(slot)+SLOTB)); }while(0)
  const int vb0=(int)(lds0+LDS_V)+((lane>>4)&1)*32+(lane&3)*8+(4*hi+((lane&15)>>2))*64;
  const char*Kbase=shm+LDS_K; bf16x8 kf[8];
  const lds_cptr shm3=(lds_cptr)shm; const lds_cptr kp0=shm3+LDS_K+hi*1024+r32*16; const lds_cptr vp0=shm3+LDS_V+((lane>>4)&1)*32+(lane&3)*8+(4*hi+((lane&15)>>2))*64;
  const int NT=(q0+QB)/KVBLK;
  DMA_K(0,0);DMA_V(0,0);DMA_K(1,SLOTB);
  bf16x8 qr[4];
  #pragma unroll
  for(int d0=0;d0<4;++d0)qr[d0]=*reinterpret_cast<const bf16x8*>(&Qw[(long)r32*PQ+d0*16+hi*8]);
  const lds_cptr qp0=shm3+LDS_OST+wid*4096+hi*512+r32*16;
  #pragma unroll
  for(int d0=0;d0<4;++d0)*(__attribute__((address_space(3))) bf16x8*)(shm3+LDS_OST+wid*4096+hi*512+r32*16+d0*1024)=qr[d0];
  #define QLD(d0) (*(const __attribute__((address_space(3))) bf16x8*)(qp0+(d0)*1024))
  float mhat=0.f,l_reg=0.f;f32x16 o[2],o2[2];o[0]=f32x16{};o[1]=f32x16{};o2[0]=f32x16{};o2[1]=f32x16{};f32x16 negm=f32x16{};asm volatile("":"+v"(negm));
  const int qrel=wid*QBLK+r32;
  #define CMASK(P0,P1,t) do{int jb_=(t)-(NT-4); if(jb_>=0)cmask(P0,P1,jb_,qrel,hi);}while(0)
  bool resc=false;
  #define START(P0,P1) do{ const float rm=rowmax(P0,P1); resc=false; \
    { const float dl=rm; mhat=fadd_s(mhat,dl); \
      _Pragma("unroll") for(int r=0;r<16;++r){P0[r]=fsub_s(P0[r],dl);P1[r]=fsub_s(P1[r],dl);} \
      _Pragma("unroll") for(int r=0;r<16;++r)negm[r]=-mhat; asm volatile("":"+v"(negm)); } \
    _Pragma("unroll") for(int r=0;r<16;++r)P0[r]=__builtin_amdgcn_exp2f(P0[r]); }while(0)
  #define RESC() do{ if(resc){ asm volatile("s_waitcnt lgkmcnt(0)":::"memory"); \
      _Pragma("unroll") for(int d_=0;d_<2;++d_) _Pragma("unroll") for(int r=0;r<16;++r){ const float f_=wsf[crow(r,hi)]; o[d_][r]*=f_; o2[d_][r]*=f_; } } }while(0)
  f32x16 pA0,pA1,pB0,pB1;
  int sl_prev=0,sl_cur=0,sl_next=SLOTB;
  #define ROT() do{sl_prev=sl_cur;sl_cur=sl_next;sl_next=(sl_next==(NSLOT-1)*SLOTB)?0:sl_next+SLOTB;}while(0)
  DMA_K(2,2*SLOTB);
  WAIT_BAR(4);
  qkt(pA0,pA1,Kbase,qr,negm,r32,hi);asm volatile("s_nop 15\n\ts_nop 7":"+v"(pA0),"+v"(pA1));CMASK(pA0,pA1,0);
  START(pA0,pA1);
  _Pragma("unroll") for(int r=0;r<16;++r)pA1[r]=__builtin_amdgcn_exp2f(pA1[r]);
  WAIT_BAR(0);
  DMA_K(3,0);DMA_V(1,SLOTB);
  ROT();
  kload8(kf,kp0+sl_cur);
  WAIT_BAR(3);
  s16x4 vlo[8],vhi[8]; u32x4 pw0,pw1,pw2,pw3;
  #define PKW(P,B) cvtpk_s(P[B],P[B+1])
  #define PAF(k) __builtin_bit_cast(bf16x8,pw##k)
  #define VFR(i) (bf16x8){vlo[i][0],vlo[i][1],vlo[i][2],vlo[i][3],vhi[i][0],vhi[i][1],vhi[i][2],vhi[i][3]}
  #define PIN(x) asm volatile("":"+v"(x))
  #define MX3(a,b,c) __builtin_fmaxf(__builtin_fmaxf((a),(b)),(c))
  #define GAPA(MF,A0,A1,A2,A3,W0,W1,PW) do{ MF; sacc+=A0; sacc+=A1; sacc+=A2; sacc+=A3; PIN(sacc); W0; W1; PIN(PW); SBAR(); }while(0)
  #define EX(v) __builtin_amdgcn_exp2f(v)
  #define GAPB(MF,X,B) do{ MF; X[B]=EX(X[B]); X[B+1]=EX(X[B+1]); X[B+2]=EX(X[B+2]); X[B+3]=EX(X[B+3]); PIN(X); SBAR(); }while(0)
  #define VRD(i) do{ vlo[i]=vtr(vp_+(((i)>>2)*4096+((i)&3)*1024)); vhi[i]=vtr(vp_+(((i)>>2)*4096+((i)&3)*1024+512)); }while(0)
  #define KRD(G,j) do{ if(G){ kload2(kf,kp0+sl_next,j); SBAR(); } }while(0)
  #define STEP(C0,C1,P0,P1,t,GK,GV,GL) do{ SBAR(); \
    const lds_cptr vp_=vp0+2*sl_prev; \
    VRD(0); bf16x8 qa_=QLD(0),qb_=QLD(1); SBAR(); float sacc=(P0[0]+P0[1]); \
    GAPA(C0=__builtin_amdgcn_mfma_f32_32x32x16_bf16(kf[0],qa_,negm,0,0,0), P0[2],P0[3],P0[4],P0[5],     pw0[0]=PKW(P0,0), pw0[1]=PKW(P0,2), pw0); \
    VRD(4); SBAR(); GAPA(C1=__builtin_amdgcn_mfma_f32_32x32x16_bf16(kf[1],qa_,negm,0,0,0), P0[6],P0[7],P0[8],P0[9],     pw0[2]=PKW(P0,4), pw0[3]=PKW(P0,6), pw0); \
    VRD(1); qa_=QLD(2); SBAR(); GAPA(C0=__builtin_amdgcn_mfma_f32_32x32x16_bf16(kf[2],qb_,C0,0,0,0),   P0[10],P0[11],P0[12],P0[13], pw1[0]=PKW(P0,8), pw1[1]=PKW(P0,10), pw1); \
    VRD(5); SBAR(); GAPA(C1=__builtin_amdgcn_mfma_f32_32x32x16_bf16(kf[3],qb_,C1,0,0,0),   P0[14],P0[15],P1[0],P1[1],   pw1[2]=PKW(P0,12),pw1[3]=PKW(P0,14), pw1); \
    VRD(2); qb_=QLD(3); SBAR(); GAPA(C0=__builtin_amdgcn_mfma_f32_32x32x16_bf16(kf[4],qa_,C0,0,0,0),   P1[2],P1[3],P1[4],P1[5],     pw2[0]=PKW(P1,0), pw2[1]=PKW(P1,2), pw2); \
    VRD(6); SBAR(); GAPA(C1=__builtin_amdgcn_mfma_f32_32x32x16_bf16(kf[5],qa_,C1,0,0,0),   P1[6],P1[7],P1[8],P1[9],     pw2[2]=PKW(P1,4), pw2[3]=PKW(P1,6), pw2); \
    VRD(3); SBAR(); GAPA(C0=__builtin_amdgcn_mfma_f32_32x32x16_bf16(kf[6],qb_,C0,0,0,0),   P1[10],P1[11],P1[12],P1[13], pw3[0]=PKW(P1,8), pw3[1]=PKW(P1,10), pw3); \
    VRD(7); SBAR(); GAPA(C1=__builtin_amdgcn_mfma_f32_32x32x16_bf16(kf[7],qb_,C1,0,0,0),   P1[14],P1[15],0.f,0.f,       pw3[2]=PKW(P1,12),pw3[3]=PKW(P1,14), pw3); \
    l_reg+=sacc; \
    if(GK){DMA_K((t)+3,sl_cur);} if(GV){DMA_V((t)+1,sl_next);} \
    CMASK(C0,C1,t); \
    { float a=MX3(C0[0],C0[1],C1[0]),b=MX3(C0[2],C0[3],C1[1]); a=MX3(a,C1[2],C1[3]); \
      _Pragma("unroll") for(int r=4;r<16;r+=4){a=MX3(a,C0[r],C0[r+1]);b=MX3(b,C0[r+2],C0[r+3]);a=MX3(a,C1[r],C1[r+1]);b=MX3(b,C1[r+2],C1[r+3]);} \
      float rm=__builtin_fmaxf(a,b); { auto rr=__builtin_amdgcn_permlane32_swap(__float_as_uint(rm),__float_as_uint(rm),false,false); rm=__builtin_fmaxf(__uint_as_float(rr[0]),__uint_as_float(rr[1])); } \
      resc=false; \
      if(__builtin_expect(__any(rm>(float)THRL),0)){ const float dl=__builtin_fmaxf(rm,0.f); mhat+=dl; \
        _Pragma("unroll") for(int r=0;r<16;++r){C0[r]-=dl;C1[r]-=dl;} \
        _Pragma("unroll") for(int r=0;r<16;++r)negm[r]=-mhat; asm volatile("":"+v"(negm)); \
        const float f=__builtin_amdgcn_exp2f(-dl); l_reg*=f; { const int l2_=lane_now(); if(l2_<32)((__attribute__((address_space(3))) float*)(shm3+LDS_WS))[wid*64+l2_]=f; } resc=true; } } \
    SBAR(); \
    GAPB(o[0]=__builtin_amdgcn_mfma_f32_32x32x16_bf16(PAF(0),VFR(0),o[0],0,0,0), C0,0); \
    GAPB(o[1]=__builtin_amdgcn_mfma_f32_32x32x16_bf16(PAF(0),VFR(4),o[1],0,0,0), C0,4); \
    KRD(GL,0); GAPB(o[0]=__builtin_amdgcn_mfma_f32_32x32x16_bf16(PAF(1),VFR(1),o[0],0,0,0), C0,8); \
    KRD(GL,1); GAPB(o[1]=__builtin_amdgcn_mfma_f32_32x32x16_bf16(PAF(1),VFR(5),o[1],0,0,0), C0,12); \
    KRD(GL,2); GAPB(o[0]=__builtin_amdgcn_mfma_f32_32x32x16_bf16(PAF(2),VFR(2),o[0],0,0,0), C1,0); \
    KRD(GL,3); GAPB(o[1]=__builtin_amdgcn_mfma_f32_32x32x16_bf16(PAF(2),VFR(6),o[1],0,0,0), C1,4); \
    GAPB(o[0]=__builtin_amdgcn_mfma_f32_32x32x16_bf16(PAF(3),VFR(3),o[0],0,0,0), C1,8); \
    GAPB(o[1]=__builtin_amdgcn_mfma_f32_32x32x16_bf16(PAF(3),VFR(7),o[1],0,0,0), C1,12); \
    pv_pipe(o2,vb0+2*sl_prev+SLOTB,PAF(0),PAF(1),PAF(2),PAF(3)); SBAR();     \
    }while(0)
  int t=1;
  #undef CMASK
  #define CMASK(P0,P1,t) do{}while(0)
  for(;t+5<NT;t+=2){
    STEP(pB0,pB1,pA0,pA1,t,true,true,true);     WAIT_BAR(3); RESC(); ROT();
    STEP(pA0,pA1,pB0,pB1,t+1,true,true,true);   WAIT_BAR(3); RESC(); ROT();
  }
  #undef CMASK
  int qrelb=qrel; asm volatile("":"+v"(qrelb));
  #define CMASK(P0,P1,t) do{int jb_=(t)-(NT-4); if(jb_>=0)cmask(P0,P1,jb_,qrelb,hi);}while(0)
  #define ENDW(tt) do{ if((tt)+3<NT){WAIT_BAR(3);} else if((tt)+2<NT){WAIT_BAR(2);} else {WAIT_BAR(0);} }while(0)
  for(;t+1<NT;t+=2){
    STEP(pB0,pB1,pA0,pA1,t,(t+3<NT),(t+1<NT),(t+1<NT));       ENDW(t);   RESC(); ROT();
    STEP(pA0,pA1,pB0,pB1,t+1,(t+4<NT),(t+2<NT),(t+2<NT));     ENDW(t+1); RESC(); ROT();
  }
  STEP(pB0,pB1,pA0,pA1,NT-1,false,false,false); RESC();
  { float sacc=pB0[0]+pB0[1]; _Pragma("unroll") for(int r=2;r<16;++r)sacc+=pB0[r]; _Pragma("unroll") for(int r=0;r<16;++r)sacc+=pB1[r]; l_reg+=sacc;
    pw0=(u32x4){PKW(pB0,0),PKW(pB0,2),PKW(pB0,4),PKW(pB0,6)};pw1=(u32x4){PKW(pB0,8),PKW(pB0,10),PKW(pB0,12),PKW(pB0,14)};pw2=(u32x4){PKW(pB1,0),PKW(pB1,2),PKW(pB1,4),PKW(pB1,6)};pw3=(u32x4){PKW(pB1,8),PKW(pB1,10),PKW(pB1,12),PKW(pB1,14)};
    SBAR(); { const int l3_=lane_now(); const int vb3_=(int)(lds0+LDS_V)+((l3_>>4)&1)*32+(l3_&3)*8+(4*(l3_>>5)+((l3_&15)>>2))*64;
      pv(o,vb3_+2*sl_cur,PAF(0),PAF(1),PAF(2),PAF(3)); pv(o2,vb3_+2*sl_cur+SLOTB,PAF(0),PAF(1),PAF(2),PAF(3)); } }
  #undef PKW
  #undef PAF
  #undef VFR
  #undef PIN
  #undef MX3
  #undef GAPA
  #undef GAPB
  #undef EX
  #undef VRD
  #undef KRD
  #undef STEP
  #undef ENDW
  {auto rr=__builtin_amdgcn_permlane32_swap(__float_as_uint(l_reg),__float_as_uint(l_reg),false,false);l_reg=__uint_as_float(rr[0])+__uint_as_float(rr[1]);}
  { const int le=lane_now(),r32e=le&31,hie=le>>5; float*wse=(float*)(shm+LDS_WS)+wid*64;
  if(hie==0)wse[32+r32e]=l_reg;asm volatile("s_waitcnt lgkmcnt(0)":::"memory");
  float rli[16];
  #pragma unroll
  for(int r=0;r<16;++r)rli[r]=__builtin_amdgcn_rcpf(wse[32+crow(r,hie)]);
  bf16*Ow=O+(rowbase+q0+wid*QBLK)*PO;
  { bf16*stg=(bf16*)(shm+LDS_OST)+wid*2048;
    float yv[2][4][8];
    #pragma unroll
    for(int half=0;half<2;++half){
      #pragma unroll
      for(int r=0;r<16;++r){const int orow=crow(r,hie);
        #pragma unroll
        for(int d0=0;d0<2;++d0)stg[orow*64+d0*32+r32e]=__float2bfloat16((half?o2[d0][r]:o[d0][r])*rli[r]);}
      asm volatile("s_waitcnt lgkmcnt(0)":::"memory");
      #pragma unroll
      for(int i=0;i<4;++i){const int row=i*8+(le>>3),ch=le&7; const u32x4 v=*(const u32x4*)(stg+row*64+ch*8);
        if(MODE==0){ ATTN_STORE16(Ow+(long)row*PO+half*64+ch*8,v); }
        else{ const u32x4 w=*(const u32x4*)(Ow+(long)row*PO+half*64+ch*8);
          #pragma unroll
          for(int e=0;e<4;++e){ yv[half][i][2*e]=__uint_as_float(w[e]<<16)-lam*__uint_as_float(v[e]<<16); yv[half][i][2*e+1]=__uint_as_float(w[e]&0xffff0000u)-lam*__uint_as_float(v[e]&0xffff0000u); } } }
      asm volatile("s_waitcnt lgkmcnt(0)":::"memory"); }
    if(MODE==1){ const int ch=le&7; float gg[2][8];
      #pragma unroll
      for(int half=0;half<2;++half)
        #pragma unroll
        for(int e=0;e<8;++e)gg[half][e]=sg[half*64+ch*8+e]*oscale;
      #pragma unroll
      for(int i=0;i<4;++i){ float ss=0.f;
        #pragma unroll
        for(int half=0;half<2;++half)
          #pragma unroll
          for(int e=0;e<8;++e)ss+=yv[half][i][e]*yv[half][i][e];
        ss+=__builtin_bit_cast(float,__builtin_amdgcn_update_dpp(0,__builtin_bit_cast(int,ss),0xB1,0xF,0xF,false));
        ss+=__builtin_bit_cast(float,__builtin_amdgcn_update_dpp(0,__builtin_bit_cast(int,ss),0x4E,0xF,0xF,false));
        ss+=__builtin_bit_cast(float,__builtin_amdgcn_update_dpp(0,__builtin_bit_cast(int,ss),0x141,0xF,0xF,false));
        const float rs=__builtin_amdgcn_rsqf(ss*(1.f/128.f)+eps); const int row=i*8+(le>>3);
        #pragma unroll
        for(int half=0;half<2;++half){ u32x4 ov;
          #pragma unroll
          for(int e=0;e<4;++e)ov[e]=cvtpk_s(yv[half][i][2*e]*rs*gg[half][2*e],yv[half][i][2*e+1]*rs*gg[half][2*e+1]);
          ATTN_STORE16(Ow+(long)row*PO+half*64+ch*8,ov); } } } } }
  asm volatile("s_waitcnt lgkmcnt(0)\n\ts_barrier":::"memory");
  #undef DMA_K
  #undef DMA_V
  #undef QLD
  #undef CMASK
  #undef START
  #undef RESC
  #undef ROT
}
constexpr int ATTN_LDS_BYTES=LDS_BYTES;
struct AttnTensors { const bf16* Q; const bf16* K; const bf16* V; bf16* O; float lam, oscale, eps; const float* sg; };
struct AttnUnit { int b; int h; int qb; };
struct StaticOrder {
  int vcu, G;
  __device__ __forceinline__ StaticOrder(int grid,int vcu_):vcu(vcu_),G(grid){}
  __device__ __forceinline__ bool next(int i,AttnUnit&u)const{
    if(G==256){ if(i>=2)return false; const int s=vcu&7,bv=vcu>>3; u.b=bv>>2; u.h=bv&3; u.qb=(i==0)?s:15-s; return true; }
    const int L=i*G+vcu; if(L>=BATCH*4*NQB)return false; u.b=L/(4*NQB); u.h=(L/NQB)%4; u.qb=L%NQB; return true; }
};
template<class Sched,int THRL=8> __device__ __forceinline__ void attn_phase(char*lds,const AttnTensors&T,const Sched&S,const int wv){
  AttnUnit u;
  for(int i=0;S.next(i,u);++i){ const int h=u.h;
    attn_unit<THRL,0>(u.b,u.qb,T.Q+(2*h)*64,T.K+(2*h)*64,T.V+h*128,T.O+h*128,lds,wv,T.lam,T.oscale,T.eps,T.sg);
    attn_unit<THRL,1>(u.b,u.qb,T.Q+(2*h+1)*64,T.K+(2*h+1)*64,T.V+h*128,T.O+h*128,lds,wv,T.lam,T.oscale,T.eps,T.sg); }
}
#undef SBAR
#undef WAIT_BAR
}

constexpr int NWAVES = 8;
#ifndef MK_N_LAUNCHES
#define MK_N_LAUNCHES 1
#endif
constexpr int NPHASE = 13;
constexpr int N_LAUNCHES = MK_N_LAUNCHES;

constexpr int BATCH = 8, SEQ = 4096, D = 1024, M = BATCH * SEQ;
constexpr int NPROJ = 3072;
constexpr int C_DQ = 0, C_DK = 512, C_DV = 1024, C_MQ = 1536, C_MK = 2048, C_MO = 2560;
constexpr int MEMLEN = 256, MROWS = BATCH * MEMLEN;
constexpr int NEXP = 32, DEXP = 512, MAXROWS = 73728;
constexpr int NCH = 64, CHL = 64, DVX = 144;
constexpr int CS_UNIT = DVX * 128;
constexpr float EPS = 1e-6f;
constexpr float LAM_INIT = 0.2f;
constexpr float XSCALE = 0.0625f * 1.4426950408889634f;

constexpr size_t MiB = 1u << 20;
constexpr size_t WS_CTL = 0, CTL_ZERO_BYTES = 1 * MiB;
constexpr size_t WS_GATE = 2 * MiB, WS_ROPE = 3 * MiB, WS_ACUM = 4 * MiB, WS_USUB = 4 * MiB + 512 * 1024, WS_SC = 5 * MiB;
constexpr size_t WS_RT = 5 * MiB + 768 * 1024;
constexpr size_t WS_RSTD2 = 5 * MiB + 512 * 1024;
constexpr size_t WS_TOKL = 6 * MiB, WS_ASG = 10 * MiB, WS_MEMN = 12 * MiB, WS_MK = 16 * MiB, WS_MVT2 = 20 * MiB;
constexpr size_t WS_WIN = 24 * MiB, WS_WOUT = 31 * MiB, WS_WXQ = 33 * MiB, WS_WKV = 35 * MiB, WS_WXO = 39 * MiB, WS_W13 = 41 * MiB, WS_W2 = 105 * MiB;
constexpr size_t WS_PROJ = 140 * MiB;
constexpr size_t WS_MVT = 332 * MiB;
constexpr size_t WS_XB = 140 * MiB, WS_XQ = 204 * MiB, WS_XO = 268 * MiB;
constexpr size_t WS_H3 = 204 * MiB, WS_ACT = 268 * MiB, WS_YE = 340 * MiB;
constexpr size_t WS_FOLD = 432 * MiB;
constexpr size_t WS_OA = 364 * MiB;
constexpr size_t WS_END = 484 * MiB;
static_assert(WS_YE + (size_t)MAXROWS * 1024 * 2 <= WS_END && WS_ACT + (size_t)MAXROWS * 512 * 2 <= WS_YE && WS_PROJ + (size_t)M * NPROJ * 2 <= WS_MVT && WS_MVT + (size_t)512 * M * 2 <= WS_OA, "d_ws map");
constexpr int CW_TMO = 0, CW_CODE = 1, CW_CNT = 1024, CW_ROWSS = 16384, CW_READY = 49152, CW_BAR = 65536;
constexpr int RING_OFF = 0, RING_BYTES = 131072;
constexpr int XT_TS = 131072, XT_TOK = 131072 + 256, XT_RS = XT_TOK + 5 * 1024;
constexpr int LDSCTL_OFF = 158720, MISC_OFF = LDSCTL_OFF + 320;
constexpr int LDS_BYTES = 159744;
static_assert(MISC_OFF + 128 <= LDS_BYTES, "LDS map");

#define GAS __attribute__((address_space(1)))
#define LAS __attribute__((address_space(3)))
typedef unsigned short bf16;
typedef unsigned v4u __attribute__((ext_vector_type(4)));
typedef float f32x4 __attribute__((ext_vector_type(4)));
typedef short bf16x8 __attribute__((ext_vector_type(8)));
typedef GAS unsigned gu32;
typedef GAS unsigned long long gu64;
#define RLX_AGENT __ATOMIC_RELAXED, __HIP_MEMORY_SCOPE_AGENT
#define LDS_WAIT() asm volatile("s_waitcnt lgkmcnt(0)" ::: "memory")
#define VM_WAIT() asm volatile("s_waitcnt vmcnt(0)" ::: "memory")
__device__ __forceinline__ unsigned long long rt() { return __builtin_amdgcn_s_memrealtime(); }
__device__ __forceinline__ unsigned f2bf(float f) { unsigned u = __builtin_bit_cast(unsigned, f); return (u + 0x7fffu + ((u >> 16) & 1u)) >> 16; }
typedef float f32x2_t_ __attribute__((ext_vector_type(2))); typedef __bf16 bf16x2_t_ __attribute__((ext_vector_type(2)));
__device__ __forceinline__ unsigned pk2(float lo, float hi) { f32x2_t_ v = {lo, hi}; bf16x2_t_ b = __builtin_convertvector(v, bf16x2_t_); return __builtin_bit_cast(unsigned, b); }

#define XB_TMO      128
#define XB_XCNT(j)  (256  + 64 * (j))
#define XB_XSUB(j)  (1280 + 64 * (j))
#define XB_XGEN(j)  (2304 + 64 * (j))
#define XB_TOP      3328
#define XB_TOPGEN   3392
#define XCD_BAR_WORDS 3456
#define XB_SPIN_CAP (1u << 18)

__device__ __forceinline__ unsigned xb_ld(unsigned* p)              { return __hip_atomic_load(p, __ATOMIC_RELAXED, __HIP_MEMORY_SCOPE_AGENT); }
__device__ __forceinline__ unsigned xb_add(unsigned* p, unsigned v) { return __hip_atomic_fetch_add(p, v, __ATOMIC_RELAXED, __HIP_MEMORY_SCOPE_AGENT); }
__device__ __forceinline__ unsigned xb_xcc_id() { return (unsigned)__builtin_amdgcn_s_getreg((3 << 11) | 20) & 0xFu; }
#define XB_SPIN(cond, bar) do { unsigned _sp = 0; while (cond) { __builtin_amdgcn_s_sleep(1); \
    if ((++_sp & 255u) == 0u) { if (xb_ld(&(bar)[XB_TMO])) break; if (_sp > XB_SPIN_CAP) { atomicAdd(&(bar)[XB_TMO], 1u); break; } } } } while (0)

struct XcdBarrier {
    unsigned* bar; unsigned x;
    volatile LAS unsigned* st;
};

__device__ __forceinline__ XcdBarrier xcd_barrier_post(unsigned* bar, volatile LAS unsigned* st) {
    XcdBarrier b; b.bar = bar; b.x = xb_xcc_id(); b.st = st;
    if (threadIdx.x == 0) (void)xb_add(&bar[XB_XCNT(b.x)], 1u);
    return b;
}
__device__ __forceinline__ void xcd_barrier_complete(unsigned* bar, unsigned x, unsigned& nloc, unsigned& nx) {
    const unsigned G = gridDim.x * gridDim.y * gridDim.z;
    unsigned sum, cnt, mine, sp = 0u;
    for (;;) {
        sum = 0u; cnt = 0u; mine = 0u;
#pragma unroll
        for (unsigned j = 0; j < 16; ++j) { const unsigned c = xb_ld(&bar[XB_XCNT(j)]); sum += c; cnt += (c > 0u) ? 1u : 0u; mine = (j == x) ? c : mine; }
        if (sum == G) break;
        __builtin_amdgcn_s_sleep(1);
        if ((++sp & 255u) == 0u) { if (xb_ld(&bar[XB_TMO])) break; if (sp > XB_SPIN_CAP) { atomicAdd(&bar[XB_TMO], 1u); break; } }
    }
    nloc = mine > 0u ? mine : 1u; nx = cnt > 0u ? cnt : 1u;
}

__device__ __forceinline__ void xcd_barrier(const XcdBarrier& b, const int wv) {
    asm volatile("s_waitcnt vmcnt(0)" ::: "memory");
    __syncthreads();
    if (wv == 0 && lane_now() == 0) {
        unsigned* bar = b.bar;
        __builtin_amdgcn_s_waitcnt(0);
        unsigned nloc = b.st[0], nx = b.st[1];
        if (nloc == 0u) { xcd_barrier_complete(bar, b.x, nloc, nx); b.st[0] = nloc; b.st[1] = nx; }
        const unsigned old = xb_add(&bar[XB_XSUB(b.x)], 1u);
        const unsigned gen = old / nloc;
        if (old + 1u == (gen + 1u) * nloc) {
            __builtin_amdgcn_fence(__ATOMIC_RELEASE, "agent");
            asm volatile("s_waitcnt vmcnt(0)" ::: "memory");
            const unsigned og = xb_add(&bar[XB_TOP], 1u);
            const unsigned tg = og / nx;
            if (og + 1u == (tg + 1u) * nx) xb_add(&bar[XB_TOPGEN], 1u);
            else XB_SPIN(xb_ld(&bar[XB_TOPGEN]) == tg, bar);
            __builtin_amdgcn_fence(__ATOMIC_ACQUIRE, "agent");
            xb_add(&bar[XB_XGEN(b.x)], 1u);
            asm volatile("s_waitcnt vmcnt(0)" ::: "memory");
        } else {
            XB_SPIN(xb_ld(&bar[XB_XGEN(b.x)]) == gen, bar);
            __builtin_amdgcn_fence(__ATOMIC_ACQUIRE, "agent");
            asm volatile("s_waitcnt vmcnt(0)" ::: "memory");
        }
    }
    __syncthreads();
}


typedef unsigned u32x2 __attribute__((ext_vector_type(2))); typedef unsigned u32x4 __attribute__((ext_vector_type(4)));
struct Frame {
    LAS unsigned char* lds;
    volatile LAS unsigned* MISC;
    gu32* ctl;
    int wave;
    int vcu, G;
    const float* in[26]; float* out; unsigned char* ws;
};
#ifndef PRIM_RED
#define PRIM_RED 1
#define PRIM_ROW 1
#define PRIM_SCAN 1
#define PRIM_MATH 1
#endif
#define DPPF(old_, v_, ctrl, rm) __builtin_bit_cast(float, __builtin_amdgcn_update_dpp(__builtin_bit_cast(int, (float)(old_)), __builtin_bit_cast(int, (float)(v_)), ctrl, rm, 0xF, false))
#if PRIM_RED
__device__ __forceinline__ float wave_sum(float v) {
    v += DPPF(0.f, v, 0xB1, 0xF); v += DPPF(0.f, v, 0x4E, 0xF); v += DPPF(0.f, v, 0x141, 0xF); v += DPPF(0.f, v, 0x140, 0xF);
    { auto r = __builtin_amdgcn_permlane16_swap(__float_as_uint(v), __float_as_uint(v), false, false); v = __uint_as_float(r[0]) + __uint_as_float(r[1]); }
    { auto r = __builtin_amdgcn_permlane32_swap(__float_as_uint(v), __float_as_uint(v), false, false); v = __uint_as_float(r[0]) + __uint_as_float(r[1]); }
    return v;
}
__device__ __forceinline__ float wave_max(float v) {
    v = fmaxf(v, DPPF(v, v, 0xB1, 0xF)); v = fmaxf(v, DPPF(v, v, 0x4E, 0xF)); v = fmaxf(v, DPPF(v, v, 0x141, 0xF)); v = fmaxf(v, DPPF(v, v, 0x140, 0xF));
    { auto r = __builtin_amdgcn_permlane16_swap(__float_as_uint(v), __float_as_uint(v), false, false); v = fmaxf(__uint_as_float(r[0]), __uint_as_float(r[1])); }
    { auto r = __builtin_amdgcn_permlane32_swap(__float_as_uint(v), __float_as_uint(v), false, false); v = fmaxf(__uint_as_float(r[0]), __uint_as_float(r[1])); }
    return v;
}
#else
__device__ __forceinline__ float wave_sum(float v) { for (int o = 1; o < 64; o <<= 1) v += __shfl_xor(v, o); return v; }
__device__ __forceinline__ float wave_max(float v) { for (int o = 1; o < 64; o <<= 1) v = fmaxf(v, __shfl_xor(v, o)); return v; }
#endif
#if PRIM_ROW
__device__ __forceinline__ float row8_sum(float v) { v += DPPF(0.f, v, 0xB1, 0xF); v += DPPF(0.f, v, 0x4E, 0xF); v += DPPF(0.f, v, 0x141, 0xF); return v; }
__device__ __forceinline__ float row16_sum(float v) { v += DPPF(0.f, v, 0xB1, 0xF); v += DPPF(0.f, v, 0x4E, 0xF); v += DPPF(0.f, v, 0x141, 0xF); v += DPPF(0.f, v, 0x140, 0xF); return v; }
#else
__device__ __forceinline__ float row16_sum(float v) { v += __shfl_xor(v, 1); v += __shfl_xor(v, 2); v += __shfl_xor(v, 4); v += __shfl_xor(v, 8); return v; }
__device__ __forceinline__ float row8_sum(float v) { v += __shfl_xor(v, 1); v += __shfl_xor(v, 2); v += __shfl_xor(v, 4); return v; }
#endif
#if PRIM_SCAN
__device__ __forceinline__ float wave_scan_sum(float v) {
    v += DPPF(0.f, v, 0x111, 0xF); v += DPPF(0.f, v, 0x112, 0xF); v += DPPF(0.f, v, 0x114, 0xF); v += DPPF(0.f, v, 0x118, 0xF);
    v += DPPF(0.f, v, 0x142, 0xA); v += DPPF(0.f, v, 0x143, 0xC); return v;
}
__device__ __forceinline__ float wave_scan_max(float v) {
    const float NI = -INFINITY;
    v = fmaxf(v, DPPF(NI, v, 0x111, 0xF)); v = fmaxf(v, DPPF(NI, v, 0x112, 0xF)); v = fmaxf(v, DPPF(NI, v, 0x114, 0xF)); v = fmaxf(v, DPPF(NI, v, 0x118, 0xF));
    v = fmaxf(v, DPPF(NI, v, 0x142, 0xA)); v = fmaxf(v, DPPF(NI, v, 0x143, 0xC)); return v;
}
#else
__device__ __forceinline__ float wave_scan_sum(float v) { const int l = lane_now(); for (int o = 1; o < 64; o <<= 1) { const float t = __shfl_up(v, o); if (l >= o) v += t; } return v; }
__device__ __forceinline__ float wave_scan_max(float v) { const int l = lane_now(); for (int o = 1; o < 64; o <<= 1) { const float t = __shfl_up(v, o); if (l >= o) v = fmaxf(v, t); } return v; }
#endif
#if PRIM_MATH
__device__ __forceinline__ float fexp(float x) { return __builtin_amdgcn_exp2f(x * 1.4426950408889634f); }
__device__ __forceinline__ float fsigmoid(float x) { return __builtin_amdgcn_rcpf(1.f + __builtin_amdgcn_exp2f(-1.4426950408889634f * x)); }
__device__ __forceinline__ float frsq(float x) { return __builtin_amdgcn_rsqf(x); }
#else
__device__ __forceinline__ float fexp(float x) { return expf(x); }
__device__ __forceinline__ float fsigmoid(float x) { return 1.f / (1.f + expf(-x)); }
__device__ __forceinline__ float frsq(float x) { return 1.f / sqrtf(x); }
#endif
__device__ __forceinline__ float bf2f(unsigned short b) { return __uint_as_float((unsigned)b << 16); }
__device__ __forceinline__ float bflo(unsigned w) { return __uint_as_float(w << 16); }
__device__ __forceinline__ float bfhi(unsigned w) { return __uint_as_float(w & 0xffff0000u); }
__device__ __forceinline__ float dot4(f32x4 a, f32x4 b) { return (a.x * b.x + a.y * b.y) + (a.z * b.z + a.w * b.w); }
#define WG_SYNC() __syncthreads()

struct RowMap { int mode, off;
    __device__ __forceinline__ int operator()(int n) const {
        if (mode == 1) return (n < 1024) ? ((n & ~255) | (((n >> 5) & 1) << 7) | (((n >> 6) & 3) << 5) | (n & 31)) : (n < 2560) ? n : (n < 3072) ? n + 512 : n - 512;
        if (mode == 2) return ((n >> 7) << 8) + off + (n & 127);
        return off + n; } };
struct TrItem { const float* W; bf16* WT; const float* ks; int K, ldw, nblk, local; RowMap rm; };
__device__ __forceinline__ void tr_load(const TrItem& t, int lane, f32x4 (&x)[8]) {
    const int kb = t.local / t.nblk, nb = t.local % t.nblk, k0 = 64 * kb, n0 = 32 * nb;
#pragma unroll
    for (int i = 0; i < 8; ++i) x[i] = __builtin_nontemporal_load((const GAS f32x4*)(t.W + (size_t)(k0 + 8 * i + (lane >> 3)) * t.ldw + n0 + 4 * (lane & 7)));
}
__device__ __forceinline__ void tr_finish(const TrItem& t, int lane, const f32x4 (&x)[8], LAS float* scr) {
    const int kb = t.local / t.nblk, nb = t.local % t.nblk, k0 = 64 * kb, n0 = 32 * nb;
#pragma unroll
    for (int i = 0; i < 8; ++i) { LAS float* d = scr + (8 * i + (lane >> 3)) * 33 + 4 * (lane & 7); d[0] = x[i].x; d[1] = x[i].y; d[2] = x[i].z; d[3] = x[i].w; }
    LDS_WAIT(); asm volatile("" ::: "memory");
    const int c = lane & 7;
    f32x4 ks0 = {1.f, 1.f, 1.f, 1.f}, ks1 = ks0;
    if (t.ks) { ks0 = *(const GAS f32x4*)(t.ks + k0 + 8 * c); ks1 = *(const GAS f32x4*)(t.ks + k0 + 8 * c + 4); }
#pragma unroll
    for (int j = 0; j < 4; ++j) { const int n = (lane >> 3) + 8 * j; const LAS float* s = scr + (8 * c) * 33 + n;
        v4u o; o.x = pk2(s[0 * 33] * ks0.x, s[1 * 33] * ks0.y); o.y = pk2(s[2 * 33] * ks0.z, s[3 * 33] * ks0.w); o.z = pk2(s[4 * 33] * ks1.x, s[5 * 33] * ks1.y); o.w = pk2(s[6 * 33] * ks1.z, s[7 * 33] * ks1.w);
        GAS v4u* dst_ = (GAS v4u*)(t.WT + (size_t)t.rm(n0 + n) * t.K + k0 + 8 * c);
        if (t.rm.mode == 2) __builtin_nontemporal_store(o, dst_); else *dst_ = o; }
    LDS_WAIT(); asm volatile("" ::: "memory");
}
__device__ __forceinline__ void p0_transpose_item(const float* W, int K, int ldw, int nblk, bf16* WT, const RowMap rm, const float* kscale, LAS float* scr, int item, int lane) {
    TrItem t{W, WT, kscale, K, ldw, nblk, item, rm}; f32x4 x[8]; tr_load(t, lane, x); tr_finish(t, lane, x, scr);
}
__device__ __forceinline__ void rms_row(const int lane, f32x4 (&v)[4], const float* g, bf16* orow, const LAS float* gw, float* gate_out, const float* gate_b) {
    const GAS f32x4* gr = (const GAS f32x4*)g + 2 * lane;
    float s = 0.f;
#pragma unroll
    for (int j = 0; j < 4; ++j) s += dot4(v[j], v[j]);
    const float rstd = frsq(wave_sum(s) * (1.f / D) + EPS);
    v[0] = v[0] * rstd * gr[0]; v[1] = v[1] * rstd * gr[1]; v[2] = v[2] * rstd * gr[128]; v[3] = v[3] * rstd * gr[129];
    GAS v4u* o16 = (GAS v4u*)orow + lane; v4u o;
    o.x = pk2(v[0].x, v[0].y); o.y = pk2(v[0].z, v[0].w); o.z = pk2(v[1].x, v[1].y); o.w = pk2(v[1].z, v[1].w); o16[0] = o;
    o.x = pk2(v[2].x, v[2].y); o.y = pk2(v[2].z, v[2].w); o.z = pk2(v[3].x, v[3].y); o.w = pk2(v[3].z, v[3].w); o16[64] = o;
    if (gw) {
        float mine = 0.f;
#pragma unroll
        for (int q = 0; q < 8; ++q) { const LAS float* wp = gw + q * 1024 + 8 * lane;
            float a = (dot4(v[0], *(const LAS f32x4*)(wp)) + dot4(v[1], *(const LAS f32x4*)(wp + 4))) + (dot4(v[2], *(const LAS f32x4*)(wp + 512)) + dot4(v[3], *(const LAS f32x4*)(wp + 516)));
            a = wave_sum(a); mine = (lane == q) ? a : mine; }
        if (lane < 8) gate_out[lane] = mine + gate_b[lane];
    }
}
__device__ __forceinline__ void sincos_acc(float ang, float& sn, float& cs) {
    const double a = (double)ang; const double q = rint(a * 0.63661977236758134308); const double z = a - q * 1.57079632679489661923;
    const double z2 = z * z;
    const double sp = z * (1.0 + z2 * (-1.0 / 6 + z2 * (1.0 / 120 + z2 * (-1.0 / 5040 + z2 * (1.0 / 362880 + z2 * (-1.0 / 39916800 + z2 * (1.0 / 6227020800.0)))))));
    const double cp = 1.0 + z2 * (-0.5 + z2 * (1.0 / 24 + z2 * (-1.0 / 720 + z2 * (1.0 / 40320 + z2 * (-1.0 / 3628800 + z2 * (1.0 / 479001600.0 + z2 * (-1.0 / 87178291200.0)))))));
    const int qi = ((int)(long long)q) & 3;
    const double s_ = (qi == 0) ? sp : (qi == 1) ? cp : (qi == 2) ? -sp : -cp;
    const double c_ = (qi == 0) ? cp : (qi == 1) ? -sp : (qi == 2) ? -cp : sp;
    sn = (float)s_; cs = (float)c_;
}
__device__ __forceinline__ void p0_prologue(Frame& F) {
    const int lane = lane_now(), wave = F.wave, tid = wave * 64 + lane; (void)tid; (void)lane; (void)wave;
    const int gw = F.vcu * NWAVES + wave, NGW = F.G * NWAVES;
    LAS float* scr = (LAS float*)(F.lds + wave * 8704);
    LAS float* gwt = (LAS float*)(F.lds + 69632);
    for (int i = tid; i < 8192; i += NWAVES * 64) { const int k = i >> 3, q = i & 7; gwt[q * 1024 + k] = F.in[3][(size_t)k * 3592 + 3584 + q]; }
    WG_SYNC();
    bf16* wsb = (bf16*)F.ws;
    constexpr int I_IN = 16 * 112, I_SQ = 16 * 32, I_E = 32 * 256;
    constexpr int NITEMS = I_IN + 4 * I_SQ + 2 * I_E;
    auto decode = [&](int it) -> TrItem { int r = it;
        if (r < I_IN) return TrItem{F.in[3], (bf16*)(F.ws + WS_WIN), nullptr, D, 3592, 112, r, RowMap{1, 0}}; r -= I_IN;
        if (r < I_SQ) return TrItem{F.in[4], (bf16*)(F.ws + WS_WOUT), nullptr, D, D, 32, r, RowMap{0, 0}}; r -= I_SQ;
        if (r < I_SQ) return TrItem{F.in[14], (bf16*)(F.ws + WS_WKV), nullptr, D, D, 32, r, RowMap{0, 0}}; r -= I_SQ;
        if (r < I_SQ) return TrItem{F.in[15], (bf16*)(F.ws + WS_WKV), nullptr, D, D, 32, r, RowMap{0, 1024}}; r -= I_SQ;
        if (r < I_SQ) return TrItem{F.in[16], (bf16*)(F.ws + WS_WXO), nullptr, D, D, 32, r, RowMap{0, 0}}; r -= I_SQ;
        if (r < I_E) { const int e = r >> 8; return TrItem{F.in[22] + (size_t)e * D * DEXP, (bf16*)(F.ws + WS_W13) + (size_t)e * D * D, F.in[17], D, DEXP, 16, r & 255, RowMap{2, 0}}; } r -= I_E;
        { const int e = r >> 8; return TrItem{F.in[23] + (size_t)e * D * DEXP, (bf16*)(F.ws + WS_W13) + (size_t)e * D * D, F.in[17], D, DEXP, 16, r & 255, RowMap{2, 128}}; } };
    { f32x4 xa[8], xb[8];
      int it = gw; if (it < NITEMS) { const TrItem t0 = decode(it); tr_load(t0, lane, xa); }
      for (; it < NITEMS; it += 2 * NGW) {
          const TrItem ta = decode(it); const bool hb = it + NGW < NITEMS; TrItem tb = ta; if (hb) { tb = decode(it + NGW); tr_load(tb, lane, xb); }
          tr_finish(ta, lane, xa, scr);
          if (it + 2 * NGW < NITEMS) { const TrItem tc = decode(it + 2 * NGW); tr_load(tc, lane, xa); }
          if (hb) tr_finish(tb, lane, xb, scr); } }
    (void)wsb;
    { f32x4 nx[4];
#define P0_LOADROW(base, m_) do { const GAS f32x4* xr_ = (const GAS f32x4*)((base) + (size_t)(m_) * D) + 2 * lane; nx[0] = __builtin_nontemporal_load(xr_); nx[1] = __builtin_nontemporal_load(xr_ + 1); nx[2] = __builtin_nontemporal_load(xr_ + 128); nx[3] = __builtin_nontemporal_load(xr_ + 129); } while (0)
      if (gw < M) P0_LOADROW(F.in[0], gw);
      for (int m = gw; m < M; m += NGW) { f32x4 v[4] = {nx[0], nx[1], nx[2], nx[3]}; if (m + NGW < M) P0_LOADROW(F.in[0], m + NGW);
          rms_row(lane, v, F.in[2], (bf16*)F.out + (size_t)m * D, gwt, (float*)(F.ws + WS_GATE) + (size_t)m * 8, F.in[9]); }
      for (int m = gw; m < MROWS; m += NGW) { P0_LOADROW(F.in[1], m); f32x4 v[4] = {nx[0], nx[1], nx[2], nx[3]}; rms_row(lane, v, F.in[12], (bf16*)(F.ws + WS_MEMN) + (size_t)m * D, nullptr, nullptr, nullptr); }
#undef P0_LOADROW
    }
    for (int i = F.vcu * (NWAVES * 64) + tid; i < D * D / 8; i += F.G * NWAVES * 64) { const int k = i >> 7, c8 = i & 127; const float gk = F.in[11][k];
        const GAS f32x4* s = (const GAS f32x4*)(F.in[13] + (size_t)k * D + c8 * 8); const f32x4 a = __builtin_nontemporal_load(s), b = __builtin_nontemporal_load(s + 1);
        v4u o; o.x = pk2(a.x * gk, a.y * gk); o.y = pk2(a.z * gk, a.w * gk); o.z = pk2(b.x * gk, b.y * gk); o.w = pk2(b.z * gk, b.w * gk); *(GAS v4u*)((bf16*)(F.ws + WS_WXQ) + (size_t)k * D + c8 * 8) = o; }
    for (int i = F.vcu * (NWAVES * 64) + tid; i < 36 * 1024; i += F.G * NWAVES * 64) { const int n = i >> 10, k = i & 1023;
        const float v = ((n < 32) ? F.in[20][k * 32 + n] : F.in[18][k * 4 + (n - 32)]) * F.in[17][k]; const unsigned hi = f2bf(v); const float rem = v - __uint_as_float(hi << 16);
        bf16* rt_ = (bf16*)(F.ws + WS_RT); rt_[n * 1024 + k] = (bf16)hi; rt_[(36 + n) * 1024 + k] = (bf16)f2bf(rem); }
    float* rope = (float*)(F.ws + WS_ROPE);
    for (int i = F.vcu * (NWAVES * 64) + tid; i < SEQ * 32; i += F.G * NWAVES * 64) { const int pos = i >> 5, fi = i & 31;
        const float invf = (float)exp2(-(double)fi * (13.287712379549449 / 32.0));
        const float ang = (float)pos * invf; float sn, cs; sincos_acc(ang, sn, cs); rope[i] = cs; rope[SEQ * 32 + i] = sn; }
}


__device__ __forceinline__ void p10_w2_items(Frame& F, int nunits) {
    const int lane = lane_now(), wave = F.wave;
    LAS float* scr = (LAS float*)(F.lds + wave * 8704);
    const int rem = nunits % F.G; const int first = rem, nidle = (rem == 0) ? F.G : F.G - rem;
    const int rank = (rem == 0) ? (int)blockIdx.x : (int)blockIdx.x - first; if (rank < 0) return;
    for (int r = rank * NWAVES + wave; r < 32 * 256; r += nidle * NWAVES) { const int e = r >> 8;
        p0_transpose_item(F.in[24] + (size_t)e * DEXP * D, DEXP, D, 32, (bf16*)(F.ws + WS_W2) + (size_t)e * D * DEXP, RowMap{0, 0}, nullptr, scr, r & 255, lane); }
}
__device__ __forceinline__ void gate_scan(Frame& F, int bh) {
    const int lane = lane_now(), wave = F.wave;
    const int b = bh >> 2, h = bh & 3; const float* gate = (const float*)(F.ws + WS_GATE);
    float* acum = (float*)(F.ws + WS_ACUM) + (size_t)bh * SEQ; float* usub = (float*)(F.ws + WS_USUB) + (size_t)bh * SEQ; float* sc = (float*)(F.ws + WS_SC) + (size_t)bh * NCH * 4;
    LAS float* GB = (LAS float*)F.lds;
    for (int jj = 0; jj < 8; ++jj) { const int j = wave * 8 + jj; const int t = j * CHL + lane; const size_t row = (size_t)b * SEQ + t;
        const float gi = gate[row * 8 + h], gf = gate[row * 8 + 4 + h];
        const float a = wave_scan_sum(fminf(gf, 0.f) - log1pf(expf(-fabsf(gf))));
        const float g = __builtin_bit_cast(float, __builtin_amdgcn_readlane(__builtin_bit_cast(int, a), 63)); const float u = gi - a;
        const float bm = wave_max(g + u);
        acum[t] = a; usub[t] = u;
        if (lane == 0) { GB[j] = g; GB[64 + j] = bm; } }
    WG_SYNC();
    if (wave == 0) { float G = GB[lane], B = GB[64 + lane]; const float g = G;
#pragma unroll
        for (int o = 1; o < 64; o <<= 1) { const float Gp = __shfl_up(G, o), Bp = __shfl_up(B, o); if (lane >= o) { B = fmaxf(Bp + G, B); G = Gp + G; } }
        const float mnew = fmaxf(G, B);
        float mprev = __shfl_up(mnew, 1); if (lane == 0) mprev = 0.f;
        sc[lane * 4 + 0] = mprev; sc[lane * 4 + 1] = mnew; sc[lane * 4 + 2] = g; sc[lane * 4 + 3] = expf(g + mprev - mnew); }
    WG_SYNC();
}

constexpr int TS64 = 144;
constexpr int TS128 = 272;
constexpr int ML_CW = 135168;
__device__ __forceinline__ void stage_convw(Frame& F) {
    const int tid = F.wave * 64 + lane_now(); LAS float* cwl = (LAS float*)(F.lds + ML_CW);
    for (int i = tid; i < 5632; i += NWAVES * 64) cwl[i] = (i < 4096) ? F.in[7][i] : (i < 5120) ? F.in[8][i - 4096] : F.in[10][i - 5120];
    WG_SYNC();
}
__device__ __forceinline__ void conv2_silu8(const bf16* src, int t, const LAS float* cwl, int ch0, float (&y0)[8], float (&y1)[8]) {
    v4u x[5];
#pragma unroll
    for (int i = 0; i < 5; ++i) { const int tt = t - 3 + i; x[i] = (tt >= 0) ? *(const GAS v4u*)(src + (size_t)tt * NPROJ) : (v4u){0u, 0u, 0u, 0u}; }
#pragma unroll
    for (int hh = 0; hh < 2; ++hh) {
        const f32x4 bb = *(const LAS f32x4*)(cwl + 4096 + ch0 + 4 * hh); f32x4 a0 = bb, a1 = bb;
#pragma unroll
        for (int tau = 0; tau < 4; ++tau) { const f32x4 w = *(const LAS f32x4*)(cwl + tau * 1024 + ch0 + 4 * hh);
            const unsigned p0 = hh ? x[tau].z : x[tau].x, p1 = hh ? x[tau].w : x[tau].y, q0 = hh ? x[tau + 1].z : x[tau + 1].x, q1 = hh ? x[tau + 1].w : x[tau + 1].y;
            a0 += w * (f32x4){bflo(p0), bfhi(p0), bflo(p1), bfhi(p1)}; a1 += w * (f32x4){bflo(q0), bfhi(q0), bflo(q1), bfhi(q1)}; }
#pragma unroll
        for (int e = 0; e < 4; ++e) { y0[4 * hh + e] = a0[e] * fsigmoid(a0[e]); y1[4 * hh + e] = a1[e] * fsigmoid(a1[e]); } }
}
__device__ __forceinline__ void stage_vt(Frame& F, int tid, int b, int t0, int h, LAS unsigned char* VT) {
    const bf16* mvt = (const bf16*)(F.ws + WS_MVT);
#pragma unroll
    for (int i = 0; i < 2; ++i) { const int id = tid + 512 * i, r = id >> 3, c = id & 7;
        *(LAS v4u*)(VT + r * TS64 + c * 16) = *(const GAS v4u*)(mvt + (size_t)(h * 128 + r) * M + (size_t)b * SEQ + t0 + c * 8); }
    if (tid < 128) { const int r = 128 + (tid >> 3), c = tid & 7; const unsigned one2 = (r == 128) ? 0x3F803F80u : 0u; *(LAS v4u*)(VT + r * TS64 + c * 16) = (v4u){one2, one2, one2, one2}; }
}

#define LDS_BARRIER() asm volatile("s_waitcnt lgkmcnt(0)\n\ts_barrier" ::: "memory")
__device__ __forceinline__ void conv2_math(const v4u (&x)[5], const LAS float* cwl, int ch0, float (&y0)[8], float (&y1)[8]) {
#pragma unroll
    for (int hh = 0; hh < 2; ++hh) {
        const f32x4 bb = *(const LAS f32x4*)(cwl + 4096 + ch0 + 4 * hh); f32x4 a0 = bb, a1 = bb;
#pragma unroll
        for (int tau = 0; tau < 4; ++tau) { const f32x4 w = *(const LAS f32x4*)(cwl + tau * 1024 + ch0 + 4 * hh);
            const unsigned p0 = hh ? x[tau].z : x[tau].x, p1 = hh ? x[tau].w : x[tau].y, q0 = hh ? x[tau + 1].z : x[tau + 1].x, q1 = hh ? x[tau + 1].w : x[tau + 1].y;
            a0 += w * (f32x4){bflo(p0), bfhi(p0), bflo(p1), bfhi(p1)}; a1 += w * (f32x4){bflo(q0), bfhi(q0), bflo(q1), bfhi(q1)}; }
#pragma unroll
        for (int e = 0; e < 4; ++e) { y0[4 * hh + e] = a0[e] * fsigmoid(a0[e]); y1[4 * hh + e] = a1[e] * fsigmoid(a1[e]); } }
}
struct M1Pre { v4u xk[5], vt[2]; float u0, u1; };
__device__ __forceinline__ void m1_load(Frame& F, int bh, int j, int lane, int wave, int tid, M1Pre& p) {
    const int b = bh >> 2, h = bh & 3, t0 = j * CHL; const bf16* proj = (const bf16*)(F.ws + WS_PROJ);
    const int c8 = (lane & 7) + 8 * (wave & 1), r0 = 2 * ((wave >> 1) * 8 + (lane >> 3));
    const bf16* sk = proj + (size_t)b * SEQ * NPROJ + C_MK + h * 128 + c8 * 8;
#pragma unroll
    for (int i = 0; i < 5; ++i) { const int tt = t0 + r0 - 3 + i, tc = tt < 0 ? 0 : tt; p.xk[i] = *(const GAS v4u*)(sk + (size_t)tc * NPROJ); }
    const bf16* mvt = (const bf16*)(F.ws + WS_MVT);
#pragma unroll
    for (int i = 0; i < 2; ++i) { const int id = tid + 512 * i, r = id >> 3, c = id & 7; p.vt[i] = *(const GAS v4u*)(mvt + (size_t)(h * 128 + r) * M + (size_t)b * SEQ + t0 + c * 8); }
    const float* usub = (const float*)(F.ws + WS_USUB) + (size_t)bh * SEQ + t0; p.u0 = usub[r0]; p.u1 = usub[r0 + 1];
}
__device__ __forceinline__ void m1_unit(Frame& F, int bh, int j, M1Pre& p, int nbh, int nj) {
    const int lane = lane_now(), wave = F.wave, tid = wave * 64 + lane;
    const int b = bh >> 2, h = bh & 3, t0 = j * CHL; (void)b;
    LAS unsigned char* KWT = F.lds; LAS unsigned char* VT = F.lds + 128 * TS64; const LAS float* cwl = (const LAS float*)(F.lds + ML_CW);
    const float* sc = (const float*)(F.ws + WS_SC) + ((size_t)bh * NCH + j) * 4; const float mnew = sc[1], g = sc[2];
    { const int c8 = (lane & 7) + 8 * (wave & 1), r0 = 2 * ((wave >> 1) * 8 + (lane >> 3)); float y0[8], y1[8];
#pragma unroll
        for (int i = 0; i < 3; ++i) { if (t0 + r0 - 3 + i < 0) p.xk[i] = (v4u){0u, 0u, 0u, 0u}; }
        conv2_math(p.xk, cwl, 512 + h * 128 + c8 * 8, y0, y1);
        const float w0 = 0.08838834764831845f * fexp(g + p.u0 - mnew), w1 = 0.08838834764831845f * fexp(g + p.u1 - mnew);
#pragma unroll
        for (int e = 0; e < 8; ++e) *(LAS unsigned*)(KWT + (c8 * 8 + e) * TS64 + r0 * 2) = pk2(y0[e] * w0, y1[e] * w1); }
#pragma unroll
    for (int i = 0; i < 2; ++i) { const int id = tid + 512 * i, r = id >> 3, c = id & 7; *(LAS v4u*)(VT + r * TS64 + c * 16) = p.vt[i]; }
    if (tid < 128) { const int r = 128 + (tid >> 3), c = tid & 7; const unsigned one2 = (r == 128) ? 0x3F803F80u : 0u; *(LAS v4u*)(VT + r * TS64 + c * 16) = (v4u){one2, one2, one2, one2}; }
    LDS_BARRIER();
    if (nbh >= 0) m1_load(F, nbh, nj, lane, wave, tid, p);
    const int r16 = lane & 15, q = lane >> 4, w = wave;
    bf16x8 xa[2];
#pragma unroll
    for (int ks = 0; ks < 2; ++ks) xa[ks] = *(const LAS bf16x8*)(KWT + (16 * w + r16) * TS64 + ks * 64 + q * 16);
    bf16* dst = (bf16*)F.out + ((size_t)bh * NCH + j) * CS_UNIT;
    f32x4 acc[9];
#pragma unroll
    for (int nt = 0; nt < 9; ++nt) { acc[nt] = (f32x4){0.f, 0.f, 0.f, 0.f};
#pragma unroll
        for (int ks = 0; ks < 2; ++ks) { const bf16x8 yb = *(const LAS bf16x8*)(VT + (16 * nt + r16) * TS64 + ks * 64 + q * 16); acc[nt] = __builtin_amdgcn_mfma_f32_16x16x32_bf16(xa[ks], yb, acc[nt], 0, 0, 0); } }
#pragma unroll
    for (int pr = 0; pr < 4; ++pr) { const int ta = 2 * pr, tb = 2 * pr + 1;
        const unsigned x0 = pk2(acc[ta][0], acc[ta][1]), x1 = pk2(acc[ta][2], acc[ta][3]), y0 = pk2(acc[tb][0], acc[tb][1]), y1 = pk2(acc[tb][2], acc[tb][3]);
        auto s0 = __builtin_amdgcn_permlane16_swap(y0, x0, false, false); auto s1 = __builtin_amdgcn_permlane16_swap(y1, x1, false, false);
        u32x4 wv; wv.x = s0[0]; wv.y = s1[0]; wv.z = s0[1]; wv.w = s1[1];
        const int tsel = (q & 1) ? ta : tb, csel = 16 * w + 4 * (q & ~1);
        *(GAS u32x4*)(dst + (size_t)(16 * tsel + r16) * 128 + csel) = wv; }
    { u32x2 o; o.x = pk2(acc[8][0], acc[8][1]); o.y = pk2(acc[8][2], acc[8][3]); *(GAS u32x2*)(dst + (size_t)(16 * 8 + r16) * 128 + 16 * w + 4 * q) = o; }
    LDS_BARRIER();
}

__device__ __forceinline__ void p3_scan_combine(Frame& F, const int sub, const int blk0) {
    const int lane = lane_now(), wave = F.wave, tid = wave * 64 + lane;
    const int vb = (int)blockIdx.x - blk0, nb = F.G - blk0;
    const int gt = vb * (NWAVES * 64) + tid;
    if ((sub & 16) && gt < 32 * (CS_UNIT / 8)) { const int bh = gt / (CS_UNIT / 8), e8 = gt % (CS_UNIT / 8);
        GAS v4u* p = (GAS v4u*)((bf16*)F.out + (size_t)bh * NCH * CS_UNIT) + e8; const float* sc = (const float*)(F.ws + WS_SC) + (size_t)bh * NCH * 4;
        float run[8];
#pragma unroll
        for (int e = 0; e < 8; ++e) run[e] = 0.f;
        for (int j0 = 0; j0 < NCH; j0 += 8) { v4u x[8];
#pragma unroll
            for (int jj = 0; jj < 8; ++jj) x[jj] = __builtin_nontemporal_load(p + (size_t)(j0 + jj) * (CS_UNIT / 8));
#pragma unroll
            for (int jj = 0; jj < 8; ++jj) { const float dec = sc[(j0 + jj) * 4 + 3]; v4u o;
                o.x = pk2(run[0], run[1]); o.y = pk2(run[2], run[3]); o.z = pk2(run[4], run[5]); o.w = pk2(run[6], run[7]);
                p[(size_t)(j0 + jj) * (CS_UNIT / 8)] = o;
                run[0] = dec * run[0] + bflo(x[jj].x); run[1] = dec * run[1] + bfhi(x[jj].x); run[2] = dec * run[2] + bflo(x[jj].y); run[3] = dec * run[3] + bfhi(x[jj].y);
                run[4] = dec * run[4] + bflo(x[jj].z); run[5] = dec * run[5] + bfhi(x[jj].z); run[6] = dec * run[6] + bflo(x[jj].w); run[7] = dec * run[7] + bfhi(x[jj].w); } } }
    const float* lv = F.in[5];
    const float lam = expf(wave_sum(lv[lane] * lv[64 + lane])) - expf(wave_sum(lv[128 + lane] * lv[192 + lane])) + LAM_INIT;
    const int gw = vb * NWAVES + wave, NGW = nb * NWAVES; bf16* oa = (bf16*)(F.ws + WS_OA);
    float gs[8];
#pragma unroll
    for (int e = 0; e < 8; ++e) gs[e] = F.in[6][((lane * 8) & 127) + e] * (1.0f - LAM_INIT);
    if (sub & 32) for (int m = gw; m < M; m += NGW) { GAS v4u* r = (GAS v4u*)(oa + (size_t)m * 1024) + lane; const v4u a = r[0], c = r[64];
        float y[8]; y[0] = bflo(a.x) - lam * bflo(c.x); y[1] = bfhi(a.x) - lam * bfhi(c.x); y[2] = bflo(a.y) - lam * bflo(c.y); y[3] = bfhi(a.y) - lam * bfhi(c.y);
        y[4] = bflo(a.z) - lam * bflo(c.z); y[5] = bfhi(a.z) - lam * bfhi(c.z); y[6] = bflo(a.w) - lam * bflo(c.w); y[7] = bfhi(a.w) - lam * bfhi(c.w);
        float ss = 0.f;
#pragma unroll
        for (int e = 0; e < 8; ++e) ss += y[e] * y[e];
        ss = row16_sum(ss);
        const float rs = frsq(ss * (1.f / 128.f) + EPS); v4u o;
        o.x = pk2(y[0] * rs * gs[0], y[1] * rs * gs[1]); o.y = pk2(y[2] * rs * gs[2], y[3] * rs * gs[3]); o.z = pk2(y[4] * rs * gs[4], y[5] * rs * gs[5]); o.w = pk2(y[6] * rs * gs[6], y[7] * rs * gs[7]);
        r[0] = o; }
}

struct M3Pre { v4u xq[5], xk[5], vt[2], ct[5], ow[2]; float u, a; };
__device__ __forceinline__ void m3_load(Frame& F, int bh, int j, int lane, int wave, int tid, M3Pre& p) {
    const int b = bh >> 2, h = bh & 3, t0 = j * CHL; const bf16* proj = (const bf16*)(F.ws + WS_PROJ);
    const int c8 = (lane & 7) + 8 * (wave & 1), r0 = 2 * ((wave >> 1) * 8 + (lane >> 3));
    const bf16* sq = proj + (size_t)b * SEQ * NPROJ + C_MQ + h * 128 + c8 * 8; const bf16* sk = proj + (size_t)b * SEQ * NPROJ + C_MK + h * 128 + c8 * 8;
#pragma unroll
    for (int i = 0; i < 5; ++i) { const int tt = t0 + r0 - 3 + i, tc = tt < 0 ? 0 : tt;
        p.xq[i] = *(const GAS v4u*)(sq + (size_t)tc * NPROJ); p.xk[i] = *(const GAS v4u*)(sk + (size_t)tc * NPROJ); }
    const bf16* mvt = (const bf16*)(F.ws + WS_MVT);
#pragma unroll
    for (int i = 0; i < 2; ++i) { const int id = tid + 512 * i, r = id >> 3, c = id & 7; p.vt[i] = *(const GAS v4u*)(mvt + (size_t)(h * 128 + r) * M + (size_t)b * SEQ + t0 + c * 8); }
    const GAS v4u* src = (const GAS v4u*)((const bf16*)F.out + ((size_t)bh * NCH + j) * CS_UNIT);
#pragma unroll
    for (int k = 0; k < 5; ++k) { const int id = tid + 512 * k; p.ct[k] = __builtin_nontemporal_load(src + (id < DVX * 16 ? id : DVX * 16 - 1)); }
    { const GAS v4u* op = (const GAS v4u*)(proj + ((size_t)b * SEQ + t0 + (tid >> 3)) * NPROJ + C_MO + h * 128 + 16 * (tid & 7)); p.ow[0] = op[0]; p.ow[1] = op[1]; }
    p.u = ((const float*)(F.ws + WS_USUB))[(size_t)bh * SEQ + t0 + lane]; p.a = ((const float*)(F.ws + WS_ACUM))[(size_t)bh * SEQ + t0 + lane];
}
__device__ __forceinline__ void m3_phase(Frame& F) {
    const int lane = lane_now(), wave = F.wave, tid = wave * 64 + lane;
    const bf16* proj = (const bf16*)(F.ws + WS_PROJ);
    LAS unsigned char* Qs = F.lds; LAS unsigned char* Ks = F.lds + 64 * TS128; LAS unsigned char* VT = F.lds + 128 * TS128; LAS unsigned char* CT = VT + DVX * TS64;
    LAS unsigned char* SD = CT + DVX * TS128; LAS float* sv = (LAS float*)(SD + 64 * TS64);
    LAS float* HB = (LAS float*)F.lds;
    const LAS float* cwl = (const LAS float*)(F.lds + ML_CW);
    static_assert(128 * TS128 + DVX * TS64 + DVX * TS128 + 64 * TS64 + 4 * 64 * 4 <= ML_CW && 64 * 132 * 4 <= 128 * TS128 && ML_CW + 5632 * 4 <= LDSCTL_OFF, "m3 LDS");
    const int NU = 32 * NCH;
    M3Pre p;
    if (F.vcu < NU) m3_load(F, F.vcu >> 6, F.vcu & 63, lane, wave, tid, p);
    for (int u = F.vcu; u < NU; u += F.G) {
        const int bh = u >> 6, j = u & 63, b = bh >> 2, h = bh & 3, t0 = j * CHL;
        const float* sc = (const float*)(F.ws + WS_SC) + ((size_t)bh * NCH + j) * 4; const float mprev = sc[0];
        { const int c8 = (lane & 7) + 8 * (wave & 1), r0 = 2 * ((wave >> 1) * 8 + (lane >> 3)); float y0[8], y1[8]; v4u o;
#pragma unroll
            for (int i = 0; i < 3; ++i) { const bool z = t0 + r0 - 3 + i < 0; if (z) { p.xq[i] = (v4u){0u, 0u, 0u, 0u}; p.xk[i] = (v4u){0u, 0u, 0u, 0u}; } }
            conv2_math(p.xq, cwl, h * 128 + c8 * 8, y0, y1);
            o.x = pk2(y0[0], y0[1]); o.y = pk2(y0[2], y0[3]); o.z = pk2(y0[4], y0[5]); o.w = pk2(y0[6], y0[7]); *(LAS v4u*)(Qs + r0 * TS128 + c8 * 16) = o;
            o.x = pk2(y1[0], y1[1]); o.y = pk2(y1[2], y1[3]); o.z = pk2(y1[4], y1[5]); o.w = pk2(y1[6], y1[7]); *(LAS v4u*)(Qs + (r0 + 1) * TS128 + c8 * 16) = o;
            conv2_math(p.xk, cwl, 512 + h * 128 + c8 * 8, y0, y1);
            const float ksc = 0.08838834764831845f;
            o.x = pk2(y0[0] * ksc, y0[1] * ksc); o.y = pk2(y0[2] * ksc, y0[3] * ksc); o.z = pk2(y0[4] * ksc, y0[5] * ksc); o.w = pk2(y0[6] * ksc, y0[7] * ksc); *(LAS v4u*)(Ks + r0 * TS128 + c8 * 16) = o;
            o.x = pk2(y1[0] * ksc, y1[1] * ksc); o.y = pk2(y1[2] * ksc, y1[3] * ksc); o.z = pk2(y1[4] * ksc, y1[5] * ksc); o.w = pk2(y1[6] * ksc, y1[7] * ksc); *(LAS v4u*)(Ks + (r0 + 1) * TS128 + c8 * 16) = o; }
#pragma unroll
        for (int i = 0; i < 2; ++i) { const int id = tid + 512 * i, r = id >> 3, c = id & 7; *(LAS v4u*)(VT + r * TS64 + c * 16) = p.vt[i]; }
        if (tid < 128) { const int r = 128 + (tid >> 3), c = tid & 7; const unsigned one2 = (r == 128) ? 0x3F803F80u : 0u; *(LAS v4u*)(VT + r * TS64 + c * 16) = (v4u){one2, one2, one2, one2}; }
#pragma unroll
        for (int k = 0; k < 5; ++k) { const int id = tid + 512 * k; if (id < DVX * 16) { const int r = id >> 4, c = id & 15; *(LAS v4u*)(CT + r * TS128 + c * 16) = p.ct[k]; } }
        if (wave == 0) { const float um = fmaxf(mprev, wave_scan_max(p.u));
            sv[lane] = p.u; sv[64 + lane] = um; sv[128 + lane] = fexp(mprev - um); sv[192 + lane] = fexp(-(p.a + um)); }
        const v4u ow0 = p.ow[0], ow1 = p.ow[1];
        LDS_BARRIER();
        { const int un = u + F.G; if (un < NU) m3_load(F, un >> 6, un & 63, lane, wave, tid, p); }
        const int tr = tid >> 3, part = tid & 7; const size_t orow = (size_t)b * SEQ + t0 + tr;
        const int r16 = lane & 15, q = lane >> 4, tt = wave & 3, hf = wave >> 2; const int t = 16 * tt + r16;
        bf16x8 qf[4];
#pragma unroll
        for (int ks = 0; ks < 4; ++ks) qf[ks] = *(const LAS bf16x8*)(Qs + t * TS128 + ks * 64 + q * 16);
        { const float umt = sv[64 + t];
#pragma unroll
            for (int k = 0; k < 2; ++k) { const int st = 2 * hf + k; f32x4 acc = {0.f, 0.f, 0.f, 0.f};
#pragma unroll
                for (int ks = 0; ks < 4; ++ks) { const bf16x8 kf = *(const LAS bf16x8*)(Ks + (16 * st + r16) * TS128 + ks * 64 + q * 16); acc = __builtin_amdgcn_mfma_f32_16x16x32_bf16(kf, qf[ks], acc, 0, 0, 0); }
                float o[4];
#pragma unroll
                for (int i = 0; i < 4; ++i) { const int s = 16 * st + 4 * q + i; o[i] = (s <= t) ? acc[i] * fexp(sv[s] - umt) : 0.f; }
                u32x2 w; w.x = pk2(o[0], o[1]); w.y = pk2(o[2], o[3]); *(LAS u32x2*)(SD + t * TS64 + (16 * st + 4 * q) * 2) = w; } }
        f32x4 acc[5];
#pragma unroll
        for (int k = 0; k < 5; ++k) acc[k] = (f32x4){0.f, 0.f, 0.f, 0.f};
        { bf16x8 cf[3];
#pragma unroll
          for (int i = 0; i < 22; ++i) {
              if (i < 20) { const int k = i >> 2, ks = i & 3; const int mt = (k < 4) ? 4 * hf + k : 8; cf[i % 3] = *(const LAS bf16x8*)(CT + (16 * mt + r16) * TS128 + ks * 64 + q * 16); }
              __builtin_amdgcn_sched_barrier(0);
              if (i >= 2) { const int j = i - 2; acc[j >> 2] = __builtin_amdgcn_mfma_f32_16x16x32_bf16(cf[j % 3], qf[j & 3], acc[j >> 2], 0, 0, 0); }
              __builtin_amdgcn_sched_barrier(0); } }
        LDS_BARRIER();
        { const float wi = sv[128 + t];
            bf16x8 sf[2];
#pragma unroll
            for (int ks = 0; ks < 2; ++ks) sf[ks] = *(const LAS bf16x8*)(SD + t * TS64 + ks * 64 + q * 16);
#pragma unroll
            for (int k = 0; k < 5; ++k) acc[k] = acc[k] * wi;
            { bf16x8 vf[3];
#pragma unroll
              for (int i = 0; i < 12; ++i) {
                  if (i < 10) { const int k = i >> 1, ks = i & 1; const int mt = (k < 4) ? 4 * hf + k : 8; vf[i % 3] = *(const LAS bf16x8*)(VT + (16 * mt + r16) * TS64 + ks * 64 + q * 16); }
                  __builtin_amdgcn_sched_barrier(0);
                  if (i >= 2) { const int j = i - 2; acc[j >> 1] = __builtin_amdgcn_mfma_f32_16x16x32_bf16(vf[j % 3], sf[j & 1], acc[j >> 1], 0, 0, 0); }
                  __builtin_amdgcn_sched_barrier(0); } }
            const float den = __shfl(acc[4][0], r16);
            const float inv = __builtin_amdgcn_rcpf(fmaxf(fabsf(den), sv[192 + t]));
#pragma unroll
            for (int k = 0; k < 4; ++k) *(LAS f32x4*)(HB + t * 132 + 16 * (4 * hf + k) + 4 * q) = acc[k] * inv; }
        LDS_BARRIER();
        { bf16* Y = (bf16*)(F.ws + WS_OA);
            f32x4 x[4]; float s = 0.f;
#pragma unroll
            for (int i = 0; i < 4; ++i) { x[i] = *(const LAS f32x4*)(HB + tr * 132 + 16 * part + 4 * i); s += (x[i][0] + x[i][1]) + (x[i][2] + x[i][3]); }
            s = row8_sum(s);
            const float mu = s * (1.f / 128.f); float v = 0.f;
#pragma unroll
            for (int i = 0; i < 4; ++i) { x[i] = x[i] - mu; v += dot4(x[i], x[i]); }
            v = row8_sum(v);
            const float rs = frsq(v * (1.f / 128.f) + EPS);
            const LAS f32x4* gp = (const LAS f32x4*)(cwl + 5120 + h * 128 + 16 * part);
#pragma unroll
            for (int hh = 0; hh < 2; ++hh) { const v4u ow = hh ? ow1 : ow0; const f32x4 g0 = gp[2 * hh], g1 = gp[2 * hh + 1]; const f32x4 a0 = x[2 * hh] * rs * g0, a1 = x[2 * hh + 1] * rs * g1; v4u o;
                o.x = pk2(a0[0] * fsigmoid(bflo(ow.x)), a0[1] * fsigmoid(bfhi(ow.x))); o.y = pk2(a0[2] * fsigmoid(bflo(ow.y)), a0[3] * fsigmoid(bfhi(ow.y)));
                o.z = pk2(a1[0] * fsigmoid(bflo(ow.z)), a1[1] * fsigmoid(bfhi(ow.z))); o.w = pk2(a1[2] * fsigmoid(bflo(ow.w)), a1[3] * fsigmoid(bfhi(ow.w)));
                *(GAS v4u*)(Y + orow * 1024 + 512 + h * 128 + 16 * part + 8 * hh) = o; } }
        LDS_BARRIER();
    }
    WG_SYNC();
}

typedef float f32x16 __attribute__((ext_vector_type(16)));
__device__ __forceinline__ void xattn_unit(Frame& F, int rt, int h) {
    const int lane = lane_now(), wave = F.wave;
    const bf16* XQ = (const bf16*)(F.ws + WS_XQ); bf16* XO = (bf16*)(F.ws + WS_XO);
    const int r32 = lane & 31, hi = lane >> 5; const int b = (rt * 256) / SEQ; const size_t row0 = (size_t)rt * 256 + wave * 32;
    const bf16* qrow = XQ + (row0 + r32) * D + h * 256 + hi * 8;
    const bf16* Kg = (const bf16*)(F.ws + WS_MK) + (size_t)(b * MEMLEN) * D + h * 256;
    const bf16* Vg = (const bf16*)(F.ws + WS_MVT2) + (size_t)(h * 256) * MROWS + b * MEMLEN;
    LAS unsigned char* KB = F.lds; LAS unsigned char* VB = F.lds + 65536;
#define XA_KSRC(i) (Kg + (size_t)(2 * (4 * wave + (i)) + (lane >> 5)) * D + (((lane & 31) ^ ((2 * (4 * wave + (i)) + (lane >> 5)) & 15)) * 8))
#define XA_VSRC(i) (Vg + (size_t)(8 * (2 * wave + (i)) + (lane >> 3)) * MROWS + (((lane & 7) ^ (((8 * (2 * wave + (i)) + (lane >> 3)) >> 1) & 7)) * 8))
    const bf16* ks0 = XA_KSRC(0); const bf16* ks1 = XA_KSRC(1); const bf16* ks2 = XA_KSRC(2); const bf16* ks3 = XA_KSRC(3); const bf16* vs0 = XA_VSRC(0); const bf16* vs1 = XA_VSRC(1);
#define XA_ISSUE(step) do { const int kt_ = (step) & 3, hv_ = (step) >> 2, bf_ = (step) & 1, vf_ = (step) % 3; const size_t ko_ = (size_t)kt_ * 64 * D, vo_ = (size_t)hv_ * 128 * MROWS + kt_ * 64; \
        __builtin_amdgcn_global_load_lds((const unsigned*)(ks0 + ko_), (LAS unsigned*)(KB + bf_ * 32768 + (4 * wave + 0) * 1024), 16, 0, 0); \
        __builtin_amdgcn_global_load_lds((const unsigned*)(ks1 + ko_), (LAS unsigned*)(KB + bf_ * 32768 + (4 * wave + 1) * 1024), 16, 0, 0); \
        __builtin_amdgcn_global_load_lds((const unsigned*)(ks2 + ko_), (LAS unsigned*)(KB + bf_ * 32768 + (4 * wave + 2) * 1024), 16, 0, 0); \
        __builtin_amdgcn_global_load_lds((const unsigned*)(ks3 + ko_), (LAS unsigned*)(KB + bf_ * 32768 + (4 * wave + 3) * 1024), 16, 0, 0); \
        __builtin_amdgcn_global_load_lds((const unsigned*)(vs0 + vo_), (LAS unsigned*)(VB + vf_ * 16384 + (2 * wave + 0) * 1024), 16, 0, 0); \
        __builtin_amdgcn_global_load_lds((const unsigned*)(vs1 + vo_), (LAS unsigned*)(VB + vf_ * 16384 + (2 * wave + 1) * 1024), 16, 0, 0); } while (0)
#define XA_PV(step_) do { const unsigned vbase_ = (unsigned)(uintptr_t)(VB + ((step_) % 3) * 16384) + 8 * hi; u32x2 vf[3][2]; \
        _Pragma("unroll") for (int i = 0; i < 18; ++i) { \
            if (i < 16) { const int mt = i >> 2, st = i & 3; const int dv = 32 * mt + r32; const unsigned vr = vbase_ + dv * 128; const int sw = (dv >> 1) & 7; \
                asm volatile("ds_read_b64 %0, %1" : "=v"(vf[i % 3][0]) : "v"(vr + (((2 * st) ^ sw) * 16)) : "memory"); asm volatile("ds_read_b64 %0, %1" : "=v"(vf[i % 3][1]) : "v"(vr + (((2 * st + 1) ^ sw) * 16)) : "memory"); } \
            if (i >= 2) { if (i < 16) asm volatile("s_waitcnt lgkmcnt(4)" ::: "memory"); else if (i == 16) asm volatile("s_waitcnt lgkmcnt(2)" ::: "memory"); else asm volatile("s_waitcnt lgkmcnt(0)" ::: "memory"); } \
            __builtin_amdgcn_sched_barrier(0); \
            if (i >= 2) { const int j = i - 2; u32x4 w; w.x = vf[j % 3][0].x; w.y = vf[j % 3][0].y; w.z = vf[j % 3][1].x; w.w = vf[j % 3][1].y; \
                o[j >> 2] = __builtin_amdgcn_mfma_f32_32x32x16_bf16(__builtin_bit_cast(bf16x8, w), pf[j & 3], o[j >> 2], 0, 0, 0); } \
            __builtin_amdgcn_sched_barrier(0); } } while (0)
#define XA_FINISH(hv_) do { { auto rr = __builtin_amdgcn_permlane32_swap(__float_as_uint(l), __float_as_uint(l), false, false); l = __uint_as_float(rr[0]) + __uint_as_float(rr[1]); } \
        const float inv = __builtin_amdgcn_rcpf(l); bf16* orow = XO + (row0 + r32) * D + h * 256 + (hv_) * 128; \
        _Pragma("unroll") for (int mt = 0; mt < 4; ++mt) _Pragma("unroll") for (int a = 0; a < 2; ++a) { const int b2 = a + 2; \
            const unsigned x0 = pk2(o[mt][4 * a] * inv, o[mt][4 * a + 1] * inv), x1 = pk2(o[mt][4 * a + 2] * inv, o[mt][4 * a + 3] * inv); \
            const unsigned y0 = pk2(o[mt][4 * b2] * inv, o[mt][4 * b2 + 1] * inv), y1 = pk2(o[mt][4 * b2 + 2] * inv, o[mt][4 * b2 + 3] * inv); \
            auto s0_ = __builtin_amdgcn_permlane32_swap(y0, x0, false, false); auto s1_ = __builtin_amdgcn_permlane32_swap(y1, x1, false, false); \
            u32x4 w; w.x = s0_[0]; w.y = s1_[0]; w.z = s0_[1]; w.w = s1_[1]; *(GAS u32x4*)(orow + 32 * mt + 8 * (hi ? a : b2)) = w; } \
        _Pragma("unroll") for (int i = 0; i < 4; ++i) o[i] = (f32x16){}; l = 0.f; mx = -INFINITY; } while (0)
    XA_ISSUE(0);
    bf16x8 qf[16];
#pragma unroll
    for (int ks = 0; ks < 16; ++ks) qf[ks] = __builtin_nontemporal_load((const GAS bf16x8*)(qrow + ks * 16));
    const bool lag = wave >= 4;
    f32x16 o[4];
#pragma unroll
    for (int i = 0; i < 4; ++i) o[i] = (f32x16){};
    float mx = -INFINITY, l = 0.f; bf16x8 pf[4];
#pragma unroll
    for (int i = 0; i < 4; ++i) pf[i] = (bf16x8){};
    for (int step = 0; step < 8; ++step) {
        asm volatile("s_waitcnt vmcnt(0)" ::: "memory"); WG_SYNC();
        if (step < 7) XA_ISSUE(step + 1);
        if (lag && step > 0) { XA_PV(step - 1); if (step == 4) XA_FINISH(0); }
        const LAS unsigned char* kb = KB + (step & 1) * 32768;
        f32x16 s0 = (f32x16){}, s1 = (f32x16){};
        { bf16x8 kf[2][2];
          const unsigned kaddr0 = (unsigned)(uintptr_t)(kb + r32 * 512), kaddr1 = kaddr0 + 32 * 512;
#define XA_KRD(ks_) do { const unsigned pos_ = (unsigned)(((2 * (ks_) + hi) ^ (r32 & 15)) * 16); \
              asm volatile("ds_read_b128 %0, %1" : "=v"(kf[(ks_) & 1][0]) : "v"(kaddr0 + pos_) : "memory"); asm volatile("ds_read_b128 %0, %1" : "=v"(kf[(ks_) & 1][1]) : "v"(kaddr1 + pos_) : "memory"); } while (0)
          XA_KRD(0);
#pragma unroll
          for (int ks = 0; ks < 16; ++ks) {
              if (ks < 15) { XA_KRD(ks + 1); asm volatile("s_waitcnt lgkmcnt(2)" ::: "memory"); } else asm volatile("s_waitcnt lgkmcnt(0)" ::: "memory");
              __builtin_amdgcn_sched_barrier(0);
              s0 = __builtin_amdgcn_mfma_f32_32x32x16_bf16(kf[ks & 1][0], qf[ks], s0, 0, 0, 0); s1 = __builtin_amdgcn_mfma_f32_32x32x16_bf16(kf[ks & 1][1], qf[ks], s1, 0, 0, 0);
              __builtin_amdgcn_sched_barrier(0); }
#undef XA_KRD
        }
        float tm = fmaxf(s0[0], s1[0]);
#pragma unroll
        for (int r = 1; r < 16; ++r) tm = fmaxf(tm, fmaxf(s0[r], s1[r]));
        { auto rr = __builtin_amdgcn_permlane32_swap(__float_as_uint(tm), __float_as_uint(tm), false, false); tm = fmaxf(__uint_as_float(rr[0]), __uint_as_float(rr[1])); }
        float mn = mx;
        if (__any(tm > mx + 8.0f)) { mn = fmaxf(mx, tm); const float alpha = __builtin_amdgcn_exp2f(mx - mn); l *= alpha;
#pragma unroll
            for (int i = 0; i < 4; ++i) o[i] = o[i] * alpha; }
        mx = mn;
        float ps = 0.f;
#pragma unroll
        for (int r = 0; r < 16; ++r) { s0[r] = __builtin_amdgcn_exp2f(s0[r] - mn); s1[r] = __builtin_amdgcn_exp2f(s1[r] - mn); ps += s0[r] + s1[r]; }
        l += ps;
#pragma unroll
        for (int kk = 0; kk < 2; ++kk) { u32x4 w0, w1;
            w0.x = pk2(s0[8 * kk + 0], s0[8 * kk + 1]); w0.y = pk2(s0[8 * kk + 2], s0[8 * kk + 3]); w0.z = pk2(s0[8 * kk + 4], s0[8 * kk + 5]); w0.w = pk2(s0[8 * kk + 6], s0[8 * kk + 7]);
            w1.x = pk2(s1[8 * kk + 0], s1[8 * kk + 1]); w1.y = pk2(s1[8 * kk + 2], s1[8 * kk + 3]); w1.z = pk2(s1[8 * kk + 4], s1[8 * kk + 5]); w1.w = pk2(s1[8 * kk + 6], s1[8 * kk + 7]);
            pf[kk] = __builtin_bit_cast(bf16x8, w0); pf[2 + kk] = __builtin_bit_cast(bf16x8, w1); }
        if (!lag) { XA_PV(step); if (step == 3) XA_FINISH(0); }
    }
    if (lag) XA_PV(7);
    XA_FINISH(1);
#undef XA_ISSUE
#undef XA_KSRC
#undef XA_VSRC
#undef XA_PV
#undef XA_FINISH
    WG_SYNC();
}

constexpr int R_WH = 0, R_STRIDE = 2064, R_WL = 36 * R_STRIDE, R_CH = 72 * R_STRIDE, R_LCNT = R_CH + 4096, R_LBASE = R_LCNT + 128, R_EL = R_LBASE + 128;
static_assert(R_EL + 4096 <= LDSCTL_OFF, "router LDS");
__device__ __forceinline__ void p9_router(Frame& F) {
    const int lane = lane_now(), wave = F.wave, tid = wave * 64 + lane;
    LAS unsigned char* L = F.lds;
    LAS int* CH = (LAS int*)(L + R_CH); LAS int* LCNT = (LAS int*)(L + R_LCNT); LAS int* LBASE = (LAS int*)(L + R_LBASE); LAS float* EL = (LAS float*)(L + R_EL) + wave * 128;
    const bf16* x2 = (const bf16*)(F.ws + WS_XB); float* rstd2 = (float*)(F.ws + WS_RSTD2);
    const int rpb = (M + F.G - 1) / F.G; const int r0 = F.vcu * rpb; const int r1 = (r0 + rpb < M) ? r0 + rpb : M;
    const int r16 = lane & 15, q = lane >> 4;
    int base = r0 + wave * 16;
    bf16x8 xf[32];
#define R9_LOADROW() do { const int m_ = base + r16; const bf16* xr_ = x2 + (size_t)((m_ < r1) ? m_ : r0) * D + 8 * q; _Pragma("unroll") for (int j = 0; j < 32; ++j) xf[j] = *(const GAS bf16x8*)(xr_ + j * 32); } while (0)
    if (base < r1 && base - r0 < 128) R9_LOADROW();
    { const GAS v4u* rtg = (const GAS v4u*)(F.ws + WS_RT);
#pragma unroll
      for (int i = 0; i < 18; ++i) { const int id = tid + 512 * i, row = id >> 7, c = id & 127; *(LAS v4u*)(L + row * R_STRIDE + c * 16) = rtg[id]; } }
    if (tid < 32) LCNT[tid] = 0;
    WG_SYNC();
    for (; base < r1 && base - r0 < 128; base += NWAVES * 16) {
        const int m = base + r16; const bool live = m < r1;
        f32x4 acc0 = {0.f, 0.f, 0.f, 0.f}, acc1 = acc0, acc2 = acc0; float ss = 0.f;
#pragma unroll
        for (int ks = 0; ks < 32; ++ks) { const int ko = ks * 64 + q * 16;
                const bf16x8 h0 = *(const LAS bf16x8*)(L + R_WH + r16 * R_STRIDE + ko), h1 = *(const LAS bf16x8*)(L + R_WH + (16 + r16) * R_STRIDE + ko), h2 = *(const LAS bf16x8*)(L + R_WH + (32 + (r16 & 3)) * R_STRIDE + ko);
                const bf16x8 l0 = *(const LAS bf16x8*)(L + R_WL + r16 * R_STRIDE + ko), l1 = *(const LAS bf16x8*)(L + R_WL + (16 + r16) * R_STRIDE + ko), l2 = *(const LAS bf16x8*)(L + R_WL + (32 + (r16 & 3)) * R_STRIDE + ko);
                acc0 = __builtin_amdgcn_mfma_f32_16x16x32_bf16(h0, xf[ks], acc0, 0, 0, 0); acc1 = __builtin_amdgcn_mfma_f32_16x16x32_bf16(h1, xf[ks], acc1, 0, 0, 0); acc2 = __builtin_amdgcn_mfma_f32_16x16x32_bf16(h2, xf[ks], acc2, 0, 0, 0);
                acc0 = __builtin_amdgcn_mfma_f32_16x16x32_bf16(l0, xf[ks], acc0, 0, 0, 0); acc1 = __builtin_amdgcn_mfma_f32_16x16x32_bf16(l1, xf[ks], acc1, 0, 0, 0); acc2 = __builtin_amdgcn_mfma_f32_16x16x32_bf16(l2, xf[ks], acc2, 0, 0, 0);
                const u32x4 xw = __builtin_bit_cast(u32x4, xf[ks]);
                const float a0 = bflo(xw.x), a1 = bfhi(xw.x), a2 = bflo(xw.y), a3 = bfhi(xw.y), a4 = bflo(xw.z), a5 = bfhi(xw.z), a6 = bflo(xw.w), a7 = bfhi(xw.w);
                ss += ((a0 * a0 + a1 * a1) + (a2 * a2 + a3 * a3)) + ((a4 * a4 + a5 * a5) + (a6 * a6 + a7 * a7));
                __builtin_amdgcn_sched_barrier(0); }
        { const int nb_ = base + NWAVES * 16; if (nb_ < r1 && nb_ - r0 < 128) { base = nb_; R9_LOADROW(); base -= NWAVES * 16; } }
        { auto r_ = __builtin_amdgcn_permlane16_swap(__float_as_uint(ss), __float_as_uint(ss), false, false); ss = __uint_as_float(r_[0]) + __uint_as_float(r_[1]); }
        { auto r_ = __builtin_amdgcn_permlane32_swap(__float_as_uint(ss), __float_as_uint(ss), false, false); ss = __uint_as_float(r_[0]) + __uint_as_float(r_[1]); }
        const float gl0 = __shfl(acc2[0], r16), gl1 = __shfl(acc2[1], r16), gl2 = __shfl(acc2[2], r16), gl3 = __shfl(acc2[3], r16);
        const float rstd = frsq(ss * (1.f / D) + EPS);
        const float g0 = gl0 * rstd + F.in[19][0], g1 = gl1 * rstd + F.in[19][1], g2 = gl2 * rstd + F.in[19][2], g3 = gl3 * rstd + F.in[19][3];
        int gi = 0; float gm = g0; if (g1 > gm) { gm = g1; gi = 1; } if (g2 > gm) { gm = g2; gi = 2; } if (g3 > gm) { gm = g3; gi = 3; }
        const float g_w = __builtin_amdgcn_rcpf(fexp(g0 - gm) + fexp(g1 - gm) + fexp(g2 - gm) + fexp(g3 - gm));
        if ((q >> 1) == (gi & 1)) { const f32x4 a = (gi >> 1) ? acc1 : acc0; const GAS f32x4* bp = (const GAS f32x4*)(F.in[21] + gi * 8 + 4 * (q & 1));
            *(LAS f32x4*)(EL + r16 * 8 + 4 * (q & 1)) = a * rstd + *bp; }
        asm volatile("s_waitcnt lgkmcnt(0)" ::: "memory");
        if (q == 0 && live) { const f32x4 ea = *(const LAS f32x4*)(EL + r16 * 8), eb = *(const LAS f32x4*)(EL + r16 * 8 + 4);
            float el[8] = {ea.x, ea.y, ea.z, ea.w, eb.x, eb.y, eb.z, eb.w};
            int i0 = 0; float m0 = el[0];
#pragma unroll
            for (int n = 1; n < 8; ++n) if (el[n] > m0) { m0 = el[n]; i0 = n; }
            int i1 = (i0 + 1) & 7; float m1 = -INFINITY;
#pragma unroll
            for (int n = 0; n < 8; ++n) if (n != i0 && el[n] > m1) { m1 = el[n]; i1 = n; }
            const float p1r = fexp(m1 - m0); const float w0 = g_w * __builtin_amdgcn_rcpf(1.f + p1r), w1 = w0 * p1r;
            const int e0 = gi * 8 + i0, e1 = gi * 8 + i1; const int lr0 = atomicAdd((int*)&LCNT[e0], 1), lr1 = atomicAdd((int*)&LCNT[e1], 1);
            LAS int* c = CH + (m - r0) * 8; c[0] = e0; c[1] = e1; c[2] = lr0; c[3] = lr1; c[4] = __float_as_int(w0); c[5] = __float_as_int(w1);
            rstd2[m] = rstd; }
        asm volatile("s_waitcnt lgkmcnt(0)" ::: "memory");
    }
    WG_SYNC();
    if (tid < 32) LBASE[tid] = (int)atomicAdd((unsigned*)(F.ctl + CW_CNT + tid), (unsigned)LCNT[tid]);
    WG_SYNC();
    int* tokl = (int*)(F.ws + WS_TOKL); int* asg = (int*)(F.ws + WS_ASG);
    for (int r = tid; r < r1 - r0; r += NWAVES * 64) { const LAS int* c = CH + r * 8; const int m = r0 + r;
        const int e0 = c[0], e1 = c[1], k0 = LBASE[e0] + c[2], k1 = LBASE[e1] + c[3];
        tokl[(size_t)e0 * M + k0] = m; tokl[(size_t)e1 * M + k1] = m;
        asg[m * 8 + 0] = e0; asg[m * 8 + 1] = k0; asg[m * 8 + 2] = e1; asg[m * 8 + 3] = k1; asg[m * 8 + 4] = c[4]; asg[m * 8 + 5] = c[5]; }
}

template <bool GATHER> __device__ __forceinline__ int expert_tables(Frame& F) {
    const int lane = lane_now(), wave = F.wave, tid = wave * 64 + lane; (void)tid; (void)lane; (void)wave;
    LAS int* TS = (LAS int*)(F.lds + XT_TS); LAS int* TOK = (LAS int*)(F.lds + XT_TOK);
    if (tid == 0) { int acc = 0; for (int e = 0; e < 32; ++e) { TS[e] = acc; acc += ((int)F.ctl[CW_CNT + e] + 255) >> 8; } TS[32] = acc; }
    WG_SYNC();
    const int ntiles = TS[32];
    if (GATHER) { const int* tokl = (const int*)(F.ws + WS_TOKL);
        for (int ui = 0; ui < 5; ++ui) { const int L = ui * F.G + (int)blockIdx.x; if (L >= 4 * ntiles) break;
            const int rt = pg8::expert_unit_id(L, 4 * ntiles) >> 2; int e = 0; for (int k = 1; k < 32; ++k) e += (TS[k] <= rt) ? 1 : 0;
            const int cnt = (int)F.ctl[CW_CNT + e];
            if (tid < 256) { const int rank = (rt - TS[e]) * 256 + tid; const int tk = (rank < cnt) ? tokl[(size_t)e * M + rank] : 0; TOK[ui * 256 + tid] = tk; ((LAS float*)(F.lds + XT_RS))[ui * 256 + tid] = ((const float*)(F.ws + WS_RSTD2))[tk]; } }
        WG_SYNC(); }
    return ntiles;
}

__device__ __forceinline__ void p12_final(Frame& F) {
    const int lane = lane_now(), wave = F.wave, tid = wave * 64 + lane;
    LAS int* TS = (LAS int*)(F.lds + XT_TS);
    if (tid == 0) { int acc = 0; for (int e = 0; e < 32; ++e) { TS[e] = acc; acc += ((int)F.ctl[CW_CNT + e] + 255) >> 8; } TS[32] = acc; }
    WG_SYNC();
    const int gw = F.vcu * NWAVES + wave, NGW = F.G * NWAVES; const GAS v4u* asg = (const GAS v4u*)(F.ws + WS_ASG); const bf16* YE = (const bf16*)(F.ws + WS_YE); const bf16* XB = (const bf16*)(F.ws + WS_XB);
    const GAS f32x4* gr = (const GAS f32x4*)F.in[25] + 2 * lane; const f32x4 g0 = gr[0], g1 = gr[1], g2 = gr[128], g3 = gr[129];
    v4u a0 = (v4u){0u, 0u, 0u, 0u}, a1 = a0; v4u rx[2], ry0[2], ry1[2]; float cw0 = 0.f, cw1 = 0.f;
#define P12_ROWS(m_, A0, A1) do { const size_t p0_ = (size_t)TS[(A0).x & 31] * 256 + (A0).y, p1_ = (size_t)TS[(A0).z & 31] * 256 + (A0).w; \
        const GAS v4u* xr_ = (const GAS v4u*)(XB + (size_t)(m_) * D) + lane; const GAS v4u* y0_ = (const GAS v4u*)(YE + p0_ * D) + lane; const GAS v4u* y1_ = (const GAS v4u*)(YE + p1_ * D) + lane; \
        rx[0] = __builtin_nontemporal_load(xr_); rx[1] = __builtin_nontemporal_load(xr_ + 64); ry0[0] = __builtin_nontemporal_load(y0_); ry0[1] = __builtin_nontemporal_load(y0_ + 64); ry1[0] = __builtin_nontemporal_load(y1_); ry1[1] = __builtin_nontemporal_load(y1_ + 64); cw0 = __uint_as_float((A1).x); cw1 = __uint_as_float((A1).y); } while (0)
    int m = gw;
    if (m < M) { a0 = asg[2 * m]; a1 = asg[2 * m + 1]; P12_ROWS(m, a0, a1); if (m + NGW < M) { a0 = asg[2 * (m + NGW)]; a1 = asg[2 * (m + NGW) + 1]; } }
    for (; m < M; m += NGW) {
        const float w0 = cw0, w1 = cw1; f32x4 v[4]; float s = 0.f;
#pragma unroll
        for (int hh = 0; hh < 2; ++hh) { const v4u x = rx[hh], a = ry0[hh], c = ry1[hh];
            v[2 * hh] = (f32x4){bflo(x.x) + w0 * bflo(a.x) + w1 * bflo(c.x), bfhi(x.x) + w0 * bfhi(a.x) + w1 * bfhi(c.x), bflo(x.y) + w0 * bflo(a.y) + w1 * bflo(c.y), bfhi(x.y) + w0 * bfhi(a.y) + w1 * bfhi(c.y)};
            v[2 * hh + 1] = (f32x4){bflo(x.z) + w0 * bflo(a.z) + w1 * bflo(c.z), bfhi(x.z) + w0 * bfhi(a.z) + w1 * bfhi(c.z), bflo(x.w) + w0 * bflo(a.w) + w1 * bflo(c.w), bfhi(x.w) + w0 * bfhi(a.w) + w1 * bfhi(c.w)};
            s += dot4(v[2 * hh], v[2 * hh]) + dot4(v[2 * hh + 1], v[2 * hh + 1]); }
        if (m + NGW < M) { P12_ROWS(m + NGW, a0, a1); if (m + 2 * NGW < M) { a0 = asg[2 * (m + 2 * NGW)]; a1 = asg[2 * (m + 2 * NGW) + 1]; } }
        const float rstd = frsq(wave_sum(s) * (1.f / D) + EPS);
        GAS f32x4* orow = (GAS f32x4*)(F.out + (size_t)m * D) + 2 * lane;
        __builtin_nontemporal_store(v[0] * rstd * g0, orow); __builtin_nontemporal_store(v[1] * rstd * g1, orow + 1); __builtin_nontemporal_store(v[2] * rstd * g2, orow + 128); __builtin_nontemporal_store(v[3] * rstd * g3, orow + 129);
    }
#undef P12_ROWS
}

struct Args { const float* in[26]; float* out; unsigned char* ws; int ph_lo, ph_hi, li, sub; };
__global__ void __launch_bounds__(NWAVES * 64, 2) mk_fwd(Args args) {
    extern __shared__ __attribute__((aligned(16))) unsigned char lds[];
    Frame F;
    F.lds = (LAS unsigned char*)lds;
    F.MISC = (volatile LAS unsigned*)(F.lds + MISC_OFF);
    F.wave = __builtin_amdgcn_readfirstlane((int)threadIdx.x >> 6);
    F.G = gridDim.x; { const int bx = blockIdx.x; F.vcu = (F.G % 8 == 0) ? (bx % 8) * (F.G / 8) + bx / 8 : bx; }
    unsigned char* ws = args.ws; F.ws = ws; F.out = args.out;
    F.ctl = (gu32*)(ws + WS_CTL);
#pragma unroll
    for (int i = 0; i < 26; ++i) F.in[i] = args.in[i];
    for (int u = (int)threadIdx.x; u < (LDS_BYTES - LDSCTL_OFF) / 4; u += NWAVES * 64) ((LAS unsigned*)(F.lds + LDSCTL_OFF))[u] = 0u;
    __syncthreads();
    XcdBarrier bar; bar.bar = (unsigned*)(F.ctl + CW_BAR) + args.li * XCD_BAR_WORDS; bar.x = 0; bar.st = nullptr;
    if (N_LAUNCHES != NPHASE) bar = xcd_barrier_post((unsigned*)(F.ctl + CW_BAR) + args.li * XCD_BAR_WORDS, F.MISC + 8);
#define GRID_BAR(seam) do { if (N_LAUNCHES == NPHASE) { if (F.wave == 0 && lane_now() == 0) __hip_atomic_store(F.ctl + CW_TMO, 0xBADBA0u | (unsigned)(seam), RLX_AGENT); } else { xcd_barrier(bar, F.wave); } } while (0)
    const int lo = args.ph_lo, hi = args.ph_hi;
#ifndef PHASE_MASK
#define PHASE_MASK 0x1FFF
#endif
#define IN(k) (((PHASE_MASK >> (k)) & 1) && lo <= (k) && (k) < hi)
#define BOTH(k) (IN(k) && IN((k) + 1))
    bf16* Hb = (bf16*)F.out;
    bf16* PROJ = (bf16*)(ws + WS_PROJ);

    if (IN(0)) { p0_prologue(F); if (BOTH(0)) GRID_BAR(0); }

    if (IN(1)) {
        const int sub = args.sub;
        if (sub & 1) {
        if (blockIdx.x < 32) gate_scan(F, (int)blockIdx.x);
        { pg8::Gemm g{Hb, (const bf16*)(ws + WS_WIN), M, NPROJ, D}; pg8::StaticOrder S; S.init(M, NPROJ, F.G, (int)blockIdx.x);
          pg8::EpiProj E{PROJ, NPROJ, (const float*)(ws + WS_ROPE), attn_body::C2};
          pg8::gemm_phase<pg8::EpiProj, pg8::StaticOrder, PG8_ALIGN, PG8_SP2>(F.lds + RING_OFF, g, S, E, F.wave); }
        { pg8::Gemm g{(const bf16*)(ws + WS_WIN) + (size_t)NPROJ * D, Hb, 512, M, D}; pg8::StaticOrder S; S.init(512, M, F.G, (int)blockIdx.x);
          pg8::EpiBf16<0> E{(bf16*)(ws + WS_MVT), M, nullptr, 0, 0, 1.f};
          pg8::gemm_phase<pg8::EpiBf16<0>, pg8::StaticOrder, PG8_ALIGN, PG8_SP2>(F.lds + RING_OFF, g, S, E, F.wave); } }
        if (BOTH(1)) GRID_BAR(1);
    }

    if (IN(2)) {
        if (args.sub & 4) { stage_convw(F); M1Pre mp; const int ln_ = lane_now(); if (F.vcu < 32 * NCH) m1_load(F, F.vcu >> 6, F.vcu & 63, ln_, F.wave, F.wave * 64 + ln_, mp);
            for (int u = F.vcu; u < 32 * NCH; u += F.G) { const int un = u + F.G; m1_unit(F, u >> 6, u & 63, mp, un < 32 * NCH ? un >> 6 : -1, un & 63); } WG_SYNC(); }
        const float* lv = F.in[5]; const int ln_ = lane_now();
        const float lam = expf(wave_sum(lv[ln_] * lv[64 + ln_])) - expf(wave_sum(lv[128 + ln_] * lv[192 + ln_])) + LAM_INIT;
        const attn_body::AttnTensors AT{(const attn_body::bf16*)(PROJ + C_DQ), (const attn_body::bf16*)(PROJ + C_DK), (const attn_body::bf16*)(PROJ + C_DV), (attn_body::bf16*)(ws + WS_OA), lam, 1.0f - LAM_INIT, EPS, F.in[6]};
        const attn_body::StaticOrder S((int)F.G, F.vcu);
        if (args.sub & 8) attn_body::attn_phase<attn_body::StaticOrder>((char*)lds + RING_OFF, AT, S, F.wave);
        if (BOTH(2)) GRID_BAR(2);
    }

    if (IN(3)) {
        if (args.sub & 2) {
        if (blockIdx.x < 64) { pg8::Gemm g{(const bf16*)(ws + WS_MEMN), (const bf16*)(ws + WS_WKV), MROWS, 2 * D, D}; pg8::StaticOrder S; S.init(MROWS, 2 * D, 64, (int)blockIdx.x);
          pg8::EpiBf16<0> E{(bf16*)(ws + WS_MK), D, nullptr, D, (size_t)MROWS * D, 1.f};
          pg8::gemm_phase<pg8::EpiBf16<0>, pg8::StaticOrder, PG8_ALIGN, PG8_SP2>(F.lds + RING_OFF, g, S, E, F.wave); } }
        if (blockIdx.x >= 64 || F.G < 128) p3_scan_combine(F, args.sub & ~32, (F.G < 128) ? 0 : 64);
        if (BOTH(3)) GRID_BAR(3); }

    if (IN(4)) { stage_convw(F); m3_phase(F); if (BOTH(4)) GRID_BAR(4); }

    if (IN(5)) {
        pg8::Gemm g{(const bf16*)(ws + WS_OA), (const bf16*)(ws + WS_WOUT), M, D, D};
        pg8::OutFoldOrder S; S.main.init(M, D, F.G, (int)blockIdx.x); S.G = (int)F.G; S.c = (int)blockIdx.x;
        S.fold = pg8::FoldOrder{(int)F.G, (int)blockIdx.x, (const bf16*)(ws + WS_MK), (const bf16*)(ws + WS_MVT2), (const bf16*)(ws + WS_WXQ), (const bf16*)(ws + WS_WXO)};
        pg8::EpiResidFold E{pg8::EpiResid<true, true>{F.in[0], nullptr, (bf16*)(ws + WS_XB), (float*)(F.ctl + CW_ROWSS), D}, pg8::EpiBf16<0>{(bf16*)(ws + WS_FOLD), D, nullptr, 0, 0, 1.f}};
        pg8::gemm_phase<pg8::EpiResidFold, pg8::OutFoldOrder, PG8_ALIGN, PG8_SP2>(F.lds + RING_OFF, g, S, E, F.wave);
        if (BOTH(5)) GRID_BAR(5);
    }

    if (IN(6)) {
        pg8::Gemm g{(const bf16*)(ws + WS_XB), (const bf16*)(ws + WS_FOLD), M, D, D}; pg8::BatchBOrder S; S.init(M, D, F.G, (int)blockIdx.x); S.bstride = (size_t)D * D * 2; S.tpb = SEQ / 256;
        pg8::EpiSoftmaxP E{(bf16*)(ws + WS_XQ), D, (const float*)(F.ctl + CW_ROWSS), EPS, XSCALE, (LAS float*)(F.lds + XT_TS)};
        pg8::gemm_phase<pg8::EpiSoftmaxP, pg8::BatchBOrder, PG8_ALIGN, PG8_SP2>(F.lds + RING_OFF, g, S, E, F.wave);
        if (BOTH(6)) GRID_BAR(6);
    }


    if (IN(8)) {
        pg8::Gemm g{(const bf16*)(ws + WS_XQ), (const bf16*)(ws + WS_FOLD) + (size_t)8192 * D, M, D, D}; pg8::BatchBOrder S; S.init(M, D, F.G, (int)blockIdx.x); S.bstride = (size_t)D * D * 2; S.tpb = SEQ / 256;
        pg8::EpiResid<false, false> E{nullptr, (const bf16*)(ws + WS_XB), (bf16*)(ws + WS_XB), nullptr, D};
        pg8::gemm_phase<pg8::EpiResid<false, false>, pg8::BatchBOrder, PG8_ALIGN, PG8_SP2>(F.lds + RING_OFF, g, S, E, F.wave);
        if (BOTH(8)) GRID_BAR(8);
    }

    if (IN(9)) { p9_router(F); if (BOTH(9)) GRID_BAR(9); }

    if (IN(10)) {
        const int ntiles = expert_tables<true>(F);
        pg8::Gemm g{(const bf16*)(ws + WS_XB), (const bf16*)(ws + WS_W13), M, D, D};
        pg8::ExpertOrder<true> S{F.G, (int)blockIdx.x, ntiles, (const LAS int*)(F.lds + XT_TS), (const LAS int*)(F.lds + XT_TOK), (size_t)D * D * 2};
        pg8::EpiSwiGLU E{(bf16*)(ws + WS_ACT), DEXP, (const LAS float*)(F.lds + XT_RS)};
        pg8::gemm_phase<pg8::EpiSwiGLU, pg8::ExpertOrder<true>, PG8_ALIGN, PG8_SP2>(F.lds + RING_OFF, g, S, E, F.wave);
        p10_w2_items(F, 4 * ntiles);
        if (BOTH(10)) GRID_BAR(10);
    }

    if (IN(11)) {
        const int ntiles = expert_tables<false>(F);
        pg8::Gemm g{(const bf16*)(ws + WS_ACT), (const bf16*)(ws + WS_W2), MAXROWS, D, DEXP};
        pg8::ExpertOrder<false> S{F.G, (int)blockIdx.x, ntiles, (const LAS int*)(F.lds + XT_TS), (const LAS int*)(F.lds + XT_TOK), (size_t)D * DEXP * 2};
        pg8::EpiBf16<0> E{(bf16*)(ws + WS_YE), D, nullptr, 0, 0, 1.f};
        pg8::gemm_phase<pg8::EpiBf16<0>, pg8::ExpertOrder<false>, PG8_ALIGN, PG8_SP2>(F.lds + RING_OFF, g, S, E, F.wave);
        if (BOTH(11)) GRID_BAR(11);
    }

    if (IN(12)) { p12_final(F); }
#undef IN
#undef BOTH
}

extern "C" void kernel_launch(void* const* d_in, const int* in_sizes, int n_in, void* d_out, int out_size, void* d_ws, size_t ws_size, hipStream_t stream) {
    static int grid = 0;
    if (grid == 0) {
        if (n_in != 26 || in_sizes[0] != M * D || out_size != M * D || ws_size < WS_END) { fprintf(stderr, "kernel_launch: unexpected shapes (n_in %d, in0 %d, out %d, ws %zu); nothing launched\n", n_in, n_in > 0 ? in_sizes[0] : -1, out_size, ws_size); grid = -1; return; }
        int dev = 0, cus = 0, per_cu = 0;
        if (hipGetDevice(&dev) != hipSuccess || hipDeviceGetAttribute(&cus, hipDeviceAttributeMultiprocessorCount, dev) != hipSuccess) { grid = -1; return; }
        if (hipFuncSetAttribute((const void*)mk_fwd, hipFuncAttributeMaxDynamicSharedMemorySize, LDS_BYTES) != hipSuccess) { fprintf(stderr, "kernel_launch: hipFuncSetAttribute failed\n"); grid = -1; return; }
        if (hipOccupancyMaxActiveBlocksPerMultiprocessor(&per_cu, (const void*)mk_fwd, NWAVES * 64, LDS_BYTES) != hipSuccess || per_cu < 1) { fprintf(stderr, "kernel_launch: occupancy query reports %d workgroups per CU\n", per_cu); }
        (void)hipGetLastError();
        grid = cus;
    }
    if (grid < 0) return;
    if (hipMemsetAsync((char*)d_ws + WS_CTL, 0, CTL_ZERO_BYTES, stream) != hipSuccess) return;
    Args a{};
    for (int i = 0; i < 26; ++i) a.in[i] = (const float*)d_in[i];
    a.out = (float*)d_out; a.ws = (unsigned char*)d_ws;
#ifdef PROBE_PRE_MASK
    for (int r = 0; r < PROBE_REP; ++r) for (int k = 0; k < NPHASE; ++k) if ((PROBE_PRE_MASK >> k) & 1) { a.ph_lo = k; a.ph_hi = k + 1; a.li = 1; a.sub = PROBE_SUB;
        hipLaunchKernelGGL(mk_fwd, dim3(grid), dim3(NWAVES * 64), LDS_BYTES, stream, a); }
    if (hipMemsetAsync((char*)d_ws + WS_CTL, 0, CTL_ZERO_BYTES, stream) != hipSuccess) return;
#endif
    for (int li = 0; li < N_LAUNCHES; ++li) {
        a.ph_lo = (N_LAUNCHES == NPHASE) ? li : 0; a.ph_hi = (N_LAUNCHES == NPHASE) ? li + 1 : NPHASE; a.li = 0; a.sub = 0x3F;
        hipLaunchKernelGGL(mk_fwd, dim3(grid), dim3(NWAVES * 64), LDS_BYTES, stream, a);
        if (hipPeekAtLastError() != hipSuccess) break;
    }
#ifdef PROBE_POST_MASK
    for (int r = 0; r < PROBE_REP; ++r) for (int k = 0; k < NPHASE; ++k) if ((PROBE_POST_MASK >> k) & 1) { a.ph_lo = k; a.ph_hi = k + 1; a.li = 1; a.sub = PROBE_SUB;
        hipLaunchKernelGGL(mk_fwd, dim3(grid), dim3(NWAVES * 64), LDS_BYTES, stream, a); }
#endif
}
```

```cpp
#include <hip/hip_runtime.h>
#include <cstdio>
#include <cstdint>
__device__ __forceinline__ int lane_now() { int l; asm volatile("v_mbcnt_lo_u32_b32 %0, -1, 0\n\tv_mbcnt_hi_u32_b32 %0, -1, %0" : "=v"(l)); return l; }
namespace pg8 {
#define PG8_LAS __attribute__((address_space(3)))
typedef unsigned short bf16_t;
typedef short bf16x8 __attribute__((ext_vector_type(8)));
typedef float f32x4 __attribute__((ext_vector_type(4)));
typedef unsigned u32x4 __attribute__((ext_vector_type(4)));
constexpr int BM = 256, BK = 64, HALF = 128, HTB = HALF * BK * 2  , STAGE_BYTES = 8 * HTB, NXCD = 8, WGM = 8;

__host__ __device__ __forceinline__ int lds_byte(int r, int c) { const int st = (r >> 4) * 2 + (c >> 5), rr = r & 15, cc = c & 31, ob = rr * 64 + cc * 2; return st * 1024 + (ob ^ (((ob >> 9) & 1) << 5)); }
__host__ __device__ __forceinline__ void stage_rc(int b, int& R, int& C) { const int st = b / 1024, sb = b % 1024, swz = sb ^ (((sb >> 9) & 1) << 5); R = (st >> 1) * 16 + swz / 64; C = (st & 1) * 32 + (swz % 64) / 2; }
__host__ __device__ __forceinline__ int perm32(int rho) { const int n = rho >> 4, i = rho & 15; return 8 * (i >> 2) + 4 * n + (i & 3); }

struct Unit { int pm, pn, e, ui; int nt = 0; };
struct Gemm { const bf16_t* A; const bf16_t* Bt; int M, N, K; int kext = 0; };

struct StaticOrder {
    int nM, nN, nwg, G, c;
    __host__ __device__ __forceinline__ void init(int M, int N, int G_, int c_) { nM = M / BM; nN = N / BM; nwg = nM * nN; G = G_; c = c_; }
    __host__ __device__ __forceinline__ bool next(int i, Unit& u) const { const long L = (long)i * G + c; if (L >= nwg) return false; at((int)L, u); u.ui = i; return true; }
    __host__ __device__ __forceinline__ void at(int L, Unit& u) const {
        int wgid = L; { const int q = nwg / NXCD, r = nwg % NXCD, xcd = wgid % NXCD, off = wgid / NXCD; wgid = (xcd < r ? xcd * (q + 1) : r * (q + 1) + (xcd - r) * q) + off; }
        const int nig = WGM * nN, gid = wgid / nig, fm = gid * WGM, gsz = (nM - fm) < WGM ? (nM - fm) : WGM;
        u.pm = fm + ((wgid % nig) % gsz); u.pn = (wgid % nig) / gsz; u.e = 0; u.ui = 0;
    }
    __device__ __forceinline__ const char* aptr(const Gemm& g, const Unit& u, size_t tstep) const { return (const char*)g.A + (size_t)u.pm * tstep; }
    __device__ __forceinline__ const char* bptr(const Gemm& g, const Unit& u, size_t tstep) const { return (const char*)g.Bt + (size_t)u.pn * tstep; }
    __device__ __forceinline__ void avoff(const Unit&, int, const int (&R)[2], const int (&C)[2], int K, unsigned (&vo)[2][2]) const {
#pragma unroll
        for (int h = 0; h < 2; ++h)
#pragma unroll
            for (int i = 0; i < 2; ++i) vo[h][i] = (unsigned)((h * HALF + R[i]) * K + C[i]) * 2u; }
};

__device__ __forceinline__ unsigned cvt_pk_bf16(float lo, float hi) { unsigned r; asm volatile("v_cvt_pk_bf16_f32 %0, %1, %2" : "=v"(r) : "v"(lo), "v"(hi)); return r; }
typedef float f32x2 __attribute__((ext_vector_type(2)));
__device__ __forceinline__ f32x2 gelu_pk(f32x2 v) {
    const f32x2 av = __builtin_elementwise_abs(v), d = av * 0.2316418882f + 1.0f;
    f32x2 t; t.x = __builtin_amdgcn_rcpf(d.x); t.y = __builtin_amdgcn_rcpf(d.y);
    f32x2 q = t * 0.5307027145f + (-0.7265760135f); q = q * t + 0.7107068705f; q = q * t + (-0.142248368f); q = q * t + 0.127414796f; q = q * t;
    const f32x2 s = (v * v) * (-0.72134752044f);
    f32x2 e; e.x = __builtin_amdgcn_exp2f(s.x); e.y = __builtin_amdgcn_exp2f(s.y);
    const f32x2 m = v * (q * e), r = v - m;
    f32x2 o; o.x = v.x < 0.f ? m.x : r.x; o.y = v.y < 0.f ? m.y : r.y; return o;
}

template <int ACT  > struct EpiBf16 {
    static constexpr bool PERM = true, AFTER_DRAIN = false; static_assert(ACT == 0 || ACT == 1, "EpiBf16: ACT is 0 (none) or 1 (gelu_pk)");
    bf16_t* O; int ldc; const float* bias; int split_cols; size_t split_stride; float scale0;
    __device__ __forceinline__ void operator()(const f32x4 (&acc)[2][2][4][2], const Unit& u, int wr, int wc, int fr, int fq) const {
        const int row0 = u.pm * BM + wr * 64 + fr; int colt = u.pn * BM; bf16_t* base = O;
        float sc = 1.f; if (split_cols) { const int t = colt / split_cols; base += (size_t)t * split_stride; colt -= t * split_cols; if (t == 0) sc = scale0; }
        const int col0 = colt + wc * 32 + 8 * fq, bcol0 = u.pn * BM + wc * 32 + 8 * fq;
        f32x4 bv[2][2];
#pragma unroll
        for (int bj = 0; bj < 2; ++bj)
#pragma unroll
            for (int n = 0; n < 2; ++n) bv[bj][n] = bias ? *(const f32x4*)(bias + bcol0 + bj * HALF + 4 * n) : (f32x4){0.f, 0.f, 0.f, 0.f};
#pragma unroll
        for (int ai = 0; ai < 2; ++ai)
#pragma unroll
            for (int m = 0; m < 4; ++m) { bf16_t* rowp = base + (size_t)(row0 + ai * HALF + m * 16) * ldc + col0;
#pragma unroll
                for (int bj = 0; bj < 2; ++bj) { f32x4 v0 = acc[ai][bj][m][0] + bv[bj][0], v1 = acc[ai][bj][m][1] + bv[bj][1];
                    if (ACT == 1) { f32x2 a = gelu_pk((f32x2){v0[0], v0[1]}), b = gelu_pk((f32x2){v0[2], v0[3]}), c = gelu_pk((f32x2){v1[0], v1[1]}), d = gelu_pk((f32x2){v1[2], v1[3]});
                        v0 = (f32x4){a.x, a.y, b.x, b.y}; v1 = (f32x4){c.x, c.y, d.x, d.y}; }
                    v0 = v0 * sc; v1 = v1 * sc; u32x4 w; w.x = cvt_pk_bf16(v0[0], v0[1]); w.y = cvt_pk_bf16(v0[2], v0[3]); w.z = cvt_pk_bf16(v1[0], v1[1]); w.w = cvt_pk_bf16(v1[2], v1[3]);
                    *(u32x4*)(rowp + bj * HALF) = w; } }
    }
};
typedef unsigned u32x2 __attribute__((ext_vector_type(2)));
__device__ __forceinline__ u32x2 pack4(const f32x4 v) { u32x2 w; w.x = cvt_pk_bf16(v[0], v[1]); w.y = cvt_pk_bf16(v[2], v[3]); return w; }

struct EpiProj {
    static constexpr bool PERM = true, AFTER_DRAIN = false;
    bf16_t* O; int ldc; const float* rope; float qscale;
    __device__ __forceinline__ void operator()(const f32x4 (&acc)[2][2][4][2], const Unit& u, int wr, int wc, int fr, int fq) const {
        const int row0 = u.pm * BM + wr * 64 + fr;
        if (u.pn < 4) {
            const float sc = (u.pn < 2) ? qscale : 1.0f;
#pragma unroll
            for (int ai = 0; ai < 2; ++ai)
#pragma unroll
                for (int m = 0; m < 4; ++m) { const int r = row0 + ai * HALF + m * 16; const int pos = r & 4095; const float* rp = rope + pos * 32 + 8 * fq;
                    const f32x4 c0 = *(const f32x4*)rp, c1 = *(const f32x4*)(rp + 4), s0 = *(const f32x4*)(rp + 4096 * 32), s1 = *(const f32x4*)(rp + 4096 * 32 + 4);
                    const f32x4 a0 = acc[ai][0][m][0], a1 = acc[ai][0][m][1], b0 = acc[ai][1][m][0], b1 = acc[ai][1][m][1];
                    const f32x4 x0 = (a0 * c0 - b0 * s0) * sc, x1 = (a1 * c1 - b1 * s1) * sc, y0 = (b0 * c0 + a0 * s0) * sc, y1 = (b1 * c1 + a1 * s1) * sc;
                    bf16_t* p = O + (size_t)r * ldc + u.pn * BM + 64 * wc + 8 * fq; u32x4 w;
                    w.x = cvt_pk_bf16(x0[0], x0[1]); w.y = cvt_pk_bf16(x0[2], x0[3]); w.z = cvt_pk_bf16(x1[0], x1[1]); w.w = cvt_pk_bf16(x1[2], x1[3]); *(u32x4*)p = w;
                    w.x = cvt_pk_bf16(y0[0], y0[1]); w.y = cvt_pk_bf16(y0[2], y0[3]); w.z = cvt_pk_bf16(y1[0], y1[1]); w.w = cvt_pk_bf16(y1[2], y1[3]); *(u32x4*)(p + 32) = w; }
        } else {
            const int col0 = u.pn * BM + wc * 32 + 8 * fq;
#pragma unroll
            for (int ai = 0; ai < 2; ++ai)
#pragma unroll
                for (int m = 0; m < 4; ++m) { bf16_t* rowp = O + (size_t)(row0 + ai * HALF + m * 16) * ldc + col0;
#pragma unroll
                    for (int bj = 0; bj < 2; ++bj) { const f32x4 v0 = acc[ai][bj][m][0], v1 = acc[ai][bj][m][1];
                        u32x4 w; w.x = cvt_pk_bf16(v0[0], v0[1]); w.y = cvt_pk_bf16(v0[2], v0[3]); w.z = cvt_pk_bf16(v1[0], v1[1]); w.w = cvt_pk_bf16(v1[2], v1[3]);
                        *(u32x4*)(rowp + bj * HALF) = w; } }
        }
    }
};
template <bool BASE_F32, bool WITH_SS> struct EpiResid {
    static constexpr bool PERM = true, AFTER_DRAIN = false;
    const float* basef; const bf16_t* baseb; bf16_t* xb; float* rowss; int ldc;
    __device__ __forceinline__ void operator()(const f32x4 (&acc)[2][2][4][2], const Unit& u, int wr, int wc, int fr, int fq) const {
        const int row0 = u.pm * BM + wr * 64 + fr, col0 = u.pn * BM + wc * 32 + 8 * fq;
#pragma unroll
        for (int ai = 0; ai < 2; ++ai)
#pragma unroll
            for (int m = 0; m < 4; ++m) { const int r = row0 + ai * HALF + m * 16; const size_t off = (size_t)r * ldc + col0; float ss = 0.f;
#pragma unroll
                for (int bj = 0; bj < 2; ++bj) { f32x4 o0, o1;
                    if (BASE_F32) { o0 = __builtin_nontemporal_load((const f32x4*)(basef + off + bj * HALF)); o1 = __builtin_nontemporal_load((const f32x4*)(basef + off + bj * HALF + 4)); }
                    else { const u32x4 w = *(const u32x4*)(baseb + off + bj * HALF);
                        o0 = (f32x4){__uint_as_float(w.x << 16), __uint_as_float(w.x & 0xffff0000u), __uint_as_float(w.y << 16), __uint_as_float(w.y & 0xffff0000u)};
                        o1 = (f32x4){__uint_as_float(w.z << 16), __uint_as_float(w.z & 0xffff0000u), __uint_as_float(w.w << 16), __uint_as_float(w.w & 0xffff0000u)}; }
                    o0 = o0 + acc[ai][bj][m][0]; o1 = o1 + acc[ai][bj][m][1];
                    u32x4 w; w.x = cvt_pk_bf16(o0[0], o0[1]); w.y = cvt_pk_bf16(o0[2], o0[3]); w.z = cvt_pk_bf16(o1[0], o1[1]); w.w = cvt_pk_bf16(o1[2], o1[3]);
                    *(u32x4*)(xb + off + bj * HALF) = w;
                    if (WITH_SS) ss += ((o0[0] * o0[0] + o0[1] * o0[1]) + (o0[2] * o0[2] + o0[3] * o0[3])) + ((o1[0] * o1[0] + o1[1] * o1[1]) + (o1[2] * o1[2] + o1[3] * o1[3])); }
                if (WITH_SS) { ss += __shfl_xor(ss, 16); ss += __shfl_xor(ss, 32); if (fq == 0) atomicAdd(rowss + r, ss); } }
    }
};
struct EpiRowScale {
    static constexpr bool PERM = true, AFTER_DRAIN = false;
    bf16_t* O; int ldc; const float* rowss; float eps, scale;
    __device__ __forceinline__ void operator()(const f32x4 (&acc)[2][2][4][2], const Unit& u, int wr, int wc, int fr, int fq) const {
        const int row0 = u.pm * BM + wr * 64 + fr, col0 = u.pn * BM + wc * 32 + 8 * fq;
#pragma unroll
        for (int ai = 0; ai < 2; ++ai)
#pragma unroll
            for (int m = 0; m < 4; ++m) { const int r = row0 + ai * HALF + m * 16; const float sc = scale / sqrtf(rowss[r] * (1.0f / 1024.0f) + eps); bf16_t* rowp = O + (size_t)r * ldc + col0;
#pragma unroll
                for (int bj = 0; bj < 2; ++bj) { const f32x4 v0 = acc[ai][bj][m][0] * sc, v1 = acc[ai][bj][m][1] * sc;
                    u32x4 w; w.x = cvt_pk_bf16(v0[0], v0[1]); w.y = cvt_pk_bf16(v0[2], v0[3]); w.z = cvt_pk_bf16(v1[0], v1[1]); w.w = cvt_pk_bf16(v1[2], v1[3]);
                    *(u32x4*)(rowp + bj * HALF) = w; } }
    }
};
struct EpiSwiGLU {
    static constexpr bool PERM = true, AFTER_DRAIN = false;
    bf16_t* O; int ldc; const PG8_LAS float* RS;
    __device__ __forceinline__ void operator()(const f32x4 (&acc)[2][2][4][2], const Unit& u, int wr, int wc, int fr, int fq) const {
        const int row0 = u.pm * BM + wr * 64 + fr, col0 = u.pn * HALF + wc * 32 + 8 * fq;
#pragma unroll
        for (int ai = 0; ai < 2; ++ai)
#pragma unroll
            for (int m = 0; m < 4; ++m) { bf16_t* rowp = O + (size_t)(row0 + ai * HALF + m * 16) * ldc + col0; const float rs = RS[u.ui * 256 + wr * 64 + fr + ai * HALF + m * 16]; u32x4 w;
#pragma unroll
                for (int n = 0; n < 2; ++n) { const f32x4 a = acc[ai][0][m][n] * rs, b = acc[ai][1][m][n] * rs; f32x4 o;
#pragma unroll
                    for (int j = 0; j < 4; ++j) o[j] = a[j] * b[j] * __builtin_amdgcn_rcpf(1.0f + __builtin_amdgcn_exp2f(-1.4426950408889634f * a[j]));
                    const u32x2 p = pack4(o); if (n == 0) { w.x = p.x; w.y = p.y; } else { w.z = p.x; w.w = p.y; } }
                *(u32x4*)rowp = w; }
    }
};
struct EpiNull { static constexpr bool PERM = true, AFTER_DRAIN = false; float* sink;
    __device__ __forceinline__ void operator()(const f32x4 (&acc)[2][2][4][2], const Unit& u, int wr, int wc, int fr, int fq) const { float s = 0.f;
#pragma unroll
        for (int ai = 0; ai < 2; ++ai)
#pragma unroll
            for (int bj = 0; bj < 2; ++bj)
#pragma unroll
                for (int m = 0; m < 4; ++m)
#pragma unroll
                    for (int n = 0; n < 2; ++n) s += acc[ai][bj][m][n][0] + acc[ai][bj][m][n][1] + acc[ai][bj][m][n][2] + acc[ai][bj][m][n][3];
        if (s == 1.2345e-30f) *sink = s; } };
struct EpiNull2 { static constexpr bool PERM = true, AFTER_DRAIN = false; bf16_t* O; int ldc;
    __device__ __forceinline__ void operator()(const f32x4 (&acc)[2][2][4][2], const Unit& u, int wr, int wc, int fr, int fq) const {
        const int row0 = u.pm * BM + wr * 64 + fr, col0 = u.pn * BM + wc * 32 + 8 * fq;
#pragma unroll
        for (int ai = 0; ai < 2; ++ai)
#pragma unroll
            for (int m = 0; m < 4; ++m) { const int r = row0 + ai * HALF + m * 16; const float sc = 0.5f; const size_t off = (((size_t)r * ldc + col0) * 2 & 8191) + (size_t)blockIdx.x * 8192;
#pragma unroll
                for (int bj = 0; bj < 2; ++bj) { const f32x4 v0 = acc[ai][bj][m][0] * sc, v1 = acc[ai][bj][m][1] * sc;
                    u32x4 w; w.x = cvt_pk_bf16(v0[0], v0[1]); w.y = cvt_pk_bf16(v0[2], v0[3]); w.z = cvt_pk_bf16(v1[0], v1[1]); w.w = cvt_pk_bf16(v1[2], v1[3]);
                    *(u32x4*)((char*)O + ((off + bj * 256) & ~15)) = w; } }
    } };

struct BatchBOrder : StaticOrder { size_t bstride; int tpb;
    __device__ __forceinline__ const char* bptr(const Gemm& g, const Unit& u, size_t tstep) const { return (const char*)g.Bt + (size_t)(u.pm / tpb) * bstride + (size_t)u.pn * tstep; } };
struct FoldOrder { int G, c; const bf16_t* MK; const bf16_t* MV; const bf16_t* WXQN; const bf16_t* WXOT;
    __device__ __forceinline__ bool next(int i, Unit& u) const { const int L = i * G + c; if (L >= 256) return false;
        const int ty = L >> 7, l = L & 127, b = l >> 4, h = (l >> 2) & 3, j = l & 3; u.e = ty; u.ui = i;
        u.pm = ty == 0 ? b * 4 + h : 32 + b * 4 + j; u.pn = ty == 0 ? j : h; return true; }
    __device__ __forceinline__ const char* aptr(const Gemm&, const Unit& u, size_t) const {
        return u.e == 0 ? (const char*)(MK + ((size_t)(u.pm >> 2) * 256 * 1024 + (u.pm & 3) * 256)) : (const char*)(WXOT + ((size_t)((u.pm - 32) & 3) * 256 * 1024 + u.pn * 256)); }
    __device__ __forceinline__ const char* bptr(const Gemm&, const Unit& u, size_t) const {
        return u.e == 0 ? (const char*)(WXQN + ((size_t)u.pn * 256 * 1024 + (u.pm & 3) * 256)) : (const char*)(MV + ((size_t)((u.pm - 32) >> 2) * 256 * 1024 + u.pn * 256)); }
    __device__ __forceinline__ void avoff(const Unit&, int, const int (&R)[2], const int (&C)[2], int K, unsigned (&vo)[2][2]) const {
#pragma unroll
        for (int h = 0; h < 2; ++h)
#pragma unroll
            for (int i = 0; i < 2; ++i) vo[h][i] = (unsigned)((h * HALF + R[i]) * K + C[i]) * 2u; }
};
struct OutFoldOrder { StaticOrder main; FoldOrder fold; int G, c;
    __device__ __forceinline__ bool next(int i, Unit& u) const { const int P = i * G + c; if (P >= main.nwg + 256) return false;
        const bool mn = P < main.nwg; Unit t; main.at(mn ? P : 0, t);
        const int L = P - main.nwg, ty = L >> 7, l = L & 127, b = l >> 4, h = (l >> 2) & 3, j = l & 3;
        const int fpm = ty == 0 ? b * 4 + h : 32 + b * 4 + j, fpn = ty == 0 ? j : h;
        u.pm = mn ? t.pm : fpm; u.pn = mn ? t.pn : fpn; u.e = mn ? 2 : ty; u.ui = i; u.nt = mn ? 16 : 4; return true; }
    __device__ __forceinline__ const char* aptr(const Gemm& g, const Unit& u, size_t tstep) const { return u.e == 2 ? main.aptr(g, u, tstep) : fold.aptr(g, u, tstep); }
    __device__ __forceinline__ const char* bptr(const Gemm& g, const Unit& u, size_t tstep) const { return u.e == 2 ? main.bptr(g, u, tstep) : fold.bptr(g, u, tstep); }
    __device__ __forceinline__ void avoff(const Unit& u, int ui, const int (&R)[2], const int (&C)[2], int K, unsigned (&vo)[2][2]) const { main.avoff(u, ui, R, C, K, vo); }
};
struct EpiResidFold { static constexpr bool PERM = true, AFTER_DRAIN = false; EpiResid<true, true> R; EpiBf16<0> B;
    __device__ __forceinline__ void operator()(const f32x4 (&acc)[2][2][4][2], const Unit& u, int wr, int wc, int fr, int fq) const { if (u.e == 2) R(acc, u, wr, wc, fr, fq); else B(acc, u, wr, wc, fr, fq); } };
struct EpiSoftmaxP {
    static constexpr bool PERM = true, AFTER_DRAIN = false;
    bf16_t* O; int ldc; const float* rowss; float eps, scale; PG8_LAS float* ex;
    __device__ __forceinline__ void operator()(f32x4 (&acc)[2][2][4][2], const Unit& u, int wr, int wc, int fr, int fq) const {
        const int rl0 = wr * 64 + fr, row0 = u.pm * BM + rl0, col0 = u.pn * BM + wc * 32 + 8 * fq;
        float mw[2][4];
#pragma unroll
        for (int ai = 0; ai < 2; ++ai)
#pragma unroll
            for (int m = 0; m < 4; ++m) { const int rl = rl0 + ai * HALF + m * 16; const float sc = scale / sqrtf(rowss[u.pm * BM + rl] * (1.0f / 1024.0f) + eps);
                float mx = -INFINITY;
#pragma unroll
                for (int bj = 0; bj < 2; ++bj)
#pragma unroll
                    for (int n = 0; n < 2; ++n) { const f32x4 t = acc[ai][bj][m][n] * sc; acc[ai][bj][m][n] = t; mx = fmaxf(mx, fmaxf(fmaxf(t[0], t[1]), fmaxf(t[2], t[3]))); }
                { auto r = __builtin_amdgcn_permlane16_swap(__float_as_uint(mx), __float_as_uint(mx), false, false); mx = fmaxf(__uint_as_float(r[0]), __uint_as_float(r[1])); }
                { auto r = __builtin_amdgcn_permlane32_swap(__float_as_uint(mx), __float_as_uint(mx), false, false); mx = fmaxf(__uint_as_float(r[0]), __uint_as_float(r[1])); }
                float s = 0.f;
#pragma unroll
                for (int bj = 0; bj < 2; ++bj)
#pragma unroll
                    for (int n = 0; n < 2; ++n) { f32x4 t = acc[ai][bj][m][n];
#pragma unroll
                        for (int j = 0; j < 4; ++j) t[j] = __builtin_amdgcn_exp2f(t[j] - mx);
                        acc[ai][bj][m][n] = t; s += (t[0] + t[1]) + (t[2] + t[3]); }
                { auto r = __builtin_amdgcn_permlane16_swap(__float_as_uint(s), __float_as_uint(s), false, false); s = __uint_as_float(r[0]) + __uint_as_float(r[1]); }
                { auto r = __builtin_amdgcn_permlane32_swap(__float_as_uint(s), __float_as_uint(s), false, false); s = __uint_as_float(r[0]) + __uint_as_float(r[1]); }
                if (fq == 0) { f32x2 ms; ms.x = mx; ms.y = s; *(PG8_LAS f32x2*)(ex + (rl * 4 + wc) * 2) = ms; }
                mw[ai][m] = mx; }
        asm volatile("s_waitcnt lgkmcnt(0)" ::: "memory"); __builtin_amdgcn_s_barrier();
#pragma unroll
        for (int ai = 0; ai < 2; ++ai)
#pragma unroll
            for (int m = 0; m < 4; ++m) { const int rl = rl0 + ai * HALF + m * 16; const PG8_LAS f32x4* e4 = (const PG8_LAS f32x4*)(ex + rl * 8); const f32x4 a = e4[0], b = e4[1];
                const float Mx = fmaxf(fmaxf(a[0], a[2]), fmaxf(b[0], b[2]));
                const float L = (a[1] * __builtin_amdgcn_exp2f(a[0] - Mx) + a[3] * __builtin_amdgcn_exp2f(a[2] - Mx)) + (b[1] * __builtin_amdgcn_exp2f(b[0] - Mx) + b[3] * __builtin_amdgcn_exp2f(b[2] - Mx));
                const float f = __builtin_amdgcn_exp2f(mw[ai][m] - Mx) * __builtin_amdgcn_rcpf(L);
                bf16_t* rowp = O + (size_t)(row0 + ai * HALF + m * 16) * ldc + col0;
#pragma unroll
                for (int bj = 0; bj < 2; ++bj) { const f32x4 v0 = acc[ai][bj][m][0] * f, v1 = acc[ai][bj][m][1] * f;
                    u32x4 w; w.x = cvt_pk_bf16(v0[0], v0[1]); w.y = cvt_pk_bf16(v0[2], v0[3]); w.z = cvt_pk_bf16(v1[0], v1[1]); w.w = cvt_pk_bf16(v1[2], v1[3]);
                    *(u32x4*)(rowp + bj * HALF) = w; } }
    }
};
__host__ __device__ __forceinline__ int expert_unit_id(int L, int nwg) { const int q = nwg / NXCD, r = nwg % NXCD, xcd = L % NXCD, off = L / NXCD; return (xcd < r ? xcd * (q + 1) : r * (q + 1) + (xcd - r) * q) + off; }
template <bool GATHER> struct ExpertOrder {
    int G, c, ntiles; const PG8_LAS int* TS; const PG8_LAS int* TOK; size_t estride;
    __device__ __forceinline__ bool next(int i, Unit& u) const {
        const int L = i * G + c; if (L >= 4 * ntiles) return false;
        const int id = expert_unit_id(L, 4 * ntiles); const int rt = id >> 2; int e = 0;
        for (int k = 1; k < 32; ++k) e += (TS[k] <= rt) ? 1 : 0;
        u.pm = rt; u.pn = id & 3; u.e = e; u.ui = i; return true;
    }
    __device__ __forceinline__ const char* aptr(const Gemm& g, const Unit& u, size_t tstep) const { return GATHER ? (const char*)g.A : (const char*)g.A + (size_t)u.pm * tstep; }
    __device__ __forceinline__ const char* bptr(const Gemm& g, const Unit& u, size_t tstep) const { return (const char*)g.Bt + (size_t)u.e * estride + (size_t)u.pn * tstep; }
    __device__ __forceinline__ void avoff(const Unit&, int ui, const int (&R)[2], const int (&C)[2], int K, unsigned (&vo)[2][2]) const {
#pragma unroll
        for (int h = 0; h < 2; ++h)
#pragma unroll
            for (int i = 0; i < 2; ++i) { const int row = GATHER ? TOK[ui * 256 + h * HALF + R[i]] : (h * HALF + R[i]); vo[h][i] = (unsigned)(row * K + C[i]) * 2u; } }
};
template <class Epi, class Sched, bool ALIGN_EPI = false, bool SP2 = false>
__device__ __forceinline__ void gemm_phase(PG8_LAS unsigned char* lds, const Gemm g, const Sched& S, const Epi& E, const int wv) {
    const int wid = wv, lane = lane_now(), tid = wid * 64 + lane, wr = wid >> 2, wc = wid & 3, fr = lane & 15, fq = lane >> 4;
    const int K = g.K, nt = (g.kext ? g.kext : K) / BK;
    int R_[2], C_[2]; unsigned voffB[2];
#pragma unroll
    for (int i = 0; i < 2; ++i) { int R, C; stage_rc(tid * 16 + i * 8192, R, C); R_[i] = R; C_[i] = C; const int Rb = Epi::PERM ? ((R & ~31) + perm32(R & 31)) : R;
        voffB[i] = (unsigned)(Rb * K + C) * 2u; }
    const size_t kstep = (size_t)(BK * 2);
    const size_t hstep = (size_t)HALF * K * 2;
    const size_t tstep = 2 * hstep;
    const unsigned ldsw = (unsigned)wid * 1024u;
    const int aoff = lds_byte(wr * 64 + fr, fq * 8), boff = lds_byte(wc * 32 + fr, fq * 8);
#define PG8_SA(b, h) (((b) * 2 + (h)) * HTB)
#define PG8_SB(b, h) ((4 + (b) * 2 + (h)) * HTB)
#define PG8_STAGE(bufoff, gbase, voff) do { _Pragma("unroll") for (int _i = 0; _i < 2; ++_i) \
        __builtin_amdgcn_global_load_lds((const unsigned*)((const char*)(gbase) + (voff)[_i]), (PG8_LAS unsigned*)(lds + (bufoff) + ldsw + _i * 8192), 16, 0, 0); } while (0)
#define PG8_LDA(dst, b, h) do { _Pragma("unroll") for (int m = 0; m < 4; ++m) _Pragma("unroll") for (int k = 0; k < 2; ++k) dst[m][k] = *(const PG8_LAS bf16x8*)(lds + PG8_SA(b, h) + aoff + m * 2048 + k * 1024); } while (0)
#define PG8_LDB(dst, b, h) do { _Pragma("unroll") for (int n = 0; n < 2; ++n) _Pragma("unroll") for (int k = 0; k < 2; ++k) dst[n][k] = *(const PG8_LAS bf16x8*)(lds + PG8_SB(b, h) + boff + n * 2048 + k * 1024); } while (0)
#define PG8_MMA(ai, bj, At, Bt) do { __builtin_amdgcn_s_setprio(1); _Pragma("unroll") for (int m = 0; m < 4; ++m) _Pragma("unroll") for (int n = 0; n < 2; ++n) _Pragma("unroll") for (int k = 0; k < 2; ++k) \
        acc[ai][bj][m][n] = __builtin_amdgcn_mfma_f32_16x16x32_bf16(Bt[n][k], At[m][k], acc[ai][bj][m][n], 0, 0, 0); __builtin_amdgcn_s_setprio(0); } while (0)
#define PG8_WAIT_V(n) asm volatile("s_waitcnt vmcnt(" #n ")" ::: "memory")
#define PG8_WAIT_L(n) asm volatile("s_waitcnt lgkmcnt(" #n ")" ::: "memory")
#define PG8_BAR __builtin_amdgcn_s_barrier()
#define PG8_SCHED __builtin_amdgcn_sched_barrier(0)
    Unit cur, nxt; int ui = 0;
    if (!S.next(0, cur)) return;
    f32x4 acc[2][2][4][2];
#pragma unroll
    for (int a = 0; a < 2; ++a)
#pragma unroll
        for (int b = 0; b < 2; ++b)
#pragma unroll
            for (int m = 0; m < 4; ++m)
#pragma unroll
                for (int n = 0; n < 2; ++n) acc[a][b][m][n] = (f32x4){0.f, 0.f, 0.f, 0.f};
    bf16x8 At[4][2], B0[2][2], B1[2][2];
    const char* cA = S.aptr(g, cur, tstep); const char* cB = S.bptr(g, cur, tstep);
    unsigned voA[2][2], voN[2][2];
    S.avoff(cur, 0, R_, C_, K, voA);
    if constexpr (SP2) {
        PG8_STAGE(PG8_SB(0, 0), cB, voffB); PG8_STAGE(PG8_SB(0, 1), cB + hstep, voffB); PG8_STAGE(PG8_SA(0, 0), cA, voA[0]); PG8_STAGE(PG8_SA(0, 1), cA, voA[1]);
        if (wr == 1) PG8_BAR;
        PG8_WAIT_V(2); PG8_BAR;
        PG8_STAGE(PG8_SB(1, 0), cB + kstep, voffB); PG8_STAGE(PG8_SA(1, 0), cA + kstep, voA[0]); PG8_STAGE(PG8_SB(1, 1), cB + hstep + kstep, voffB);
        PG8_WAIT_V(6); PG8_BAR;
    } else {
        PG8_STAGE(PG8_SB(0, 0), cB, voffB); PG8_STAGE(PG8_SA(0, 0), cA, voA[0]); PG8_STAGE(PG8_SB(0, 1), cB + hstep, voffB); PG8_STAGE(PG8_SA(0, 1), cA, voA[1]);
        if (wr == 1) PG8_BAR;
        PG8_WAIT_V(4); PG8_BAR;
        PG8_STAGE(PG8_SB(1, 0), cB + kstep, voffB); PG8_STAGE(PG8_SA(1, 0), cA + kstep, voA[0]); PG8_STAGE(PG8_SB(1, 1), cB + hstep + kstep, voffB);
        PG8_WAIT_V(6); PG8_BAR;
    }
    for (;;) {
        const bool has_next = S.next(ui + 1, nxt);
        const char* nA = has_next ? S.aptr(g, nxt, tstep) : cA; const char* nB = has_next ? S.bptr(g, nxt, tstep) : cB;
        if (has_next) S.avoff(nxt, ui + 1, R_, C_, K, voN); else {
#pragma unroll
            for (int h = 0; h < 2; ++h)
#pragma unroll
                for (int i = 0; i < 2; ++i) voN[h][i] = voA[h][i]; }
        const int unt = cur.nt ? cur.nt : nt;
        for (int t = 0; t < unt; t += 2) {
            const bool last = (t == unt - 2);
            const char* a1 = cA + (size_t)(t + 1) * kstep;
            const char* a2 = last ? nA : cA + (size_t)(t + 2) * kstep; const char* b2 = last ? nB : cB + (size_t)(t + 2) * kstep;
            const char* a3 = a2 + kstep; const char* b3 = b2 + kstep;
            unsigned v2[2][2];
#pragma unroll
            for (int h = 0; h < 2; ++h)
#pragma unroll
                for (int i = 0; i < 2; ++i) v2[h][i] = last ? voN[h][i] : voA[h][i];
            if constexpr (SP2) {
            PG8_LDB(B0, 0, 0); PG8_LDB(B1, 0, 1); PG8_SCHED; PG8_LDA(At, 0, 0); PG8_STAGE(PG8_SA(1, 1), a1, voA[1]);
            PG8_WAIT_V(8); PG8_WAIT_L(0); PG8_BAR; PG8_MMA(0, 0, At, B0); PG8_MMA(0, 1, At, B1); PG8_BAR; PG8_SCHED;
            PG8_LDA(At, 0, 1); PG8_STAGE(PG8_SB(0, 0), b2, voffB); PG8_STAGE(PG8_SB(0, 1), b2 + hstep, voffB); PG8_STAGE(PG8_SA(0, 0), a2, v2[0]);
            PG8_WAIT_V(8); PG8_WAIT_L(0); PG8_BAR; PG8_MMA(1, 0, At, B0); PG8_MMA(1, 1, At, B1); PG8_BAR; PG8_SCHED;
            PG8_LDB(B0, 1, 0); PG8_LDB(B1, 1, 1); PG8_SCHED; PG8_LDA(At, 1, 0); PG8_STAGE(PG8_SA(0, 1), a2, v2[1]);
            PG8_WAIT_V(8); PG8_WAIT_L(0); PG8_BAR; PG8_MMA(0, 0, At, B0); PG8_MMA(0, 1, At, B1); PG8_BAR; PG8_SCHED;
            PG8_LDA(At, 1, 1); PG8_STAGE(PG8_SB(1, 0), b3, voffB); PG8_STAGE(PG8_SB(1, 1), b3 + hstep, voffB); PG8_STAGE(PG8_SA(1, 0), a3, v2[0]);
            PG8_WAIT_V(8); PG8_WAIT_L(0); PG8_BAR; PG8_MMA(1, 0, At, B0); PG8_MMA(1, 1, At, B1); PG8_BAR; PG8_SCHED;
            } else {
            PG8_LDB(B0, 0, 0); PG8_SCHED; PG8_LDA(At, 0, 0); PG8_STAGE(PG8_SA(1, 1), a1, voA[1]);
            PG8_WAIT_L(8); PG8_BAR; PG8_WAIT_L(0); PG8_MMA(0, 0, At, B0); PG8_BAR; PG8_SCHED;
            PG8_LDB(B1, 0, 1); PG8_STAGE(PG8_SB(0, 0), b2, voffB);
            PG8_BAR; PG8_WAIT_L(0); PG8_MMA(0, 1, At, B1); PG8_BAR;
            PG8_LDA(At, 0, 1); PG8_STAGE(PG8_SA(0, 0), a2, v2[0]);
            PG8_BAR; PG8_WAIT_L(0); PG8_MMA(1, 0, At, B0); PG8_BAR; PG8_SCHED;
            PG8_STAGE(PG8_SB(0, 1), b2 + hstep, voffB);
            PG8_WAIT_V(6); PG8_BAR; PG8_MMA(1, 1, At, B1); PG8_BAR;
            PG8_LDB(B0, 1, 0); PG8_SCHED; PG8_LDA(At, 1, 0); PG8_STAGE(PG8_SA(0, 1), a2, v2[1]);
            PG8_WAIT_L(8); PG8_BAR; PG8_WAIT_L(0); PG8_MMA(0, 0, At, B0); PG8_BAR; PG8_SCHED;
            PG8_LDB(B1, 1, 1); PG8_STAGE(PG8_SB(1, 0), b3, voffB);
            PG8_BAR; PG8_WAIT_L(0); PG8_MMA(0, 1, At, B1); PG8_BAR;
            PG8_LDA(At, 1, 1); PG8_STAGE(PG8_SA(1, 0), a3, v2[0]);
            PG8_BAR; PG8_WAIT_L(0); PG8_MMA(1, 0, At, B0); PG8_BAR; PG8_SCHED;
            PG8_STAGE(PG8_SB(1, 1), b3 + hstep, voffB);
            PG8_WAIT_V(6); PG8_BAR; PG8_MMA(1, 1, At, B1); PG8_BAR;
            }
        }
        if constexpr (ALIGN_EPI) { if (wr == 0) PG8_BAR; }
        if constexpr (!Epi::AFTER_DRAIN) { E(acc, cur, wr, wc, fr, fq); }
        if (!has_next) break;
#pragma unroll
        for (int a = 0; a < 2; ++a)
#pragma unroll
            for (int b = 0; b < 2; ++b)
#pragma unroll
                for (int m = 0; m < 4; ++m)
#pragma unroll
                    for (int n = 0; n < 2; ++n) acc[a][b][m][n] = (f32x4){0.f, 0.f, 0.f, 0.f};
        cur = nxt; cA = nA; cB = nB; ++ui;
#pragma unroll
        for (int h = 0; h < 2; ++h)
#pragma unroll
            for (int i = 0; i < 2; ++i) voA[h][i] = voN[h][i];
        if constexpr (ALIGN_EPI) { if (wr == 1) PG8_BAR; }
    }
    PG8_WAIT_V(0);
    if constexpr (!ALIGN_EPI) { if (wr == 0) PG8_BAR; }
    PG8_BAR;
    if constexpr (Epi::AFTER_DRAIN) { E.fused(acc, cur, wr, wc, fr, fq, lds, wid, lane); }
#undef PG8_SA
#undef PG8_SB
#undef PG8_STAGE
#undef PG8_LDA
#undef PG8_LDB
#undef PG8_MMA
#undef PG8_WAIT_V
#undef PG8_WAIT_L
#undef PG8_BAR
#undef PG8_SCHED
}
}

#ifndef PG8_SP2
#define PG8_SP2 true
#endif
#ifndef PG8_ALIGN
#define PG8_ALIGN true
#endif
#include <hip/hip_bf16.h>
#include <cmath>
namespace attn_body {
using bf16=__hip_bfloat16;
using bf16x8=__attribute__((ext_vector_type(8)))short;
using s16x4=__attribute__((ext_vector_type(4)))short;
using f32x16=__attribute__((ext_vector_type(16)))float;
using u32x4=__attribute__((ext_vector_type(4)))unsigned;
constexpr int BATCH=8,NHEAD=8,SEQ=4096,D=64,PQ=3072,PO=1024;
constexpr int NW=8,QBLK=32,QB=QBLK*NW,KVBLK=64,NQB=SEQ/QB;
constexpr int ATTN_UNIT_ROWS=QB;
__device__ __forceinline__ int crow(int r,int hi){return (r&3)+8*(r>>2)+4*hi;}
#define SBAR() __builtin_amdgcn_sched_barrier(0)
__device__ __forceinline__ void cmask(f32x16&p0,f32x16&p1,int jb,int qrel,int hi){
  const float NEG=-INFINITY; int kb=64*jb+4*hi;
  #pragma unroll
  for(int r=0;r<16;++r){int kv=kb+(r&3)+8*(r>>2); if(kv>qrel)p0[r]=NEG; if(kv+32>qrel)p1[r]=NEG;}
}

constexpr int NSLOT=3, SLOTB=8192, VSLOTB=2*SLOTB;
constexpr int LDS_K=0, LDS_V=NSLOT*SLOTB, LDS_WS=LDS_V+NSLOT*VSLOTB, LDS_OST=LDS_WS+NW*64*4, LDS_BYTES=LDS_OST+NW*4096;
constexpr float C2=0.125f*1.4426950408889634f;
__device__ __forceinline__ void glds16(const void*gsrc,unsigned lds_dst){unsigned keep;
  asm volatile("s_mov_b32 %0, m0\n\ts_mov_b32 m0, %2\n\ts_nop 0\n\tglobal_load_lds_dwordx4 %1, off\n\ts_mov_b32 m0, %0":"=&s"(keep):"v"(gsrc),"s"(lds_dst):"memory");}
__device__ __forceinline__ float max3f(float a,float b,float c){float r;asm("v_max3_f32 %0, %1, %2, %3":"=v"(r):"v"(a),"v"(b),"v"(c));return r;}
__device__ __forceinline__ float max2f(float a,float b){float r;asm("v_max_f32_e32 %0, %1, %2":"=v"(r):"v"(a),"v"(b));return r;}
__device__ __forceinline__ float fadd_s(float a,float b){float r;asm("v_add_f32_e32 %0, %1, %2":"=v"(r):"v"(a),"v"(b));return r;}
__device__ __forceinline__ float fsub_s(float a,float b){float r;asm("v_sub_f32_e32 %0, %1, %2":"=v"(r):"v"(a),"v"(b));return r;}
typedef float f32x2_t __attribute__((ext_vector_type(2))); typedef __bf16 bf16x2_t __attribute__((ext_vector_type(2)));
__device__ __forceinline__ unsigned cvtpk_s(float lo,float hi){f32x2_t v={lo,hi};bf16x2_t b=__builtin_convertvector(v,bf16x2_t);return __builtin_bit_cast(unsigned,b);}
#define WAIT_BAR(N) asm volatile("s_waitcnt vmcnt(" #N ") lgkmcnt(0)\n\ts_barrier":::"memory")

__device__ __forceinline__ void qkt(f32x16&p0,f32x16&p1,const char*Kslot,const bf16x8*qr,const f32x16&negm,int r32,int hi){
  const char*kb=Kslot+hi*1024+r32*16;
  #pragma unroll
  for(int d0=0;d0<4;++d0){
    const bf16x8 b0=*reinterpret_cast<const bf16x8*>(kb+d0*2048);
    const bf16x8 b1=*reinterpret_cast<const bf16x8*>(kb+d0*2048+512);
    if(d0==0){p0=__builtin_amdgcn_mfma_f32_32x32x16_bf16(b0,qr[0],negm,0,0,0);p1=__builtin_amdgcn_mfma_f32_32x32x16_bf16(b1,qr[0],negm,0,0,0);}
    else{p0=__builtin_amdgcn_mfma_f32_32x32x16_bf16(b0,qr[d0],p0,0,0,0);p1=__builtin_amdgcn_mfma_f32_32x32x16_bf16(b1,qr[d0],p1,0,0,0);}}
}
typedef __attribute__((address_space(3))) const char* lds_cptr;
typedef short v4i16_t __attribute__((ext_vector_type(4)));
__device__ __forceinline__ void kload8(bf16x8*kf,lds_cptr kp){
  kf[0]=*(const __attribute__((address_space(3))) bf16x8*)(kp);      kf[1]=*(const __attribute__((address_space(3))) bf16x8*)(kp+512);
  kf[2]=*(const __attribute__((address_space(3))) bf16x8*)(kp+2048); kf[3]=*(const __attribute__((address_space(3))) bf16x8*)(kp+2560);
  kf[4]=*(const __attribute__((address_space(3))) bf16x8*)(kp+4096); kf[5]=*(const __attribute__((address_space(3))) bf16x8*)(kp+4608);
  kf[6]=*(const __attribute__((address_space(3))) bf16x8*)(kp+6144); kf[7]=*(const __attribute__((address_space(3))) bf16x8*)(kp+6656);
}
__device__ __forceinline__ void kload2(bf16x8*kf,lds_cptr kp,int j){ kf[2*j]=*(const __attribute__((address_space(3))) bf16x8*)(kp+j*2048); kf[2*j+1]=*(const __attribute__((address_space(3))) bf16x8*)(kp+j*2048+512); }
__device__ __forceinline__ s16x4 vtr(lds_cptr p){ return __builtin_bit_cast(s16x4,__builtin_amdgcn_ds_read_tr16_b64_v4i16((__attribute__((address_space(3))) v4i16_t*)p)); }
__device__ __forceinline__ float rowmax(const f32x16&p0,const f32x16&p1){
  float a=max3f(p0[0],p0[1],p1[0]),b=max3f(p0[2],p0[3],p1[1]);a=max3f(a,p1[2],p1[3]);
  #pragma unroll
  for(int r=4;r<16;r+=4){a=max3f(a,p0[r],p0[r+1]);b=max3f(b,p0[r+2],p0[r+3]);a=max3f(a,p1[r],p1[r+1]);b=max3f(b,p1[r+2],p1[r+3]);}
  const float m=max2f(a,b);
  auto rr=__builtin_amdgcn_permlane32_swap(__float_as_uint(m),__float_as_uint(m),false,false);
  return max2f(__uint_as_float(rr[0]),__uint_as_float(rr[1]));
}
__device__ __forceinline__ void pv(f32x16*o,int vb,bf16x8 pa0,bf16x8 pa1,bf16x8 pa2,bf16x8 pa3){
  #pragma unroll
  for(int d0=0;d0<2;++d0){s16x4 lo[4],hi[4];
    #pragma unroll
    for(int ks=0;ks<4;++ks){
      asm volatile("ds_read_b64_tr_b16 %0,%1 offset:%c2":"=&v"(lo[ks]):"v"(vb),"i"(d0*4096+ks*1024):"memory");
      asm volatile("ds_read_b64_tr_b16 %0,%1 offset:%c2":"=&v"(hi[ks]):"v"(vb),"i"(d0*4096+ks*1024+512):"memory");}
    asm volatile("s_waitcnt lgkmcnt(0)":::"memory");SBAR();
    #define PK(k) (bf16x8){lo[k][0],lo[k][1],lo[k][2],lo[k][3],hi[k][0],hi[k][1],hi[k][2],hi[k][3]}
    o[d0]=__builtin_amdgcn_mfma_f32_32x32x16_bf16(pa0,PK(0),o[d0],0,0,0);
    o[d0]=__builtin_amdgcn_mfma_f32_32x32x16_bf16(pa1,PK(1),o[d0],0,0,0);
    o[d0]=__builtin_amdgcn_mfma_f32_32x32x16_bf16(pa2,PK(2),o[d0],0,0,0);
    o[d0]=__builtin_amdgcn_mfma_f32_32x32x16_bf16(pa3,PK(3),o[d0],0,0,0);
    #undef PK
  }
}

__device__ __forceinline__ void pv_pipe(f32x16*o,int vb,bf16x8 pa0,bf16x8 pa1,bf16x8 pa2,bf16x8 pa3){
  s16x4 lo0[4],hi0[4],lo1[4],hi1[4];
  #pragma unroll
  for(int ks=0;ks<4;++ks){
    asm volatile("ds_read_b64_tr_b16 %0,%1 offset:%c2":"=&v"(lo0[ks]):"v"(vb),"i"(ks*1024):"memory");
    asm volatile("ds_read_b64_tr_b16 %0,%1 offset:%c2":"=&v"(hi0[ks]):"v"(vb),"i"(ks*1024+512):"memory");}
  #pragma unroll
  for(int ks=0;ks<4;++ks){
    asm volatile("ds_read_b64_tr_b16 %0,%1 offset:%c2":"=&v"(lo1[ks]):"v"(vb),"i"(4096+ks*1024):"memory");
    asm volatile("ds_read_b64_tr_b16 %0,%1 offset:%c2":"=&v"(hi1[ks]):"v"(vb),"i"(4096+ks*1024+512):"memory");}
  #define PK0(k) (bf16x8){lo0[k][0],lo0[k][1],lo0[k][2],lo0[k][3],hi0[k][0],hi0[k][1],hi0[k][2],hi0[k][3]}
  #define PK1(k) (bf16x8){lo1[k][0],lo1[k][1],lo1[k][2],lo1[k][3],hi1[k][0],hi1[k][1],hi1[k][2],hi1[k][3]}
  asm volatile("s_waitcnt lgkmcnt(8)":::"memory");SBAR();
  o[0]=__builtin_amdgcn_mfma_f32_32x32x16_bf16(pa0,PK0(0),o[0],0,0,0);
  o[0]=__builtin_amdgcn_mfma_f32_32x32x16_bf16(pa1,PK0(1),o[0],0,0,0);
  asm volatile("s_waitcnt lgkmcnt(0)":::"memory");SBAR();
  o[1]=__builtin_amdgcn_mfma_f32_32x32x16_bf16(pa0,PK1(0),o[1],0,0,0);
  o[0]=__builtin_amdgcn_mfma_f32_32x32x16_bf16(pa2,PK0(2),o[0],0,0,0);
  o[1]=__builtin_amdgcn_mfma_f32_32x32x16_bf16(pa1,PK1(1),o[1],0,0,0);
  o[0]=__builtin_amdgcn_mfma_f32_32x32x16_bf16(pa3,PK0(3),o[0],0,0,0);
  o[1]=__builtin_amdgcn_mfma_f32_32x32x16_bf16(pa2,PK1(2),o[1],0,0,0);
  o[1]=__builtin_amdgcn_mfma_f32_32x32x16_bf16(pa3,PK1(3),o[1],0,0,0);
  #undef PK0
  #undef PK1
}
#ifndef ATTN_STORE16
#define ATTN_STORE16(p,v) (*(u32x4*)(p)=(v))
#endif
template<int THRL,int MODE> __device__ __forceinline__ void attn_unit(int b,int qb,const bf16*Q,const bf16*__restrict__ K,const bf16*__restrict__ V,bf16*O,char*shm,const int wv,const float lam,const float oscale,const float eps,const float*sg){
  const int lane=lane_now(),r32=lane&31,hi=lane>>5; const int wid=wv;
  const long rowbase=(long)b*SEQ; const int q0=qb*QB;
  const bf16*Qw=Q+(rowbase+q0+wid*QBLK)*PQ;
  const bf16*Kh=K+rowbase*PQ,*Vh=V+rowbase*PQ;
  const unsigned lds0=(unsigned)(uintptr_t)shm;
  float*wsf=(float*)(shm+LDS_WS)+wid*64;
  const bf16*ksrc=Kh+(long)lane*PQ+wid*8;
  const bf16*vsrc=Vh+(long)(16*(wid&3)+(lane>>2))*PQ+(wid>>2)*32+(lane&3)*8;
  const unsigned kdst=lds0+LDS_K+wid*1024, vdst=lds0+LDS_V+wid*1024;
  #define DMA_K(t,slot) glds16(ksrc+(long)(t)*KVBLK*PQ,(unsigned)__builtin_amdgcn_readfirstlane(kdst+(slot)))
  #define DMA_V(t,slot) do{ glds16(vsrc+(long)(t)*KVBLK*PQ,(unsigned)__builtin_amdgcn_readfirstlane(vdst+2*(slot))); glds16(vsrc+64+(long)(t)*KVBLK*PQ,(unsigned)__builtin_amdgcn_readfirstlane(vdst+2*(slot)+SLOTB)); }while(0)
  const int vb0=(int)(lds0+LDS_V)+((lane>>4)&1)*32+(lane&3)*8+(4*hi+((lane&15)>>2))*64;
  const char*Kbase=shm+LDS_K; bf16x8 kf[8];
  const lds_cptr shm3=(lds_cptr)shm; const lds_cptr kp0=shm3+LDS_K+hi*1024+r32*16; const lds_cptr vp0=shm3+LDS_V+((lane>>4)&1)*32+(lane&3)*8+(4*hi+((lane&15)>>2))*64;
  const int NT=(q0+QB)/KVBLK;
  DMA_K(0,0);DMA_V(0,0);DMA_K(1,SLOTB);
  bf16x8 qr[4];
  #pragma unroll
  for(int d0=0;d0<4;++d0)qr[d0]=*reinterpret_cast<const bf16x8*>(&Qw[(long)r32*PQ+d0*16+hi*8]);
  const lds_cptr qp0=shm3+LDS_OST+wid*4096+hi*512+r32*16;
  #pragma unroll
  for(int d0=0;d0<4;++d0)*(__attribute__((address_space(3))) bf16x8*)(shm3+LDS_OST+wid*4096+hi*512+r32*16+d0*1024)=qr[d0];
  #define QLD(d0) (*(const __attribute__((address_space(3))) bf16x8*)(qp0+(d0)*1024))
  float mhat=0.f,l_reg=0.f;f32x16 o[2],o2[2];o[0]=f32x16{};o[1]=f32x16{};o2[0]=f32x16{};o2[1]=f32x16{};f32x16 negm=f32x16{};asm volatile("":"+v"(negm));
  const int qrel=wid*QBLK+r32;
  #define CMASK(P0,P1,t) do{int jb_=(t)-(NT-4); if(jb_>=0)cmask(P0,P1,jb_,qrel,hi);}while(0)
  bool resc=false;
  #define START(P0,P1) do{ const float rm=rowmax(P0,P1); resc=false; \
    { const float dl=rm; mhat=fadd_s(mhat,dl); \
      _Pragma("unroll") for(int r=0;r<16;++r){P0[r]=fsub_s(P0[r],dl);P1[r]=fsub_s(P1[r],dl);} \
      _Pragma("unroll") for(int r=0;r<16;++r)negm[r]=-mhat; asm volatile("":"+v"(negm)); } \
    _Pragma("unroll") for(int r=0;r<16;++r)P0[r]=__builtin_amdgcn_exp2f(P0[r]); }while(0)
  #define RESC() do{ if(resc){ asm volatile("s_waitcnt lgkmcnt(0)":::"memory"); \
      _Pragma("unroll") for(int d_=0;d_<2;++d_) _Pragma("unroll") for(int r=0;r<16;++r){ const float f_=wsf[crow(r,hi)]; o[d_][r]*=f_; o2[d_][r]*=f_; } } }while(0)
  f32x16 pA0,pA1,pB0,pB1;
  int sl_prev=0,sl_cur=0,sl_next=SLOTB;
  #define ROT() do{sl_prev=sl_cur;sl_cur=sl_next;sl_next=(sl_next==(NSLOT-1)*SLOTB)?0:sl_next+SLOTB;}while(0)
  DMA_K(2,2*SLOTB);
  WAIT_BAR(4);
  qkt(pA0,pA1,Kbase,qr,negm,r32,hi);asm volatile("s_nop 15\n\ts_nop 7":"+v"(pA0),"+v"(pA1));CMASK(pA0,pA1,0);
  START(pA0,pA1);
  _Pragma("unroll") for(int r=0;r<16;++r)pA1[r]=__builtin_amdgcn_exp2f(pA1[r]);
  WAIT_BAR(0);
  DMA_K(3,0);DMA_V(1,SLOTB);
  ROT();
  kload8(kf,kp0+sl_cur);
  WAIT_BAR(3);
  s16x4 vlo[8],vhi[8]; u32x4 pw0,pw1,pw2,pw3;
  #define PKW(P,B) cvtpk_s(P[B],P[B+1])
  #define PAF(k) __builtin_bit_cast(bf16x8,pw##k)
  #define VFR(i) (bf16x8){vlo[i][0],vlo[i][1],vlo[i][2],vlo[i][3],vhi[i][0],vhi[i][1],vhi[i][2],vhi[i][3]}
  #define PIN(x) asm volatile("":"+v"(x))
  #define MX3(a,b,c) __builtin_fmaxf(__builtin_fmaxf((a),(b)),(c))
  #define GAPA(MF,A0,A1,A2,A3,W0,W1,PW) do{ MF; sacc+=A0; sacc+=A1; sacc+=A2; sacc+=A3; PIN(sacc); W0; W1; PIN(PW); SBAR(); }while(0)
  #define EX(v) __builtin_amdgcn_exp2f(v)
  #define GAPB(MF,X,B) do{ MF; X[B]=EX(X[B]); X[B+1]=EX(X[B+1]); X[B+2]=EX(X[B+2]); X[B+3]=EX(X[B+3]); PIN(X); SBAR(); }while(0)
  #define VRD(i) do{ vlo[i]=vtr(vp_+(((i)>>2)*4096+((i)&3)*1024)); vhi[i]=vtr(vp_+(((i)>>2)*4096+((i)&3)*1024+512)); }while(0)
  #define KRD(G,j) do{ if(G){ kload2(kf,kp0+sl_next,j); SBAR(); } }while(0)
  #define STEP(C0,C1,P0,P1,t,GK,GV,GL) do{ SBAR(); \
    const lds_cptr vp_=vp0+2*sl_prev; \
    VRD(0); bf16x8 qa_=QLD(0),qb_=QLD(1); SBAR(); float sacc=(P0[0]+P0[1]); \
    GAPA(C0=__builtin_amdgcn_mfma_f32_32x32x16_bf16(kf[0],qa_,negm,0,0,0), P0[2],P0[3],P0[4],P0[5],     pw0[0]=PKW(P0,0), pw0[1]=PKW(P0,2), pw0); \
    VRD(4); SBAR(); GAPA(C1=__builtin_amdgcn_mfma_f32_32x32x16_bf16(kf[1],qa_,negm,0,0,0), P0[6],P0[7],P0[8],P0[9],     pw0[2]=PKW(P0,4), pw0[3]=PKW(P0,6), pw0); \
    VRD(1); qa_=QLD(2); SBAR(); GAPA(C0=__builtin_amdgcn_mfma_f32_32x32x16_bf16(kf[2],qb_,C0,0,0,0),   P0[10],P0[11],P0[12],P0[13], pw1[0]=PKW(P0,8), pw1[1]=PKW(P0,10), pw1); \
    VRD(5); SBAR(); GAPA(C1=__builtin_amdgcn_mfma_f32_32x32x16_bf16(kf[3],qb_,C1,0,0,0),   P0[14],P0[15],P1[0],P1[1],   pw1[2]=PKW(P0,12),pw1[3]=PKW(P0,14), pw1); \
    VRD(2); qb_=QLD(3); SBAR(); GAPA(C0=__builtin_amdgcn_mfma_f32_32x32x16_bf16(kf[4],qa_,C0,0,0,0),   P1[2],P1[3],P1[4],P1[5],     pw2[0]=PKW(P1,0), pw2[1]=PKW(P1,2), pw2); \
    VRD(6); SBAR(); GAPA(C1=__builtin_amdgcn_mfma_f32_32x32x16_bf16(kf[5],qa_,C1,0,0,0),   P1[6],P1[7],P1[8],P1[9],     pw2[2]=PKW(P1,4), pw2[3]=PKW(P1,6), pw2); \
    VRD(3); SBAR(); GAPA(C0=__builtin_amdgcn_mfma_f32_32x32x16_bf16(kf[6],qb_,C0,0,0,0),   P1[10],P1[11],P1[12],P1[13], pw3[0]=PKW(P1,8), pw3[1]=PKW(P1,10), pw3); \
    VRD(7); SBAR(); GAPA(C1=__builtin_amdgcn_mfma_f32_32x32x16_bf16(kf[7],qb_,C1,0,0,0),   P1[14],P1[15],0.f,0.f,       pw3[2]=PKW(P1,12),pw3[3]=PKW(P1,14), pw3); \
    l_reg+=sacc; \
    if(GK){DMA_K((t)+3,sl_cur);} if(GV){DMA_V((t)+1,sl_next);} \
    CMASK(C0,C1,t); \
    { float a=MX3(C0[0],C0[1],C1[0]),b=MX3(C0[2],C0[3],C1[1]); a=MX3(a,C1[2],C1[3]); \
      _Pragma("unroll") for(int r=4;r<16;r+=4){a=MX3(a,C0[r],C0[r+1]);b=MX3(b,C0[r+2],C0[r+3]);a=MX3(a,C1[r],C1[r+1]);b=MX3(b,C1[r+2],C1[r+3]);} \
      float rm=__builtin_fmaxf(a,b); { auto rr=__builtin_amdgcn_permlane32_swap(__float_as_uint(rm),__float_as_uint(rm),false,false); rm=__builtin_fmaxf(__uint_as_float(rr[0]),__uint_as_float(rr[1])); } \
      resc=false; \
      if(__builtin_expect(__any(rm>(float)THRL),0)){ const float dl=__builtin_fmaxf(rm,0.f); mhat+=dl; \
        _Pragma("unroll") for(int r=0;r<16;++r){C0[r]-=dl;C1[r]-=dl;} \
        _Pragma("unroll") for(int r=0;r<16;++r)negm[r]=-mhat; asm volatile("":"+v"(negm)); \
        const float f=__builtin_amdgcn_exp2f(-dl); l_reg*=f; { const int l2_=lane_now(); if(l2_<32)((__attribute__((address_space(3))) float*)(shm3+LDS_WS))[wid*64+l2_]=f; } resc=true; } } \
    SBAR(); \
    GAPB(o[0]=__builtin_amdgcn_mfma_f32_32x32x16_bf16(PAF(0),VFR(0),o[0],0,0,0), C0,0); \
    GAPB(o[1]=__builtin_amdgcn_mfma_f32_32x32x16_bf16(PAF(0),VFR(4),o[1],0,0,0), C0,4); \
    KRD(GL,0); GAPB(o[0]=__builtin_amdgcn_mfma_f32_32x32x16_bf16(PAF(1),VFR(1),o[0],0,0,0), C0,8); \
    KRD(GL,1); GAPB(o[1]=__builtin_amdgcn_mfma_f32_32x32x16_bf16(PAF(1),VFR(5),o[1],0,0,0), C0,12); \
    KRD(GL,2); GAPB(o[0]=__builtin_amdgcn_mfma_f32_32x32x16_bf16(PAF(2),VFR(2),o[0],0,0,0), C1,0); \
    KRD(GL,3); GAPB(o[1]=__builtin_amdgcn_mfma_f32_32x32x16_bf16(PAF(2),VFR(6),o[1],0,0,0), C1,4); \
    GAPB(o[0]=__builtin_amdgcn_mfma_f32_32x32x16_bf16(PAF(3),VFR(3),o[0],0,0,0), C1,8); \
    GAPB(o[1]=__builtin_amdgcn_mfma_f32_32x32x16_bf16(PAF(3),VFR(7),o[1],0,0,0), C1,12); \
    pv_pipe(o2,vb0+2*sl_prev+SLOTB,PAF(0),PAF(1),PAF(2),PAF(3)); SBAR();     \
    }while(0)
  int t=1;
  #undef CMASK
  #define CMASK(P0,P1,t) do{}while(0)
  for(;t+5<NT;t+=2){
    STEP(pB0,pB1,pA0,pA1,t,true,true,true);     WAIT_BAR(3); RESC(); ROT();
    STEP(pA0,pA1,pB0,pB1,t+1,true,true,true);   WAIT_BAR(3); RESC(); ROT();
  }
  #undef CMASK
  int qrelb=qrel; asm volatile("":"+v"(qrelb));
  #define CMASK(P0,P1,t) do{int jb_=(t)-(NT-4); if(jb_>=0)cmask(P0,P1,jb_,qrelb,hi);}while(0)
  #define ENDW(tt) do{ if((tt)+3<NT){WAIT_BAR(3);} else if((tt)+2<NT){WAIT_BAR(2);} else {WAIT_BAR(0);} }while(0)
  for(;t+1<NT;t+=2){
    STEP(pB0,pB1,pA0,pA1,t,(t+3<NT),(t+1<NT),(t+1<NT));       ENDW(t);   RESC(); ROT();
    STEP(pA0,pA1,pB0,pB1,t+1,(t+4<NT),(t+2<NT),(t+2<NT));     ENDW(t+1); RESC(); ROT();
  }
  STEP(pB0,pB1,pA0,pA1,NT-1,false,false,false); RESC();
  { float sacc=pB0[0]+pB0[1]; _Pragma("unroll") for(int r=2;r<16;++r)sacc+=pB0[r]; _Pragma("unroll") for(int r=0;r<16;++r)sacc+=pB1[r]; l_reg+=sacc;
    pw0=(u32x4){PKW(pB0,0),PKW(pB0,2),PKW(pB0,4),PKW(pB0,6)};pw1=(u32x4){PKW(pB0,8),PKW(pB0,10),PKW(pB0,12),PKW(pB0,14)};pw2=(u32x4){PKW(pB1,0),PKW(pB1,2),PKW(pB1,4),PKW(pB1,6)};pw3=(u32x4){PKW(pB1,8),PKW(pB1,10),PKW(pB1,12),PKW(pB1,14)};
    SBAR(); { const int l3_=lane_now(); const int vb3_=(int)(lds0+LDS_V)+((l3_>>4)&1)*32+(l3_&3)*8+(4*(l3_>>5)+((l3_&15)>>2))*64;
      pv(o,vb3_+2*sl_cur,PAF(0),PAF(1),PAF(2),PAF(3)); pv(o2,vb3_+2*sl_cur+SLOTB,PAF(0),PAF(1),PAF(2),PAF(3)); } }
  #undef PKW
  #undef PAF
  #undef VFR
  #undef PIN
  #undef MX3
  #undef GAPA
  #undef GAPB
  #undef EX
  #undef VRD
  #undef KRD
  #undef STEP
  #undef ENDW
  {auto rr=__builtin_amdgcn_permlane32_swap(__float_as_uint(l_reg),__float_as_uint(l_reg),false,false);l_reg=__uint_as_float(rr[0])+__uint_as_float(rr[1]);}
  { const int le=lane_now(),r32e=le&31,hie=le>>5; float*wse=(float*)(shm+LDS_WS)+wid*64;
  if(hie==0)wse[32+r32e]=l_reg;asm volatile("s_waitcnt lgkmcnt(0)":::"memory");
  float rli[16];
  #pragma unroll
  for(int r=0;r<16;++r)rli[r]=__builtin_amdgcn_rcpf(wse[32+crow(r,hie)]);
  bf16*Ow=O+(rowbase+q0+wid*QBLK)*PO;
  { bf16*stg=(bf16*)(shm+LDS_OST)+wid*2048;
    float yv[2][4][8];
    #pragma unroll
    for(int half=0;half<2;++half){
      #pragma unroll
      for(int r=0;r<16;++r){const int orow=crow(r,hie);
        #pragma unroll
        for(int d0=0;d0<2;++d0)stg[orow*64+d0*32+r32e]=__float2bfloat16((half?o2[d0][r]:o[d0][r])*rli[r]);}
      asm volatile("s_waitcnt lgkmcnt(0)":::"memory");
      #pragma unroll
      for(int i=0;i<4;++i){const int row=i*8+(le>>3),ch=le&7; const u32x4 v=*(const u32x4*)(stg+row*64+ch*8);
        if(MODE==0){ ATTN_STORE16(Ow+(long)row*PO+half*64+ch*8,v); }
        else{ const u32x4 w=*(const u32x4*)(Ow+(long)row*PO+half*64+ch*8);
          #pragma unroll
          for(int e=0;e<4;++e){ yv[half][i][2*e]=__uint_as_float(w[e]<<16)-lam*__uint_as_float(v[e]<<16); yv[half][i][2*e+1]=__uint_as_float(w[e]&0xffff0000u)-lam*__uint_as_float(v[e]&0xffff0000u); } } }
      asm volatile("s_waitcnt lgkmcnt(0)":::"memory"); }
    if(MODE==1){ const int ch=le&7; float gg[2][8];
      #pragma unroll
      for(int half=0;half<2;++half)
        #pragma unroll
        for(int e=0;e<8;++e)gg[half][e]=sg[half*64+ch*8+e]*oscale;
      #pragma unroll
      for(int i=0;i<4;++i){ float ss=0.f;
        #pragma unroll
        for(int half=0;half<2;++half)
          #pragma unroll
          for(int e=0;e<8;++e)ss+=yv[half][i][e]*yv[half][i][e];
        ss+=__builtin_bit_cast(float,__builtin_amdgcn_update_dpp(0,__builtin_bit_cast(int,ss),0xB1,0xF,0xF,false));
        ss+=__builtin_bit_cast(float,__builtin_amdgcn_update_dpp(0,__builtin_bit_cast(int,ss),0x4E,0xF,0xF,false));
        ss+=__builtin_bit_cast(float,__builtin_amdgcn_update_dpp(0,__builtin_bit_cast(int,ss),0x141,0xF,0xF,false));
        const float rs=__builtin_amdgcn_rsqf(ss*(1.f/128.f)+eps); const int row=i*8+(le>>3);
        #pragma unroll
        for(int half=0;half<2;++half){ u32x4 ov;
          #pragma unroll
          for(int e=0;e<4;++e)ov[e]=cvtpk_s(yv[half][i][2*e]*rs*gg[half][2*e],yv[half][i][2*e+1]*rs*gg[half][2*e+1]);
          ATTN_STORE16(Ow+(long)row*PO+half*64+ch*8,ov); } } } } }
  asm volatile("s_waitcnt lgkmcnt(0)\n\ts_barrier":::"memory");
  #undef DMA_K
  #undef DMA_V
  #undef QLD
  #undef CMASK
  #undef START
  #undef RESC
  #undef ROT
}
constexpr int ATTN_LDS_BYTES=LDS_BYTES;
struct AttnTensors { const bf16* Q; const bf16* K; const bf16* V; bf16* O; float lam, oscale, eps; const float* sg; };
struct AttnUnit { int b; int h; int qb; };
struct StaticOrder {
  int vcu, G;
  __device__ __forceinline__ StaticOrder(int grid,int vcu_):vcu(vcu_),G(grid){}
  __device__ __forceinline__ bool next(int i,AttnUnit&u)const{
    if(G==256){ if(i>=2)return false; const int s=vcu&7,bv=vcu>>3; u.b=bv>>2; u.h=bv&3; u.qb=(i==0)?s:15-s; return true; }
    const int L=i*G+vcu; if(L>=BATCH*4*NQB)return false; u.b=L/(4*NQB); u.h=(L/NQB)%4; u.qb=L%NQB; return true; }
};
template<class Sched,int THRL=8> __device__ __forceinline__ void attn_phase(char*lds,const AttnTensors&T,const Sched&S,const int wv){
  AttnUnit u;
  for(int i=0;S.next(i,u);++i){ const int h=u.h;
    attn_unit<THRL,0>(u.b,u.qb,T.Q+(2*h)*64,T.K+(2*h)*64,T.V+h*128,T.O+h*128,lds,wv,T.lam,T.oscale,T.eps,T.sg);
    attn_unit<THRL,1>(u.b,u.qb,T.Q+(2*h+1)*64,T.K+(2*h+1)*64,T.V+h*128,T.O+h*128,lds,wv,T.lam,T.oscale,T.eps,T.sg); }
}
#undef SBAR
#undef WAIT_BAR
}

constexpr int NWAVES = 8;
#ifndef MK_N_LAUNCHES
#define MK_N_LAUNCHES 1
#endif
constexpr int NPHASE = 13;
constexpr int N_LAUNCHES = MK_N_LAUNCHES;

constexpr int BATCH = 8, SEQ = 4096, D = 1024, M = BATCH * SEQ;
constexpr int NPROJ = 3072;
constexpr int C_DQ = 0, C_DK = 512, C_DV = 1024, C_MQ = 1536, C_MK = 2048, C_MO = 2560;
constexpr int MEMLEN = 256, MROWS = BATCH * MEMLEN;
constexpr int NEXP = 32, DEXP = 512, MAXROWS = 73728;
constexpr int NCH = 64, CHL = 64, DVX = 144;
constexpr int CS_UNIT = DVX * 128;
constexpr float EPS = 1e-6f;
constexpr float LAM_INIT = 0.2f;
constexpr float XSCALE = 0.0625f * 1.4426950408889634f;

constexpr size_t MiB = 1u << 20;
constexpr size_t WS_CTL = 0, CTL_ZERO_BYTES = 1 * MiB;
constexpr size_t WS_GATE = 2 * MiB, WS_ROPE = 3 * MiB, WS_ACUM = 4 * MiB, WS_USUB = 4 * MiB + 512 * 1024, WS_SC = 5 * MiB;
constexpr size_t WS_RT = 5 * MiB + 768 * 1024;
constexpr size_t WS_RSTD2 = 5 * MiB + 512 * 1024;
constexpr size_t WS_TOKL = 6 * MiB, WS_ASG = 10 * MiB, WS_MEMN = 12 * MiB, WS_MK = 16 * MiB, WS_MVT2 = 20 * MiB;
constexpr size_t WS_WIN = 24 * MiB, WS_WOUT = 31 * MiB, WS_WXQ = 33 * MiB, WS_WKV = 35 * MiB, WS_WXO = 39 * MiB, WS_W13 = 41 * MiB, WS_W2 = 105 * MiB;
constexpr size_t WS_PROJ = 140 * MiB;
constexpr size_t WS_MVT = 332 * MiB;
constexpr size_t WS_XB = 140 * MiB, WS_XQ = 204 * MiB, WS_XO = 268 * MiB;
constexpr size_t WS_H3 = 204 * MiB, WS_ACT = 268 * MiB, WS_YE = 340 * MiB;
constexpr size_t WS_FOLD = 432 * MiB;
constexpr size_t WS_OA = 364 * MiB;
constexpr size_t WS_END = 484 * MiB;
static_assert(WS_YE + (size_t)MAXROWS * 1024 * 2 <= WS_END && WS_ACT + (size_t)MAXROWS * 512 * 2 <= WS_YE && WS_PROJ + (size_t)M * NPROJ * 2 <= WS_MVT && WS_MVT + (size_t)512 * M * 2 <= WS_OA, "d_ws map");
constexpr int CW_TMO = 0, CW_CODE = 1, CW_CNT = 1024, CW_ROWSS = 16384, CW_READY = 49152, CW_BAR = 65536;
constexpr int RING_OFF = 0, RING_BYTES = 131072;
constexpr int XT_TS = 131072, XT_TOK = 131072 + 256, XT_RS = XT_TOK + 5 * 1024;
constexpr int LDSCTL_OFF = 158720, MISC_OFF = LDSCTL_OFF + 320;
constexpr int LDS_BYTES = 159744;
static_assert(MISC_OFF + 128 <= LDS_BYTES, "LDS map");

#define GAS __attribute__((address_space(1)))
#define LAS __attribute__((address_space(3)))
typedef unsigned short bf16;
typedef unsigned v4u __attribute__((ext_vector_type(4)));
typedef float f32x4 __attribute__((ext_vector_type(4)));
typedef short bf16x8 __attribute__((ext_vector_type(8)));
typedef GAS unsigned gu32;
typedef GAS unsigned long long gu64;
#define RLX_AGENT __ATOMIC_RELAXED, __HIP_MEMORY_SCOPE_AGENT
#define LDS_WAIT() asm volatile("s_waitcnt lgkmcnt(0)" ::: "memory")
#define VM_WAIT() asm volatile("s_waitcnt vmcnt(0)" ::: "memory")
__device__ __forceinline__ unsigned long long rt() { return __builtin_amdgcn_s_memrealtime(); }
__device__ __forceinline__ unsigned f2bf(float f) { unsigned u = __builtin_bit_cast(unsigned, f); return (u + 0x7fffu + ((u >> 16) & 1u)) >> 16; }
typedef float f32x2_t_ __attribute__((ext_vector_type(2))); typedef __bf16 bf16x2_t_ __attribute__((ext_vector_type(2)));
__device__ __forceinline__ unsigned pk2(float lo, float hi) { f32x2_t_ v = {lo, hi}; bf16x2_t_ b = __builtin_convertvector(v, bf16x2_t_); return __builtin_bit_cast(unsigned, b); }

#define XB_TMO      128
#define XB_XCNT(j)  (256  + 64 * (j))
#define XB_XSUB(j)  (1280 + 64 * (j))
#define XB_XGEN(j)  (2304 + 64 * (j))
#define XB_TOP      3328
#define XB_TOPGEN   3392
#define XCD_BAR_WORDS 3456
#define XB_SPIN_CAP (1u << 18)

__device__ __forceinline__ unsigned xb_ld(unsigned* p)              { return __hip_atomic_load(p, __ATOMIC_RELAXED, __HIP_MEMORY_SCOPE_AGENT); }
__device__ __forceinline__ unsigned xb_add(unsigned* p, unsigned v) { return __hip_atomic_fetch_add(p, v, __ATOMIC_RELAXED, __HIP_MEMORY_SCOPE_AGENT); }
__device__ __forceinline__ unsigned xb_xcc_id() { return (unsigned)__builtin_amdgcn_s_getreg((3 << 11) | 20) & 0xFu; }
#define XB_SPIN(cond, bar) do { unsigned _sp = 0; while (cond) { __builtin_amdgcn_s_sleep(1); \
    if ((++_sp & 255u) == 0u) { if (xb_ld(&(bar)[XB_TMO])) break; if (_sp > XB_SPIN_CAP) { atomicAdd(&(bar)[XB_TMO], 1u); break; } } } } while (0)

struct XcdBarrier {
    unsigned* bar; unsigned x;
    volatile LAS unsigned* st;
};

__device__ __forceinline__ XcdBarrier xcd_barrier_post(unsigned* bar, volatile LAS unsigned* st) {
    XcdBarrier b; b.bar = bar; b.x = xb_xcc_id(); b.st = st;
    if (threadIdx.x == 0) (void)xb_add(&bar[XB_XCNT(b.x)], 1u);
    return b;
}
__device__ __forceinline__ void xcd_barrier_complete(unsigned* bar, unsigned x, unsigned& nloc, unsigned& nx) {
    const unsigned G = gridDim.x * gridDim.y * gridDim.z;
    unsigned sum, cnt, mine, sp = 0u;
    for (;;) {
        sum = 0u; cnt = 0u; mine = 0u;
#pragma unroll
        for (unsigned j = 0; j < 16; ++j) { const unsigned c = xb_ld(&bar[XB_XCNT(j)]); sum += c; cnt += (c > 0u) ? 1u : 0u; mine = (j == x) ? c : mine; }
        if (sum == G) break;
        __builtin_amdgcn_s_sleep(1);
        if ((++sp & 255u) == 0u) { if (xb_ld(&bar[XB_TMO])) break; if (sp > XB_SPIN_CAP) { atomicAdd(&bar[XB_TMO], 1u); break; } }
    }
    nloc = mine > 0u ? mine : 1u; nx = cnt > 0u ? cnt : 1u;
}

__device__ __forceinline__ void xcd_barrier(const XcdBarrier& b, const int wv) {
    asm volatile("s_waitcnt vmcnt(0)" ::: "memory");
    __syncthreads();
    if (wv == 0 && lane_now() == 0) {
        unsigned* bar = b.bar;
        __builtin_amdgcn_s_waitcnt(0);
        unsigned nloc = b.st[0], nx = b.st[1];
        if (nloc == 0u) { xcd_barrier_complete(bar, b.x, nloc, nx); b.st[0] = nloc; b.st[1] = nx; }
        const unsigned old = xb_add(&bar[XB_XSUB(b.x)], 1u);
        const unsigned gen = old / nloc;
        if (old + 1u == (gen + 1u) * nloc) {
            __builtin_amdgcn_fence(__ATOMIC_RELEASE, "agent");
            asm volatile("s_waitcnt vmcnt(0)" ::: "memory");
            const unsigned og = xb_add(&bar[XB_TOP], 1u);
            const unsigned tg = og / nx;
            if (og + 1u == (tg + 1u) * nx) xb_add(&bar[XB_TOPGEN], 1u);
            else XB_SPIN(xb_ld(&bar[XB_TOPGEN]) == tg, bar);
            __builtin_amdgcn_fence(__ATOMIC_ACQUIRE, "agent");
            xb_add(&bar[XB_XGEN(b.x)], 1u);
            asm volatile("s_waitcnt vmcnt(0)" ::: "memory");
        } else {
            XB_SPIN(xb_ld(&bar[XB_XGEN(b.x)]) == gen, bar);
            __builtin_amdgcn_fence(__ATOMIC_ACQUIRE, "agent");
            asm volatile("s_waitcnt vmcnt(0)" ::: "memory");
        }
    }
    __syncthreads();
}


typedef unsigned u32x2 __attribute__((ext_vector_type(2))); typedef unsigned u32x4 __attribute__((ext_vector_type(4)));
struct Frame {
    LAS unsigned char* lds;
    volatile LAS unsigned* MISC;
    gu32* ctl;
    int wave;
    int vcu, G;
    const float* in[26]; float* out; unsigned char* ws;
};
#ifndef PRIM_RED
#define PRIM_RED 1
#define PRIM_ROW 1
#define PRIM_SCAN 1
#define PRIM_MATH 1
#endif
#define DPPF(old_, v_, ctrl, rm) __builtin_bit_cast(float, __builtin_amdgcn_update_dpp(__builtin_bit_cast(int, (float)(old_)), __builtin_bit_cast(int, (float)(v_)), ctrl, rm, 0xF, false))
#if PRIM_RED
__device__ __forceinline__ float wave_sum(float v) {
    v += DPPF(0.f, v, 0xB1, 0xF); v += DPPF(0.f, v, 0x4E, 0xF); v += DPPF(0.f, v, 0x141, 0xF); v += DPPF(0.f, v, 0x140, 0xF);
    { auto r = __builtin_amdgcn_permlane16_swap(__float_as_uint(v), __float_as_uint(v), false, false); v = __uint_as_float(r[0]) + __uint_as_float(r[1]); }
    { auto r = __builtin_amdgcn_permlane32_swap(__float_as_uint(v), __float_as_uint(v), false, false); v = __uint_as_float(r[0]) + __uint_as_float(r[1]); }
    return v;
}
__device__ __forceinline__ float wave_max(float v) {
    v = fmaxf(v, DPPF(v, v, 0xB1, 0xF)); v = fmaxf(v, DPPF(v, v, 0x4E, 0xF)); v = fmaxf(v, DPPF(v, v, 0x141, 0xF)); v = fmaxf(v, DPPF(v, v, 0x140, 0xF));
    { auto r = __builtin_amdgcn_permlane16_swap(__float_as_uint(v), __float_as_uint(v), false, false); v = fmaxf(__uint_as_float(r[0]), __uint_as_float(r[1])); }
    { auto r = __builtin_amdgcn_permlane32_swap(__float_as_uint(v), __float_as_uint(v), false, false); v = fmaxf(__uint_as_float(r[0]), __uint_as_float(r[1])); }
    return v;
}
#else
__device__ __forceinline__ float wave_sum(float v) { for (int o = 1; o < 64; o <<= 1) v += __shfl_xor(v, o); return v; }
__device__ __forceinline__ float wave_max(float v) { for (int o = 1; o < 64; o <<= 1) v = fmaxf(v, __shfl_xor(v, o)); return v; }
#endif
#if PRIM_ROW
__device__ __forceinline__ float row8_sum(float v) { v += DPPF(0.f, v, 0xB1, 0xF); v += DPPF(0.f, v, 0x4E, 0xF); v += DPPF(0.f, v, 0x141, 0xF); return v; }
__device__ __forceinline__ float row16_sum(float v) { v += DPPF(0.f, v, 0xB1, 0xF); v += DPPF(0.f, v, 0x4E, 0xF); v += DPPF(0.f, v, 0x141, 0xF); v += DPPF(0.f, v, 0x140, 0xF); return v; }
#else
__device__ __forceinline__ float row16_sum(float v) { v += __shfl_xor(v, 1); v += __shfl_xor(v, 2); v += __shfl_xor(v, 4); v += __shfl_xor(v, 8); return v; }
__device__ __forceinline__ float row8_sum(float v) { v += __shfl_xor(v, 1); v += __shfl_xor(v, 2); v += __shfl_xor(v, 4); return v; }
#endif
#if PRIM_SCAN
__device__ __forceinline__ float wave_scan_sum(float v) {
    v += DPPF(0.f, v, 0x111, 0xF); v += DPPF(0.f, v, 0x112, 0xF); v += DPPF(0.f, v, 0x114, 0xF); v += DPPF(0.f, v, 0x118, 0xF);
    v += DPPF(0.f, v, 0x142, 0xA); v += DPPF(0.f, v, 0x143, 0xC); return v;
}
__device__ __forceinline__ float wave_scan_max(float v) {
    const float NI = -INFINITY;
    v = fmaxf(v, DPPF(NI, v, 0x111, 0xF)); v = fmaxf(v, DPPF(NI, v, 0x112, 0xF)); v = fmaxf(v, DPPF(NI, v, 0x114, 0xF)); v = fmaxf(v, DPPF(NI, v, 0x118, 0xF));
    v = fmaxf(v, DPPF(NI, v, 0x142, 0xA)); v = fmaxf(v, DPPF(NI, v, 0x143, 0xC)); return v;
}
#else
__device__ __forceinline__ float wave_scan_sum(float v) { const int l = lane_now(); for (int o = 1; o < 64; o <<= 1) { const float t = __shfl_up(v, o); if (l >= o) v += t; } return v; }
__device__ __forceinline__ float wave_scan_max(float v) { const int l = lane_now(); for (int o = 1; o < 64; o <<= 1) { const float t = __shfl_up(v, o); if (l >= o) v = fmaxf(v, t); } return v; }
#endif
#if PRIM_MATH
__device__ __forceinline__ float fexp(float x) { return __builtin_amdgcn_exp2f(x * 1.4426950408889634f); }
__device__ __forceinline__ float fsigmoid(float x) { return __builtin_amdgcn_rcpf(1.f + __builtin_amdgcn_exp2f(-1.4426950408889634f * x)); }
__device__ __forceinline__ float frsq(float x) { return __builtin_amdgcn_rsqf(x); }
#else
__device__ __forceinline__ float fexp(float x) { return expf(x); }
__device__ __forceinline__ float fsigmoid(float x) { return 1.f / (1.f + expf(-x)); }
__device__ __forceinline__ float frsq(float x) { return 1.f / sqrtf(x); }
#endif
__device__ __forceinline__ float bf2f(unsigned short b) { return __uint_as_float((unsigned)b << 16); }
__device__ __forceinline__ float bflo(unsigned w) { return __uint_as_float(w << 16); }
__device__ __forceinline__ float bfhi(unsigned w) { return __uint_as_float(w & 0xffff0000u); }
__device__ __forceinline__ float dot4(f32x4 a, f32x4 b) { return (a.x * b.x + a.y * b.y) + (a.z * b.z + a.w * b.w); }
#define WG_SYNC() __syncthreads()

struct RowMap { int mode, off;
    __device__ __forceinline__ int operator()(int n) const {
        if (mode == 1) return (n < 1024) ? ((n & ~255) | (((n >> 5) & 1) << 7) | (((n >> 6) & 3) << 5) | (n & 31)) : (n < 2560) ? n : (n < 3072) ? n + 512 : n - 512;
        if (mode == 2) return ((n >> 7) << 8) + off + (n & 127);
        return off + n; } };
struct TrItem { const float* W; bf16* WT; const float* ks; int K, ldw, nblk, local; RowMap rm; };
__device__ __forceinline__ void tr_load(const TrItem& t, int lane, f32x4 (&x)[8]) {
    const int kb = t.local / t.nblk, nb = t.local % t.nblk, k0 = 64 * kb, n0 = 32 * nb;
#pragma unroll
    for (int i = 0; i < 8; ++i) x[i] = __builtin_nontemporal_load((const GAS f32x4*)(t.W + (size_t)(k0 + 8 * i + (lane >> 3)) * t.ldw + n0 + 4 * (lane & 7)));
}
__device__ __forceinline__ void tr_finish(const TrItem& t, int lane, const f32x4 (&x)[8], LAS float* scr) {
    const int kb = t.local / t.nblk, nb = t.local % t.nblk, k0 = 64 * kb, n0 = 32 * nb;
#pragma unroll
    for (int i = 0; i < 8; ++i) { LAS float* d = scr + (8 * i + (lane >> 3)) * 33 + 4 * (lane & 7); d[0] = x[i].x; d[1] = x[i].y; d[2] = x[i].z; d[3] = x[i].w; }
    LDS_WAIT(); asm volatile("" ::: "memory");
    const int c = lane & 7;
    f32x4 ks0 = {1.f, 1.f, 1.f, 1.f}, ks1 = ks0;
    if (t.ks) { ks0 = *(const GAS f32x4*)(t.ks + k0 + 8 * c); ks1 = *(const GAS f32x4*)(t.ks + k0 + 8 * c + 4); }
#pragma unroll
    for (int j = 0; j < 4; ++j) { const int n = (lane >> 3) + 8 * j; const LAS float* s = scr + (8 * c) * 33 + n;
        v4u o; o.x = pk2(s[0 * 33] * ks0.x, s[1 * 33] * ks0.y); o.y = pk2(s[2 * 33] * ks0.z, s[3 * 33] * ks0.w); o.z = pk2(s[4 * 33] * ks1.x, s[5 * 33] * ks1.y); o.w = pk2(s[6 * 33] * ks1.z, s[7 * 33] * ks1.w);
        GAS v4u* dst_ = (GAS v4u*)(t.WT + (size_t)t.rm(n0 + n) * t.K + k0 + 8 * c);
        if (t.rm.mode == 2) __builtin_nontemporal_store(o, dst_); else *dst_ = o; }
    LDS_WAIT(); asm volatile("" ::: "memory");
}
__device__ __forceinline__ void p0_transpose_item(const float* W, int K, int ldw, int nblk, bf16* WT, const RowMap rm, const float* kscale, LAS float* scr, int item, int lane) {
    TrItem t{W, WT, kscale, K, ldw, nblk, item, rm}; f32x4 x[8]; tr_load(t, lane, x); tr_finish(t, lane, x, scr);
}
__device__ __forceinline__ void rms_row(const int lane, f32x4 (&v)[4], const float* g, bf16* orow, const LAS float* gw, float* gate_out, const float* gate_b) {
    const GAS f32x4* gr = (const GAS f32x4*)g + 2 * lane;
    float s = 0.f;
#pragma unroll
    for (int j = 0; j < 4; ++j) s += dot4(v[j], v[j]);
    const float rstd = frsq(wave_sum(s) * (1.f / D) + EPS);
    v[0] = v[0] * rstd * gr[0]; v[1] = v[1] * rstd * gr[1]; v[2] = v[2] * rstd * gr[128]; v[3] = v[3] * rstd * gr[129];
    GAS v4u* o16 = (GAS v4u*)orow + lane; v4u o;
    o.x = pk2(v[0].x, v[0].y); o.y = pk2(v[0].z, v[0].w); o.z = pk2(v[1].x, v[1].y); o.w = pk2(v[1].z, v[1].w); o16[0] = o;
    o.x = pk2(v[2].x, v[2].y); o.y = pk2(v[2].z, v[2].w); o.z = pk2(v[3].x, v[3].y); o.w = pk2(v[3].z, v[3].w); o16[64] = o;
    if (gw) {
        float mine = 0.f;
#pragma unroll
        for (int q = 0; q < 8; ++q) { const LAS float* wp = gw + q * 1024 + 8 * lane;
            float a = (dot4(v[0], *(const LAS f32x4*)(wp)) + dot4(v[1], *(const LAS f32x4*)(wp + 4))) + (dot4(v[2], *(const LAS f32x4*)(wp + 512)) + dot4(v[3], *(const LAS f32x4*)(wp + 516)));
            a = wave_sum(a); mine = (lane == q) ? a : mine; }
        if (lane < 8) gate_out[lane] = mine + gate_b[lane];
    }
}
__device__ __forceinline__ void sincos_acc(float ang, float& sn, float& cs) {
    const double a = (double)ang; const double q = rint(a * 0.63661977236758134308); const double z = a - q * 1.57079632679489661923;
    const double z2 = z * z;
    const double sp = z * (1.0 + z2 * (-1.0 / 6 + z2 * (1.0 / 120 + z2 * (-1.0 / 5040 + z2 * (1.0 / 362880 + z2 * (-1.0 / 39916800 + z2 * (1.0 / 6227020800.0)))))));
    const double cp = 1.0 + z2 * (-0.5 + z2 * (1.0 / 24 + z2 * (-1.0 / 720 + z2 * (1.0 / 40320 + z2 * (-1.0 / 3628800 + z2 * (1.0 / 479001600.0 + z2 * (-1.0 / 87178291200.0)))))));
    const int qi = ((int)(long long)q) & 3;
    const double s_ = (qi == 0) ? sp : (qi == 1) ? cp : (qi == 2) ? -sp : -cp;
    const double c_ = (qi == 0) ? cp : (qi == 1) ? -sp : (qi == 2) ? -cp : sp;
    sn = (float)s_; cs = (float)c_;
}
__device__ __forceinline__ void p0_prologue(Frame& F) {
    const int lane = lane_now(), wave = F.wave, tid = wave * 64 + lane; (void)tid; (void)lane; (void)wave;
    const int gw = F.vcu * NWAVES + wave, NGW = F.G * NWAVES;
    LAS float* scr = (LAS float*)(F.lds + wave * 8704);
    LAS float* gwt = (LAS float*)(F.lds + 69632);
    for (int i = tid; i < 8192; i += NWAVES * 64) { const int k = i >> 3, q = i & 7; gwt[q * 1024 + k] = F.in[3][(size_t)k * 3592 + 3584 + q]; }
    WG_SYNC();
    bf16* wsb = (bf16*)F.ws;
    constexpr int I_IN = 16 * 112, I_SQ = 16 * 32, I_E = 32 * 256;
    constexpr int NITEMS = I_IN + 4 * I_SQ + 2 * I_E;
    auto decode = [&](int it) -> TrItem { int r = it;
        if (r < I_IN) return TrItem{F.in[3], (bf16*)(F.ws + WS_WIN), nullptr, D, 3592, 112, r, RowMap{1, 0}}; r -= I_IN;
        if (r < I_SQ) return TrItem{F.in[4], (bf16*)(F.ws + WS_WOUT), nullptr, D, D, 32, r, RowMap{0, 0}}; r -= I_SQ;
        if (r < I_SQ) return TrItem{F.in[14], (bf16*)(F.ws + WS_WKV), nullptr, D, D, 32, r, RowMap{0, 0}}; r -= I_SQ;
        if (r < I_SQ) return TrItem{F.in[15], (bf16*)(F.ws + WS_WKV), nullptr, D, D, 32, r, RowMap{0, 1024}}; r -= I_SQ;
        if (r < I_SQ) return TrItem{F.in[16], (bf16*)(F.ws + WS_WXO), nullptr, D, D, 32, r, RowMap{0, 0}}; r -= I_SQ;
        if (r < I_E) { const int e = r >> 8; return TrItem{F.in[22] + (size_t)e * D * DEXP, (bf16*)(F.ws + WS_W13) + (size_t)e * D * D, F.in[17], D, DEXP, 16, r & 255, RowMap{2, 0}}; } r -= I_E;
        { const int e = r >> 8; return TrItem{F.in[23] + (size_t)e * D * DEXP, (bf16*)(F.ws + WS_W13) + (size_t)e * D * D, F.in[17], D, DEXP, 16, r & 255, RowMap{2, 128}}; } };
    { f32x4 xa[8], xb[8];
      int it = gw; if (it < NITEMS) { const TrItem t0 = decode(it); tr_load(t0, lane, xa); }
      for (; it < NITEMS; it += 2 * NGW) {
          const TrItem ta = decode(it); const bool hb = it + NGW < NITEMS; TrItem tb = ta; if (hb) { tb = decode(it + NGW); tr_load(tb, lane, xb); }
          tr_finish(ta, lane, xa, scr);
          if (it + 2 * NGW < NITEMS) { const TrItem tc = decode(it + 2 * NGW); tr_load(tc, lane, xa); }
          if (hb) tr_finish(tb, lane, xb, scr); } }
    (void)wsb;
    { f32x4 nx[4];
#define P0_LOADROW(base, m_) do { const GAS f32x4* xr_ = (const GAS f32x4*)((base) + (size_t)(m_) * D) + 2 * lane; nx[0] = __builtin_nontemporal_load(xr_); nx[1] = __builtin_nontemporal_load(xr_ + 1); nx[2] = __builtin_nontemporal_load(xr_ + 128); nx[3] = __builtin_nontemporal_load(xr_ + 129); } while (0)
      if (gw < M) P0_LOADROW(F.in[0], gw);
      for (int m = gw; m < M; m += NGW) { f32x4 v[4] = {nx[0], nx[1], nx[2], nx[3]}; if (m + NGW < M) P0_LOADROW(F.in[0], m + NGW);
          rms_row(lane, v, F.in[2], (bf16*)F.out + (size_t)m * D, gwt, (float*)(F.ws + WS_GATE) + (size_t)m * 8, F.in[9]); }
      for (int m = gw; m < MROWS; m += NGW) { P0_LOADROW(F.in[1], m); f32x4 v[4] = {nx[0], nx[1], nx[2], nx[3]}; rms_row(lane, v, F.in[12], (bf16*)(F.ws + WS_MEMN) + (size_t)m * D, nullptr, nullptr, nullptr); }
#undef P0_LOADROW
    }
    for (int i = F.vcu * (NWAVES * 64) + tid; i < D * D / 8; i += F.G * NWAVES * 64) { const int k = i >> 7, c8 = i & 127; const float gk = F.in[11][k];
        const GAS f32x4* s = (const GAS f32x4*)(F.in[13] + (size_t)k * D + c8 * 8); const f32x4 a = __builtin_nontemporal_load(s), b = __builtin_nontemporal_load(s + 1);
        v4u o; o.x = pk2(a.x * gk, a.y * gk); o.y = pk2(a.z * gk, a.w * gk); o.z = pk2(b.x * gk, b.y * gk); o.w = pk2(b.z * gk, b.w * gk); *(GAS v4u*)((bf16*)(F.ws + WS_WXQ) + (size_t)k * D + c8 * 8) = o; }
    for (int i = F.vcu * (NWAVES * 64) + tid; i < 36 * 1024; i += F.G * NWAVES * 64) { const int n = i >> 10, k = i & 1023;
        const float v = ((n < 32) ? F.in[20][k * 32 + n] : F.in[18][k * 4 + (n - 32)]) * F.in[17][k]; const unsigned hi = f2bf(v); const float rem = v - __uint_as_float(hi << 16);
        bf16* rt_ = (bf16*)(F.ws + WS_RT); rt_[n * 1024 + k] = (bf16)hi; rt_[(36 + n) * 1024 + k] = (bf16)f2bf(rem); }
    float* rope = (float*)(F.ws + WS_ROPE);
    for (int i = F.vcu * (NWAVES * 64) + tid; i < SEQ * 32; i += F.G * NWAVES * 64) { const int pos = i >> 5, fi = i & 31;
        const float invf = (float)exp2(-(double)fi * (13.287712379549449 / 32.0));
        const float ang = (float)pos * invf; float sn, cs; sincos_acc(ang, sn, cs); rope[i] = cs; rope[SEQ * 32 + i] = sn; }
}


__device__ __forceinline__ void p10_w2_items(Frame& F, int nunits) {
    const int lane = lane_now(), wave = F.wave;
    LAS float* scr = (LAS float*)(F.lds + wave * 8704);
    const int rem = nunits % F.G; const int first = rem, nidle = (rem == 0) ? F.G : F.G - rem;
    const int rank = (rem == 0) ? (int)blockIdx.x : (int)blockIdx.x - first; if (rank < 0) return;
    for (int r = rank * NWAVES + wave; r < 32 * 256; r += nidle * NWAVES) { const int e = r >> 8;
        p0_transpose_item(F.in[24] + (size_t)e * DEXP * D, DEXP, D, 32, (bf16*)(F.ws + WS_W2) + (size_t)e * D * DEXP, RowMap{0, 0}, nullptr, scr, r & 255, lane); }
}
__device__ __forceinline__ void gate_scan(Frame& F, int bh) {
    const int lane = lane_now(), wave = F.wave;
    const int b = bh >> 2, h = bh & 3; const float* gate = (const float*)(F.ws + WS_GATE);
    float* acum = (float*)(F.ws + WS_ACUM) + (size_t)bh * SEQ; float* usub = (float*)(F.ws + WS_USUB) + (size_t)bh * SEQ; float* sc = (float*)(F.ws + WS_SC) + (size_t)bh * NCH * 4;
    LAS float* GB = (LAS float*)F.lds;
    for (int jj = 0; jj < 8; ++jj) { const int j = wave * 8 + jj; const int t = j * CHL + lane; const size_t row = (size_t)b * SEQ + t;
        const float gi = gate[row * 8 + h], gf = gate[row * 8 + 4 + h];
        const float a = wave_scan_sum(fminf(gf, 0.f) - log1pf(expf(-fabsf(gf))));
        const float g = __builtin_bit_cast(float, __builtin_amdgcn_readlane(__builtin_bit_cast(int, a), 63)); const float u = gi - a;
        const float bm = wave_max(g + u);
        acum[t] = a; usub[t] = u;
        if (lane == 0) { GB[j] = g; GB[64 + j] = bm; } }
    WG_SYNC();
    if (wave == 0) { float G = GB[lane], B = GB[64 + lane]; const float g = G;
#pragma unroll
        for (int o = 1; o < 64; o <<= 1) { const float Gp = __shfl_up(G, o), Bp = __shfl_up(B, o); if (lane >= o) { B = fmaxf(Bp + G, B); G = Gp + G; } }
        const float mnew = fmaxf(G, B);
        float mprev = __shfl_up(mnew, 1); if (lane == 0) mprev = 0.f;
        sc[lane * 4 + 0] = mprev; sc[lane * 4 + 1] = mnew; sc[lane * 4 + 2] = g; sc[lane * 4 + 3] = expf(g + mprev - mnew); }
    WG_SYNC();
}

constexpr int TS64 = 144;
constexpr int TS128 = 272;
constexpr int ML_CW = 135168;
__device__ __forceinline__ void stage_convw(Frame& F) {
    const int tid = F.wave * 64 + lane_now(); LAS float* cwl = (LAS float*)(F.lds + ML_CW);
    for (int i = tid; i < 5632; i += NWAVES * 64) cwl[i] = (i < 4096) ? F.in[7][i] : (i < 5120) ? F.in[8][i - 4096] : F.in[10][i - 5120];
    WG_SYNC();
}
__device__ __forceinline__ void conv2_silu8(const bf16* src, int t, const LAS float* cwl, int ch0, float (&y0)[8], float (&y1)[8]) {
    v4u x[5];
#pragma unroll
    for (int i = 0; i < 5; ++i) { const int tt = t - 3 + i; x[i] = (tt >= 0) ? *(const GAS v4u*)(src + (size_t)tt * NPROJ) : (v4u){0u, 0u, 0u, 0u}; }
#pragma unroll
    for (int hh = 0; hh < 2; ++hh) {
        const f32x4 bb = *(const LAS f32x4*)(cwl + 4096 + ch0 + 4 * hh); f32x4 a0 = bb, a1 = bb;
#pragma unroll
        for (int tau = 0; tau < 4; ++tau) { const f32x4 w = *(const LAS f32x4*)(cwl + tau * 1024 + ch0 + 4 * hh);
            const unsigned p0 = hh ? x[tau].z : x[tau].x, p1 = hh ? x[tau].w : x[tau].y, q0 = hh ? x[tau + 1].z : x[tau + 1].x, q1 = hh ? x[tau + 1].w : x[tau + 1].y;
            a0 += w * (f32x4){bflo(p0), bfhi(p0), bflo(p1), bfhi(p1)}; a1 += w * (f32x4){bflo(q0), bfhi(q0), bflo(q1), bfhi(q1)}; }
#pragma unroll
        for (int e = 0; e < 4; ++e) { y0[4 * hh + e] = a0[e] * fsigmoid(a0[e]); y1[4 * hh + e] = a1[e] * fsigmoid(a1[e]); } }
}
__device__ __forceinline__ void stage_vt(Frame& F, int tid, int b, int t0, int h, LAS unsigned char* VT) {
    const bf16* mvt = (const bf16*)(F.ws + WS_MVT);
#pragma unroll
    for (int i = 0; i < 2; ++i) { const int id = tid + 512 * i, r = id >> 3, c = id & 7;
        *(LAS v4u*)(VT + r * TS64 + c * 16) = *(const GAS v4u*)(mvt + (size_t)(h * 128 + r) * M + (size_t)b * SEQ + t0 + c * 8); }
    if (tid < 128) { const int r = 128 + (tid >> 3), c = tid & 7; const unsigned one2 = (r == 128) ? 0x3F803F80u : 0u; *(LAS v4u*)(VT + r * TS64 + c * 16) = (v4u){one2, one2, one2, one2}; }
}

#define LDS_BARRIER() asm volatile("s_waitcnt lgkmcnt(0)\n\ts_barrier" ::: "memory")
__device__ __forceinline__ void conv2_math(const v4u (&x)[5], const LAS float* cwl, int ch0, float (&y0)[8], float (&y1)[8]) {
#pragma unroll
    for (int hh = 0; hh < 2; ++hh) {
        const f32x4 bb = *(const LAS f32x4*)(cwl + 4096 + ch0 + 4 * hh); f32x4 a0 = bb, a1 = bb;
#pragma unroll
        for (int tau = 0; tau < 4; ++tau) { const f32x4 w = *(const LAS f32x4*)(cwl + tau * 1024 + ch0 + 4 * hh);
            const unsigned p0 = hh ? x[tau].z : x[tau].x, p1 = hh ? x[tau].w : x[tau].y, q0 = hh ? x[tau + 1].z : x[tau + 1].x, q1 = hh ? x[tau + 1].w : x[tau + 1].y;
            a0 += w * (f32x4){bflo(p0), bfhi(p0), bflo(p1), bfhi(p1)}; a1 += w * (f32x4){bflo(q0), bfhi(q0), bflo(q1), bfhi(q1)}; }
#pragma unroll
        for (int e = 0; e < 4; ++e) { y0[4 * hh + e] = a0[e] * fsigmoid(a0[e]); y1[4 * hh + e] = a1[e] * fsigmoid(a1[e]); } }
}
struct M1Pre { v4u xk[5], vt[2]; float u0, u1; };
__device__ __forceinline__ void m1_load(Frame& F, int bh, int j, int lane, int wave, int tid, M1Pre& p) {
    const int b = bh >> 2, h = bh & 3, t0 = j * CHL; const bf16* proj = (const bf16*)(F.ws + WS_PROJ);
    const int c8 = (lane & 7) + 8 * (wave & 1), r0 = 2 * ((wave >> 1) * 8 + (lane >> 3));
    const bf16* sk = proj + (size_t)b * SEQ * NPROJ + C_MK + h * 128 + c8 * 8;
#pragma unroll
    for (int i = 0; i < 5; ++i) { const int tt = t0 + r0 - 3 + i, tc = tt < 0 ? 0 : tt; p.xk[i] = *(const GAS v4u*)(sk + (size_t)tc * NPROJ); }
    const bf16* mvt = (const bf16*)(F.ws + WS_MVT);
#pragma unroll
    for (int i = 0; i < 2; ++i) { const int id = tid + 512 * i, r = id >> 3, c = id & 7; p.vt[i] = *(const GAS v4u*)(mvt + (size_t)(h * 128 + r) * M + (size_t)b * SEQ + t0 + c * 8); }
    const float* usub = (const float*)(F.ws + WS_USUB) + (size_t)bh * SEQ + t0; p.u0 = usub[r0]; p.u1 = usub[r0 + 1];
}
constexpr int NGRP = 8, GCH = NCH / NGRP, ST_V4 = 9 * NWAVES * 64;
__device__ __forceinline__ void m1g_phase(Frame& F) {
    const int lane = lane_now(), wave = F.wave, tid = wave * 64 + lane;
    LAS unsigned char* KWT = F.lds; LAS unsigned char* VT = F.lds + 128 * TS64; const LAS float* cwl = (const LAS float*)(F.lds + ML_CW);
    const int r16 = lane & 15, q = lane >> 4, w = wave;
    for (int u = F.vcu; u < 32 * NGRP; u += F.G) { const int bh = u / NGRP, g = u % NGRP, h = bh & 3;
        M1Pre p; m1_load(F, bh, g * GCH, lane, wave, tid, p);
        f32x4 acc[9];
#pragma unroll
        for (int nt = 0; nt < 9; ++nt) acc[nt] = (f32x4){0.f, 0.f, 0.f, 0.f};
        for (int jj = 0; jj < GCH; ++jj) { const int j = g * GCH + jj, t0 = j * CHL;
            const float* sc = (const float*)(F.ws + WS_SC) + ((size_t)bh * NCH + j) * 4; const float mnew = sc[1], gj = sc[2], dec = sc[3];
            { const int c8 = (lane & 7) + 8 * (wave & 1), r0 = 2 * ((wave >> 1) * 8 + (lane >> 3)); float y0[8], y1[8];
#pragma unroll
                for (int i = 0; i < 3; ++i) { if (t0 + r0 - 3 + i < 0) p.xk[i] = (v4u){0u, 0u, 0u, 0u}; }
                conv2_math(p.xk, cwl, 512 + h * 128 + c8 * 8, y0, y1);
                const float w0 = 0.08838834764831845f * fexp(gj + p.u0 - mnew), w1 = 0.08838834764831845f * fexp(gj + p.u1 - mnew);
#pragma unroll
                for (int e = 0; e < 8; ++e) *(LAS unsigned*)(KWT + (c8 * 8 + e) * TS64 + r0 * 2) = pk2(y0[e] * w0, y1[e] * w1); }
#pragma unroll
            for (int i = 0; i < 2; ++i) { const int id = tid + 512 * i, r = id >> 3, c = id & 7; *(LAS v4u*)(VT + r * TS64 + c * 16) = p.vt[i]; }
            if (tid < 128) { const int r = 128 + (tid >> 3), c = tid & 7; const unsigned one2 = (r == 128) ? 0x3F803F80u : 0u; *(LAS v4u*)(VT + r * TS64 + c * 16) = (v4u){one2, one2, one2, one2}; }
            LDS_BARRIER();
            if (jj + 1 < GCH) m1_load(F, bh, j + 1, lane, wave, tid, p);
            bf16x8 xa[2];
#pragma unroll
            for (int ks = 0; ks < 2; ++ks) xa[ks] = *(const LAS bf16x8*)(KWT + (16 * w + r16) * TS64 + ks * 64 + q * 16);
#pragma unroll
            for (int nt = 0; nt < 9; ++nt) { acc[nt] = acc[nt] * dec;
#pragma unroll
                for (int ks = 0; ks < 2; ++ks) { const bf16x8 yb = *(const LAS bf16x8*)(VT + (16 * nt + r16) * TS64 + ks * 64 + q * 16); acc[nt] = __builtin_amdgcn_mfma_f32_16x16x32_bf16(xa[ks], yb, acc[nt], 0, 0, 0); } }
            LDS_BARRIER();
        }
        GAS f32x4* tg = (GAS f32x4*)F.out + (size_t)u * ST_V4 + tid;
#pragma unroll
        for (int nt = 0; nt < 9; ++nt) tg[nt * 512] = acc[nt];
    }
    WG_SYNC();
}

__device__ __forceinline__ void p3_scan_combine(Frame& F, const int sub, const int blk0) {
    const int lane = lane_now(), wave = F.wave, tid = wave * 64 + lane;
    const int vb = (int)blockIdx.x - blk0, nb = F.G - blk0;
    if (sub & 16) { const GAS f32x4* TG = (const GAS f32x4*)F.out; GAS f32x4* CIN = (GAS f32x4*)F.out + (size_t)2 * 1024 * 1024;
        for (int ch = vb * (NWAVES * 64) + tid; ch < 32 * ST_V4; ch += nb * NWAVES * 64) { const int bh = ch / ST_V4, e = ch % ST_V4;
            const float* sc = (const float*)(F.ws + WS_SC) + (size_t)bh * NCH * 4; f32x4 t[NGRP];
#pragma unroll
            for (int g = 0; g < NGRP; ++g) t[g] = TG[((size_t)bh * NGRP + g) * ST_V4 + e];
            f32x4 run = {0.f, 0.f, 0.f, 0.f};
#pragma unroll
            for (int g = 0; g < NGRP; ++g) { CIN[((size_t)bh * NGRP + g) * ST_V4 + e] = run; float dg = 1.f;
#pragma unroll
                for (int jj = 0; jj < GCH; ++jj) dg *= sc[(g * GCH + jj) * 4 + 3];
                run = run * dg + t[g]; } } }
    const float* lv = F.in[5];
    const float lam = expf(wave_sum(lv[lane] * lv[64 + lane])) - expf(wave_sum(lv[128 + lane] * lv[192 + lane])) + LAM_INIT;
    const int gw = vb * NWAVES + wave, NGW = nb * NWAVES; bf16* oa = (bf16*)(F.ws + WS_OA);
    float gs[8];
#pragma unroll
    for (int e = 0; e < 8; ++e) gs[e] = F.in[6][((lane * 8) & 127) + e] * (1.0f - LAM_INIT);
    if (sub & 32) for (int m = gw; m < M; m += NGW) { GAS v4u* r = (GAS v4u*)(oa + (size_t)m * 1024) + lane; const v4u a = r[0], c = r[64];
        float y[8]; y[0] = bflo(a.x) - lam * bflo(c.x); y[1] = bfhi(a.x) - lam * bfhi(c.x); y[2] = bflo(a.y) - lam * bflo(c.y); y[3] = bfhi(a.y) - lam * bfhi(c.y);
        y[4] = bflo(a.z) - lam * bflo(c.z); y[5] = bfhi(a.z) - lam * bfhi(c.z); y[6] = bflo(a.w) - lam * bflo(c.w); y[7] = bfhi(a.w) - lam * bfhi(c.w);
        float ss = 0.f;
#pragma unroll
        for (int e = 0; e < 8; ++e) ss += y[e] * y[e];
        ss = row16_sum(ss);
        const float rs = frsq(ss * (1.f / 128.f) + EPS); v4u o;
        o.x = pk2(y[0] * rs * gs[0], y[1] * rs * gs[1]); o.y = pk2(y[2] * rs * gs[2], y[3] * rs * gs[3]); o.z = pk2(y[4] * rs * gs[4], y[5] * rs * gs[5]); o.w = pk2(y[6] * rs * gs[6], y[7] * rs * gs[7]);
        r[0] = o; }
}

struct M3Pre { v4u xq[5], xk[5], vt[2], ow[2]; float u, a, u0, u1; };
__device__ __forceinline__ void m3_load(Frame& F, int bh, int j, int lane, int wave, int tid, M3Pre& p) {
    const int b = bh >> 2, h = bh & 3, t0 = j * CHL; const bf16* proj = (const bf16*)(F.ws + WS_PROJ);
    const int c8 = (lane & 7) + 8 * (wave & 1), r0 = 2 * ((wave >> 1) * 8 + (lane >> 3));
    const bf16* sq = proj + (size_t)b * SEQ * NPROJ + C_MQ + h * 128 + c8 * 8; const bf16* sk = proj + (size_t)b * SEQ * NPROJ + C_MK + h * 128 + c8 * 8;
#pragma unroll
    for (int i = 0; i < 5; ++i) { const int tt = t0 + r0 - 3 + i, tc = tt < 0 ? 0 : tt;
        p.xq[i] = *(const GAS v4u*)(sq + (size_t)tc * NPROJ); p.xk[i] = *(const GAS v4u*)(sk + (size_t)tc * NPROJ); }
    const bf16* mvt = (const bf16*)(F.ws + WS_MVT);
#pragma unroll
    for (int i = 0; i < 2; ++i) { const int id = tid + 512 * i, r = id >> 3, c = id & 7; p.vt[i] = *(const GAS v4u*)(mvt + (size_t)(h * 128 + r) * M + (size_t)b * SEQ + t0 + c * 8); }
    { const GAS v4u* op = (const GAS v4u*)(proj + ((size_t)b * SEQ + t0 + (tid >> 3)) * NPROJ + C_MO + h * 128 + 16 * (tid & 7)); p.ow[0] = op[0]; p.ow[1] = op[1]; }
    p.u = ((const float*)(F.ws + WS_USUB))[(size_t)bh * SEQ + t0 + lane]; p.a = ((const float*)(F.ws + WS_ACUM))[(size_t)bh * SEQ + t0 + lane];
    p.u0 = ((const float*)(F.ws + WS_USUB))[(size_t)bh * SEQ + t0 + r0]; p.u1 = ((const float*)(F.ws + WS_USUB))[(size_t)bh * SEQ + t0 + r0 + 1];
}
__device__ __forceinline__ void m3_phase(Frame& F) {
    const int lane = lane_now(), wave = F.wave, tid = wave * 64 + lane;
    const bf16* proj = (const bf16*)(F.ws + WS_PROJ);
    LAS unsigned char* Qs = F.lds; LAS unsigned char* Ks = F.lds + 64 * TS128; LAS unsigned char* VT = F.lds + 128 * TS128; LAS unsigned char* CT = VT + DVX * TS64;
    LAS unsigned char* SD = CT + DVX * TS128; LAS float* sv = (LAS float*)(SD + 64 * TS64);
    LAS unsigned char* KWT = SD + 64 * TS64 + 1024;
    LAS float* HB = (LAS float*)F.lds;
    const LAS float* cwl = (const LAS float*)(F.lds + ML_CW);
    static_assert(128 * TS128 + DVX * TS64 + DVX * TS128 + 64 * TS64 + 4 * 64 * 4 + 128 * TS64 <= ML_CW && 64 * 132 * 4 <= 128 * TS128 && ML_CW + 5632 * 4 <= LDSCTL_OFF, "m3 LDS");
    M3Pre p;
    for (int ug = F.vcu; ug < 32 * NGRP; ug += F.G) {
    const int bh = ug / NGRP, g = ug % NGRP;
    f32x4 cst[9];
    { const GAS f32x4* cin = (const GAS f32x4*)F.out + (size_t)2 * 1024 * 1024 + (size_t)ug * ST_V4 + tid;
#pragma unroll
      for (int nt = 0; nt < 9; ++nt) cst[nt] = cin[nt * 512]; }
    m3_load(F, bh, g * GCH, lane, wave, tid, p);
    for (int jj = 0; jj < GCH; ++jj) {
        const int j = g * GCH + jj, b = bh >> 2, h = bh & 3, t0 = j * CHL;
        const float* sc = (const float*)(F.ws + WS_SC) + ((size_t)bh * NCH + j) * 4; const float mprev = sc[0], mnew = sc[1], gj = sc[2], dec = sc[3];
        { const int c8 = (lane & 7) + 8 * (wave & 1), r0 = 2 * ((wave >> 1) * 8 + (lane >> 3)); float y0[8], y1[8]; v4u o;
#pragma unroll
            for (int i = 0; i < 3; ++i) { const bool z = t0 + r0 - 3 + i < 0; if (z) { p.xq[i] = (v4u){0u, 0u, 0u, 0u}; p.xk[i] = (v4u){0u, 0u, 0u, 0u}; } }
            conv2_math(p.xq, cwl, h * 128 + c8 * 8, y0, y1);
            o.x = pk2(y0[0], y0[1]); o.y = pk2(y0[2], y0[3]); o.z = pk2(y0[4], y0[5]); o.w = pk2(y0[6], y0[7]); *(LAS v4u*)(Qs + r0 * TS128 + c8 * 16) = o;
            o.x = pk2(y1[0], y1[1]); o.y = pk2(y1[2], y1[3]); o.z = pk2(y1[4], y1[5]); o.w = pk2(y1[6], y1[7]); *(LAS v4u*)(Qs + (r0 + 1) * TS128 + c8 * 16) = o;
            conv2_math(p.xk, cwl, 512 + h * 128 + c8 * 8, y0, y1);
            const float ksc = 0.08838834764831845f;
            o.x = pk2(y0[0] * ksc, y0[1] * ksc); o.y = pk2(y0[2] * ksc, y0[3] * ksc); o.z = pk2(y0[4] * ksc, y0[5] * ksc); o.w = pk2(y0[6] * ksc, y0[7] * ksc); *(LAS v4u*)(Ks + r0 * TS128 + c8 * 16) = o;
            o.x = pk2(y1[0] * ksc, y1[1] * ksc); o.y = pk2(y1[2] * ksc, y1[3] * ksc); o.z = pk2(y1[4] * ksc, y1[5] * ksc); o.w = pk2(y1[6] * ksc, y1[7] * ksc); *(LAS v4u*)(Ks + (r0 + 1) * TS128 + c8 * 16) = o;
            const float w0 = ksc * fexp(gj + p.u0 - mnew), w1 = ksc * fexp(gj + p.u1 - mnew);
#pragma unroll
            for (int e = 0; e < 8; ++e) *(LAS unsigned*)(KWT + (c8 * 8 + e) * TS64 + r0 * 2) = pk2(y0[e] * w0, y1[e] * w1); }
#pragma unroll
        for (int i = 0; i < 2; ++i) { const int id = tid + 512 * i, r = id >> 3, c = id & 7; *(LAS v4u*)(VT + r * TS64 + c * 16) = p.vt[i]; }
        if (tid < 128) { const int r = 128 + (tid >> 3), c = tid & 7; const unsigned one2 = (r == 128) ? 0x3F803F80u : 0u; *(LAS v4u*)(VT + r * TS64 + c * 16) = (v4u){one2, one2, one2, one2}; }
        { const int r16s = lane & 15, qs = lane >> 4;
#pragma unroll
          for (int nt = 0; nt < 9; ++nt) { u32x2 o2; o2.x = pk2(cst[nt][0], cst[nt][1]); o2.y = pk2(cst[nt][2], cst[nt][3]); *(LAS u32x2*)(CT + (16 * nt + r16s) * TS128 + (16 * wave + 4 * qs) * 2) = o2; } }
        if (wave == 0) { const float um = fmaxf(mprev, wave_scan_max(p.u));
            sv[lane] = p.u; sv[64 + lane] = um; sv[128 + lane] = fexp(mprev - um); sv[192 + lane] = fexp(-(p.a + um)); }
        const v4u ow0 = p.ow[0], ow1 = p.ow[1];
        LDS_BARRIER();
        if (jj + 1 < GCH) m3_load(F, bh, j + 1, lane, wave, tid, p);
        const int tr = tid >> 3, part = tid & 7; const size_t orow = (size_t)b * SEQ + t0 + tr;
        const int r16 = lane & 15, q = lane >> 4, tt = wave & 3, hf = wave >> 2; const int t = 16 * tt + r16;
        bf16x8 qf[4];
#pragma unroll
        for (int ks = 0; ks < 4; ++ks) qf[ks] = *(const LAS bf16x8*)(Qs + t * TS128 + ks * 64 + q * 16);
        { const float umt = sv[64 + t];
#pragma unroll
            for (int k = 0; k < 2; ++k) { const int st = 2 * hf + k; f32x4 acc = {0.f, 0.f, 0.f, 0.f};
#pragma unroll
                for (int ks = 0; ks < 4; ++ks) { const bf16x8 kf = *(const LAS bf16x8*)(Ks + (16 * st + r16) * TS128 + ks * 64 + q * 16); acc = __builtin_amdgcn_mfma_f32_16x16x32_bf16(kf, qf[ks], acc, 0, 0, 0); }
                float o[4];
#pragma unroll
                for (int i = 0; i < 4; ++i) { const int s = 16 * st + 4 * q + i; o[i] = (s <= t) ? acc[i] * fexp(sv[s] - umt) : 0.f; }
                u32x2 w; w.x = pk2(o[0], o[1]); w.y = pk2(o[2], o[3]); *(LAS u32x2*)(SD + t * TS64 + (16 * st + 4 * q) * 2) = w; } }
        f32x4 acc[5];
#pragma unroll
        for (int k = 0; k < 5; ++k) acc[k] = (f32x4){0.f, 0.f, 0.f, 0.f};
        { bf16x8 cf[3];
#pragma unroll
          for (int i = 0; i < 22; ++i) {
              if (i < 20) { const int k = i >> 2, ks = i & 3; const int mt = (k < 4) ? 4 * hf + k : 8; cf[i % 3] = *(const LAS bf16x8*)(CT + (16 * mt + r16) * TS128 + ks * 64 + q * 16); }
              __builtin_amdgcn_sched_barrier(0);
              if (i >= 2) { const int j = i - 2; acc[j >> 2] = __builtin_amdgcn_mfma_f32_16x16x32_bf16(cf[j % 3], qf[j & 3], acc[j >> 2], 0, 0, 0); }
              __builtin_amdgcn_sched_barrier(0); } }
        { bf16x8 xa[2];
#pragma unroll
          for (int ks = 0; ks < 2; ++ks) xa[ks] = *(const LAS bf16x8*)(KWT + (16 * wave + r16) * TS64 + ks * 64 + q * 16);
#pragma unroll
          for (int nt = 0; nt < 9; ++nt) { cst[nt] = cst[nt] * dec;
#pragma unroll
              for (int ks = 0; ks < 2; ++ks) { const bf16x8 yb = *(const LAS bf16x8*)(VT + (16 * nt + r16) * TS64 + ks * 64 + q * 16); cst[nt] = __builtin_amdgcn_mfma_f32_16x16x32_bf16(xa[ks], yb, cst[nt], 0, 0, 0); } } }
        LDS_BARRIER();
        { const float wi = sv[128 + t];
            bf16x8 sf[2];
#pragma unroll
            for (int ks = 0; ks < 2; ++ks) sf[ks] = *(const LAS bf16x8*)(SD + t * TS64 + ks * 64 + q * 16);
#pragma unroll
            for (int k = 0; k < 5; ++k) acc[k] = acc[k] * wi;
            { bf16x8 vf[3];
#pragma unroll
              for (int i = 0; i < 12; ++i) {
                  if (i < 10) { const int k = i >> 1, ks = i & 1; const int mt = (k < 4) ? 4 * hf + k : 8; vf[i % 3] = *(const LAS bf16x8*)(VT + (16 * mt + r16) * TS64 + ks * 64 + q * 16); }
                  __builtin_amdgcn_sched_barrier(0);
                  if (i >= 2) { const int j = i - 2; acc[j >> 1] = __builtin_amdgcn_mfma_f32_16x16x32_bf16(vf[j % 3], sf[j & 1], acc[j >> 1], 0, 0, 0); }
                  __builtin_amdgcn_sched_barrier(0); } }
            const float den = __shfl(acc[4][0], r16);
            const float inv = __builtin_amdgcn_rcpf(fmaxf(fabsf(den), sv[192 + t]));
#pragma unroll
            for (int k = 0; k < 4; ++k) *(LAS f32x4*)(HB + t * 132 + 16 * (4 * hf + k) + 4 * q) = acc[k] * inv; }
        LDS_BARRIER();
        { bf16* Y = (bf16*)(F.ws + WS_OA);
            f32x4 x[4]; float s = 0.f;
#pragma unroll
            for (int i = 0; i < 4; ++i) { x[i] = *(const LAS f32x4*)(HB + tr * 132 + 16 * part + 4 * i); s += (x[i][0] + x[i][1]) + (x[i][2] + x[i][3]); }
            s = row8_sum(s);
            const float mu = s * (1.f / 128.f); float v = 0.f;
#pragma unroll
            for (int i = 0; i < 4; ++i) { x[i] = x[i] - mu; v += dot4(x[i], x[i]); }
            v = row8_sum(v);
            const float rs = frsq(v * (1.f / 128.f) + EPS);
            const LAS f32x4* gp = (const LAS f32x4*)(cwl + 5120 + h * 128 + 16 * part);
#pragma unroll
            for (int hh = 0; hh < 2; ++hh) { const v4u ow = hh ? ow1 : ow0; const f32x4 g0 = gp[2 * hh], g1 = gp[2 * hh + 1]; const f32x4 a0 = x[2 * hh] * rs * g0, a1 = x[2 * hh + 1] * rs * g1; v4u o;
                o.x = pk2(a0[0] * fsigmoid(bflo(ow.x)), a0[1] * fsigmoid(bfhi(ow.x))); o.y = pk2(a0[2] * fsigmoid(bflo(ow.y)), a0[3] * fsigmoid(bfhi(ow.y)));
                o.z = pk2(a1[0] * fsigmoid(bflo(ow.z)), a1[1] * fsigmoid(bfhi(ow.z))); o.w = pk2(a1[2] * fsigmoid(bflo(ow.w)), a1[3] * fsigmoid(bfhi(ow.w)));
                *(GAS v4u*)(Y + orow * 1024 + 512 + h * 128 + 16 * part + 8 * hh) = o; } }
        LDS_BARRIER();
    }
    }
    WG_SYNC();
}

typedef float f32x16 __attribute__((ext_vector_type(16)));
__device__ __forceinline__ void xattn_unit(Frame& F, int rt, int h) {
    const int lane = lane_now(), wave = F.wave;
    const bf16* XQ = (const bf16*)(F.ws + WS_XQ); bf16* XO = (bf16*)(F.ws + WS_XO);
    const int r32 = lane & 31, hi = lane >> 5; const int b = (rt * 256) / SEQ; const size_t row0 = (size_t)rt * 256 + wave * 32;
    const bf16* qrow = XQ + (row0 + r32) * D + h * 256 + hi * 8;
    const bf16* Kg = (const bf16*)(F.ws + WS_MK) + (size_t)(b * MEMLEN) * D + h * 256;
    const bf16* Vg = (const bf16*)(F.ws + WS_MVT2) + (size_t)(h * 256) * MROWS + b * MEMLEN;
    LAS unsigned char* KB = F.lds; LAS unsigned char* VB = F.lds + 65536;
#define XA_KSRC(i) (Kg + (size_t)(2 * (4 * wave + (i)) + (lane >> 5)) * D + (((lane & 31) ^ ((2 * (4 * wave + (i)) + (lane >> 5)) & 15)) * 8))
#define XA_VSRC(i) (Vg + (size_t)(8 * (2 * wave + (i)) + (lane >> 3)) * MROWS + (((lane & 7) ^ (((8 * (2 * wave + (i)) + (lane >> 3)) >> 1) & 7)) * 8))
    const bf16* ks0 = XA_KSRC(0); const bf16* ks1 = XA_KSRC(1); const bf16* ks2 = XA_KSRC(2); const bf16* ks3 = XA_KSRC(3); const bf16* vs0 = XA_VSRC(0); const bf16* vs1 = XA_VSRC(1);
#define XA_ISSUE(step) do { const int kt_ = (step) & 3, hv_ = (step) >> 2, bf_ = (step) & 1, vf_ = (step) % 3; const size_t ko_ = (size_t)kt_ * 64 * D, vo_ = (size_t)hv_ * 128 * MROWS + kt_ * 64; \
        __builtin_amdgcn_global_load_lds((const unsigned*)(ks0 + ko_), (LAS unsigned*)(KB + bf_ * 32768 + (4 * wave + 0) * 1024), 16, 0, 0); \
        __builtin_amdgcn_global_load_lds((const unsigned*)(ks1 + ko_), (LAS unsigned*)(KB + bf_ * 32768 + (4 * wave + 1) * 1024), 16, 0, 0); \
        __builtin_amdgcn_global_load_lds((const unsigned*)(ks2 + ko_), (LAS unsigned*)(KB + bf_ * 32768 + (4 * wave + 2) * 1024), 16, 0, 0); \
        __builtin_amdgcn_global_load_lds((const unsigned*)(ks3 + ko_), (LAS unsigned*)(KB + bf_ * 32768 + (4 * wave + 3) * 1024), 16, 0, 0); \
        __builtin_amdgcn_global_load_lds((const unsigned*)(vs0 + vo_), (LAS unsigned*)(VB + vf_ * 16384 + (2 * wave + 0) * 1024), 16, 0, 0); \
        __builtin_amdgcn_global_load_lds((const unsigned*)(vs1 + vo_), (LAS unsigned*)(VB + vf_ * 16384 + (2 * wave + 1) * 1024), 16, 0, 0); } while (0)
#define XA_PV(step_) do { const unsigned vbase_ = (unsigned)(uintptr_t)(VB + ((step_) % 3) * 16384) + 8 * hi; u32x2 vf[3][2]; \
        _Pragma("unroll") for (int i = 0; i < 18; ++i) { \
            if (i < 16) { const int mt = i >> 2, st = i & 3; const int dv = 32 * mt + r32; const unsigned vr = vbase_ + dv * 128; const int sw = (dv >> 1) & 7; \
                asm volatile("ds_read_b64 %0, %1" : "=v"(vf[i % 3][0]) : "v"(vr + (((2 * st) ^ sw) * 16)) : "memory"); asm volatile("ds_read_b64 %0, %1" : "=v"(vf[i % 3][1]) : "v"(vr + (((2 * st + 1) ^ sw) * 16)) : "memory"); } \
            if (i >= 2) { if (i < 16) asm volatile("s_waitcnt lgkmcnt(4)" ::: "memory"); else if (i == 16) asm volatile("s_waitcnt lgkmcnt(2)" ::: "memory"); else asm volatile("s_waitcnt lgkmcnt(0)" ::: "memory"); } \
            __builtin_amdgcn_sched_barrier(0); \
            if (i >= 2) { const int j = i - 2; u32x4 w; w.x = vf[j % 3][0].x; w.y = vf[j % 3][0].y; w.z = vf[j % 3][1].x; w.w = vf[j % 3][1].y; \
                o[j >> 2] = __builtin_amdgcn_mfma_f32_32x32x16_bf16(__builtin_bit_cast(bf16x8, w), pf[j & 3], o[j >> 2], 0, 0, 0); } \
            __builtin_amdgcn_sched_barrier(0); } } while (0)
#define XA_FINISH(hv_) do { { auto rr = __builtin_amdgcn_permlane32_swap(__float_as_uint(l), __float_as_uint(l), false, false); l = __uint_as_float(rr[0]) + __uint_as_float(rr[1]); } \
        const float inv = __builtin_amdgcn_rcpf(l); bf16* orow = XO + (row0 + r32) * D + h * 256 + (hv_) * 128; \
        _Pragma("unroll") for (int mt = 0; mt < 4; ++mt) _Pragma("unroll") for (int a = 0; a < 2; ++a) { const int b2 = a + 2; \
            const unsigned x0 = pk2(o[mt][4 * a] * inv, o[mt][4 * a + 1] * inv), x1 = pk2(o[mt][4 * a + 2] * inv, o[mt][4 * a + 3] * inv); \
            const unsigned y0 = pk2(o[mt][4 * b2] * inv, o[mt][4 * b2 + 1] * inv), y1 = pk2(o[mt][4 * b2 + 2] * inv, o[mt][4 * b2 + 3] * inv); \
            auto s0_ = __builtin_amdgcn_permlane32_swap(y0, x0, false, false); auto s1_ = __builtin_amdgcn_permlane32_swap(y1, x1, false, false); \
            u32x4 w; w.x = s0_[0]; w.y = s1_[0]; w.z = s0_[1]; w.w = s1_[1]; *(GAS u32x4*)(orow + 32 * mt + 8 * (hi ? a : b2)) = w; } \
        _Pragma("unroll") for (int i = 0; i < 4; ++i) o[i] = (f32x16){}; l = 0.f; mx = -INFINITY; } while (0)
    XA_ISSUE(0);
    bf16x8 qf[16];
#pragma unroll
    for (int ks = 0; ks < 16; ++ks) qf[ks] = __builtin_nontemporal_load((const GAS bf16x8*)(qrow + ks * 16));
    const bool lag = wave >= 4;
    f32x16 o[4];
#pragma unroll
    for (int i = 0; i < 4; ++i) o[i] = (f32x16){};
    float mx = -INFINITY, l = 0.f; bf16x8 pf[4];
#pragma unroll
    for (int i = 0; i < 4; ++i) pf[i] = (bf16x8){};
    for (int step = 0; step < 8; ++step) {
        asm volatile("s_waitcnt vmcnt(0)" ::: "memory"); WG_SYNC();
        if (step < 7) XA_ISSUE(step + 1);
        if (lag && step > 0) { XA_PV(step - 1); if (step == 4) XA_FINISH(0); }
        const LAS unsigned char* kb = KB + (step & 1) * 32768;
        f32x16 s0 = (f32x16){}, s1 = (f32x16){};
        { bf16x8 kf[2][2];
          const unsigned kaddr0 = (unsigned)(uintptr_t)(kb + r32 * 512), kaddr1 = kaddr0 + 32 * 512;
#define XA_KRD(ks_) do { const unsigned pos_ = (unsigned)(((2 * (ks_) + hi) ^ (r32 & 15)) * 16); \
              asm volatile("ds_read_b128 %0, %1" : "=v"(kf[(ks_) & 1][0]) : "v"(kaddr0 + pos_) : "memory"); asm volatile("ds_read_b128 %0, %1" : "=v"(kf[(ks_) & 1][1]) : "v"(kaddr1 + pos_) : "memory"); } while (0)
          XA_KRD(0);
#pragma unroll
          for (int ks = 0; ks < 16; ++ks) {
              if (ks < 15) { XA_KRD(ks + 1); asm volatile("s_waitcnt lgkmcnt(2)" ::: "memory"); } else asm volatile("s_waitcnt lgkmcnt(0)" ::: "memory");
              __builtin_amdgcn_sched_barrier(0);
              s0 = __builtin_amdgcn_mfma_f32_32x32x16_bf16(kf[ks & 1][0], qf[ks], s0, 0, 0, 0); s1 = __builtin_amdgcn_mfma_f32_32x32x16_bf16(kf[ks & 1][1], qf[ks], s1, 0, 0, 0);
              __builtin_amdgcn_sched_barrier(0); }
#undef XA_KRD
        }
        float tm = fmaxf(s0[0], s1[0]);
#pragma unroll
        for (int r = 1; r < 16; ++r) tm = fmaxf(tm, fmaxf(s0[r], s1[r]));
        { auto rr = __builtin_amdgcn_permlane32_swap(__float_as_uint(tm), __float_as_uint(tm), false, false); tm = fmaxf(__uint_as_float(rr[0]), __uint_as_float(rr[1])); }
        float mn = mx;
        if (__any(tm > mx + 8.0f)) { mn = fmaxf(mx, tm); const float alpha = __builtin_amdgcn_exp2f(mx - mn); l *= alpha;
#pragma unroll
            for (int i = 0; i < 4; ++i) o[i] = o[i] * alpha; }
        mx = mn;
        float ps = 0.f;
#pragma unroll
        for (int r = 0; r < 16; ++r) { s0[r] = __builtin_amdgcn_exp2f(s0[r] - mn); s1[r] = __builtin_amdgcn_exp2f(s1[r] - mn); ps += s0[r] + s1[r]; }
        l += ps;
#pragma unroll
        for (int kk = 0; kk < 2; ++kk) { u32x4 w0, w1;
            w0.x = pk2(s0[8 * kk + 0], s0[8 * kk + 1]); w0.y = pk2(s0[8 * kk + 2], s0[8 * kk + 3]); w0.z = pk2(s0[8 * kk + 4], s0[8 * kk + 5]); w0.w = pk2(s0[8 * kk + 6], s0[8 * kk + 7]);
            w1.x = pk2(s1[8 * kk + 0], s1[8 * kk + 1]); w1.y = pk2(s1[8 * kk + 2], s1[8 * kk + 3]); w1.z = pk2(s1[8 * kk + 4], s1[8 * kk + 5]); w1.w = pk2(s1[8 * kk + 6], s1[8 * kk + 7]);
            pf[kk] = __builtin_bit_cast(bf16x8, w0); pf[2 + kk] = __builtin_bit_cast(bf16x8, w1); }
        if (!lag) { XA_PV(step); if (step == 3) XA_FINISH(0); }
    }
    if (lag) XA_PV(7);
    XA_FINISH(1);
#undef XA_ISSUE
#undef XA_KSRC
#undef XA_VSRC
#undef XA_PV
#undef XA_FINISH
    WG_SYNC();
}

constexpr int R_WH = 0, R_STRIDE = 2064, R_WL = 36 * R_STRIDE, R_CH = 72 * R_STRIDE, R_LCNT = R_CH + 4096, R_LBASE = R_LCNT + 128, R_EL = R_LBASE + 128;
static_assert(R_EL + 4096 <= LDSCTL_OFF, "router LDS");
__device__ __forceinline__ void p9_router(Frame& F) {
    const int lane = lane_now(), wave = F.wave, tid = wave * 64 + lane;
    LAS unsigned char* L = F.lds;
    LAS int* CH = (LAS int*)(L + R_CH); LAS int* LCNT = (LAS int*)(L + R_LCNT); LAS int* LBASE = (LAS int*)(L + R_LBASE); LAS float* EL = (LAS float*)(L + R_EL) + wave * 128;
    const bf16* x2 = (const bf16*)(F.ws + WS_XB); float* rstd2 = (float*)(F.ws + WS_RSTD2);
    const int rpb = (M + F.G - 1) / F.G; const int r0 = F.vcu * rpb; const int r1 = (r0 + rpb < M) ? r0 + rpb : M;
    const int r16 = lane & 15, q = lane >> 4;
    int base = r0 + wave * 16;
    bf16x8 xf[32];
#define R9_LOADROW() do { const int m_ = base + r16; const bf16* xr_ = x2 + (size_t)((m_ < r1) ? m_ : r0) * D + 8 * q; _Pragma("unroll") for (int j = 0; j < 32; ++j) xf[j] = *(const GAS bf16x8*)(xr_ + j * 32); } while (0)
    if (base < r1 && base - r0 < 128) R9_LOADROW();
    { const GAS v4u* rtg = (const GAS v4u*)(F.ws + WS_RT);
#pragma unroll
      for (int i = 0; i < 18; ++i) { const int id = tid + 512 * i, row = id >> 7, c = id & 127; *(LAS v4u*)(L + row * R_STRIDE + c * 16) = rtg[id]; } }
    if (tid < 32) LCNT[tid] = 0;
    WG_SYNC();
    for (; base < r1 && base - r0 < 128; base += NWAVES * 16) {
        const int m = base + r16; const bool live = m < r1;
        f32x4 acc0 = {0.f, 0.f, 0.f, 0.f}, acc1 = acc0, acc2 = acc0; float ss = 0.f;
#pragma unroll
        for (int ks = 0; ks < 32; ++ks) { const int ko = ks * 64 + q * 16;
                const bf16x8 h0 = *(const LAS bf16x8*)(L + R_WH + r16 * R_STRIDE + ko), h1 = *(const LAS bf16x8*)(L + R_WH + (16 + r16) * R_STRIDE + ko), h2 = *(const LAS bf16x8*)(L + R_WH + (32 + (r16 & 3)) * R_STRIDE + ko);
                const bf16x8 l0 = *(const LAS bf16x8*)(L + R_WL + r16 * R_STRIDE + ko), l1 = *(const LAS bf16x8*)(L + R_WL + (16 + r16) * R_STRIDE + ko), l2 = *(const LAS bf16x8*)(L + R_WL + (32 + (r16 & 3)) * R_STRIDE + ko);
                acc0 = __builtin_amdgcn_mfma_f32_16x16x32_bf16(h0, xf[ks], acc0, 0, 0, 0); acc1 = __builtin_amdgcn_mfma_f32_16x16x32_bf16(h1, xf[ks], acc1, 0, 0, 0); acc2 = __builtin_amdgcn_mfma_f32_16x16x32_bf16(h2, xf[ks], acc2, 0, 0, 0);
                acc0 = __builtin_amdgcn_mfma_f32_16x16x32_bf16(l0, xf[ks], acc0, 0, 0, 0); acc1 = __builtin_amdgcn_mfma_f32_16x16x32_bf16(l1, xf[ks], acc1, 0, 0, 0); acc2 = __builtin_amdgcn_mfma_f32_16x16x32_bf16(l2, xf[ks], acc2, 0, 0, 0);
                const u32x4 xw = __builtin_bit_cast(u32x4, xf[ks]);
                const float a0 = bflo(xw.x), a1 = bfhi(xw.x), a2 = bflo(xw.y), a3 = bfhi(xw.y), a4 = bflo(xw.z), a5 = bfhi(xw.z), a6 = bflo(xw.w), a7 = bfhi(xw.w);
                ss += ((a0 * a0 + a1 * a1) + (a2 * a2 + a3 * a3)) + ((a4 * a4 + a5 * a5) + (a6 * a6 + a7 * a7));
                __builtin_amdgcn_sched_barrier(0); }
        { const int nb_ = base + NWAVES * 16; if (nb_ < r1 && nb_ - r0 < 128) { base = nb_; R9_LOADROW(); base -= NWAVES * 16; } }
        { auto r_ = __builtin_amdgcn_permlane16_swap(__float_as_uint(ss), __float_as_uint(ss), false, false); ss = __uint_as_float(r_[0]) + __uint_as_float(r_[1]); }
        { auto r_ = __builtin_amdgcn_permlane32_swap(__float_as_uint(ss), __float_as_uint(ss), false, false); ss = __uint_as_float(r_[0]) + __uint_as_float(r_[1]); }
        const float gl0 = __shfl(acc2[0], r16), gl1 = __shfl(acc2[1], r16), gl2 = __shfl(acc2[2], r16), gl3 = __shfl(acc2[3], r16);
        const float rstd = frsq(ss * (1.f / D) + EPS);
        const float g0 = gl0 * rstd + F.in[19][0], g1 = gl1 * rstd + F.in[19][1], g2 = gl2 * rstd + F.in[19][2], g3 = gl3 * rstd + F.in[19][3];
        int gi = 0; float gm = g0; if (g1 > gm) { gm = g1; gi = 1; } if (g2 > gm) { gm = g2; gi = 2; } if (g3 > gm) { gm = g3; gi = 3; }
        const float g_w = __builtin_amdgcn_rcpf(fexp(g0 - gm) + fexp(g1 - gm) + fexp(g2 - gm) + fexp(g3 - gm));
        if ((q >> 1) == (gi & 1)) { const f32x4 a = (gi >> 1) ? acc1 : acc0; const GAS f32x4* bp = (const GAS f32x4*)(F.in[21] + gi * 8 + 4 * (q & 1));
            *(LAS f32x4*)(EL + r16 * 8 + 4 * (q & 1)) = a * rstd + *bp; }
        asm volatile("s_waitcnt lgkmcnt(0)" ::: "memory");
        if (q == 0 && live) { const f32x4 ea = *(const LAS f32x4*)(EL + r16 * 8), eb = *(const LAS f32x4*)(EL + r16 * 8 + 4);
            float el[8] = {ea.x, ea.y, ea.z, ea.w, eb.x, eb.y, eb.z, eb.w};
            int i0 = 0; float m0 = el[0];
#pragma unroll
            for (int n = 1; n < 8; ++n) if (el[n] > m0) { m0 = el[n]; i0 = n; }
            int i1 = (i0 + 1) & 7; float m1 = -INFINITY;
#pragma unroll
            for (int n = 0; n < 8; ++n) if (n != i0 && el[n] > m1) { m1 = el[n]; i1 = n; }
            const float p1r = fexp(m1 - m0); const float w0 = g_w * __builtin_amdgcn_rcpf(1.f + p1r), w1 = w0 * p1r;
            const int e0 = gi * 8 + i0, e1 = gi * 8 + i1; const int lr0 = atomicAdd((int*)&LCNT[e0], 1), lr1 = atomicAdd((int*)&LCNT[e1], 1);
            LAS int* c = CH + (m - r0) * 8; c[0] = e0; c[1] = e1; c[2] = lr0; c[3] = lr1; c[4] = __float_as_int(w0); c[5] = __float_as_int(w1);
            rstd2[m] = rstd; }
        asm volatile("s_waitcnt lgkmcnt(0)" ::: "memory");
    }
    WG_SYNC();
    if (tid < 32) LBASE[tid] = (int)atomicAdd((unsigned*)(F.ctl + CW_CNT + tid), (unsigned)LCNT[tid]);
    WG_SYNC();
    int* tokl = (int*)(F.ws + WS_TOKL); int* asg = (int*)(F.ws + WS_ASG);
    for (int r = tid; r < r1 - r0; r += NWAVES * 64) { const LAS int* c = CH + r * 8; const int m = r0 + r;
        const int e0 = c[0], e1 = c[1], k0 = LBASE[e0] + c[2], k1 = LBASE[e1] + c[3];
        tokl[(size_t)e0 * M + k0] = m; tokl[(size_t)e1 * M + k1] = m;
        asg[m * 8 + 0] = e0; asg[m * 8 + 1] = k0; asg[m * 8 + 2] = e1; asg[m * 8 + 3] = k1; asg[m * 8 + 4] = c[4]; asg[m * 8 + 5] = c[5]; }
}

template <bool GATHER> __device__ __forceinline__ int expert_tables(Frame& F) {
    const int lane = lane_now(), wave = F.wave, tid = wave * 64 + lane; (void)tid; (void)lane; (void)wave;
    LAS int* TS = (LAS int*)(F.lds + XT_TS); LAS int* TOK = (LAS int*)(F.lds + XT_TOK);
    if (tid == 0) { int acc = 0; for (int e = 0; e < 32; ++e) { TS[e] = acc; acc += ((int)F.ctl[CW_CNT + e] + 255) >> 8; } TS[32] = acc; }
    WG_SYNC();
    const int ntiles = TS[32];
    if (GATHER) { const int* tokl = (const int*)(F.ws + WS_TOKL);
        for (int ui = 0; ui < 5; ++ui) { const int L = ui * F.G + (int)blockIdx.x; if (L >= 4 * ntiles) break;
            const int rt = pg8::expert_unit_id(L, 4 * ntiles) >> 2; int e = 0; for (int k = 1; k < 32; ++k) e += (TS[k] <= rt) ? 1 : 0;
            const int cnt = (int)F.ctl[CW_CNT + e];
            if (tid < 256) { const int rank = (rt - TS[e]) * 256 + tid; const int tk = (rank < cnt) ? tokl[(size_t)e * M + rank] : 0; TOK[ui * 256 + tid] = tk; ((LAS float*)(F.lds + XT_RS))[ui * 256 + tid] = ((const float*)(F.ws + WS_RSTD2))[tk]; } }
        WG_SYNC(); }
    return ntiles;
}

__device__ __forceinline__ void p12_final(Frame& F) {
    const int lane = lane_now(), wave = F.wave, tid = wave * 64 + lane;
    LAS int* TS = (LAS int*)(F.lds + XT_TS);
    if (tid == 0) { int acc = 0; for (int e = 0; e < 32; ++e) { TS[e] = acc; acc += ((int)F.ctl[CW_CNT + e] + 255) >> 8; } TS[32] = acc; }
    WG_SYNC();
    const int gw = F.vcu * NWAVES + wave, NGW = F.G * NWAVES; const GAS v4u* asg = (const GAS v4u*)(F.ws + WS_ASG); const bf16* YE = (const bf16*)(F.ws + WS_YE); const bf16* XB = (const bf16*)(F.ws + WS_XB);
    const GAS f32x4* gr = (const GAS f32x4*)F.in[25] + 2 * lane; const f32x4 g0 = gr[0], g1 = gr[1], g2 = gr[128], g3 = gr[129];
    v4u a0 = (v4u){0u, 0u, 0u, 0u}, a1 = a0; v4u rx[2], ry0[2], ry1[2]; float cw0 = 0.f, cw1 = 0.f;
#define P12_ROWS(m_, A0, A1) do { const size_t p0_ = (size_t)TS[(A0).x & 31] * 256 + (A0).y, p1_ = (size_t)TS[(A0).z & 31] * 256 + (A0).w; \
        const GAS v4u* xr_ = (const GAS v4u*)(XB + (size_t)(m_) * D) + lane; const GAS v4u* y0_ = (const GAS v4u*)(YE + p0_ * D) + lane; const GAS v4u* y1_ = (const GAS v4u*)(YE + p1_ * D) + lane; \
        rx[0] = __builtin_nontemporal_load(xr_); rx[1] = __builtin_nontemporal_load(xr_ + 64); ry0[0] = __builtin_nontemporal_load(y0_); ry0[1] = __builtin_nontemporal_load(y0_ + 64); ry1[0] = __builtin_nontemporal_load(y1_); ry1[1] = __builtin_nontemporal_load(y1_ + 64); cw0 = __uint_as_float((A1).x); cw1 = __uint_as_float((A1).y); } while (0)
    int m = gw;
    if (m < M) { a0 = asg[2 * m]; a1 = asg[2 * m + 1]; P12_ROWS(m, a0, a1); if (m + NGW < M) { a0 = asg[2 * (m + NGW)]; a1 = asg[2 * (m + NGW) + 1]; } }
    for (; m < M; m += NGW) {
        const float w0 = cw0, w1 = cw1; f32x4 v[4]; float s = 0.f;
#pragma unroll
        for (int hh = 0; hh < 2; ++hh) { const v4u x = rx[hh], a = ry0[hh], c = ry1[hh];
            v[2 * hh] = (f32x4){bflo(x.x) + w0 * bflo(a.x) + w1 * bflo(c.x), bfhi(x.x) + w0 * bfhi(a.x) + w1 * bfhi(c.x), bflo(x.y) + w0 * bflo(a.y) + w1 * bflo(c.y), bfhi(x.y) + w0 * bfhi(a.y) + w1 * bfhi(c.y)};
            v[2 * hh + 1] = (f32x4){bflo(x.z) + w0 * bflo(a.z) + w1 * bflo(c.z), bfhi(x.z) + w0 * bfhi(a.z) + w1 * bfhi(c.z), bflo(x.w) + w0 * bflo(a.w) + w1 * bflo(c.w), bfhi(x.w) + w0 * bfhi(a.w) + w1 * bfhi(c.w)};
            s += dot4(v[2 * hh], v[2 * hh]) + dot4(v[2 * hh + 1], v[2 * hh + 1]); }
        if (m + NGW < M) { P12_ROWS(m + NGW, a0, a1); if (m + 2 * NGW < M) { a0 = asg[2 * (m + 2 * NGW)]; a1 = asg[2 * (m + 2 * NGW) + 1]; } }
        const float rstd = frsq(wave_sum(s) * (1.f / D) + EPS);
        GAS f32x4* orow = (GAS f32x4*)(F.out + (size_t)m * D) + 2 * lane;
        __builtin_nontemporal_store(v[0] * rstd * g0, orow); __builtin_nontemporal_store(v[1] * rstd * g1, orow + 1); __builtin_nontemporal_store(v[2] * rstd * g2, orow + 128); __builtin_nontemporal_store(v[3] * rstd * g3, orow + 129);
    }
#undef P12_ROWS
}

struct Args { const float* in[26]; float* out; unsigned char* ws; int ph_lo, ph_hi, li, sub; };
__global__ void __launch_bounds__(NWAVES * 64, 2) mk_fwd(Args args) {
    extern __shared__ __attribute__((aligned(16))) unsigned char lds[];
    Frame F;
    F.lds = (LAS unsigned char*)lds;
    F.MISC = (volatile LAS unsigned*)(F.lds + MISC_OFF);
    F.wave = __builtin_amdgcn_readfirstlane((int)threadIdx.x >> 6);
    F.G = gridDim.x; { const int bx = blockIdx.x; F.vcu = (F.G % 8 == 0) ? (bx % 8) * (F.G / 8) + bx / 8 : bx; }
    unsigned char* ws = args.ws; F.ws = ws; F.out = args.out;
    F.ctl = (gu32*)(ws + WS_CTL);
#pragma unroll
    for (int i = 0; i < 26; ++i) F.in[i] = args.in[i];
    for (int u = (int)threadIdx.x; u < (LDS_BYTES - LDSCTL_OFF) / 4; u += NWAVES * 64) ((LAS unsigned*)(F.lds + LDSCTL_OFF))[u] = 0u;
    __syncthreads();
    XcdBarrier bar; bar.bar = (unsigned*)(F.ctl + CW_BAR) + args.li * XCD_BAR_WORDS; bar.x = 0; bar.st = nullptr;
    if (N_LAUNCHES != NPHASE) bar = xcd_barrier_post((unsigned*)(F.ctl + CW_BAR) + args.li * XCD_BAR_WORDS, F.MISC + 8);
#define GRID_BAR(seam) do { if (N_LAUNCHES == NPHASE) { if (F.wave == 0 && lane_now() == 0) __hip_atomic_store(F.ctl + CW_TMO, 0xBADBA0u | (unsigned)(seam), RLX_AGENT); } else { xcd_barrier(bar, F.wave); } } while (0)
    const int lo = args.ph_lo, hi = args.ph_hi;
#ifndef PHASE_MASK
#define PHASE_MASK 0x1FFF
#endif
#define IN(k) (((PHASE_MASK >> (k)) & 1) && lo <= (k) && (k) < hi)
#define BOTH(k) (IN(k) && IN((k) + 1))
    bf16* Hb = (bf16*)F.out;
    bf16* PROJ = (bf16*)(ws + WS_PROJ);

    if (IN(0)) { p0_prologue(F); if (BOTH(0)) GRID_BAR(0); }

    if (IN(1)) {
        const int sub = args.sub;
        if (sub & 1) {
        if (blockIdx.x < 32) gate_scan(F, (int)blockIdx.x);
        { pg8::Gemm g{Hb, (const bf16*)(ws + WS_WIN), M, NPROJ, D}; pg8::StaticOrder S; S.init(M, NPROJ, F.G, (int)blockIdx.x);
          pg8::EpiProj E{PROJ, NPROJ, (const float*)(ws + WS_ROPE), attn_body::C2};
          pg8::gemm_phase<pg8::EpiProj, pg8::StaticOrder, PG8_ALIGN, PG8_SP2>(F.lds + RING_OFF, g, S, E, F.wave); }
        { pg8::Gemm g{(const bf16*)(ws + WS_WIN) + (size_t)NPROJ * D, Hb, 512, M, D}; pg8::StaticOrder S; S.init(512, M, F.G, (int)blockIdx.x);
          pg8::EpiBf16<0> E{(bf16*)(ws + WS_MVT), M, nullptr, 0, 0, 1.f};
          pg8::gemm_phase<pg8::EpiBf16<0>, pg8::StaticOrder, PG8_ALIGN, PG8_SP2>(F.lds + RING_OFF, g, S, E, F.wave); } }
        if (BOTH(1)) GRID_BAR(1);
    }

    if (IN(2)) {
        if (args.sub & 4) { stage_convw(F); m1g_phase(F); }
        const float* lv = F.in[5]; const int ln_ = lane_now();
        const float lam = expf(wave_sum(lv[ln_] * lv[64 + ln_])) - expf(wave_sum(lv[128 + ln_] * lv[192 + ln_])) + LAM_INIT;
        const attn_body::AttnTensors AT{(const attn_body::bf16*)(PROJ + C_DQ), (const attn_body::bf16*)(PROJ + C_DK), (const attn_body::bf16*)(PROJ + C_DV), (attn_body::bf16*)(ws + WS_OA), lam, 1.0f - LAM_INIT, EPS, F.in[6]};
        const attn_body::StaticOrder S((int)F.G, F.vcu);
        if (args.sub & 8) attn_body::attn_phase<attn_body::StaticOrder>((char*)lds + RING_OFF, AT, S, F.wave);
        if (BOTH(2)) GRID_BAR(2);
    }

    if (IN(3)) {
        if (args.sub & 2) {
        if (blockIdx.x < 64) { pg8::Gemm g{(const bf16*)(ws + WS_MEMN), (const bf16*)(ws + WS_WKV), MROWS, 2 * D, D}; pg8::StaticOrder S; S.init(MROWS, 2 * D, 64, (int)blockIdx.x);
          pg8::EpiBf16<0> E{(bf16*)(ws + WS_MK), D, nullptr, D, (size_t)MROWS * D, 1.f};
          pg8::gemm_phase<pg8::EpiBf16<0>, pg8::StaticOrder, PG8_ALIGN, PG8_SP2>(F.lds + RING_OFF, g, S, E, F.wave); } }
        if (blockIdx.x >= 64 || F.G < 128) p3_scan_combine(F, args.sub & ~32, (F.G < 128) ? 0 : 64);
        if (BOTH(3)) GRID_BAR(3); }

    if (IN(4)) { stage_convw(F); m3_phase(F); if (BOTH(4)) GRID_BAR(4); }

    if (IN(5)) {
        pg8::Gemm g{(const bf16*)(ws + WS_OA), (const bf16*)(ws + WS_WOUT), M, D, D};
        pg8::OutFoldOrder S; S.main.init(M, D, F.G, (int)blockIdx.x); S.G = (int)F.G; S.c = (int)blockIdx.x;
        S.fold = pg8::FoldOrder{(int)F.G, (int)blockIdx.x, (const bf16*)(ws + WS_MK), (const bf16*)(ws + WS_MVT2), (const bf16*)(ws + WS_WXQ), (const bf16*)(ws + WS_WXO)};
        pg8::EpiResidFold E{pg8::EpiResid<true, true>{F.in[0], nullptr, (bf16*)(ws + WS_XB), (float*)(F.ctl + CW_ROWSS), D}, pg8::EpiBf16<0>{(bf16*)(ws + WS_FOLD), D, nullptr, 0, 0, 1.f}};
        pg8::gemm_phase<pg8::EpiResidFold, pg8::OutFoldOrder, PG8_ALIGN, PG8_SP2>(F.lds + RING_OFF, g, S, E, F.wave);
        if (BOTH(5)) GRID_BAR(5);
    }

    if (IN(6)) {
        pg8::Gemm g{(const bf16*)(ws + WS_XB), (const bf16*)(ws + WS_FOLD), M, D, D}; pg8::BatchBOrder S; S.init(M, D, F.G, (int)blockIdx.x); S.bstride = (size_t)D * D * 2; S.tpb = SEQ / 256;
        pg8::EpiSoftmaxP E{(bf16*)(ws + WS_XQ), D, (const float*)(F.ctl + CW_ROWSS), EPS, XSCALE, (LAS float*)(F.lds + XT_TS)};
        pg8::gemm_phase<pg8::EpiSoftmaxP, pg8::BatchBOrder, PG8_ALIGN, PG8_SP2>(F.lds + RING_OFF, g, S, E, F.wave);
        if (BOTH(6)) GRID_BAR(6);
    }


    if (IN(8)) {
        pg8::Gemm g{(const bf16*)(ws + WS_XQ), (const bf16*)(ws + WS_FOLD) + (size_t)8192 * D, M, D, D}; pg8::BatchBOrder S; S.init(M, D, F.G, (int)blockIdx.x); S.bstride = (size_t)D * D * 2; S.tpb = SEQ / 256;
        pg8::EpiResid<false, false> E{nullptr, (const bf16*)(ws + WS_XB), (bf16*)(ws + WS_XB), nullptr, D};
        pg8::gemm_phase<pg8::EpiResid<false, false>, pg8::BatchBOrder, PG8_ALIGN, PG8_SP2>(F.lds + RING_OFF, g, S, E, F.wave);
        if (BOTH(8)) GRID_BAR(8);
    }

    if (IN(9)) { p9_router(F); if (BOTH(9)) GRID_BAR(9); }

    if (IN(10)) {
        const int ntiles = expert_tables<true>(F);
        pg8::Gemm g{(const bf16*)(ws + WS_XB), (const bf16*)(ws + WS_W13), M, D, D};
        pg8::ExpertOrder<true> S{F.G, (int)blockIdx.x, ntiles, (const LAS int*)(F.lds + XT_TS), (const LAS int*)(F.lds + XT_TOK), (size_t)D * D * 2};
        pg8::EpiSwiGLU E{(bf16*)(ws + WS_ACT), DEXP, (const LAS float*)(F.lds + XT_RS)};
        pg8::gemm_phase<pg8::EpiSwiGLU, pg8::ExpertOrder<true>, PG8_ALIGN, PG8_SP2>(F.lds + RING_OFF, g, S, E, F.wave);
        p10_w2_items(F, 4 * ntiles);
        if (BOTH(10)) GRID_BAR(10);
    }

    if (IN(11)) {
        const int ntiles = expert_tables<false>(F);
        pg8::Gemm g{(const bf16*)(ws + WS_ACT), (const bf16*)(ws + WS_W2), MAXROWS, D, DEXP};
        pg8::ExpertOrder<false> S{F.G, (int)blockIdx.x, ntiles, (const LAS int*)(F.lds + XT_TS), (const LAS int*)(F.lds + XT_TOK), (size_t)D * DEXP * 2};
        pg8::EpiBf16<0> E{(bf16*)(ws + WS_YE), D, nullptr, 0, 0, 1.f};
        pg8::gemm_phase<pg8::EpiBf16<0>, pg8::ExpertOrder<false>, PG8_ALIGN, PG8_SP2>(F.lds + RING_OFF, g, S, E, F.wave);
        if (BOTH(11)) GRID_BAR(11);
    }

    if (IN(12)) { p12_final(F); }
#undef IN
#undef BOTH
}

extern "C" void kernel_launch(void* const* d_in, const int* in_sizes, int n_in, void* d_out, int out_size, void* d_ws, size_t ws_size, hipStream_t stream) {
    static int grid = 0;
    if (grid == 0) {
        if (n_in != 26 || in_sizes[0] != M * D || out_size != M * D || ws_size < WS_END) { fprintf(stderr, "kernel_launch: unexpected shapes (n_in %d, in0 %d, out %d, ws %zu); nothing launched\n", n_in, n_in > 0 ? in_sizes[0] : -1, out_size, ws_size); grid = -1; return; }
        int dev = 0, cus = 0, per_cu = 0;
        if (hipGetDevice(&dev) != hipSuccess || hipDeviceGetAttribute(&cus, hipDeviceAttributeMultiprocessorCount, dev) != hipSuccess) { grid = -1; return; }
        if (hipFuncSetAttribute((const void*)mk_fwd, hipFuncAttributeMaxDynamicSharedMemorySize, LDS_BYTES) != hipSuccess) { fprintf(stderr, "kernel_launch: hipFuncSetAttribute failed\n"); grid = -1; return; }
        if (hipOccupancyMaxActiveBlocksPerMultiprocessor(&per_cu, (const void*)mk_fwd, NWAVES * 64, LDS_BYTES) != hipSuccess || per_cu < 1) { fprintf(stderr, "kernel_launch: occupancy query reports %d workgroups per CU\n", per_cu); }
        (void)hipGetLastError();
        grid = cus;
    }
    if (grid < 0) return;
    if (hipMemsetAsync((char*)d_ws + WS_CTL, 0, CTL_ZERO_BYTES, stream) != hipSuccess) return;
    Args a{};
    for (int i = 0; i < 26; ++i) a.in[i] = (const float*)d_in[i];
    a.out = (float*)d_out; a.ws = (unsigned char*)d_ws;
#ifdef PROBE_PRE_MASK
    for (int r = 0; r < PROBE_REP; ++r) for (int k = 0; k < NPHASE; ++k) if ((PROBE_PRE_MASK >> k) & 1) { a.ph_lo = k; a.ph_hi = k + 1; a.li = 1; a.sub = PROBE_SUB;
        hipLaunchKernelGGL(mk_fwd, dim3(grid), dim3(NWAVES * 64), LDS_BYTES, stream, a); }
    if (hipMemsetAsync((char*)d_ws + WS_CTL, 0, CTL_ZERO_BYTES, stream) != hipSuccess) return;
#endif
    for (int li = 0; li < N_LAUNCHES; ++li) {
        a.ph_lo = (N_LAUNCHES == NPHASE) ? li : 0; a.ph_hi = (N_LAUNCHES == NPHASE) ? li + 1 : NPHASE; a.li = 0; a.sub = 0x3F;
        hipLaunchKernelGGL(mk_fwd, dim3(grid), dim3(NWAVES * 64), LDS_BYTES, stream, a);
        if (hipPeekAtLastError() != hipSuccess) break;
    }
#ifdef PROBE_POST_MASK
    for (int r = 0; r < PROBE_REP; ++r) for (int k = 0; k < NPHASE; ++k) if ((PROBE_POST_MASK >> k) & 1) { a.ph_lo = k; a.ph_hi = k + 1; a.li = 1; a.sub = PROBE_SUB;
        hipLaunchKernelGGL(mk_fwd, dim3(grid), dim3(NWAVES * 64), LDS_BYTES, stream, a); }
#endif
}
```

```cpp
#include <hip/hip_runtime.h>
#include <cstdio>
#include <cstdint>
__device__ __forceinline__ int lane_now() { int l; asm volatile("v_mbcnt_lo_u32_b32 %0, -1, 0\n\tv_mbcnt_hi_u32_b32 %0, -1, %0" : "=v"(l)); return l; }
namespace pg8 {
#define PG8_LAS __attribute__((address_space(3)))
typedef unsigned short bf16_t;
typedef short bf16x8 __attribute__((ext_vector_type(8)));
typedef float f32x4 __attribute__((ext_vector_type(4)));
typedef unsigned u32x4 __attribute__((ext_vector_type(4)));
constexpr int BM = 256, BK = 64, HALF = 128, HTB = HALF * BK * 2  , STAGE_BYTES = 8 * HTB, NXCD = 8, WGM = 8;

__host__ __device__ __forceinline__ int lds_byte(int r, int c) { const int st = (r >> 4) * 2 + (c >> 5), rr = r & 15, cc = c & 31, ob = rr * 64 + cc * 2; return st * 1024 + (ob ^ (((ob >> 9) & 1) << 5)); }
__host__ __device__ __forceinline__ void stage_rc(int b, int& R, int& C) { const int st = b / 1024, sb = b % 1024, swz = sb ^ (((sb >> 9) & 1) << 5); R = (st >> 1) * 16 + swz / 64; C = (st & 1) * 32 + (swz % 64) / 2; }
__host__ __device__ __forceinline__ int perm32(int rho) { const int n = rho >> 4, i = rho & 15; return 8 * (i >> 2) + 4 * n + (i & 3); }

struct Unit { int pm, pn, e, ui; int nt = 0; };
struct Gemm { const bf16_t* A; const bf16_t* Bt; int M, N, K; int kext = 0; };

struct StaticOrder {
    int nM, nN, nwg, G, c;
    __host__ __device__ __forceinline__ void init(int M, int N, int G_, int c_) { nM = M / BM; nN = N / BM; nwg = nM * nN; G = G_; c = c_; }
    __host__ __device__ __forceinline__ bool next(int i, Unit& u) const { const long L = (long)i * G + c; if (L >= nwg) return false; at((int)L, u); u.ui = i; return true; }
    __host__ __device__ __forceinline__ void at(int L, Unit& u) const {
        int wgid = L; { const int q = nwg / NXCD, r = nwg % NXCD, xcd = wgid % NXCD, off = wgid / NXCD; wgid = (xcd < r ? xcd * (q + 1) : r * (q + 1) + (xcd - r) * q) + off; }
        const int nig = WGM * nN, gid = wgid / nig, fm = gid * WGM, gsz = (nM - fm) < WGM ? (nM - fm) : WGM;
        u.pm = fm + ((wgid % nig) % gsz); u.pn = (wgid % nig) / gsz; u.e = 0; u.ui = 0;
    }
    __device__ __forceinline__ const char* aptr(const Gemm& g, const Unit& u, size_t tstep) const { return (const char*)g.A + (size_t)u.pm * tstep; }
    __device__ __forceinline__ const char* bptr(const Gemm& g, const Unit& u, size_t tstep) const { return (const char*)g.Bt + (size_t)u.pn * tstep; }
    __device__ __forceinline__ void avoff(const Unit&, int, const int (&R)[2], const int (&C)[2], int K, unsigned (&vo)[2][2]) const {
#pragma unroll
        for (int h = 0; h < 2; ++h)
#pragma unroll
            for (int i = 0; i < 2; ++i) vo[h][i] = (unsigned)((h * HALF + R[i]) * K + C[i]) * 2u; }
};

__device__ __forceinline__ unsigned cvt_pk_bf16(float lo, float hi) { unsigned r; asm volatile("v_cvt_pk_bf16_f32 %0, %1, %2" : "=v"(r) : "v"(lo), "v"(hi)); return r; }
typedef float f32x2 __attribute__((ext_vector_type(2)));
__device__ __forceinline__ f32x2 gelu_pk(f32x2 v) {
    const f32x2 av = __builtin_elementwise_abs(v), d = av * 0.2316418882f + 1.0f;
    f32x2 t; t.x = __builtin_amdgcn_rcpf(d.x); t.y = __builtin_amdgcn_rcpf(d.y);
    f32x2 q = t * 0.5307027145f + (-0.7265760135f); q = q * t + 0.7107068705f; q = q * t + (-0.142248368f); q = q * t + 0.127414796f; q = q * t;
    const f32x2 s = (v * v) * (-0.72134752044f);
    f32x2 e; e.x = __builtin_amdgcn_exp2f(s.x); e.y = __builtin_amdgcn_exp2f(s.y);
    const f32x2 m = v * (q * e), r = v - m;
    f32x2 o; o.x = v.x < 0.f ? m.x : r.x; o.y = v.y < 0.f ? m.y : r.y; return o;
}

template <int ACT  > struct EpiBf16 {
    static constexpr bool PERM = true, AFTER_DRAIN = false; static_assert(ACT == 0 || ACT == 1, "EpiBf16: ACT is 0 (none) or 1 (gelu_pk)");
    bf16_t* O; int ldc; const float* bias; int split_cols; size_t split_stride; float scale0;
    __device__ __forceinline__ void operator()(const f32x4 (&acc)[2][2][4][2], const Unit& u, int wr, int wc, int fr, int fq) const {
        const int row0 = u.pm * BM + wr * 64 + fr; int colt = u.pn * BM; bf16_t* base = O;
        float sc = 1.f; if (split_cols) { const int t = colt / split_cols; base += (size_t)t * split_stride; colt -= t * split_cols; if (t == 0) sc = scale0; }
        const int col0 = colt + wc * 32 + 8 * fq, bcol0 = u.pn * BM + wc * 32 + 8 * fq;
        f32x4 bv[2][2];
#pragma unroll
        for (int bj = 0; bj < 2; ++bj)
#pragma unroll
            for (int n = 0; n < 2; ++n) bv[bj][n] = bias ? *(const f32x4*)(bias + bcol0 + bj * HALF + 4 * n) : (f32x4){0.f, 0.f, 0.f, 0.f};
#pragma unroll
        for (int ai = 0; ai < 2; ++ai)
#pragma unroll
            for (int m = 0; m < 4; ++m) { bf16_t* rowp = base + (size_t)(row0 + ai * HALF + m * 16) * ldc + col0;
#pragma unroll
                for (int bj = 0; bj < 2; ++bj) { f32x4 v0 = acc[ai][bj][m][0] + bv[bj][0], v1 = acc[ai][bj][m][1] + bv[bj][1];
                    if (ACT == 1) { f32x2 a = gelu_pk((f32x2){v0[0], v0[1]}), b = gelu_pk((f32x2){v0[2], v0[3]}), c = gelu_pk((f32x2){v1[0], v1[1]}), d = gelu_pk((f32x2){v1[2], v1[3]});
                        v0 = (f32x4){a.x, a.y, b.x, b.y}; v1 = (f32x4){c.x, c.y, d.x, d.y}; }
                    v0 = v0 * sc; v1 = v1 * sc; u32x4 w; w.x = cvt_pk_bf16(v0[0], v0[1]); w.y = cvt_pk_bf16(v0[2], v0[3]); w.z = cvt_pk_bf16(v1[0], v1[1]); w.w = cvt_pk_bf16(v1[2], v1[3]);
                    *(u32x4*)(rowp + bj * HALF) = w; } }
    }
};
typedef unsigned u32x2 __attribute__((ext_vector_type(2)));
__device__ __forceinline__ u32x2 pack4(const f32x4 v) { u32x2 w; w.x = cvt_pk_bf16(v[0], v[1]); w.y = cvt_pk_bf16(v[2], v[3]); return w; }

struct EpiProj {
    static constexpr bool PERM = true, AFTER_DRAIN = false;
    bf16_t* O; int ldc; const float* rope; float qscale;
    __device__ __forceinline__ void operator()(const f32x4 (&acc)[2][2][4][2], const Unit& u, int wr, int wc, int fr, int fq) const {
        const int row0 = u.pm * BM + wr * 64 + fr;
        if (u.pn < 4) {
            const float sc = (u.pn < 2) ? qscale : 1.0f;
#pragma unroll
            for (int ai = 0; ai < 2; ++ai)
#pragma unroll
                for (int m = 0; m < 4; ++m) { const int r = row0 + ai * HALF + m * 16; const int pos = r & 4095; const float* rp = rope + pos * 32 + 8 * fq;
                    const f32x4 c0 = *(const f32x4*)rp, c1 = *(const f32x4*)(rp + 4), s0 = *(const f32x4*)(rp + 4096 * 32), s1 = *(const f32x4*)(rp + 4096 * 32 + 4);
                    const f32x4 a0 = acc[ai][0][m][0], a1 = acc[ai][0][m][1], b0 = acc[ai][1][m][0], b1 = acc[ai][1][m][1];
                    const f32x4 x0 = (a0 * c0 - b0 * s0) * sc, x1 = (a1 * c1 - b1 * s1) * sc, y0 = (b0 * c0 + a0 * s0) * sc, y1 = (b1 * c1 + a1 * s1) * sc;
                    bf16_t* p = O + (size_t)r * ldc + u.pn * BM + 64 * wc + 8 * fq; u32x4 w;
                    w.x = cvt_pk_bf16(x0[0], x0[1]); w.y = cvt_pk_bf16(x0[2], x0[3]); w.z = cvt_pk_bf16(x1[0], x1[1]); w.w = cvt_pk_bf16(x1[2], x1[3]); *(u32x4*)p = w;
                    w.x = cvt_pk_bf16(y0[0], y0[1]); w.y = cvt_pk_bf16(y0[2], y0[3]); w.z = cvt_pk_bf16(y1[0], y1[1]); w.w = cvt_pk_bf16(y1[2], y1[3]); *(u32x4*)(p + 32) = w; }
        } else {
            const int col0 = u.pn * BM + wc * 32 + 8 * fq;
#pragma unroll
            for (int ai = 0; ai < 2; ++ai)
#pragma unroll
                for (int m = 0; m < 4; ++m) { bf16_t* rowp = O + (size_t)(row0 + ai * HALF + m * 16) * ldc + col0;
#pragma unroll
                    for (int bj = 0; bj < 2; ++bj) { const f32x4 v0 = acc[ai][bj][m][0], v1 = acc[ai][bj][m][1];
                        u32x4 w; w.x = cvt_pk_bf16(v0[0], v0[1]); w.y = cvt_pk_bf16(v0[2], v0[3]); w.z = cvt_pk_bf16(v1[0], v1[1]); w.w = cvt_pk_bf16(v1[2], v1[3]);
                        *(u32x4*)(rowp + bj * HALF) = w; } }
        }
    }
};
template <bool BASE_F32, bool WITH_SS> struct EpiResid {
    static constexpr bool PERM = true, AFTER_DRAIN = false;
    const float* basef; const bf16_t* baseb; bf16_t* xb; float* rowss; int ldc;
    __device__ __forceinline__ void operator()(const f32x4 (&acc)[2][2][4][2], const Unit& u, int wr, int wc, int fr, int fq) const {
        const int row0 = u.pm * BM + wr * 64 + fr, col0 = u.pn * BM + wc * 32 + 8 * fq;
#pragma unroll
        for (int ai = 0; ai < 2; ++ai)
#pragma unroll
            for (int m = 0; m < 4; ++m) { const int r = row0 + ai * HALF + m * 16; const size_t off = (size_t)r * ldc + col0; float ss = 0.f;
#pragma unroll
                for (int bj = 0; bj < 2; ++bj) { f32x4 o0, o1;
                    if (BASE_F32) { o0 = __builtin_nontemporal_load((const f32x4*)(basef + off + bj * HALF)); o1 = __builtin_nontemporal_load((const f32x4*)(basef + off + bj * HALF + 4)); }
                    else { const u32x4 w = *(const u32x4*)(baseb + off + bj * HALF);
                        o0 = (f32x4){__uint_as_float(w.x << 16), __uint_as_float(w.x & 0xffff0000u), __uint_as_float(w.y << 16), __uint_as_float(w.y & 0xffff0000u)};
                        o1 = (f32x4){__uint_as_float(w.z << 16), __uint_as_float(w.z & 0xffff0000u), __uint_as_float(w.w << 16), __uint_as_float(w.w & 0xffff0000u)}; }
                    o0 = o0 + acc[ai][bj][m][0]; o1 = o1 + acc[ai][bj][m][1];
                    u32x4 w; w.x = cvt_pk_bf16(o0[0], o0[1]); w.y = cvt_pk_bf16(o0[2], o0[3]); w.z = cvt_pk_bf16(o1[0], o1[1]); w.w = cvt_pk_bf16(o1[2], o1[3]);
                    *(u32x4*)(xb + off + bj * HALF) = w;
                    if (WITH_SS) ss += ((o0[0] * o0[0] + o0[1] * o0[1]) + (o0[2] * o0[2] + o0[3] * o0[3])) + ((o1[0] * o1[0] + o1[1] * o1[1]) + (o1[2] * o1[2] + o1[3] * o1[3])); }
                if (WITH_SS) { ss += __shfl_xor(ss, 16); ss += __shfl_xor(ss, 32); if (fq == 0) atomicAdd(rowss + r, ss); } }
    }
};
struct EpiRowScale {
    static constexpr bool PERM = true, AFTER_DRAIN = false;
    bf16_t* O; int ldc; const float* rowss; float eps, scale;
    __device__ __forceinline__ void operator()(const f32x4 (&acc)[2][2][4][2], const Unit& u, int wr, int wc, int fr, int fq) const {
        const int row0 = u.pm * BM + wr * 64 + fr, col0 = u.pn * BM + wc * 32 + 8 * fq;
#pragma unroll
        for (int ai = 0; ai < 2; ++ai)
#pragma unroll
            for (int m = 0; m < 4; ++m) { const int r = row0 + ai * HALF + m * 16; const float sc = scale / sqrtf(rowss[r] * (1.0f / 1024.0f) + eps); bf16_t* rowp = O + (size_t)r * ldc + col0;
#pragma unroll
                for (int bj = 0; bj < 2; ++bj) { const f32x4 v0 = acc[ai][bj][m][0] * sc, v1 = acc[ai][bj][m][1] * sc;
                    u32x4 w; w.x = cvt_pk_bf16(v0[0], v0[1]); w.y = cvt_pk_bf16(v0[2], v0[3]); w.z = cvt_pk_bf16(v1[0], v1[1]); w.w = cvt_pk_bf16(v1[2], v1[3]);
                    *(u32x4*)(rowp + bj * HALF) = w; } }
    }
};
struct EpiSwiGLU {
    static constexpr bool PERM = true, AFTER_DRAIN = false;
    bf16_t* O; int ldc; const PG8_LAS float* RS;
    __device__ __forceinline__ void operator()(const f32x4 (&acc)[2][2][4][2], const Unit& u, int wr, int wc, int fr, int fq) const {
        const int row0 = u.pm * BM + wr * 64 + fr, col0 = u.pn * HALF + wc * 32 + 8 * fq;
#pragma unroll
        for (int ai = 0; ai < 2; ++ai)
#pragma unroll
            for (int m = 0; m < 4; ++m) { bf16_t* rowp = O + (size_t)(row0 + ai * HALF + m * 16) * ldc + col0; const float rs = RS[u.ui * 256 + wr * 64 + fr + ai * HALF + m * 16]; u32x4 w;
#pragma unroll
                for (int n = 0; n < 2; ++n) { const f32x4 a = acc[ai][0][m][n] * rs, b = acc[ai][1][m][n] * rs; f32x4 o;
#pragma unroll
                    for (int j = 0; j < 4; ++j) o[j] = a[j] * b[j] * __builtin_amdgcn_rcpf(1.0f + __builtin_amdgcn_exp2f(-1.4426950408889634f * a[j]));
                    const u32x2 p = pack4(o); if (n == 0) { w.x = p.x; w.y = p.y; } else { w.z = p.x; w.w = p.y; } }
                *(u32x4*)rowp = w; }
    }
};
struct EpiNull { static constexpr bool PERM = true, AFTER_DRAIN = false; float* sink;
    __device__ __forceinline__ void operator()(const f32x4 (&acc)[2][2][4][2], const Unit& u, int wr, int wc, int fr, int fq) const { float s = 0.f;
#pragma unroll
        for (int ai = 0; ai < 2; ++ai)
#pragma unroll
            for (int bj = 0; bj < 2; ++bj)
#pragma unroll
                for (int m = 0; m < 4; ++m)
#pragma unroll
                    for (int n = 0; n < 2; ++n) s += acc[ai][bj][m][n][0] + acc[ai][bj][m][n][1] + acc[ai][bj][m][n][2] + acc[ai][bj][m][n][3];
        if (s == 1.2345e-30f) *sink = s; } };
struct EpiNull2 { static constexpr bool PERM = true, AFTER_DRAIN = false; bf16_t* O; int ldc;
    __device__ __forceinline__ void operator()(const f32x4 (&acc)[2][2][4][2], const Unit& u, int wr, int wc, int fr, int fq) const {
        const int row0 = u.pm * BM + wr * 64 + fr, col0 = u.pn * BM + wc * 32 + 8 * fq;
#pragma unroll
        for (int ai = 0; ai < 2; ++ai)
#pragma unroll
            for (int m = 0; m < 4; ++m) { const int r = row0 + ai * HALF + m * 16; const float sc = 0.5f; const size_t off = (((size_t)r * ldc + col0) * 2 & 8191) + (size_t)blockIdx.x * 8192;
#pragma unroll
                for (int bj = 0; bj < 2; ++bj) { const f32x4 v0 = acc[ai][bj][m][0] * sc, v1 = acc[ai][bj][m][1] * sc;
                    u32x4 w; w.x = cvt_pk_bf16(v0[0], v0[1]); w.y = cvt_pk_bf16(v0[2], v0[3]); w.z = cvt_pk_bf16(v1[0], v1[1]); w.w = cvt_pk_bf16(v1[2], v1[3]);
                    *(u32x4*)((char*)O + ((off + bj * 256) & ~15)) = w; } }
    } };

struct BatchBOrder : StaticOrder { size_t bstride; int tpb;
    __device__ __forceinline__ const char* bptr(const Gemm& g, const Unit& u, size_t tstep) const { return (const char*)g.Bt + (size_t)(u.pm / tpb) * bstride + (size_t)u.pn * tstep; } };
struct FoldOrder { int G, c; const bf16_t* MK; const bf16_t* MV; const bf16_t* WXQN; const bf16_t* WXOT;
    __device__ __forceinline__ bool next(int i, Unit& u) const { const int L = i * G + c; if (L >= 256) return false;
        const int ty = L >> 7, l = L & 127, b = l >> 4, h = (l >> 2) & 3, j = l & 3; u.e = ty; u.ui = i;
        u.pm = ty == 0 ? b * 4 + h : 32 + b * 4 + j; u.pn = ty == 0 ? j : h; return true; }
    __device__ __forceinline__ const char* aptr(const Gemm&, const Unit& u, size_t) const {
        return u.e == 0 ? (const char*)(MK + ((size_t)(u.pm >> 2) * 256 * 1024 + (u.pm & 3) * 256)) : (const char*)(WXOT + ((size_t)((u.pm - 32) & 3) * 256 * 1024 + u.pn * 256)); }
    __device__ __forceinline__ const char* bptr(const Gemm&, const Unit& u, size_t) const {
        return u.e == 0 ? (const char*)(WXQN + ((size_t)u.pn * 256 * 1024 + (u.pm & 3) * 256)) : (const char*)(MV + ((size_t)((u.pm - 32) >> 2) * 256 * 1024 + u.pn * 256)); }
    __device__ __forceinline__ void avoff(const Unit&, int, const int (&R)[2], const int (&C)[2], int K, unsigned (&vo)[2][2]) const {
#pragma unroll
        for (int h = 0; h < 2; ++h)
#pragma unroll
            for (int i = 0; i < 2; ++i) vo[h][i] = (unsigned)((h * HALF + R[i]) * K + C[i]) * 2u; }
};
struct OutFoldOrder { StaticOrder main; FoldOrder fold; int G, c;
    __device__ __forceinline__ bool next(int i, Unit& u) const { const int P = i * G + c; if (P >= main.nwg + 256) return false;
        const bool mn = P < main.nwg; Unit t; main.at(mn ? P : 0, t);
        const int L = P - main.nwg, ty = L >> 7, l = L & 127, b = l >> 4, h = (l >> 2) & 3, j = l & 3;
        const int fpm = ty == 0 ? b * 4 + h : 32 + b * 4 + j, fpn = ty == 0 ? j : h;
        u.pm = mn ? t.pm : fpm; u.pn = mn ? t.pn : fpn; u.e = mn ? 2 : ty; u.ui = i; u.nt = mn ? 16 : 4; return true; }
    __device__ __forceinline__ const char* aptr(const Gemm& g, const Unit& u, size_t tstep) const { return u.e == 2 ? main.aptr(g, u, tstep) : fold.aptr(g, u, tstep); }
    __device__ __forceinline__ const char* bptr(const Gemm& g, const Unit& u, size_t tstep) const { return u.e == 2 ? main.bptr(g, u, tstep) : fold.bptr(g, u, tstep); }
    __device__ __forceinline__ void avoff(const Unit& u, int ui, const int (&R)[2], const int (&C)[2], int K, unsigned (&vo)[2][2]) const { main.avoff(u, ui, R, C, K, vo); }
};
struct EpiResidFold { static constexpr bool PERM = true, AFTER_DRAIN = false; EpiResid<true, true> R; EpiBf16<0> B;
    __device__ __forceinline__ void operator()(const f32x4 (&acc)[2][2][4][2], const Unit& u, int wr, int wc, int fr, int fq) const { if (u.e == 2) R(acc, u, wr, wc, fr, fq); else B(acc, u, wr, wc, fr, fq); } };
struct EpiSoftmaxP {
    static constexpr bool PERM = true, AFTER_DRAIN = false;
    bf16_t* O; int ldc; const float* rowss; float eps, scale; PG8_LAS float* ex;
    __device__ __forceinline__ void operator()(f32x4 (&acc)[2][2][4][2], const Unit& u, int wr, int wc, int fr, int fq) const {
        const int rl0 = wr * 64 + fr, row0 = u.pm * BM + rl0, col0 = u.pn * BM + wc * 32 + 8 * fq;
        float mw[2][4];
#pragma unroll
        for (int ai = 0; ai < 2; ++ai)
#pragma unroll
            for (int m = 0; m < 4; ++m) { const int rl = rl0 + ai * HALF + m * 16; const float sc = scale / sqrtf(rowss[u.pm * BM + rl] * (1.0f / 1024.0f) + eps);
                float mx = -INFINITY;
#pragma unroll
                for (int bj = 0; bj < 2; ++bj)
#pragma unroll
                    for (int n = 0; n < 2; ++n) { const f32x4 t = acc[ai][bj][m][n] * sc; acc[ai][bj][m][n] = t; mx = fmaxf(mx, fmaxf(fmaxf(t[0], t[1]), fmaxf(t[2], t[3]))); }
                { auto r = __builtin_amdgcn_permlane16_swap(__float_as_uint(mx), __float_as_uint(mx), false, false); mx = fmaxf(__uint_as_float(r[0]), __uint_as_float(r[1])); }
                { auto r = __builtin_amdgcn_permlane32_swap(__float_as_uint(mx), __float_as_uint(mx), false, false); mx = fmaxf(__uint_as_float(r[0]), __uint_as_float(r[1])); }
                float s = 0.f;
#pragma unroll
                for (int bj = 0; bj < 2; ++bj)
#pragma unroll
                    for (int n = 0; n < 2; ++n) { f32x4 t = acc[ai][bj][m][n];
#pragma unroll
                        for (int j = 0; j < 4; ++j) t[j] = __builtin_amdgcn_exp2f(t[j] - mx);
                        acc[ai][bj][m][n] = t; s += (t[0] + t[1]) + (t[2] + t[3]); }
                { auto r = __builtin_amdgcn_permlane16_swap(__float_as_uint(s), __float_as_uint(s), false, false); s = __uint_as_float(r[0]) + __uint_as_float(r[1]); }
                { auto r = __builtin_amdgcn_permlane32_swap(__float_as_uint(s), __float_as_uint(s), false, false); s = __uint_as_float(r[0]) + __uint_as_float(r[1]); }
                if (fq == 0) { f32x2 ms; ms.x = mx; ms.y = s; *(PG8_LAS f32x2*)(ex + (rl * 4 + wc) * 2) = ms; }
                mw[ai][m] = mx; }
        asm volatile("s_waitcnt lgkmcnt(0)" ::: "memory"); __builtin_amdgcn_s_barrier();
#pragma unroll
        for (int ai = 0; ai < 2; ++ai)
#pragma unroll
            for (int m = 0; m < 4; ++m) { const int rl = rl0 + ai * HALF + m * 16; const PG8_LAS f32x4* e4 = (const PG8_LAS f32x4*)(ex + rl * 8); const f32x4 a = e4[0], b = e4[1];
                const float Mx = fmaxf(fmaxf(a[0], a[2]), fmaxf(b[0], b[2]));
                const float L = (a[1] * __builtin_amdgcn_exp2f(a[0] - Mx) + a[3] * __builtin_amdgcn_exp2f(a[2] - Mx)) + (b[1] * __builtin_amdgcn_exp2f(b[0] - Mx) + b[3] * __builtin_amdgcn_exp2f(b[2] - Mx));
                const float f = __builtin_amdgcn_exp2f(mw[ai][m] - Mx) * __builtin_amdgcn_rcpf(L);
                bf16_t* rowp = O + (size_t)(row0 + ai * HALF + m * 16) * ldc + col0;
#pragma unroll
                for (int bj = 0; bj < 2; ++bj) { const f32x4 v0 = acc[ai][bj][m][0] * f, v1 = acc[ai][bj][m][1] * f;
                    u32x4 w; w.x = cvt_pk_bf16(v0[0], v0[1]); w.y = cvt_pk_bf16(v0[2], v0[3]); w.z = cvt_pk_bf16(v1[0], v1[1]); w.w = cvt_pk_bf16(v1[2], v1[3]);
                    *(u32x4*)(rowp + bj * HALF) = w; } }
    }
};
__host__ __device__ __forceinline__ int expert_unit_id(int L, int nwg) { const int q = nwg / NXCD, r = nwg % NXCD, xcd = L % NXCD, off = L / NXCD; return (xcd < r ? xcd * (q + 1) : r * (q + 1) + (xcd - r) * q) + off; }
template <bool GATHER> struct ExpertOrder {
    int G, c, ntiles; const PG8_LAS int* TS; const PG8_LAS int* TOK; size_t estride;
    int lo = 0, hi = -1, r0 = 0;
    __device__ __forceinline__ bool next(int i, Unit& u) const {
        const int L = lo + (i + r0) * G + c; if (L >= (hi < 0 ? 4 * ntiles : hi)) return false;
        const int id = L; const int rt = id >> 2; int e = 0;
        for (int k = 1; k < 32; ++k) e += (TS[k] <= rt) ? 1 : 0;
        u.pm = rt; u.pn = id & 3; u.e = e; u.ui = i + r0; return true;
    }
    __device__ __forceinline__ const char* aptr(const Gemm& g, const Unit& u, size_t tstep) const { return GATHER ? (const char*)g.A : (const char*)g.A + (size_t)u.pm * tstep; }
    __device__ __forceinline__ const char* bptr(const Gemm& g, const Unit& u, size_t tstep) const { return (const char*)g.Bt + (size_t)u.e * estride + (size_t)u.pn * tstep; }
    __device__ __forceinline__ void avoff(const Unit& u, int, const int (&R)[2], const int (&C)[2], int K, unsigned (&vo)[2][2]) const {
#pragma unroll
        for (int h = 0; h < 2; ++h)
#pragma unroll
            for (int i = 0; i < 2; ++i) { const int row = GATHER ? TOK[u.ui * 256 + h * HALF + R[i]] : (h * HALF + R[i]); vo[h][i] = (unsigned)(row * K + C[i]) * 2u; } }
};
template <class Epi, class Sched, bool ALIGN_EPI = false, bool SP2 = false>
__device__ __forceinline__ void gemm_phase(PG8_LAS unsigned char* lds, const Gemm g, const Sched& S, const Epi& E, const int wv) {
    const int wid = wv, lane = lane_now(), tid = wid * 64 + lane, wr = wid >> 2, wc = wid & 3, fr = lane & 15, fq = lane >> 4;
    const int K = g.K, nt = (g.kext ? g.kext : K) / BK;
    int R_[2], C_[2]; unsigned voffB[2];
#pragma unroll
    for (int i = 0; i < 2; ++i) { int R, C; stage_rc(tid * 16 + i * 8192, R, C); R_[i] = R; C_[i] = C; const int Rb = Epi::PERM ? ((R & ~31) + perm32(R & 31)) : R;
        voffB[i] = (unsigned)(Rb * K + C) * 2u; }
    const size_t kstep = (size_t)(BK * 2);
    const size_t hstep = (size_t)HALF * K * 2;
    const size_t tstep = 2 * hstep;
    const unsigned ldsw = (unsigned)wid * 1024u;
    const int aoff = lds_byte(wr * 64 + fr, fq * 8), boff = lds_byte(wc * 32 + fr, fq * 8);
#define PG8_SA(b, h) (((b) * 2 + (h)) * HTB)
#define PG8_SB(b, h) ((4 + (b) * 2 + (h)) * HTB)
#define PG8_STAGE(bufoff, gbase, voff) do { _Pragma("unroll") for (int _i = 0; _i < 2; ++_i) \
        __builtin_amdgcn_global_load_lds((const unsigned*)((const char*)(gbase) + (voff)[_i]), (PG8_LAS unsigned*)(lds + (bufoff) + ldsw + _i * 8192), 16, 0, 0); } while (0)
#define PG8_LDA(dst, b, h) do { _Pragma("unroll") for (int m = 0; m < 4; ++m) _Pragma("unroll") for (int k = 0; k < 2; ++k) dst[m][k] = *(const PG8_LAS bf16x8*)(lds + PG8_SA(b, h) + aoff + m * 2048 + k * 1024); } while (0)
#define PG8_LDB(dst, b, h) do { _Pragma("unroll") for (int n = 0; n < 2; ++n) _Pragma("unroll") for (int k = 0; k < 2; ++k) dst[n][k] = *(const PG8_LAS bf16x8*)(lds + PG8_SB(b, h) + boff + n * 2048 + k * 1024); } while (0)
#define PG8_MMA(ai, bj, At, Bt) do { __builtin_amdgcn_s_setprio(1); _Pragma("unroll") for (int m = 0; m < 4; ++m) _Pragma("unroll") for (int n = 0; n < 2; ++n) _Pragma("unroll") for (int k = 0; k < 2; ++k) \
        acc[ai][bj][m][n] = __builtin_amdgcn_mfma_f32_16x16x32_bf16(Bt[n][k], At[m][k], acc[ai][bj][m][n], 0, 0, 0); __builtin_amdgcn_s_setprio(0); } while (0)
#define PG8_WAIT_V(n) asm volatile("s_waitcnt vmcnt(" #n ")" ::: "memory")
#define PG8_WAIT_L(n) asm volatile("s_waitcnt lgkmcnt(" #n ")" ::: "memory")
#define PG8_BAR __builtin_amdgcn_s_barrier()
#define PG8_SCHED __builtin_amdgcn_sched_barrier(0)
    Unit cur, nxt; int ui = 0;
    if (!S.next(0, cur)) return;
    f32x4 acc[2][2][4][2];
#pragma unroll
    for (int a = 0; a < 2; ++a)
#pragma unroll
        for (int b = 0; b < 2; ++b)
#pragma unroll
            for (int m = 0; m < 4; ++m)
#pragma unroll
                for (int n = 0; n < 2; ++n) acc[a][b][m][n] = (f32x4){0.f, 0.f, 0.f, 0.f};
    bf16x8 At[4][2], B0[2][2], B1[2][2];
    const char* cA = S.aptr(g, cur, tstep); const char* cB = S.bptr(g, cur, tstep);
    unsigned voA[2][2], voN[2][2];
    S.avoff(cur, 0, R_, C_, K, voA);
    if constexpr (SP2) {
        PG8_STAGE(PG8_SB(0, 0), cB, voffB); PG8_STAGE(PG8_SB(0, 1), cB + hstep, voffB); PG8_STAGE(PG8_SA(0, 0), cA, voA[0]); PG8_STAGE(PG8_SA(0, 1), cA, voA[1]);
        if (wr == 1) PG8_BAR;
        PG8_WAIT_V(2); PG8_BAR;
        PG8_STAGE(PG8_SB(1, 0), cB + kstep, voffB); PG8_STAGE(PG8_SA(1, 0), cA + kstep, voA[0]); PG8_STAGE(PG8_SB(1, 1), cB + hstep + kstep, voffB);
        PG8_WAIT_V(6); PG8_BAR;
    } else {
        PG8_STAGE(PG8_SB(0, 0), cB, voffB); PG8_STAGE(PG8_SA(0, 0), cA, voA[0]); PG8_STAGE(PG8_SB(0, 1), cB + hstep, voffB); PG8_STAGE(PG8_SA(0, 1), cA, voA[1]);
        if (wr == 1) PG8_BAR;
        PG8_WAIT_V(4); PG8_BAR;
        PG8_STAGE(PG8_SB(1, 0), cB + kstep, voffB); PG8_STAGE(PG8_SA(1, 0), cA + kstep, voA[0]); PG8_STAGE(PG8_SB(1, 1), cB + hstep + kstep, voffB);
        PG8_WAIT_V(6); PG8_BAR;
    }
    for (;;) {
        const bool has_next = S.next(ui + 1, nxt);
        const char* nA = has_next ? S.aptr(g, nxt, tstep) : cA; const char* nB = has_next ? S.bptr(g, nxt, tstep) : cB;
        if (has_next) S.avoff(nxt, ui + 1, R_, C_, K, voN); else {
#pragma unroll
            for (int h = 0; h < 2; ++h)
#pragma unroll
                for (int i = 0; i < 2; ++i) voN[h][i] = voA[h][i]; }
        const int unt = cur.nt ? cur.nt : nt;
        for (int t = 0; t < unt; t += 2) {
            const bool last = (t == unt - 2);
            const char* a1 = cA + (size_t)(t + 1) * kstep;
            const char* a2 = last ? nA : cA + (size_t)(t + 2) * kstep; const char* b2 = last ? nB : cB + (size_t)(t + 2) * kstep;
            const char* a3 = a2 + kstep; const char* b3 = b2 + kstep;
            unsigned v2[2][2];
#pragma unroll
            for (int h = 0; h < 2; ++h)
#pragma unroll
                for (int i = 0; i < 2; ++i) v2[h][i] = last ? voN[h][i] : voA[h][i];
            if constexpr (SP2) {
            PG8_LDB(B0, 0, 0); PG8_LDB(B1, 0, 1); PG8_SCHED; PG8_LDA(At, 0, 0); PG8_STAGE(PG8_SA(1, 1), a1, voA[1]);
            PG8_WAIT_V(8); PG8_WAIT_L(0); PG8_BAR; PG8_MMA(0, 0, At, B0); PG8_MMA(0, 1, At, B1); PG8_BAR; PG8_SCHED;
            PG8_LDA(At, 0, 1); PG8_STAGE(PG8_SB(0, 0), b2, voffB); PG8_STAGE(PG8_SB(0, 1), b2 + hstep, voffB); PG8_STAGE(PG8_SA(0, 0), a2, v2[0]);
            PG8_WAIT_V(8); PG8_WAIT_L(0); PG8_BAR; PG8_MMA(1, 0, At, B0); PG8_MMA(1, 1, At, B1); PG8_BAR; PG8_SCHED;
            PG8_LDB(B0, 1, 0); PG8_LDB(B1, 1, 1); PG8_SCHED; PG8_LDA(At, 1, 0); PG8_STAGE(PG8_SA(0, 1), a2, v2[1]);
            PG8_WAIT_V(8); PG8_WAIT_L(0); PG8_BAR; PG8_MMA(0, 0, At, B0); PG8_MMA(0, 1, At, B1); PG8_BAR; PG8_SCHED;
            PG8_LDA(At, 1, 1); PG8_STAGE(PG8_SB(1, 0), b3, voffB); PG8_STAGE(PG8_SB(1, 1), b3 + hstep, voffB); PG8_STAGE(PG8_SA(1, 0), a3, v2[0]);
            PG8_WAIT_V(8); PG8_WAIT_L(0); PG8_BAR; PG8_MMA(1, 0, At, B0); PG8_MMA(1, 1, At, B1); PG8_BAR; PG8_SCHED;
            } else {
            PG8_LDB(B0, 0, 0); PG8_SCHED; PG8_LDA(At, 0, 0); PG8_STAGE(PG8_SA(1, 1), a1, voA[1]);
            PG8_WAIT_L(8); PG8_BAR; PG8_WAIT_L(0); PG8_MMA(0, 0, At, B0); PG8_BAR; PG8_SCHED;
            PG8_LDB(B1, 0, 1); PG8_STAGE(PG8_SB(0, 0), b2, voffB);
            PG8_BAR; PG8_WAIT_L(0); PG8_MMA(0, 1, At, B1); PG8_BAR;
            PG8_LDA(At, 0, 1); PG8_STAGE(PG8_SA(0, 0), a2, v2[0]);
            PG8_BAR; PG8_WAIT_L(0); PG8_MMA(1, 0, At, B0); PG8_BAR; PG8_SCHED;
            PG8_STAGE(PG8_SB(0, 1), b2 + hstep, voffB);
            PG8_WAIT_V(6); PG8_BAR; PG8_MMA(1, 1, At, B1); PG8_BAR;
            PG8_LDB(B0, 1, 0); PG8_SCHED; PG8_LDA(At, 1, 0); PG8_STAGE(PG8_SA(0, 1), a2, v2[1]);
            PG8_WAIT_L(8); PG8_BAR; PG8_WAIT_L(0); PG8_MMA(0, 0, At, B0); PG8_BAR; PG8_SCHED;
            PG8_LDB(B1, 1, 1); PG8_STAGE(PG8_SB(1, 0), b3, voffB);
            PG8_BAR; PG8_WAIT_L(0); PG8_MMA(0, 1, At, B1); PG8_BAR;
            PG8_LDA(At, 1, 1); PG8_STAGE(PG8_SA(1, 0), a3, v2[0]);
            PG8_BAR; PG8_WAIT_L(0); PG8_MMA(1, 0, At, B0); PG8_BAR; PG8_SCHED;
            PG8_STAGE(PG8_SB(1, 1), b3 + hstep, voffB);
            PG8_WAIT_V(6); PG8_BAR; PG8_MMA(1, 1, At, B1); PG8_BAR;
            }
        }
        if constexpr (ALIGN_EPI) { if (wr == 0) PG8_BAR; }
        if constexpr (!Epi::AFTER_DRAIN) { E(acc, cur, wr, wc, fr, fq); }
        if (!has_next) break;
#pragma unroll
        for (int a = 0; a < 2; ++a)
#pragma unroll
            for (int b = 0; b < 2; ++b)
#pragma unroll
                for (int m = 0; m < 4; ++m)
#pragma unroll
                    for (int n = 0; n < 2; ++n) acc[a][b][m][n] = (f32x4){0.f, 0.f, 0.f, 0.f};
        cur = nxt; cA = nA; cB = nB; ++ui;
#pragma unroll
        for (int h = 0; h < 2; ++h)
#pragma unroll
            for (int i = 0; i < 2; ++i) voA[h][i] = voN[h][i];
        if constexpr (ALIGN_EPI) { if (wr == 1) PG8_BAR; }
    }
    PG8_WAIT_V(0);
    if constexpr (!ALIGN_EPI) { if (wr == 0) PG8_BAR; }
    PG8_BAR;
    if constexpr (Epi::AFTER_DRAIN) { E.fused(acc, cur, wr, wc, fr, fq, lds, wid, lane); }
#undef PG8_SA
#undef PG8_SB
#undef PG8_STAGE
#undef PG8_LDA
#undef PG8_LDB
#undef PG8_MMA
#undef PG8_WAIT_V
#undef PG8_WAIT_L
#undef PG8_BAR
#undef PG8_SCHED
}
}

#ifndef PG8_SP2
#define PG8_SP2 true
#endif
#ifndef PG8_ALIGN
#define PG8_ALIGN true
#endif
#include <hip/hip_bf16.h>
#include <cmath>
namespace attn_body {
using bf16=__hip_bfloat16;
using bf16x8=__attribute__((ext_vector_type(8)))short;
using s16x4=__attribute__((ext_vector_type(4)))short;
using f32x16=__attribute__((ext_vector_type(16)))float;
using u32x4=__attribute__((ext_vector_type(4)))unsigned;
constexpr int BATCH=8,NHEAD=8,SEQ=4096,D=64,PQ=3072,PO=1024;
constexpr int NW=8,QBLK=32,QB=QBLK*NW,KVBLK=64,NQB=SEQ/QB;
constexpr int ATTN_UNIT_ROWS=QB;
__device__ __forceinline__ int crow(int r,int hi){return (r&3)+8*(r>>2)+4*hi;}
#define SBAR() __builtin_amdgcn_sched_barrier(0)
__device__ __forceinline__ void cmask(f32x16&p0,f32x16&p1,int jb,int qrel,int hi){
  const float NEG=-INFINITY; int kb=64*jb+4*hi;
  #pragma unroll
  for(int r=0;r<16;++r){int kv=kb+(r&3)+8*(r>>2); if(kv>qrel)p0[r]=NEG; if(kv+32>qrel)p1[r]=NEG;}
}

constexpr int NSLOT=3, SLOTB=8192, VSLOTB=2*SLOTB;
constexpr int LDS_K=0, LDS_V=NSLOT*SLOTB, LDS_WS=LDS_V+NSLOT*VSLOTB, LDS_OST=LDS_WS+NW*64*4, LDS_BYTES=LDS_OST+NW*4096;
constexpr float C2=0.125f*1.4426950408889634f;
__device__ __forceinline__ void glds16(const void*gsrc,unsigned lds_dst){unsigned keep;
  asm volatile("s_mov_b32 %0, m0\n\ts_mov_b32 m0, %2\n\ts_nop 0\n\tglobal_load_lds_dwordx4 %1, off\n\ts_mov_b32 m0, %0":"=&s"(keep):"v"(gsrc),"s"(lds_dst):"memory");}
__device__ __forceinline__ float max3f(float a,float b,float c){float r;asm("v_max3_f32 %0, %1, %2, %3":"=v"(r):"v"(a),"v"(b),"v"(c));return r;}
__device__ __forceinline__ float max2f(float a,float b){float r;asm("v_max_f32_e32 %0, %1, %2":"=v"(r):"v"(a),"v"(b));return r;}
__device__ __forceinline__ float fadd_s(float a,float b){float r;asm("v_add_f32_e32 %0, %1, %2":"=v"(r):"v"(a),"v"(b));return r;}
__device__ __forceinline__ float fsub_s(float a,float b){float r;asm("v_sub_f32_e32 %0, %1, %2":"=v"(r):"v"(a),"v"(b));return r;}
typedef float f32x2_t __attribute__((ext_vector_type(2))); typedef __bf16 bf16x2_t __attribute__((ext_vector_type(2)));
__device__ __forceinline__ unsigned cvtpk_s(float lo,float hi){f32x2_t v={lo,hi};bf16x2_t b=__builtin_convertvector(v,bf16x2_t);return __builtin_bit_cast(unsigned,b);}
#define WAIT_BAR(N) asm volatile("s_waitcnt vmcnt(" #N ") lgkmcnt(0)\n\ts_barrier":::"memory")

__device__ __forceinline__ void qkt(f32x16&p0,f32x16&p1,const char*Kslot,const bf16x8*qr,const f32x16&negm,int r32,int hi){
  const char*kb=Kslot+hi*1024+r32*16;
  #pragma unroll
  for(int d0=0;d0<4;++d0){
    const bf16x8 b0=*reinterpret_cast<const bf16x8*>(kb+d0*2048);
    const bf16x8 b1=*reinterpret_cast<const bf16x8*>(kb+d0*2048+512);
    if(d0==0){p0=__builtin_amdgcn_mfma_f32_32x32x16_bf16(b0,qr[0],negm,0,0,0);p1=__builtin_amdgcn_mfma_f32_32x32x16_bf16(b1,qr[0],negm,0,0,0);}
    else{p0=__builtin_amdgcn_mfma_f32_32x32x16_bf16(b0,qr[d0],p0,0,0,0);p1=__builtin_amdgcn_mfma_f32_32x32x16_bf16(b1,qr[d0],p1,0,0,0);}}
}
typedef __attribute__((address_space(3))) const char* lds_cptr;
typedef short v4i16_t __attribute__((ext_vector_type(4)));
__device__ __forceinline__ void kload8(bf16x8*kf,lds_cptr kp){
  kf[0]=*(const __attribute__((address_space(3))) bf16x8*)(kp);      kf[1]=*(const __attribute__((address_space(3))) bf16x8*)(kp+512);
  kf[2]=*(const __attribute__((address_space(3))) bf16x8*)(kp+2048); kf[3]=*(const __attribute__((address_space(3))) bf16x8*)(kp+2560);
  kf[4]=*(const __attribute__((address_space(3))) bf16x8*)(kp+4096); kf[5]=*(const __attribute__((address_space(3))) bf16x8*)(kp+4608);
  kf[6]=*(const __attribute__((address_space(3))) bf16x8*)(kp+6144); kf[7]=*(const __attribute__((address_space(3))) bf16x8*)(kp+6656);
}
__device__ __forceinline__ void kload2(bf16x8*kf,lds_cptr kp,int j){ kf[2*j]=*(const __attribute__((address_space(3))) bf16x8*)(kp+j*2048); kf[2*j+1]=*(const __attribute__((address_space(3))) bf16x8*)(kp+j*2048+512); }
__device__ __forceinline__ s16x4 vtr(lds_cptr p){ return __builtin_bit_cast(s16x4,__builtin_amdgcn_ds_read_tr16_b64_v4i16((__attribute__((address_space(3))) v4i16_t*)p)); }
__device__ __forceinline__ float rowmax(const f32x16&p0,const f32x16&p1){
  float a=max3f(p0[0],p0[1],p1[0]),b=max3f(p0[2],p0[3],p1[1]);a=max3f(a,p1[2],p1[3]);
  #pragma unroll
  for(int r=4;r<16;r+=4){a=max3f(a,p0[r],p0[r+1]);b=max3f(b,p0[r+2],p0[r+3]);a=max3f(a,p1[r],p1[r+1]);b=max3f(b,p1[r+2],p1[r+3]);}
  const float m=max2f(a,b);
  auto rr=__builtin_amdgcn_permlane32_swap(__float_as_uint(m),__float_as_uint(m),false,false);
  return max2f(__uint_as_float(rr[0]),__uint_as_float(rr[1]));
}
__device__ __forceinline__ void pv(f32x16*o,int vb,bf16x8 pa0,bf16x8 pa1,bf16x8 pa2,bf16x8 pa3){
  #pragma unroll
  for(int d0=0;d0<2;++d0){s16x4 lo[4],hi[4];
    #pragma unroll
    for(int ks=0;ks<4;++ks){
      asm volatile("ds_read_b64_tr_b16 %0,%1 offset:%c2":"=&v"(lo[ks]):"v"(vb),"i"(d0*4096+ks*1024):"memory");
      asm volatile("ds_read_b64_tr_b16 %0,%1 offset:%c2":"=&v"(hi[ks]):"v"(vb),"i"(d0*4096+ks*1024+512):"memory");}
    asm volatile("s_waitcnt lgkmcnt(0)":::"memory");SBAR();
    #define PK(k) (bf16x8){lo[k][0],lo[k][1],lo[k][2],lo[k][3],hi[k][0],hi[k][1],hi[k][2],hi[k][3]}
    o[d0]=__builtin_amdgcn_mfma_f32_32x32x16_bf16(pa0,PK(0),o[d0],0,0,0);
    o[d0]=__builtin_amdgcn_mfma_f32_32x32x16_bf16(pa1,PK(1),o[d0],0,0,0);
    o[d0]=__builtin_amdgcn_mfma_f32_32x32x16_bf16(pa2,PK(2),o[d0],0,0,0);
    o[d0]=__builtin_amdgcn_mfma_f32_32x32x16_bf16(pa3,PK(3),o[d0],0,0,0);
    #undef PK
  }
}

__device__ __forceinline__ void pv_pipe(f32x16*o,int vb,bf16x8 pa0,bf16x8 pa1,bf16x8 pa2,bf16x8 pa3){
  s16x4 lo0[4],hi0[4],lo1[4],hi1[4];
  #pragma unroll
  for(int ks=0;ks<4;++ks){
    asm volatile("ds_read_b64_tr_b16 %0,%1 offset:%c2":"=&v"(lo0[ks]):"v"(vb),"i"(ks*1024):"memory");
    asm volatile("ds_read_b64_tr_b16 %0,%1 offset:%c2":"=&v"(hi0[ks]):"v"(vb),"i"(ks*1024+512):"memory");}
  #pragma unroll
  for(int ks=0;ks<4;++ks){
    asm volatile("ds_read_b64_tr_b16 %0,%1 offset:%c2":"=&v"(lo1[ks]):"v"(vb),"i"(4096+ks*1024):"memory");
    asm volatile("ds_read_b64_tr_b16 %0,%1 offset:%c2":"=&v"(hi1[ks]):"v"(vb),"i"(4096+ks*1024+512):"memory");}
  #define PK0(k) (bf16x8){lo0[k][0],lo0[k][1],lo0[k][2],lo0[k][3],hi0[k][0],hi0[k][1],hi0[k][2],hi0[k][3]}
  #define PK1(k) (bf16x8){lo1[k][0],lo1[k][1],lo1[k][2],lo1[k][3],hi1[k][0],hi1[k][1],hi1[k][2],hi1[k][3]}
  asm volatile("s_waitcnt lgkmcnt(8)":::"memory");SBAR();
  o[0]=__builtin_amdgcn_mfma_f32_32x32x16_bf16(pa0,PK0(0),o[0],0,0,0);
  o[0]=__builtin_amdgcn_mfma_f32_32x32x16_bf16(pa1,PK0(1),o[0],0,0,0);
  asm volatile("s_waitcnt lgkmcnt(0)":::"memory");SBAR();
  o[1]=__builtin_amdgcn_mfma_f32_32x32x16_bf16(pa0,PK1(0),o[1],0,0,0);
  o[0]=__builtin_amdgcn_mfma_f32_32x32x16_bf16(pa2,PK0(2),o[0],0,0,0);
  o[1]=__builtin_amdgcn_mfma_f32_32x32x16_bf16(pa1,PK1(1),o[1],0,0,0);
  o[0]=__builtin_amdgcn_mfma_f32_32x32x16_bf16(pa3,PK0(3),o[0],0,0,0);
  o[1]=__builtin_amdgcn_mfma_f32_32x32x16_bf16(pa2,PK1(2),o[1],0,0,0);
  o[1]=__builtin_amdgcn_mfma_f32_32x32x16_bf16(pa3,PK1(3),o[1],0,0,0);
  #undef PK0
  #undef PK1
}
#ifndef ATTN_STORE16
#define ATTN_STORE16(p,v) (*(u32x4*)(p)=(v))
#endif
template<int THRL,int MODE> __device__ __forceinline__ void attn_unit(int b,int qb,const bf16*Q,const bf16*__restrict__ K,const bf16*__restrict__ V,bf16*O,char*shm,const int wv,const float lam,const float oscale,const float eps,const float*sg){
  const int lane=lane_now(),r32=lane&31,hi=lane>>5; const int wid=wv;
  const long rowbase=(long)b*SEQ; const int q0=qb*QB;
  const bf16*Qw=Q+(rowbase+q0+wid*QBLK)*PQ;
  const bf16*Kh=K+rowbase*PQ,*Vh=V+rowbase*PQ;
  const unsigned lds0=(unsigned)(uintptr_t)shm;
  float*wsf=(float*)(shm+LDS_WS)+wid*64;
  const bf16*ksrc=Kh+(long)lane*PQ+wid*8;
  const bf16*vsrc=Vh+(long)(16*(wid&3)+(lane>>2))*PQ+(wid>>2)*32+(lane&3)*8;
  const unsigned kdst=lds0+LDS_K+wid*1024, vdst=lds0+LDS_V+wid*1024;
  #define DMA_K(t,slot) glds16(ksrc+(long)(t)*KVBLK*PQ,(unsigned)__builtin_amdgcn_readfirstlane(kdst+(slot)))
  #define DMA_V(t,slot) do{ glds16(vsrc+(long)(t)*KVBLK*PQ,(unsigned)__builtin_amdgcn_readfirstlane(vdst+2*(slot))); glds16(vsrc+64+(long)(t)*KVBLK*PQ,(unsigned)__builtin_amdgcn_readfirstlane(vdst+2*(slot)+SLOTB)); }while(0)
  const int vb0=(int)(lds0+LDS_V)+((lane>>4)&1)*32+(lane&3)*8+(4*hi+((lane&15)>>2))*64;
  const char*Kbase=shm+LDS_K; bf16x8 kf[8];
  const lds_cptr shm3=(lds_cptr)shm; const lds_cptr kp0=shm3+LDS_K+hi*1024+r32*16; const lds_cptr vp0=shm3+LDS_V+((lane>>4)&1)*32+(lane&3)*8+(4*hi+((lane&15)>>2))*64;
  const int NT=(q0+QB)/KVBLK;
  DMA_K(0,0);DMA_V(0,0);DMA_K(1,SLOTB);
  bf16x8 qr[4];
  #pragma unroll
  for(int d0=0;d0<4;++d0)qr[d0]=*reinterpret_cast<const bf16x8*>(&Qw[(long)r32*PQ+d0*16+hi*8]);
  const lds_cptr qp0=shm3+LDS_OST+wid*4096+hi*512+r32*16;
  #pragma unroll
  for(int d0=0;d0<4;++d0)*(__attribute__((address_space(3))) bf16x8*)(shm3+LDS_OST+wid*4096+hi*512+r32*16+d0*1024)=qr[d0];
  #define QLD(d0) (*(const __attribute__((address_space(3))) bf16x8*)(qp0+(d0)*1024))
  float mhat=0.f,l_reg=0.f;f32x16 o[2],o2[2];o[0]=f32x16{};o[1]=f32x16{};o2[0]=f32x16{};o2[1]=f32x16{};f32x16 negm=f32x16{};asm volatile("":"+v"(negm));
  const int qrel=wid*QBLK+r32;
  #define CMASK(P0,P1,t) do{int jb_=(t)-(NT-4); if(jb_>=0)cmask(P0,P1,jb_,qrel,hi);}while(0)
  bool resc=false;
  #define START(P0,P1) do{ const float rm=rowmax(P0,P1); resc=false; \
    { const float dl=rm; mhat=fadd_s(mhat,dl); \
      _Pragma("unroll") for(int r=0;r<16;++r){P0[r]=fsub_s(P0[r],dl);P1[r]=fsub_s(P1[r],dl);} \
      _Pragma("unroll") for(int r=0;r<16;++r)negm[r]=-mhat; asm volatile("":"+v"(negm)); } \
    _Pragma("unroll") for(int r=0;r<16;++r)P0[r]=__builtin_amdgcn_exp2f(P0[r]); }while(0)
  #define RESC() do{ if(resc){ asm volatile("s_waitcnt lgkmcnt(0)":::"memory"); \
      _Pragma("unroll") for(int d_=0;d_<2;++d_) _Pragma("unroll") for(int r=0;r<16;++r){ const float f_=wsf[crow(r,hi)]; o[d_][r]*=f_; o2[d_][r]*=f_; } } }while(0)
  f32x16 pA0,pA1,pB0,pB1;
  int sl_prev=0,sl_cur=0,sl_next=SLOTB;
  #define ROT() do{sl_prev=sl_cur;sl_cur=sl_next;sl_next=(sl_next==(NSLOT-1)*SLOTB)?0:sl_next+SLOTB;}while(0)
  DMA_K(2,2*SLOTB);
  WAIT_BAR(4);
  qkt(pA0,pA1,Kbase,qr,negm,r32,hi);asm volatile("s_nop 15\n\ts_nop 7":"+v"(pA0),"+v"(pA1));CMASK(pA0,pA1,0);
  START(pA0,pA1);
  _Pragma("unroll") for(int r=0;r<16;++r)pA1[r]=__builtin_amdgcn_exp2f(pA1[r]);
  WAIT_BAR(0);
  DMA_K(3,0);DMA_V(1,SLOTB);
  ROT();
  kload8(kf,kp0+sl_cur);
  WAIT_BAR(3);
  s16x4 vlo[8],vhi[8]; u32x4 pw0,pw1,pw2,pw3;
  #define PKW(P,B) cvtpk_s(P[B],P[B+1])
  #define PAF(k) __builtin_bit_cast(bf16x8,pw##k)
  #define VFR(i) (bf16x8){vlo[i][0],vlo[i][1],vlo[i][2],vlo[i][3],vhi[i][0],vhi[i][1],vhi[i][2],vhi[i][3]}
  #define PIN(x) asm volatile("":"+v"(x))
  #define MX3(a,b,c) __builtin_fmaxf(__builtin_fmaxf((a),(b)),(c))
  #define GAPA(MF,A0,A1,A2,A3,W0,W1,PW) do{ MF; sacc+=A0; sacc+=A1; sacc+=A2; sacc+=A3; PIN(sacc); W0; W1; PIN(PW); SBAR(); }while(0)
  #define EX(v) __builtin_amdgcn_exp2f(v)
  #define GAPB(MF,X,B) do{ MF; X[B]=EX(X[B]); X[B+1]=EX(X[B+1]); X[B+2]=EX(X[B+2]); X[B+3]=EX(X[B+3]); PIN(X); SBAR(); }while(0)
  #define VRD(i) do{ vlo[i]=vtr(vp_+(((i)>>2)*4096+((i)&3)*1024)); vhi[i]=vtr(vp_+(((i)>>2)*4096+((i)&3)*1024+512)); }while(0)
  #define KRD(G,j) do{ if(G){ kload2(kf,kp0+sl_next,j); SBAR(); } }while(0)
  #define STEP(C0,C1,P0,P1,t,GK,GV,GL) do{ SBAR(); \
    const lds_cptr vp_=vp0+2*sl_prev; \
    VRD(0); bf16x8 qa_=QLD(0),qb_=QLD(1); SBAR(); float sacc=(P0[0]+P0[1]); \
    GAPA(C0=__builtin_amdgcn_mfma_f32_32x32x16_bf16(kf[0],qa_,negm,0,0,0), P0[2],P0[3],P0[4],P0[5],     pw0[0]=PKW(P0,0), pw0[1]=PKW(P0,2), pw0); \
    VRD(4); SBAR(); GAPA(C1=__builtin_amdgcn_mfma_f32_32x32x16_bf16(kf[1],qa_,negm,0,0,0), P0[6],P0[7],P0[8],P0[9],     pw0[2]=PKW(P0,4), pw0[3]=PKW(P0,6), pw0); \
    VRD(1); qa_=QLD(2); SBAR(); GAPA(C0=__builtin_amdgcn_mfma_f32_32x32x16_bf16(kf[2],qb_,C0,0,0,0),   P0[10],P0[11],P0[12],P0[13], pw1[0]=PKW(P0,8), pw1[1]=PKW(P0,10), pw1); \
    VRD(5); SBAR(); GAPA(C1=__builtin_amdgcn_mfma_f32_32x32x16_bf16(kf[3],qb_,C1,0,0,0),   P0[14],P0[15],P1[0],P1[1],   pw1[2]=PKW(P0,12),pw1[3]=PKW(P0,14), pw1); \
    VRD(2); qb_=QLD(3); SBAR(); GAPA(C0=__builtin_amdgcn_mfma_f32_32x32x16_bf16(kf[4],qa_,C0,0,0,0),   P1[2],P1[3],P1[4],P1[5],     pw2[0]=PKW(P1,0), pw2[1]=PKW(P1,2), pw2); \
    VRD(6); SBAR(); GAPA(C1=__builtin_amdgcn_mfma_f32_32x32x16_bf16(kf[5],qa_,C1,0,0,0),   P1[6],P1[7],P1[8],P1[9],     pw2[2]=PKW(P1,4), pw2[3]=PKW(P1,6), pw2); \
    VRD(3); SBAR(); GAPA(C0=__builtin_amdgcn_mfma_f32_32x32x16_bf16(kf[6],qb_,C0,0,0,0),   P1[10],P1[11],P1[12],P1[13], pw3[0]=PKW(P1,8), pw3[1]=PKW(P1,10), pw3); \
    VRD(7); SBAR(); GAPA(C1=__builtin_amdgcn_mfma_f32_32x32x16_bf16(kf[7],qb_,C1,0,0,0),   P1[14],P1[15],0.f,0.f,       pw3[2]=PKW(P1,12),pw3[3]=PKW(P1,14), pw3); \
    l_reg+=sacc; \
    if(GK){DMA_K((t)+3,sl_cur);} if(GV){DMA_V((t)+1,sl_next);} \
    CMASK(C0,C1,t); \
    { float a=MX3(C0[0],C0[1],C1[0]),b=MX3(C0[2],C0[3],C1[1]); a=MX3(a,C1[2],C1[3]); \
      _Pragma("unroll") for(int r=4;r<16;r+=4){a=MX3(a,C0[r],C0[r+1]);b=MX3(b,C0[r+2],C0[r+3]);a=MX3(a,C1[r],C1[r+1]);b=MX3(b,C1[r+2],C1[r+3]);} \
      float rm=__builtin_fmaxf(a,b); { auto rr=__builtin_amdgcn_permlane32_swap(__float_as_uint(rm),__float_as_uint(rm),false,false); rm=__builtin_fmaxf(__uint_as_float(rr[0]),__uint_as_float(rr[1])); } \
      resc=false; \
      if(__builtin_expect(__any(rm>(float)THRL),0)){ const float dl=__builtin_fmaxf(rm,0.f); mhat+=dl; \
        _Pragma("unroll") for(int r=0;r<16;++r){C0[r]-=dl;C1[r]-=dl;} \
        _Pragma("unroll") for(int r=0;r<16;++r)negm[r]=-mhat; asm volatile("":"+v"(negm)); \
        const float f=__builtin_amdgcn_exp2f(-dl); l_reg*=f; { const int l2_=lane_now(); if(l2_<32)((__attribute__((address_space(3))) float*)(shm3+LDS_WS))[wid*64+l2_]=f; } resc=true; } } \
    SBAR(); \
    GAPB(o[0]=__builtin_amdgcn_mfma_f32_32x32x16_bf16(PAF(0),VFR(0),o[0],0,0,0), C0,0); \
    GAPB(o[1]=__builtin_amdgcn_mfma_f32_32x32x16_bf16(PAF(0),VFR(4),o[1],0,0,0), C0,4); \
    KRD(GL,0); GAPB(o[0]=__builtin_amdgcn_mfma_f32_32x32x16_bf16(PAF(1),VFR(1),o[0],0,0,0), C0,8); \
    KRD(GL,1); GAPB(o[1]=__builtin_amdgcn_mfma_f32_32x32x16_bf16(PAF(1),VFR(5),o[1],0,0,0), C0,12); \
    KRD(GL,2); GAPB(o[0]=__builtin_amdgcn_mfma_f32_32x32x16_bf16(PAF(2),VFR(2),o[0],0,0,0), C1,0); \
    KRD(GL,3); GAPB(o[1]=__builtin_amdgcn_mfma_f32_32x32x16_bf16(PAF(2),VFR(6),o[1],0,0,0), C1,4); \
    GAPB(o[0]=__builtin_amdgcn_mfma_f32_32x32x16_bf16(PAF(3),VFR(3),o[0],0,0,0), C1,8); \
    GAPB(o[1]=__builtin_amdgcn_mfma_f32_32x32x16_bf16(PAF(3),VFR(7),o[1],0,0,0), C1,12); \
    pv_pipe(o2,vb0+2*sl_prev+SLOTB,PAF(0),PAF(1),PAF(2),PAF(3)); SBAR();     \
    }while(0)
  int t=1;
  #undef CMASK
  #define CMASK(P0,P1,t) do{}while(0)
  for(;t+5<NT;t+=2){
    STEP(pB0,pB1,pA0,pA1,t,true,true,true);     WAIT_BAR(3); RESC(); ROT();
    STEP(pA0,pA1,pB0,pB1,t+1,true,true,true);   WAIT_BAR(3); RESC(); ROT();
  }
  #undef CMASK
  int qrelb=qrel; asm volatile("":"+v"(qrelb));
  #define CMASK(P0,P1,t) do{int jb_=(t)-(NT-4); if(jb_>=0)cmask(P0,P1,jb_,qrelb,hi);}while(0)
  #define ENDW(tt) do{ if((tt)+3<NT){WAIT_BAR(3);} else if((tt)+2<NT){WAIT_BAR(2);} else {WAIT_BAR(0);} }while(0)
  for(;t+1<NT;t+=2){
    STEP(pB0,pB1,pA0,pA1,t,(t+3<NT),(t+1<NT),(t+1<NT));       ENDW(t);   RESC(); ROT();
    STEP(pA0,pA1,pB0,pB1,t+1,(t+4<NT),(t+2<NT),(t+2<NT));     ENDW(t+1); RESC(); ROT();
  }
  STEP(pB0,pB1,pA0,pA1,NT-1,false,false,false); RESC();
  { float sacc=pB0[0]+pB0[1]; _Pragma("unroll") for(int r=2;r<16;++r)sacc+=pB0[r]; _Pragma("unroll") for(int r=0;r<16;++r)sacc+=pB1[r]; l_reg+=sacc;
    pw0=(u32x4){PKW(pB0,0),PKW(pB0,2),PKW(pB0,4),PKW(pB0,6)};pw1=(u32x4){PKW(pB0,8),PKW(pB0,10),PKW(pB0,12),PKW(pB0,14)};pw2=(u32x4){PKW(pB1,0),PKW(pB1,2),PKW(pB1,4),PKW(pB1,6)};pw3=(u32x4){PKW(pB1,8),PKW(pB1,10),PKW(pB1,12),PKW(pB1,14)};
    SBAR(); { const int l3_=lane_now(); const int vb3_=(int)(lds0+LDS_V)+((l3_>>4)&1)*32+(l3_&3)*8+(4*(l3_>>5)+((l3_&15)>>2))*64;
      pv(o,vb3_+2*sl_cur,PAF(0),PAF(1),PAF(2),PAF(3)); pv(o2,vb3_+2*sl_cur+SLOTB,PAF(0),PAF(1),PAF(2),PAF(3)); } }
  #undef PKW
  #undef PAF
  #undef VFR
  #undef PIN
  #undef MX3
  #undef GAPA
  #undef GAPB
  #undef EX
  #undef VRD
  #undef KRD
  #undef STEP
  #undef ENDW
  {auto rr=__builtin_amdgcn_permlane32_swap(__float_as_uint(l_reg),__float_as_uint(l_reg),false,false);l_reg=__uint_as_float(rr[0])+__uint_as_float(rr[1]);}
  { const int le=lane_now(),r32e=le&31,hie=le>>5; float*wse=(float*)(shm+LDS_WS)+wid*64;
  if(hie==0)wse[32+r32e]=l_reg;asm volatile("s_waitcnt lgkmcnt(0)":::"memory");
  float rli[16];
  #pragma unroll
  for(int r=0;r<16;++r)rli[r]=__builtin_amdgcn_rcpf(wse[32+crow(r,hie)]);
  bf16*Ow=O+(rowbase+q0+wid*QBLK)*PO;
  { bf16*stg=(bf16*)(shm+LDS_OST)+wid*2048;
    float yv[2][4][8];
    #pragma unroll
    for(int half=0;half<2;++half){
      #pragma unroll
      for(int r=0;r<16;++r){const int orow=crow(r,hie);
        #pragma unroll
        for(int d0=0;d0<2;++d0)stg[orow*64+d0*32+r32e]=__float2bfloat16((half?o2[d0][r]:o[d0][r])*rli[r]);}
      asm volatile("s_waitcnt lgkmcnt(0)":::"memory");
      #pragma unroll
      for(int i=0;i<4;++i){const int row=i*8+(le>>3),ch=le&7; const u32x4 v=*(const u32x4*)(stg+row*64+ch*8);
        if(MODE==0){ ATTN_STORE16(Ow+(long)row*PO+half*64+ch*8,v); }
        else{ const u32x4 w=*(const u32x4*)(Ow+(long)row*PO+half*64+ch*8);
          #pragma unroll
          for(int e=0;e<4;++e){ yv[half][i][2*e]=__uint_as_float(w[e]<<16)-lam*__uint_as_float(v[e]<<16); yv[half][i][2*e+1]=__uint_as_float(w[e]&0xffff0000u)-lam*__uint_as_float(v[e]&0xffff0000u); } } }
      asm volatile("s_waitcnt lgkmcnt(0)":::"memory"); }
    if(MODE==1){ const int ch=le&7; float gg[2][8];
      #pragma unroll
      for(int half=0;half<2;++half)
        #pragma unroll
        for(int e=0;e<8;++e)gg[half][e]=sg[half*64+ch*8+e]*oscale;
      #pragma unroll
      for(int i=0;i<4;++i){ float ss=0.f;
        #pragma unroll
        for(int half=0;half<2;++half)
          #pragma unroll
          for(int e=0;e<8;++e)ss+=yv[half][i][e]*yv[half][i][e];
        ss+=__builtin_bit_cast(float,__builtin_amdgcn_update_dpp(0,__builtin_bit_cast(int,ss),0xB1,0xF,0xF,false));
        ss+=__builtin_bit_cast(float,__builtin_amdgcn_update_dpp(0,__builtin_bit_cast(int,ss),0x4E,0xF,0xF,false));
        ss+=__builtin_bit_cast(float,__builtin_amdgcn_update_dpp(0,__builtin_bit_cast(int,ss),0x141,0xF,0xF,false));
        const float rs=__builtin_amdgcn_rsqf(ss*(1.f/128.f)+eps); const int row=i*8+(le>>3);
        #pragma unroll
        for(int half=0;half<2;++half){ u32x4 ov;
          #pragma unroll
          for(int e=0;e<4;++e)ov[e]=cvtpk_s(yv[half][i][2*e]*rs*gg[half][2*e],yv[half][i][2*e+1]*rs*gg[half][2*e+1]);
          ATTN_STORE16(Ow+(long)row*PO+half*64+ch*8,ov); } } } } }
  asm volatile("s_waitcnt lgkmcnt(0)\n\ts_barrier":::"memory");
  #undef DMA_K
  #undef DMA_V
  #undef QLD
  #undef CMASK
  #undef START
  #undef RESC
  #undef ROT
}
constexpr int ATTN_LDS_BYTES=LDS_BYTES;
struct AttnTensors { const bf16* Q; const bf16* K; const bf16* V; bf16* O; float lam, oscale, eps; const float* sg; };
struct AttnUnit { int b; int h; int qb; };
struct StaticOrder {
  int vcu, G;
  __device__ __forceinline__ StaticOrder(int grid,int vcu_):vcu(vcu_),G(grid){}
  __device__ __forceinline__ bool next(int i,AttnUnit&u)const{
    if(G==256){ if(i>=2)return false; const int s=vcu&7,bv=vcu>>3; u.b=bv>>2; u.h=bv&3; u.qb=(i==0)?s:15-s; return true; }
    const int L=i*G+vcu; if(L>=BATCH*4*NQB)return false; u.b=L/(4*NQB); u.h=(L/NQB)%4; u.qb=L%NQB; return true; }
};
template<class Sched,int THRL=8> __device__ __forceinline__ void attn_phase(char*lds,const AttnTensors&T,const Sched&S,const int wv){
  AttnUnit u;
  for(int i=0;S.next(i,u);++i){ const int h=u.h;
    attn_unit<THRL,0>(u.b,u.qb,T.Q+(2*h)*64,T.K+(2*h)*64,T.V+h*128,T.O+h*128,lds,wv,T.lam,T.oscale,T.eps,T.sg);
    attn_unit<THRL,1>(u.b,u.qb,T.Q+(2*h+1)*64,T.K+(2*h+1)*64,T.V+h*128,T.O+h*128,lds,wv,T.lam,T.oscale,T.eps,T.sg); }
}
#undef SBAR
#undef WAIT_BAR
}

constexpr int NWAVES = 8;
#ifndef MK_N_LAUNCHES
#define MK_N_LAUNCHES 1
#endif
constexpr int NPHASE = 13;
constexpr int N_LAUNCHES = MK_N_LAUNCHES;

constexpr int BATCH = 8, SEQ = 4096, D = 1024, M = BATCH * SEQ;
constexpr int NPROJ = 3072;
constexpr int C_DQ = 0, C_DK = 512, C_DV = 1024, C_MQ = 1536, C_MK = 2048, C_MO = 2560;
constexpr int MEMLEN = 256, MROWS = BATCH * MEMLEN;
constexpr int NEXP = 32, DEXP = 512, MAXROWS = 73728;
constexpr int NCH = 64, CHL = 64, DVX = 144;
constexpr int CS_UNIT = DVX * 128;
constexpr float EPS = 1e-6f;
constexpr float LAM_INIT = 0.2f;
constexpr float XSCALE = 0.0625f * 1.4426950408889634f;

constexpr size_t MiB = 1u << 20;
constexpr size_t WS_CTL = 0, CTL_ZERO_BYTES = 1 * MiB;
constexpr size_t WS_GATE = 2 * MiB, WS_ROPE = 3 * MiB, WS_ACUM = 4 * MiB, WS_USUB = 4 * MiB + 512 * 1024, WS_SC = 5 * MiB;
constexpr size_t WS_RT = 5 * MiB + 768 * 1024;
constexpr size_t WS_RSTD2 = 5 * MiB + 512 * 1024;
constexpr size_t WS_TOKL = 6 * MiB, WS_ASG = 10 * MiB, WS_MEMN = 12 * MiB, WS_MK = 16 * MiB, WS_MVT2 = 20 * MiB;
constexpr size_t WS_WIN = 24 * MiB, WS_WOUT = 31 * MiB, WS_WXQ = 33 * MiB, WS_WKV = 35 * MiB, WS_WXO = 39 * MiB, WS_W13 = 41 * MiB, WS_W2 = 105 * MiB;
constexpr size_t WS_PROJ = 140 * MiB;
constexpr size_t WS_MVT = 332 * MiB;
constexpr size_t WS_XB = 140 * MiB, WS_XQ = 204 * MiB, WS_XO = 268 * MiB;
constexpr size_t WS_H3 = 204 * MiB, WS_ACT = 268 * MiB, WS_YE = 340 * MiB;
constexpr size_t WS_FOLD = 432 * MiB;
constexpr size_t WS_OA = 364 * MiB;
constexpr size_t WS_END = 484 * MiB;
static_assert(WS_YE + (size_t)MAXROWS * 1024 * 2 <= WS_END && WS_ACT + (size_t)MAXROWS * 512 * 2 <= WS_YE && WS_PROJ + (size_t)M * NPROJ * 2 <= WS_MVT && WS_MVT + (size_t)512 * M * 2 <= WS_OA, "d_ws map");
constexpr int CW_TMO = 0, CW_CODE = 1, CW_CNT = 1024, CW_ROWSS = 16384, CW_READY = 49152, CW_BAR = 65536;
constexpr int RING_OFF = 0, RING_BYTES = 131072;
constexpr int XT_TS = 131072, XT_TOK = 131072 + 256, XT_RS = XT_TOK + 5 * 1024;
constexpr int LDSCTL_OFF = 158720, MISC_OFF = LDSCTL_OFF + 320;
constexpr int LDS_BYTES = 159744;
static_assert(MISC_OFF + 128 <= LDS_BYTES, "LDS map");

#define GAS __attribute__((address_space(1)))
#define LAS __attribute__((address_space(3)))
typedef unsigned short bf16;
typedef unsigned v4u __attribute__((ext_vector_type(4)));
typedef float f32x4 __attribute__((ext_vector_type(4)));
typedef short bf16x8 __attribute__((ext_vector_type(8)));
typedef GAS unsigned gu32;
typedef GAS unsigned long long gu64;
#define RLX_AGENT __ATOMIC_RELAXED, __HIP_MEMORY_SCOPE_AGENT
#define LDS_WAIT() asm volatile("s_waitcnt lgkmcnt(0)" ::: "memory")
#define VM_WAIT() asm volatile("s_waitcnt vmcnt(0)" ::: "memory")
__device__ __forceinline__ unsigned long long rt() { return __builtin_amdgcn_s_memrealtime(); }
__device__ __forceinline__ unsigned f2bf(float f) { unsigned u = __builtin_bit_cast(unsigned, f); return (u + 0x7fffu + ((u >> 16) & 1u)) >> 16; }
typedef float f32x2_t_ __attribute__((ext_vector_type(2))); typedef __bf16 bf16x2_t_ __attribute__((ext_vector_type(2)));
__device__ __forceinline__ unsigned pk2(float lo, float hi) { f32x2_t_ v = {lo, hi}; bf16x2_t_ b = __builtin_convertvector(v, bf16x2_t_); return __builtin_bit_cast(unsigned, b); }

#define XB_TMO      128
#define XB_XCNT(j)  (256  + 64 * (j))
#define XB_XSUB(j)  (1280 + 64 * (j))
#define XB_XGEN(j)  (2304 + 64 * (j))
#define XB_TOP      3328
#define XB_TOPGEN   3392
#define XCD_BAR_WORDS 3456
#define XB_SPIN_CAP (1u << 18)

__device__ __forceinline__ unsigned xb_ld(unsigned* p)              { return __hip_atomic_load(p, __ATOMIC_RELAXED, __HIP_MEMORY_SCOPE_AGENT); }
__device__ __forceinline__ unsigned xb_add(unsigned* p, unsigned v) { return __hip_atomic_fetch_add(p, v, __ATOMIC_RELAXED, __HIP_MEMORY_SCOPE_AGENT); }
__device__ __forceinline__ unsigned xb_xcc_id() { return (unsigned)__builtin_amdgcn_s_getreg((3 << 11) | 20) & 0xFu; }
#define XB_SPIN(cond, bar) do { unsigned _sp = 0; while (cond) { __builtin_amdgcn_s_sleep(1); \
    if ((++_sp & 255u) == 0u) { if (xb_ld(&(bar)[XB_TMO])) break; if (_sp > XB_SPIN_CAP) { atomicAdd(&(bar)[XB_TMO], 1u); break; } } } } while (0)

struct XcdBarrier {
    unsigned* bar; unsigned x;
    volatile LAS unsigned* st;
};

__device__ __forceinline__ XcdBarrier xcd_barrier_post(unsigned* bar, volatile LAS unsigned* st) {
    XcdBarrier b; b.bar = bar; b.x = xb_xcc_id(); b.st = st;
    if (threadIdx.x == 0) (void)xb_add(&bar[XB_XCNT(b.x)], 1u);
    return b;
}
__device__ __forceinline__ void xcd_barrier_complete(unsigned* bar, unsigned x, unsigned& nloc, unsigned& nx) {
    const unsigned G = gridDim.x * gridDim.y * gridDim.z;
    unsigned sum, cnt, mine, sp = 0u;
    for (;;) {
        sum = 0u; cnt = 0u; mine = 0u;
#pragma unroll
        for (unsigned j = 0; j < 16; ++j) { const unsigned c = xb_ld(&bar[XB_XCNT(j)]); sum += c; cnt += (c > 0u) ? 1u : 0u; mine = (j == x) ? c : mine; }
        if (sum == G) break;
        __builtin_amdgcn_s_sleep(1);
        if ((++sp & 255u) == 0u) { if (xb_ld(&bar[XB_TMO])) break; if (sp > XB_SPIN_CAP) { atomicAdd(&bar[XB_TMO], 1u); break; } }
    }
    nloc = mine > 0u ? mine : 1u; nx = cnt > 0u ? cnt : 1u;
}

__device__ __forceinline__ void xcd_barrier(const XcdBarrier& b, const int wv) {
    asm volatile("s_waitcnt vmcnt(0)" ::: "memory");
    __syncthreads();
    if (wv == 0 && lane_now() == 0) {
        unsigned* bar = b.bar;
        __builtin_amdgcn_s_waitcnt(0);
        unsigned nloc = b.st[0], nx = b.st[1];
        if (nloc == 0u) { xcd_barrier_complete(bar, b.x, nloc, nx); b.st[0] = nloc; b.st[1] = nx; }
        const unsigned old = xb_add(&bar[XB_XSUB(b.x)], 1u);
        const unsigned gen = old / nloc;
        if (old + 1u == (gen + 1u) * nloc) {
            __builtin_amdgcn_fence(__ATOMIC_RELEASE, "agent");
            asm volatile("s_waitcnt vmcnt(0)" ::: "memory");
            const unsigned og = xb_add(&bar[XB_TOP], 1u);
            const unsigned tg = og / nx;
            if (og + 1u == (tg + 1u) * nx) xb_add(&bar[XB_TOPGEN], 1u);
            else XB_SPIN(xb_ld(&bar[XB_TOPGEN]) == tg, bar);
            __builtin_amdgcn_fence(__ATOMIC_ACQUIRE, "agent");
            xb_add(&bar[XB_XGEN(b.x)], 1u);
            asm volatile("s_waitcnt vmcnt(0)" ::: "memory");
        } else {
            XB_SPIN(xb_ld(&bar[XB_XGEN(b.x)]) == gen, bar);
            __builtin_amdgcn_fence(__ATOMIC_ACQUIRE, "agent");
            asm volatile("s_waitcnt vmcnt(0)" ::: "memory");
        }
    }
    __syncthreads();
}


typedef unsigned u32x2 __attribute__((ext_vector_type(2))); typedef unsigned u32x4 __attribute__((ext_vector_type(4)));
struct Frame {
    LAS unsigned char* lds;
    volatile LAS unsigned* MISC;
    gu32* ctl;
    int wave;
    int vcu, G;
    const float* in[26]; float* out; unsigned char* ws;
};
#ifndef PRIM_RED
#define PRIM_RED 1
#define PRIM_ROW 1
#define PRIM_SCAN 1
#define PRIM_MATH 1
#endif
#define DPPF(old_, v_, ctrl, rm) __builtin_bit_cast(float, __builtin_amdgcn_update_dpp(__builtin_bit_cast(int, (float)(old_)), __builtin_bit_cast(int, (float)(v_)), ctrl, rm, 0xF, false))
#if PRIM_RED
__device__ __forceinline__ float wave_sum(float v) {
    v += DPPF(0.f, v, 0xB1, 0xF); v += DPPF(0.f, v, 0x4E, 0xF); v += DPPF(0.f, v, 0x141, 0xF); v += DPPF(0.f, v, 0x140, 0xF);
    { auto r = __builtin_amdgcn_permlane16_swap(__float_as_uint(v), __float_as_uint(v), false, false); v = __uint_as_float(r[0]) + __uint_as_float(r[1]); }
    { auto r = __builtin_amdgcn_permlane32_swap(__float_as_uint(v), __float_as_uint(v), false, false); v = __uint_as_float(r[0]) + __uint_as_float(r[1]); }
    return v;
}
__device__ __forceinline__ float wave_max(float v) {
    v = fmaxf(v, DPPF(v, v, 0xB1, 0xF)); v = fmaxf(v, DPPF(v, v, 0x4E, 0xF)); v = fmaxf(v, DPPF(v, v, 0x141, 0xF)); v = fmaxf(v, DPPF(v, v, 0x140, 0xF));
    { auto r = __builtin_amdgcn_permlane16_swap(__float_as_uint(v), __float_as_uint(v), false, false); v = fmaxf(__uint_as_float(r[0]), __uint_as_float(r[1])); }
    { auto r = __builtin_amdgcn_permlane32_swap(__float_as_uint(v), __float_as_uint(v), false, false); v = fmaxf(__uint_as_float(r[0]), __uint_as_float(r[1])); }
    return v;
}
#else
__device__ __forceinline__ float wave_sum(float v) { for (int o = 1; o < 64; o <<= 1) v += __shfl_xor(v, o); return v; }
__device__ __forceinline__ float wave_max(float v) { for (int o = 1; o < 64; o <<= 1) v = fmaxf(v, __shfl_xor(v, o)); return v; }
#endif
#if PRIM_ROW
__device__ __forceinline__ float row8_sum(float v) { v += DPPF(0.f, v, 0xB1, 0xF); v += DPPF(0.f, v, 0x4E, 0xF); v += DPPF(0.f, v, 0x141, 0xF); return v; }
__device__ __forceinline__ float row16_sum(float v) { v += DPPF(0.f, v, 0xB1, 0xF); v += DPPF(0.f, v, 0x4E, 0xF); v += DPPF(0.f, v, 0x141, 0xF); v += DPPF(0.f, v, 0x140, 0xF); return v; }
#else
__device__ __forceinline__ float row16_sum(float v) { v += __shfl_xor(v, 1); v += __shfl_xor(v, 2); v += __shfl_xor(v, 4); v += __shfl_xor(v, 8); return v; }
__device__ __forceinline__ float row8_sum(float v) { v += __shfl_xor(v, 1); v += __shfl_xor(v, 2); v += __shfl_xor(v, 4); return v; }
#endif
#if PRIM_SCAN
__device__ __forceinline__ float wave_scan_sum(float v) {
    v += DPPF(0.f, v, 0x111, 0xF); v += DPPF(0.f, v, 0x112, 0xF); v += DPPF(0.f, v, 0x114, 0xF); v += DPPF(0.f, v, 0x118, 0xF);
    v += DPPF(0.f, v, 0x142, 0xA); v += DPPF(0.f, v, 0x143, 0xC); return v;
}
__device__ __forceinline__ float wave_scan_max(float v) {
    const float NI = -INFINITY;
    v = fmaxf(v, DPPF(NI, v, 0x111, 0xF)); v = fmaxf(v, DPPF(NI, v, 0x112, 0xF)); v = fmaxf(v, DPPF(NI, v, 0x114, 0xF)); v = fmaxf(v, DPPF(NI, v, 0x118, 0xF));
    v = fmaxf(v, DPPF(NI, v, 0x142, 0xA)); v = fmaxf(v, DPPF(NI, v, 0x143, 0xC)); return v;
}
#else
__device__ __forceinline__ float wave_scan_sum(float v) { const int l = lane_now(); for (int o = 1; o < 64; o <<= 1) { const float t = __shfl_up(v, o); if (l >= o) v += t; } return v; }
__device__ __forceinline__ float wave_scan_max(float v) { const int l = lane_now(); for (int o = 1; o < 64; o <<= 1) { const float t = __shfl_up(v, o); if (l >= o) v = fmaxf(v, t); } return v; }
#endif
#if PRIM_MATH
__device__ __forceinline__ float fexp(float x) { return __builtin_amdgcn_exp2f(x * 1.4426950408889634f); }
__device__ __forceinline__ float fsigmoid(float x) { return __builtin_amdgcn_rcpf(1.f + __builtin_amdgcn_exp2f(-1.4426950408889634f * x)); }
__device__ __forceinline__ float frsq(float x) { return __builtin_amdgcn_rsqf(x); }
#else
__device__ __forceinline__ float fexp(float x) { return expf(x); }
__device__ __forceinline__ float fsigmoid(float x) { return 1.f / (1.f + expf(-x)); }
__device__ __forceinline__ float frsq(float x) { return 1.f / sqrtf(x); }
#endif
__device__ __forceinline__ float bf2f(unsigned short b) { return __uint_as_float((unsigned)b << 16); }
__device__ __forceinline__ float bflo(unsigned w) { return __uint_as_float(w << 16); }
__device__ __forceinline__ float bfhi(unsigned w) { return __uint_as_float(w & 0xffff0000u); }
__device__ __forceinline__ float dot4(f32x4 a, f32x4 b) { return (a.x * b.x + a.y * b.y) + (a.z * b.z + a.w * b.w); }
#define WG_SYNC() __syncthreads()

struct RowMap { int mode, off;
    __device__ __forceinline__ int operator()(int n) const {
        if (mode == 1) return (n < 1024) ? ((n & ~255) | (((n >> 5) & 1) << 7) | (((n >> 6) & 3) << 5) | (n & 31)) : (n < 2560) ? n : (n < 3072) ? n + 512 : n - 512;
        if (mode == 2) return ((n >> 7) << 8) + off + (n & 127);
        return off + n; } };
struct TrItem { const float* W; bf16* WT; const float* ks; int K, ldw, nblk, local; RowMap rm; };
__device__ __forceinline__ void tr_load(const TrItem& t, int lane, f32x4 (&x)[8]) {
    const int kb = t.local / t.nblk, nb = t.local % t.nblk, k0 = 64 * kb, n0 = 32 * nb;
#pragma unroll
    for (int i = 0; i < 8; ++i) x[i] = __builtin_nontemporal_load((const GAS f32x4*)(t.W + (size_t)(k0 + 8 * i + (lane >> 3)) * t.ldw + n0 + 4 * (lane & 7)));
}
__device__ __forceinline__ void tr_finish(const TrItem& t, int lane, const f32x4 (&x)[8], LAS float* scr) {
    const int kb = t.local / t.nblk, nb = t.local % t.nblk, k0 = 64 * kb, n0 = 32 * nb;
#pragma unroll
    for (int i = 0; i < 8; ++i) { LAS float* d = scr + (8 * i + (lane >> 3)) * 33 + 4 * (lane & 7); d[0] = x[i].x; d[1] = x[i].y; d[2] = x[i].z; d[3] = x[i].w; }
    LDS_WAIT(); asm volatile("" ::: "memory");
    const int c = lane & 7;
    f32x4 ks0 = {1.f, 1.f, 1.f, 1.f}, ks1 = ks0;
    if (t.ks) { ks0 = *(const GAS f32x4*)(t.ks + k0 + 8 * c); ks1 = *(const GAS f32x4*)(t.ks + k0 + 8 * c + 4); }
#pragma unroll
    for (int j = 0; j < 4; ++j) { const int n = (lane >> 3) + 8 * j; const LAS float* s = scr + (8 * c) * 33 + n;
        v4u o; o.x = pk2(s[0 * 33] * ks0.x, s[1 * 33] * ks0.y); o.y = pk2(s[2 * 33] * ks0.z, s[3 * 33] * ks0.w); o.z = pk2(s[4 * 33] * ks1.x, s[5 * 33] * ks1.y); o.w = pk2(s[6 * 33] * ks1.z, s[7 * 33] * ks1.w);
        GAS v4u* dst_ = (GAS v4u*)(t.WT + (size_t)t.rm(n0 + n) * t.K + k0 + 8 * c);
        if (t.rm.mode == 2) __builtin_nontemporal_store(o, dst_); else *dst_ = o; }
    LDS_WAIT(); asm volatile("" ::: "memory");
}
__device__ __forceinline__ void p0_transpose_item(const float* W, int K, int ldw, int nblk, bf16* WT, const RowMap rm, const float* kscale, LAS float* scr, int item, int lane) {
    TrItem t{W, WT, kscale, K, ldw, nblk, item, rm}; f32x4 x[8]; tr_load(t, lane, x); tr_finish(t, lane, x, scr);
}
__device__ __forceinline__ void rms_row(const int lane, f32x4 (&v)[4], const float* g, bf16* orow, const LAS float* gw, float* gate_out, const float* gate_b) {
    const GAS f32x4* gr = (const GAS f32x4*)g + 2 * lane;
    float s = 0.f;
#pragma unroll
    for (int j = 0; j < 4; ++j) s += dot4(v[j], v[j]);
    const float rstd = frsq(wave_sum(s) * (1.f / D) + EPS);
    v[0] = v[0] * rstd * gr[0]; v[1] = v[1] * rstd * gr[1]; v[2] = v[2] * rstd * gr[128]; v[3] = v[3] * rstd * gr[129];
    GAS v4u* o16 = (GAS v4u*)orow + lane; v4u o;
    o.x = pk2(v[0].x, v[0].y); o.y = pk2(v[0].z, v[0].w); o.z = pk2(v[1].x, v[1].y); o.w = pk2(v[1].z, v[1].w); o16[0] = o;
    o.x = pk2(v[2].x, v[2].y); o.y = pk2(v[2].z, v[2].w); o.z = pk2(v[3].x, v[3].y); o.w = pk2(v[3].z, v[3].w); o16[64] = o;
    if (gw) {
        float mine = 0.f;
#pragma unroll
        for (int q = 0; q < 8; ++q) { const LAS float* wp = gw + q * 1024 + 8 * lane;
            float a = (dot4(v[0], *(const LAS f32x4*)(wp)) + dot4(v[1], *(const LAS f32x4*)(wp + 4))) + (dot4(v[2], *(const LAS f32x4*)(wp + 512)) + dot4(v[3], *(const LAS f32x4*)(wp + 516)));
            a = wave_sum(a); mine = (lane == q) ? a : mine; }
        if (lane < 8) gate_out[lane] = mine + gate_b[lane];
    }
}
__device__ __forceinline__ void sincos_acc(float ang, float& sn, float& cs) {
    const double a = (double)ang; const double q = rint(a * 0.63661977236758134308); const double z = a - q * 1.57079632679489661923;
    const double z2 = z * z;
    const double sp = z * (1.0 + z2 * (-1.0 / 6 + z2 * (1.0 / 120 + z2 * (-1.0 / 5040 + z2 * (1.0 / 362880 + z2 * (-1.0 / 39916800 + z2 * (1.0 / 6227020800.0)))))));
    const double cp = 1.0 + z2 * (-0.5 + z2 * (1.0 / 24 + z2 * (-1.0 / 720 + z2 * (1.0 / 40320 + z2 * (-1.0 / 3628800 + z2 * (1.0 / 479001600.0 + z2 * (-1.0 / 87178291200.0)))))));
    const int qi = ((int)(long long)q) & 3;
    const double s_ = (qi == 0) ? sp : (qi == 1) ? cp : (qi == 2) ? -sp : -cp;
    const double c_ = (qi == 0) ? cp : (qi == 1) ? -sp : (qi == 2) ? -cp : sp;
    sn = (float)s_; cs = (float)c_;
}
__device__ __forceinline__ void p0_prologue(Frame& F) {
    const int lane = lane_now(), wave = F.wave, tid = wave * 64 + lane; (void)tid; (void)lane; (void)wave;
    const int gw = F.vcu * NWAVES + wave, NGW = F.G * NWAVES;
    LAS float* scr = (LAS float*)(F.lds + wave * 8704);
    LAS float* gwt = (LAS float*)(F.lds + 69632);
    for (int i = tid; i < 8192; i += NWAVES * 64) { const int k = i >> 3, q = i & 7; gwt[q * 1024 + k] = F.in[3][(size_t)k * 3592 + 3584 + q]; }
    WG_SYNC();
    bf16* wsb = (bf16*)F.ws;
    constexpr int I_IN = 16 * 112, I_SQ = 16 * 32, I_E = 32 * 256;
    constexpr int NITEMS = I_IN + 4 * I_SQ + 2 * I_E;
    auto decode = [&](int it) -> TrItem { int r = it;
        if (r < I_IN) return TrItem{F.in[3], (bf16*)(F.ws + WS_WIN), nullptr, D, 3592, 112, r, RowMap{1, 0}}; r -= I_IN;
        if (r < I_SQ) return TrItem{F.in[4], (bf16*)(F.ws + WS_WOUT), nullptr, D, D, 32, r, RowMap{0, 0}}; r -= I_SQ;
        if (r < I_SQ) return TrItem{F.in[14], (bf16*)(F.ws + WS_WKV), nullptr, D, D, 32, r, RowMap{0, 0}}; r -= I_SQ;
        if (r < I_SQ) return TrItem{F.in[15], (bf16*)(F.ws + WS_WKV), nullptr, D, D, 32, r, RowMap{0, 1024}}; r -= I_SQ;
        if (r < I_SQ) return TrItem{F.in[16], (bf16*)(F.ws + WS_WXO), nullptr, D, D, 32, r, RowMap{0, 0}}; r -= I_SQ;
        if (r < I_E) { const int e = r >> 8; return TrItem{F.in[22] + (size_t)e * D * DEXP, (bf16*)(F.ws + WS_W13) + (size_t)e * D * D, F.in[17], D, DEXP, 16, r & 255, RowMap{2, 0}}; } r -= I_E;
        { const int e = r >> 8; return TrItem{F.in[23] + (size_t)e * D * DEXP, (bf16*)(F.ws + WS_W13) + (size_t)e * D * D, F.in[17], D, DEXP, 16, r & 255, RowMap{2, 128}}; } };
    { f32x4 xa[8], xb[8];
      int it = gw; if (it < NITEMS) { const TrItem t0 = decode(it); tr_load(t0, lane, xa); }
      for (; it < NITEMS; it += 2 * NGW) {
          const TrItem ta = decode(it); const bool hb = it + NGW < NITEMS; TrItem tb = ta; if (hb) { tb = decode(it + NGW); tr_load(tb, lane, xb); }
          tr_finish(ta, lane, xa, scr);
          if (it + 2 * NGW < NITEMS) { const TrItem tc = decode(it + 2 * NGW); tr_load(tc, lane, xa); }
          if (hb) tr_finish(tb, lane, xb, scr); } }
    (void)wsb;
    { f32x4 nx[4];
#define P0_LOADROW(base, m_) do { const GAS f32x4* xr_ = (const GAS f32x4*)((base) + (size_t)(m_) * D) + 2 * lane; nx[0] = __builtin_nontemporal_load(xr_); nx[1] = __builtin_nontemporal_load(xr_ + 1); nx[2] = __builtin_nontemporal_load(xr_ + 128); nx[3] = __builtin_nontemporal_load(xr_ + 129); } while (0)
      if (gw < M) P0_LOADROW(F.in[0], gw);
      for (int m = gw; m < M; m += NGW) { f32x4 v[4] = {nx[0], nx[1], nx[2], nx[3]}; if (m + NGW < M) P0_LOADROW(F.in[0], m + NGW);
          rms_row(lane, v, F.in[2], (bf16*)F.out + (size_t)m * D, gwt, (float*)(F.ws + WS_GATE) + (size_t)m * 8, F.in[9]); }
      for (int m = gw; m < MROWS; m += NGW) { P0_LOADROW(F.in[1], m); f32x4 v[4] = {nx[0], nx[1], nx[2], nx[3]}; rms_row(lane, v, F.in[12], (bf16*)(F.ws + WS_MEMN) + (size_t)m * D, nullptr, nullptr, nullptr); }
#undef P0_LOADROW
    }
    for (int i = F.vcu * (NWAVES * 64) + tid; i < D * D / 8; i += F.G * NWAVES * 64) { const int k = i >> 7, c8 = i & 127; const float gk = F.in[11][k];
        const GAS f32x4* s = (const GAS f32x4*)(F.in[13] + (size_t)k * D + c8 * 8); const f32x4 a = __builtin_nontemporal_load(s), b = __builtin_nontemporal_load(s + 1);
        v4u o; o.x = pk2(a.x * gk, a.y * gk); o.y = pk2(a.z * gk, a.w * gk); o.z = pk2(b.x * gk, b.y * gk); o.w = pk2(b.z * gk, b.w * gk); *(GAS v4u*)((bf16*)(F.ws + WS_WXQ) + (size_t)k * D + c8 * 8) = o; }
    for (int i = F.vcu * (NWAVES * 64) + tid; i < 36 * 1024; i += F.G * NWAVES * 64) { const int n = i >> 10, k = i & 1023;
        const float v = ((n < 32) ? F.in[20][k * 32 + n] : F.in[18][k * 4 + (n - 32)]) * F.in[17][k]; const unsigned hi = f2bf(v); const float rem = v - __uint_as_float(hi << 16);
        bf16* rt_ = (bf16*)(F.ws + WS_RT); rt_[n * 1024 + k] = (bf16)hi; rt_[(36 + n) * 1024 + k] = (bf16)f2bf(rem); }
    float* rope = (float*)(F.ws + WS_ROPE);
    for (int i = F.vcu * (NWAVES * 64) + tid; i < SEQ * 32; i += F.G * NWAVES * 64) { const int pos = i >> 5, fi = i & 31;
        const float invf = (float)exp2(-(double)fi * (13.287712379549449 / 32.0));
        const float ang = (float)pos * invf; float sn, cs; sincos_acc(ang, sn, cs); rope[i] = cs; rope[SEQ * 32 + i] = sn; }
}


__device__ __forceinline__ void w2_items(Frame& F, int rank, int nidle) {
    const int lane = lane_now(), wave = F.wave;
    LAS float* scr = (LAS float*)(F.lds + wave * 8704);
    if (rank < 0) return;
    for (int r = rank * NWAVES + wave; r < 32 * 256; r += nidle * NWAVES) { const int e = r >> 8;
        p0_transpose_item(F.in[24] + (size_t)e * DEXP * D, DEXP, D, 32, (bf16*)(F.ws + WS_W2) + (size_t)e * D * DEXP, RowMap{0, 0}, nullptr, scr, r & 255, lane); }
}
__device__ __forceinline__ void gate_scan(Frame& F, int bh) {
    const int lane = lane_now(), wave = F.wave;
    const int b = bh >> 2, h = bh & 3; const float* gate = (const float*)(F.ws + WS_GATE);
    float* acum = (float*)(F.ws + WS_ACUM) + (size_t)bh * SEQ; float* usub = (float*)(F.ws + WS_USUB) + (size_t)bh * SEQ; float* sc = (float*)(F.ws + WS_SC) + (size_t)bh * NCH * 4;
    LAS float* GB = (LAS float*)F.lds;
    for (int jj = 0; jj < 8; ++jj) { const int j = wave * 8 + jj; const int t = j * CHL + lane; const size_t row = (size_t)b * SEQ + t;
        const float gi = gate[row * 8 + h], gf = gate[row * 8 + 4 + h];
        const float a = wave_scan_sum(fminf(gf, 0.f) - log1pf(expf(-fabsf(gf))));
        const float g = __builtin_bit_cast(float, __builtin_amdgcn_readlane(__builtin_bit_cast(int, a), 63)); const float u = gi - a;
        const float bm = wave_max(g + u);
        acum[t] = a; usub[t] = u;
        if (lane == 0) { GB[j] = g; GB[64 + j] = bm; } }
    WG_SYNC();
    if (wave == 0) { float G = GB[lane], B = GB[64 + lane]; const float g = G;
#pragma unroll
        for (int o = 1; o < 64; o <<= 1) { const float Gp = __shfl_up(G, o), Bp = __shfl_up(B, o); if (lane >= o) { B = fmaxf(Bp + G, B); G = Gp + G; } }
        const float mnew = fmaxf(G, B);
        float mprev = __shfl_up(mnew, 1); if (lane == 0) mprev = 0.f;
        sc[lane * 4 + 0] = mprev; sc[lane * 4 + 1] = mnew; sc[lane * 4 + 2] = g; sc[lane * 4 + 3] = expf(g + mprev - mnew); }
    WG_SYNC();
}

constexpr int TS64 = 144;
constexpr int TS128 = 272;
constexpr int ML_CW = 135168;
__device__ __forceinline__ void stage_convw(Frame& F) {
    const int tid = F.wave * 64 + lane_now(); LAS float* cwl = (LAS float*)(F.lds + ML_CW);
    for (int i = tid; i < 5632; i += NWAVES * 64) cwl[i] = (i < 4096) ? F.in[7][i] : (i < 5120) ? F.in[8][i - 4096] : F.in[10][i - 5120];
    WG_SYNC();
}
__device__ __forceinline__ void conv2_silu8(const bf16* src, int t, const LAS float* cwl, int ch0, float (&y0)[8], float (&y1)[8]) {
    v4u x[5];
#pragma unroll
    for (int i = 0; i < 5; ++i) { const int tt = t - 3 + i; x[i] = (tt >= 0) ? *(const GAS v4u*)(src + (size_t)tt * NPROJ) : (v4u){0u, 0u, 0u, 0u}; }
#pragma unroll
    for (int hh = 0; hh < 2; ++hh) {
        const f32x4 bb = *(const LAS f32x4*)(cwl + 4096 + ch0 + 4 * hh); f32x4 a0 = bb, a1 = bb;
#pragma unroll
        for (int tau = 0; tau < 4; ++tau) { const f32x4 w = *(const LAS f32x4*)(cwl + tau * 1024 + ch0 + 4 * hh);
            const unsigned p0 = hh ? x[tau].z : x[tau].x, p1 = hh ? x[tau].w : x[tau].y, q0 = hh ? x[tau + 1].z : x[tau + 1].x, q1 = hh ? x[tau + 1].w : x[tau + 1].y;
            a0 += w * (f32x4){bflo(p0), bfhi(p0), bflo(p1), bfhi(p1)}; a1 += w * (f32x4){bflo(q0), bfhi(q0), bflo(q1), bfhi(q1)}; }
#pragma unroll
        for (int e = 0; e < 4; ++e) { y0[4 * hh + e] = a0[e] * fsigmoid(a0[e]); y1[4 * hh + e] = a1[e] * fsigmoid(a1[e]); } }
}
__device__ __forceinline__ void stage_vt(Frame& F, int tid, int b, int t0, int h, LAS unsigned char* VT) {
    const bf16* mvt = (const bf16*)(F.ws + WS_MVT);
#pragma unroll
    for (int i = 0; i < 2; ++i) { const int id = tid + 512 * i, r = id >> 3, c = id & 7;
        *(LAS v4u*)(VT + r * TS64 + c * 16) = *(const GAS v4u*)(mvt + (size_t)(h * 128 + r) * M + (size_t)b * SEQ + t0 + c * 8); }
    if (tid < 128) { const int r = 128 + (tid >> 3), c = tid & 7; const unsigned one2 = (r == 128) ? 0x3F803F80u : 0u; *(LAS v4u*)(VT + r * TS64 + c * 16) = (v4u){one2, one2, one2, one2}; }
}

#define LDS_BARRIER() asm volatile("s_waitcnt lgkmcnt(0)\n\ts_barrier" ::: "memory")
__device__ __forceinline__ void conv2_math(const v4u (&x)[5], const LAS float* cwl, int ch0, float (&y0)[8], float (&y1)[8]) {
#pragma unroll
    for (int hh = 0; hh < 2; ++hh) {
        const f32x4 bb = *(const LAS f32x4*)(cwl + 4096 + ch0 + 4 * hh); f32x4 a0 = bb, a1 = bb;
#pragma unroll
        for (int tau = 0; tau < 4; ++tau) { const f32x4 w = *(const LAS f32x4*)(cwl + tau * 1024 + ch0 + 4 * hh);
            const unsigned p0 = hh ? x[tau].z : x[tau].x, p1 = hh ? x[tau].w : x[tau].y, q0 = hh ? x[tau + 1].z : x[tau + 1].x, q1 = hh ? x[tau + 1].w : x[tau + 1].y;
            a0 += w * (f32x4){bflo(p0), bfhi(p0), bflo(p1), bfhi(p1)}; a1 += w * (f32x4){bflo(q0), bfhi(q0), bflo(q1), bfhi(q1)}; }
#pragma unroll
        for (int e = 0; e < 4; ++e) { y0[4 * hh + e] = a0[e] * fsigmoid(a0[e]); y1[4 * hh + e] = a1[e] * fsigmoid(a1[e]); } }
}
struct M1Pre { v4u xk[5], vt[2]; float u0, u1; };
__device__ __forceinline__ void m1_load(Frame& F, int bh, int j, int lane, int wave, int tid, M1Pre& p) {
    const int b = bh >> 2, h = bh & 3, t0 = j * CHL; const bf16* proj = (const bf16*)(F.ws + WS_PROJ);
    const int c8 = (lane & 7) + 8 * (wave & 1), r0 = 2 * ((wave >> 1) * 8 + (lane >> 3));
    const bf16* sk = proj + (size_t)b * SEQ * NPROJ + C_MK + h * 128 + c8 * 8;
#pragma unroll
    for (int i = 0; i < 5; ++i) { const int tt = t0 + r0 - 3 + i, tc = tt < 0 ? 0 : tt; p.xk[i] = *(const GAS v4u*)(sk + (size_t)tc * NPROJ); }
    const bf16* mvt = (const bf16*)(F.ws + WS_MVT);
#pragma unroll
    for (int i = 0; i < 2; ++i) { const int id = tid + 512 * i, r = id >> 3, c = id & 7; p.vt[i] = *(const GAS v4u*)(mvt + (size_t)(h * 128 + r) * M + (size_t)b * SEQ + t0 + c * 8); }
    const float* usub = (const float*)(F.ws + WS_USUB) + (size_t)bh * SEQ + t0; p.u0 = usub[r0]; p.u1 = usub[r0 + 1];
}
constexpr int NGRP = 8, GCH = NCH / NGRP, ST_V4 = 9 * NWAVES * 64;
__device__ __forceinline__ void m1g_phase(Frame& F) {
    const int lane = lane_now(), wave = F.wave, tid = wave * 64 + lane;
    LAS unsigned char* KWT = F.lds; LAS unsigned char* VT = F.lds + 128 * TS64; const LAS float* cwl = (const LAS float*)(F.lds + ML_CW);
    const int r16 = lane & 15, q = lane >> 4, w = wave;
    for (int u = F.vcu; u < 32 * NGRP; u += F.G) { const int bh = u / NGRP, g = u % NGRP, h = bh & 3;
        M1Pre p; m1_load(F, bh, g * GCH, lane, wave, tid, p);
        f32x4 acc[9];
#pragma unroll
        for (int nt = 0; nt < 9; ++nt) acc[nt] = (f32x4){0.f, 0.f, 0.f, 0.f};
        for (int jj = 0; jj < GCH; ++jj) { const int j = g * GCH + jj, t0 = j * CHL;
            const float* sc = (const float*)(F.ws + WS_SC) + ((size_t)bh * NCH + j) * 4; const float mnew = sc[1], gj = sc[2], dec = sc[3];
            { const int c8 = (lane & 7) + 8 * (wave & 1), r0 = 2 * ((wave >> 1) * 8 + (lane >> 3)); float y0[8], y1[8];
#pragma unroll
                for (int i = 0; i < 3; ++i) { if (t0 + r0 - 3 + i < 0) p.xk[i] = (v4u){0u, 0u, 0u, 0u}; }
                conv2_math(p.xk, cwl, 512 + h * 128 + c8 * 8, y0, y1);
                const float w0 = 0.08838834764831845f * fexp(gj + p.u0 - mnew), w1 = 0.08838834764831845f * fexp(gj + p.u1 - mnew);
#pragma unroll
                for (int e = 0; e < 8; ++e) *(LAS unsigned*)(KWT + (c8 * 8 + e) * TS64 + r0 * 2) = pk2(y0[e] * w0, y1[e] * w1); }
#pragma unroll
            for (int i = 0; i < 2; ++i) { const int id = tid + 512 * i, r = id >> 3, c = id & 7; *(LAS v4u*)(VT + r * TS64 + c * 16) = p.vt[i]; }
            if (tid < 128) { const int r = 128 + (tid >> 3), c = tid & 7; const unsigned one2 = (r == 128) ? 0x3F803F80u : 0u; *(LAS v4u*)(VT + r * TS64 + c * 16) = (v4u){one2, one2, one2, one2}; }
            LDS_BARRIER();
            if (jj + 1 < GCH) m1_load(F, bh, j + 1, lane, wave, tid, p);
            bf16x8 xa[2];
#pragma unroll
            for (int ks = 0; ks < 2; ++ks) xa[ks] = *(const LAS bf16x8*)(KWT + (16 * w + r16) * TS64 + ks * 64 + q * 16);
#pragma unroll
            for (int nt = 0; nt < 9; ++nt) { acc[nt] = acc[nt] * dec;
#pragma unroll
                for (int ks = 0; ks < 2; ++ks) { const bf16x8 yb = *(const LAS bf16x8*)(VT + (16 * nt + r16) * TS64 + ks * 64 + q * 16); acc[nt] = __builtin_amdgcn_mfma_f32_16x16x32_bf16(xa[ks], yb, acc[nt], 0, 0, 0); } }
            LDS_BARRIER();
        }
        GAS f32x4* tg = (GAS f32x4*)F.out + (size_t)u * ST_V4 + tid;
#pragma unroll
        for (int nt = 0; nt < 9; ++nt) tg[nt * 512] = acc[nt];
    }
    WG_SYNC();
}

__device__ __forceinline__ void p3_scan_combine(Frame& F, const int sub, const int blk0) {
    const int lane = lane_now(), wave = F.wave, tid = wave * 64 + lane;
    const int vb = (int)blockIdx.x - blk0, nb = F.G - blk0;
    if (sub & 16) { const GAS f32x4* TG = (const GAS f32x4*)F.out; GAS f32x4* CIN = (GAS f32x4*)F.out + (size_t)2 * 1024 * 1024;
        for (int ch = vb * (NWAVES * 64) + tid; ch < 32 * ST_V4; ch += nb * NWAVES * 64) { const int bh = ch / ST_V4, e = ch % ST_V4;
            const float* sc = (const float*)(F.ws + WS_SC) + (size_t)bh * NCH * 4; f32x4 t[NGRP];
#pragma unroll
            for (int g = 0; g < NGRP; ++g) t[g] = TG[((size_t)bh * NGRP + g) * ST_V4 + e];
            f32x4 run = {0.f, 0.f, 0.f, 0.f};
#pragma unroll
            for (int g = 0; g < NGRP; ++g) { CIN[((size_t)bh * NGRP + g) * ST_V4 + e] = run; float dg = 1.f;
#pragma unroll
                for (int jj = 0; jj < GCH; ++jj) dg *= sc[(g * GCH + jj) * 4 + 3];
                run = run * dg + t[g]; } } }
    const float* lv = F.in[5];
    const float lam = expf(wave_sum(lv[lane] * lv[64 + lane])) - expf(wave_sum(lv[128 + lane] * lv[192 + lane])) + LAM_INIT;
    const int gw = vb * NWAVES + wave, NGW = nb * NWAVES; bf16* oa = (bf16*)(F.ws + WS_OA);
    float gs[8];
#pragma unroll
    for (int e = 0; e < 8; ++e) gs[e] = F.in[6][((lane * 8) & 127) + e] * (1.0f - LAM_INIT);
    if (sub & 32) for (int m = gw; m < M; m += NGW) { GAS v4u* r = (GAS v4u*)(oa + (size_t)m * 1024) + lane; const v4u a = r[0], c = r[64];
        float y[8]; y[0] = bflo(a.x) - lam * bflo(c.x); y[1] = bfhi(a.x) - lam * bfhi(c.x); y[2] = bflo(a.y) - lam * bflo(c.y); y[3] = bfhi(a.y) - lam * bfhi(c.y);
        y[4] = bflo(a.z) - lam * bflo(c.z); y[5] = bfhi(a.z) - lam * bfhi(c.z); y[6] = bflo(a.w) - lam * bflo(c.w); y[7] = bfhi(a.w) - lam * bfhi(c.w);
        float ss = 0.f;
#pragma unroll
        for (int e = 0; e < 8; ++e) ss += y[e] * y[e];
        ss = row16_sum(ss);
        const float rs = frsq(ss * (1.f / 128.f) + EPS); v4u o;
        o.x = pk2(y[0] * rs * gs[0], y[1] * rs * gs[1]); o.y = pk2(y[2] * rs * gs[2], y[3] * rs * gs[3]); o.z = pk2(y[4] * rs * gs[4], y[5] * rs * gs[5]); o.w = pk2(y[6] * rs * gs[6], y[7] * rs * gs[7]);
        r[0] = o; }
}

struct M3Pre { v4u xq[5], xk[5], vt[2], ow[2]; float u, a, u0, u1; };
__device__ __forceinline__ void m3_load(Frame& F, int bh, int j, int lane, int wave, int tid, M3Pre& p) {
    const int b = bh >> 2, h = bh & 3, t0 = j * CHL; const bf16* proj = (const bf16*)(F.ws + WS_PROJ);
    const int c8 = (lane & 7) + 8 * (wave & 1), r0 = 2 * ((wave >> 1) * 8 + (lane >> 3));
    const bf16* sq = proj + (size_t)b * SEQ * NPROJ + C_MQ + h * 128 + c8 * 8; const bf16* sk = proj + (size_t)b * SEQ * NPROJ + C_MK + h * 128 + c8 * 8;
#pragma unroll
    for (int i = 0; i < 5; ++i) { const int tt = t0 + r0 - 3 + i, tc = tt < 0 ? 0 : tt;
        p.xq[i] = *(const GAS v4u*)(sq + (size_t)tc * NPROJ); p.xk[i] = *(const GAS v4u*)(sk + (size_t)tc * NPROJ); }
    const bf16* mvt = (const bf16*)(F.ws + WS_MVT);
#pragma unroll
    for (int i = 0; i < 2; ++i) { const int id = tid + 512 * i, r = id >> 3, c = id & 7; p.vt[i] = *(const GAS v4u*)(mvt + (size_t)(h * 128 + r) * M + (size_t)b * SEQ + t0 + c * 8); }
    { const GAS v4u* op = (const GAS v4u*)(proj + ((size_t)b * SEQ + t0 + (tid >> 3)) * NPROJ + C_MO + h * 128 + 16 * (tid & 7)); p.ow[0] = op[0]; p.ow[1] = op[1]; }
    p.u = ((const float*)(F.ws + WS_USUB))[(size_t)bh * SEQ + t0 + lane]; p.a = ((const float*)(F.ws + WS_ACUM))[(size_t)bh * SEQ + t0 + lane];
    p.u0 = ((const float*)(F.ws + WS_USUB))[(size_t)bh * SEQ + t0 + r0]; p.u1 = ((const float*)(F.ws + WS_USUB))[(size_t)bh * SEQ + t0 + r0 + 1];
}
__device__ __forceinline__ void m3_phase(Frame& F) {
    const int lane = lane_now(), wave = F.wave, tid = wave * 64 + lane;
    const bf16* proj = (const bf16*)(F.ws + WS_PROJ);
    LAS unsigned char* Qs = F.lds; LAS unsigned char* Ks = F.lds + 64 * TS128; LAS unsigned char* VT = F.lds + 128 * TS128; LAS unsigned char* CT = VT + DVX * TS64;
    LAS unsigned char* SD = CT + DVX * TS128; LAS float* sv = (LAS float*)(SD + 64 * TS64);
    LAS unsigned char* KWT = SD + 64 * TS64 + 1024;
    LAS float* HB = (LAS float*)F.lds;
    const LAS float* cwl = (const LAS float*)(F.lds + ML_CW);
    static_assert(128 * TS128 + DVX * TS64 + DVX * TS128 + 64 * TS64 + 4 * 64 * 4 + 128 * TS64 <= ML_CW && 64 * 132 * 4 <= 128 * TS128 && ML_CW + 5632 * 4 <= LDSCTL_OFF, "m3 LDS");
    M3Pre p;
    for (int ug = F.vcu; ug < 32 * NGRP; ug += F.G) {
    const int bh = ug / NGRP, g = ug % NGRP;
    f32x4 cst[9];
    { const GAS f32x4* cin = (const GAS f32x4*)F.out + (size_t)2 * 1024 * 1024 + (size_t)ug * ST_V4 + tid;
#pragma unroll
      for (int nt = 0; nt < 9; ++nt) cst[nt] = cin[nt * 512]; }
    m3_load(F, bh, g * GCH, lane, wave, tid, p);
    for (int jj = 0; jj < GCH; ++jj) {
        const int j = g * GCH + jj, b = bh >> 2, h = bh & 3, t0 = j * CHL;
        const float* sc = (const float*)(F.ws + WS_SC) + ((size_t)bh * NCH + j) * 4; const float mprev = sc[0], mnew = sc[1], gj = sc[2], dec = sc[3];
        { const int c8 = (lane & 7) + 8 * (wave & 1), r0 = 2 * ((wave >> 1) * 8 + (lane >> 3)); float y0[8], y1[8]; v4u o;
#pragma unroll
            for (int i = 0; i < 3; ++i) { const bool z = t0 + r0 - 3 + i < 0; if (z) { p.xq[i] = (v4u){0u, 0u, 0u, 0u}; p.xk[i] = (v4u){0u, 0u, 0u, 0u}; } }
            conv2_math(p.xq, cwl, h * 128 + c8 * 8, y0, y1);
            o.x = pk2(y0[0], y0[1]); o.y = pk2(y0[2], y0[3]); o.z = pk2(y0[4], y0[5]); o.w = pk2(y0[6], y0[7]); *(LAS v4u*)(Qs + r0 * TS128 + c8 * 16) = o;
            o.x = pk2(y1[0], y1[1]); o.y = pk2(y1[2], y1[3]); o.z = pk2(y1[4], y1[5]); o.w = pk2(y1[6], y1[7]); *(LAS v4u*)(Qs + (r0 + 1) * TS128 + c8 * 16) = o;
            conv2_math(p.xk, cwl, 512 + h * 128 + c8 * 8, y0, y1);
            const float ksc = 0.08838834764831845f;
            o.x = pk2(y0[0] * ksc, y0[1] * ksc); o.y = pk2(y0[2] * ksc, y0[3] * ksc); o.z = pk2(y0[4] * ksc, y0[5] * ksc); o.w = pk2(y0[6] * ksc, y0[7] * ksc); *(LAS v4u*)(Ks + r0 * TS128 + c8 * 16) = o;
            o.x = pk2(y1[0] * ksc, y1[1] * ksc); o.y = pk2(y1[2] * ksc, y1[3] * ksc); o.z = pk2(y1[4] * ksc, y1[5] * ksc); o.w = pk2(y1[6] * ksc, y1[7] * ksc); *(LAS v4u*)(Ks + (r0 + 1) * TS128 + c8 * 16) = o;
            const float w0 = ksc * fexp(gj + p.u0 - mnew), w1 = ksc * fexp(gj + p.u1 - mnew);
#pragma unroll
            for (int e = 0; e < 8; ++e) *(LAS unsigned*)(KWT + (c8 * 8 + e) * TS64 + r0 * 2) = pk2(y0[e] * w0, y1[e] * w1); }
#pragma unroll
        for (int i = 0; i < 2; ++i) { const int id = tid + 512 * i, r = id >> 3, c = id & 7; *(LAS v4u*)(VT + r * TS64 + c * 16) = p.vt[i]; }
        if (tid < 128) { const int r = 128 + (tid >> 3), c = tid & 7; const unsigned one2 = (r == 128) ? 0x3F803F80u : 0u; *(LAS v4u*)(VT + r * TS64 + c * 16) = (v4u){one2, one2, one2, one2}; }
        { const int r16s = lane & 15, qs = lane >> 4;
#pragma unroll
          for (int nt = 0; nt < 9; ++nt) { u32x2 o2; o2.x = pk2(cst[nt][0], cst[nt][1]); o2.y = pk2(cst[nt][2], cst[nt][3]); *(LAS u32x2*)(CT + (16 * nt + r16s) * TS128 + (16 * wave + 4 * qs) * 2) = o2; } }
        if (wave == 0) { const float um = fmaxf(mprev, wave_scan_max(p.u));
            sv[lane] = p.u; sv[64 + lane] = um; sv[128 + lane] = fexp(mprev - um); sv[192 + lane] = fexp(-(p.a + um)); }
        const v4u ow0 = p.ow[0], ow1 = p.ow[1];
        LDS_BARRIER();
        if (jj + 1 < GCH) m3_load(F, bh, j + 1, lane, wave, tid, p);
        const int tr = tid >> 3, part = tid & 7; const size_t orow = (size_t)b * SEQ + t0 + tr;
        const int r16 = lane & 15, q = lane >> 4, tt = wave & 3, hf = wave >> 2; const int t = 16 * tt + r16;
        bf16x8 qf[4];
#pragma unroll
        for (int ks = 0; ks < 4; ++ks) qf[ks] = *(const LAS bf16x8*)(Qs + t * TS128 + ks * 64 + q * 16);
        { const float umt = sv[64 + t];
#pragma unroll
            for (int k = 0; k < 2; ++k) { const int st = 2 * hf + k; f32x4 acc = {0.f, 0.f, 0.f, 0.f};
#pragma unroll
                for (int ks = 0; ks < 4; ++ks) { const bf16x8 kf = *(const LAS bf16x8*)(Ks + (16 * st + r16) * TS128 + ks * 64 + q * 16); acc = __builtin_amdgcn_mfma_f32_16x16x32_bf16(kf, qf[ks], acc, 0, 0, 0); }
                float o[4];
#pragma unroll
                for (int i = 0; i < 4; ++i) { const int s = 16 * st + 4 * q + i; o[i] = (s <= t) ? acc[i] * fexp(sv[s] - umt) : 0.f; }
                u32x2 w; w.x = pk2(o[0], o[1]); w.y = pk2(o[2], o[3]); *(LAS u32x2*)(SD + t * TS64 + (16 * st + 4 * q) * 2) = w; } }
        f32x4 acc[5];
#pragma unroll
        for (int k = 0; k < 5; ++k) acc[k] = (f32x4){0.f, 0.f, 0.f, 0.f};
        { bf16x8 cf[3];
#pragma unroll
          for (int i = 0; i < 22; ++i) {
              if (i < 20) { const int k = i >> 2, ks = i & 3; const int mt = (k < 4) ? 4 * hf + k : 8; cf[i % 3] = *(const LAS bf16x8*)(CT + (16 * mt + r16) * TS128 + ks * 64 + q * 16); }
              __builtin_amdgcn_sched_barrier(0);
              if (i >= 2) { const int j = i - 2; acc[j >> 2] = __builtin_amdgcn_mfma_f32_16x16x32_bf16(cf[j % 3], qf[j & 3], acc[j >> 2], 0, 0, 0); }
              __builtin_amdgcn_sched_barrier(0); } }
        { bf16x8 xa[2];
#pragma unroll
          for (int ks = 0; ks < 2; ++ks) xa[ks] = *(const LAS bf16x8*)(KWT + (16 * wave + r16) * TS64 + ks * 64 + q * 16);
#pragma unroll
          for (int nt = 0; nt < 9; ++nt) { cst[nt] = cst[nt] * dec;
#pragma unroll
              for (int ks = 0; ks < 2; ++ks) { const bf16x8 yb = *(const LAS bf16x8*)(VT + (16 * nt + r16) * TS64 + ks * 64 + q * 16); cst[nt] = __builtin_amdgcn_mfma_f32_16x16x32_bf16(xa[ks], yb, cst[nt], 0, 0, 0); } } }
        LDS_BARRIER();
        { const float wi = sv[128 + t];
            bf16x8 sf[2];
#pragma unroll
            for (int ks = 0; ks < 2; ++ks) sf[ks] = *(const LAS bf16x8*)(SD + t * TS64 + ks * 64 + q * 16);
#pragma unroll
            for (int k = 0; k < 5; ++k) acc[k] = acc[k] * wi;
            { bf16x8 vf[3];
#pragma unroll
              for (int i = 0; i < 12; ++i) {
                  if (i < 10) { const int k = i >> 1, ks = i & 1; const int mt = (k < 4) ? 4 * hf + k : 8; vf[i % 3] = *(const LAS bf16x8*)(VT + (16 * mt + r16) * TS64 + ks * 64 + q * 16); }
                  __builtin_amdgcn_sched_barrier(0);
                  if (i >= 2) { const int j = i - 2; acc[j >> 1] = __builtin_amdgcn_mfma_f32_16x16x32_bf16(vf[j % 3], sf[j & 1], acc[j >> 1], 0, 0, 0); }
                  __builtin_amdgcn_sched_barrier(0); } }
            const float den = __shfl(acc[4][0], r16);
            const float inv = __builtin_amdgcn_rcpf(fmaxf(fabsf(den), sv[192 + t]));
#pragma unroll
            for (int k = 0; k < 4; ++k) *(LAS f32x4*)(HB + t * 132 + 16 * (4 * hf + k) + 4 * q) = acc[k] * inv; }
        LDS_BARRIER();
        { bf16* Y = (bf16*)(F.ws + WS_OA);
            f32x4 x[4]; float s = 0.f;
#pragma unroll
            for (int i = 0; i < 4; ++i) { x[i] = *(const LAS f32x4*)(HB + tr * 132 + 16 * part + 4 * i); s += (x[i][0] + x[i][1]) + (x[i][2] + x[i][3]); }
            s = row8_sum(s);
            const float mu = s * (1.f / 128.f); float v = 0.f;
#pragma unroll
            for (int i = 0; i < 4; ++i) { x[i] = x[i] - mu; v += dot4(x[i], x[i]); }
            v = row8_sum(v);
            const float rs = frsq(v * (1.f / 128.f) + EPS);
            const LAS f32x4* gp = (const LAS f32x4*)(cwl + 5120 + h * 128 + 16 * part);
#pragma unroll
            for (int hh = 0; hh < 2; ++hh) { const v4u ow = hh ? ow1 : ow0; const f32x4 g0 = gp[2 * hh], g1 = gp[2 * hh + 1]; const f32x4 a0 = x[2 * hh] * rs * g0, a1 = x[2 * hh + 1] * rs * g1; v4u o;
                o.x = pk2(a0[0] * fsigmoid(bflo(ow.x)), a0[1] * fsigmoid(bfhi(ow.x))); o.y = pk2(a0[2] * fsigmoid(bflo(ow.y)), a0[3] * fsigmoid(bfhi(ow.y)));
                o.z = pk2(a1[0] * fsigmoid(bflo(ow.z)), a1[1] * fsigmoid(bfhi(ow.z))); o.w = pk2(a1[2] * fsigmoid(bflo(ow.w)), a1[3] * fsigmoid(bfhi(ow.w)));
                *(GAS v4u*)(Y + orow * 1024 + 512 + h * 128 + 16 * part + 8 * hh) = o; } }
        LDS_BARRIER();
    }
    }
    WG_SYNC();
}

typedef float f32x16 __attribute__((ext_vector_type(16)));
__device__ __forceinline__ void xattn_unit(Frame& F, int rt, int h) {
    const int lane = lane_now(), wave = F.wave;
    const bf16* XQ = (const bf16*)(F.ws + WS_XQ); bf16* XO = (bf16*)(F.ws + WS_XO);
    const int r32 = lane & 31, hi = lane >> 5; const int b = (rt * 256) / SEQ; const size_t row0 = (size_t)rt * 256 + wave * 32;
    const bf16* qrow = XQ + (row0 + r32) * D + h * 256 + hi * 8;
    const bf16* Kg = (const bf16*)(F.ws + WS_MK) + (size_t)(b * MEMLEN) * D + h * 256;
    const bf16* Vg = (const bf16*)(F.ws + WS_MVT2) + (size_t)(h * 256) * MROWS + b * MEMLEN;
    LAS unsigned char* KB = F.lds; LAS unsigned char* VB = F.lds + 65536;
#define XA_KSRC(i) (Kg + (size_t)(2 * (4 * wave + (i)) + (lane >> 5)) * D + (((lane & 31) ^ ((2 * (4 * wave + (i)) + (lane >> 5)) & 15)) * 8))
#define XA_VSRC(i) (Vg + (size_t)(8 * (2 * wave + (i)) + (lane >> 3)) * MROWS + (((lane & 7) ^ (((8 * (2 * wave + (i)) + (lane >> 3)) >> 1) & 7)) * 8))
    const bf16* ks0 = XA_KSRC(0); const bf16* ks1 = XA_KSRC(1); const bf16* ks2 = XA_KSRC(2); const bf16* ks3 = XA_KSRC(3); const bf16* vs0 = XA_VSRC(0); const bf16* vs1 = XA_VSRC(1);
#define XA_ISSUE(step) do { const int kt_ = (step) & 3, hv_ = (step) >> 2, bf_ = (step) & 1, vf_ = (step) % 3; const size_t ko_ = (size_t)kt_ * 64 * D, vo_ = (size_t)hv_ * 128 * MROWS + kt_ * 64; \
        __builtin_amdgcn_global_load_lds((const unsigned*)(ks0 + ko_), (LAS unsigned*)(KB + bf_ * 32768 + (4 * wave + 0) * 1024), 16, 0, 0); \
        __builtin_amdgcn_global_load_lds((const unsigned*)(ks1 + ko_), (LAS unsigned*)(KB + bf_ * 32768 + (4 * wave + 1) * 1024), 16, 0, 0); \
        __builtin_amdgcn_global_load_lds((const unsigned*)(ks2 + ko_), (LAS unsigned*)(KB + bf_ * 32768 + (4 * wave + 2) * 1024), 16, 0, 0); \
        __builtin_amdgcn_global_load_lds((const unsigned*)(ks3 + ko_), (LAS unsigned*)(KB + bf_ * 32768 + (4 * wave + 3) * 1024), 16, 0, 0); \
        __builtin_amdgcn_global_load_lds((const unsigned*)(vs0 + vo_), (LAS unsigned*)(VB + vf_ * 16384 + (2 * wave + 0) * 1024), 16, 0, 0); \
        __builtin_amdgcn_global_load_lds((const unsigned*)(vs1 + vo_), (LAS unsigned*)(VB + vf_ * 16384 + (2 * wave + 1) * 1024), 16, 0, 0); } while (0)
#define XA_PV(step_) do { const unsigned vbase_ = (unsigned)(uintptr_t)(VB + ((step_) % 3) * 16384) + 8 * hi; u32x2 vf[3][2]; \
        _Pragma("unroll") for (int i = 0; i < 18; ++i) { \
            if (i < 16) { const int mt = i >> 2, st = i & 3; const int dv = 32 * mt + r32; const unsigned vr = vbase_ + dv * 128; const int sw = (dv >> 1) & 7; \
                asm volatile("ds_read_b64 %0, %1" : "=v"(vf[i % 3][0]) : "v"(vr + (((2 * st) ^ sw) * 16)) : "memory"); asm volatile("ds_read_b64 %0, %1" : "=v"(vf[i % 3][1]) : "v"(vr + (((2 * st + 1) ^ sw) * 16)) : "memory"); } \
            if (i >= 2) { if (i < 16) asm volatile("s_waitcnt lgkmcnt(4)" ::: "memory"); else if (i == 16) asm volatile("s_waitcnt lgkmcnt(2)" ::: "memory"); else asm volatile("s_waitcnt lgkmcnt(0)" ::: "memory"); } \
            __builtin_amdgcn_sched_barrier(0); \
            if (i >= 2) { const int j = i - 2; u32x4 w; w.x = vf[j % 3][0].x; w.y = vf[j % 3][0].y; w.z = vf[j % 3][1].x; w.w = vf[j % 3][1].y; \
                o[j >> 2] = __builtin_amdgcn_mfma_f32_32x32x16_bf16(__builtin_bit_cast(bf16x8, w), pf[j & 3], o[j >> 2], 0, 0, 0); } \
            __builtin_amdgcn_sched_barrier(0); } } while (0)
#define XA_FINISH(hv_) do { { auto rr = __builtin_amdgcn_permlane32_swap(__float_as_uint(l), __float_as_uint(l), false, false); l = __uint_as_float(rr[0]) + __uint_as_float(rr[1]); } \
        const float inv = __builtin_amdgcn_rcpf(l); bf16* orow = XO + (row0 + r32) * D + h * 256 + (hv_) * 128; \
        _Pragma("unroll") for (int mt = 0; mt < 4; ++mt) _Pragma("unroll") for (int a = 0; a < 2; ++a) { const int b2 = a + 2; \
            const unsigned x0 = pk2(o[mt][4 * a] * inv, o[mt][4 * a + 1] * inv), x1 = pk2(o[mt][4 * a + 2] * inv, o[mt][4 * a + 3] * inv); \
            const unsigned y0 = pk2(o[mt][4 * b2] * inv, o[mt][4 * b2 + 1] * inv), y1 = pk2(o[mt][4 * b2 + 2] * inv, o[mt][4 * b2 + 3] * inv); \
            auto s0_ = __builtin_amdgcn_permlane32_swap(y0, x0, false, false); auto s1_ = __builtin_amdgcn_permlane32_swap(y1, x1, false, false); \
            u32x4 w; w.x = s0_[0]; w.y = s1_[0]; w.z = s0_[1]; w.w = s1_[1]; *(GAS u32x4*)(orow + 32 * mt + 8 * (hi ? a : b2)) = w; } \
        _Pragma("unroll") for (int i = 0; i < 4; ++i) o[i] = (f32x16){}; l = 0.f; mx = -INFINITY; } while (0)
    XA_ISSUE(0);
    bf16x8 qf[16];
#pragma unroll
    for (int ks = 0; ks < 16; ++ks) qf[ks] = __builtin_nontemporal_load((const GAS bf16x8*)(qrow + ks * 16));
    const bool lag = wave >= 4;
    f32x16 o[4];
#pragma unroll
    for (int i = 0; i < 4; ++i) o[i] = (f32x16){};
    float mx = -INFINITY, l = 0.f; bf16x8 pf[4];
#pragma unroll
    for (int i = 0; i < 4; ++i) pf[i] = (bf16x8){};
    for (int step = 0; step < 8; ++step) {
        asm volatile("s_waitcnt vmcnt(0)" ::: "memory"); WG_SYNC();
        if (step < 7) XA_ISSUE(step + 1);
        if (lag && step > 0) { XA_PV(step - 1); if (step == 4) XA_FINISH(0); }
        const LAS unsigned char* kb = KB + (step & 1) * 32768;
        f32x16 s0 = (f32x16){}, s1 = (f32x16){};
        { bf16x8 kf[2][2];
          const unsigned kaddr0 = (unsigned)(uintptr_t)(kb + r32 * 512), kaddr1 = kaddr0 + 32 * 512;
#define XA_KRD(ks_) do { const unsigned pos_ = (unsigned)(((2 * (ks_) + hi) ^ (r32 & 15)) * 16); \
              asm volatile("ds_read_b128 %0, %1" : "=v"(kf[(ks_) & 1][0]) : "v"(kaddr0 + pos_) : "memory"); asm volatile("ds_read_b128 %0, %1" : "=v"(kf[(ks_) & 1][1]) : "v"(kaddr1 + pos_) : "memory"); } while (0)
          XA_KRD(0);
#pragma unroll
          for (int ks = 0; ks < 16; ++ks) {
              if (ks < 15) { XA_KRD(ks + 1); asm volatile("s_waitcnt lgkmcnt(2)" ::: "memory"); } else asm volatile("s_waitcnt lgkmcnt(0)" ::: "memory");
              __builtin_amdgcn_sched_barrier(0);
              s0 = __builtin_amdgcn_mfma_f32_32x32x16_bf16(kf[ks & 1][0], qf[ks], s0, 0, 0, 0); s1 = __builtin_amdgcn_mfma_f32_32x32x16_bf16(kf[ks & 1][1], qf[ks], s1, 0, 0, 0);
              __builtin_amdgcn_sched_barrier(0); }
#undef XA_KRD
        }
        float tm = fmaxf(s0[0], s1[0]);
#pragma unroll
        for (int r = 1; r < 16; ++r) tm = fmaxf(tm, fmaxf(s0[r], s1[r]));
        { auto rr = __builtin_amdgcn_permlane32_swap(__float_as_uint(tm), __float_as_uint(tm), false, false); tm = fmaxf(__uint_as_float(rr[0]), __uint_as_float(rr[1])); }
        float mn = mx;
        if (__any(tm > mx + 8.0f)) { mn = fmaxf(mx, tm); const float alpha = __builtin_amdgcn_exp2f(mx - mn); l *= alpha;
#pragma unroll
            for (int i = 0; i < 4; ++i) o[i] = o[i] * alpha; }
        mx = mn;
        float ps = 0.f;
#pragma unroll
        for (int r = 0; r < 16; ++r) { s0[r] = __builtin_amdgcn_exp2f(s0[r] - mn); s1[r] = __builtin_amdgcn_exp2f(s1[r] - mn); ps += s0[r] + s1[r]; }
        l += ps;
#pragma unroll
        for (int kk = 0; kk < 2; ++kk) { u32x4 w0, w1;
            w0.x = pk2(s0[8 * kk + 0], s0[8 * kk + 1]); w0.y = pk2(s0[8 * kk + 2], s0[8 * kk + 3]); w0.z = pk2(s0[8 * kk + 4], s0[8 * kk + 5]); w0.w = pk2(s0[8 * kk + 6], s0[8 * kk + 7]);
            w1.x = pk2(s1[8 * kk + 0], s1[8 * kk + 1]); w1.y = pk2(s1[8 * kk + 2], s1[8 * kk + 3]); w1.z = pk2(s1[8 * kk + 4], s1[8 * kk + 5]); w1.w = pk2(s1[8 * kk + 6], s1[8 * kk + 7]);
            pf[kk] = __builtin_bit_cast(bf16x8, w0); pf[2 + kk] = __builtin_bit_cast(bf16x8, w1); }
        if (!lag) { XA_PV(step); if (step == 3) XA_FINISH(0); }
    }
    if (lag) XA_PV(7);
    XA_FINISH(1);
#undef XA_ISSUE
#undef XA_KSRC
#undef XA_VSRC
#undef XA_PV
#undef XA_FINISH
    WG_SYNC();
}

constexpr int R_WH = 0, R_STRIDE = 2064, R_WL = 36 * R_STRIDE, R_CH = 72 * R_STRIDE, R_LCNT = R_CH + 4096, R_LBASE = R_LCNT + 128, R_EL = R_LBASE + 128;
static_assert(R_EL + 4096 <= LDSCTL_OFF, "router LDS");
__device__ __forceinline__ void p9_router(Frame& F) {
    const int lane = lane_now(), wave = F.wave, tid = wave * 64 + lane;
    LAS unsigned char* L = F.lds;
    LAS int* CH = (LAS int*)(L + R_CH); LAS int* LCNT = (LAS int*)(L + R_LCNT); LAS int* LBASE = (LAS int*)(L + R_LBASE); LAS float* EL = (LAS float*)(L + R_EL) + wave * 128;
    const bf16* x2 = (const bf16*)(F.ws + WS_XB); float* rstd2 = (float*)(F.ws + WS_RSTD2);
    const int rpb = (M + F.G - 1) / F.G; const int r0 = F.vcu * rpb; const int r1 = (r0 + rpb < M) ? r0 + rpb : M;
    const int r16 = lane & 15, q = lane >> 4;
    int base = r0 + wave * 16;
    bf16x8 xf[32];
#define R9_LOADROW() do { const int m_ = base + r16; const bf16* xr_ = x2 + (size_t)((m_ < r1) ? m_ : r0) * D + 8 * q; _Pragma("unroll") for (int j = 0; j < 32; ++j) xf[j] = *(const GAS bf16x8*)(xr_ + j * 32); } while (0)
    if (base < r1 && base - r0 < 128) R9_LOADROW();
    { const GAS v4u* rtg = (const GAS v4u*)(F.ws + WS_RT);
#pragma unroll
      for (int i = 0; i < 18; ++i) { const int id = tid + 512 * i, row = id >> 7, c = id & 127; *(LAS v4u*)(L + row * R_STRIDE + c * 16) = rtg[id]; } }
    if (tid < 32) LCNT[tid] = 0;
    WG_SYNC();
    for (; base < r1 && base - r0 < 128; base += NWAVES * 16) {
        const int m = base + r16; const bool live = m < r1;
        f32x4 acc0 = {0.f, 0.f, 0.f, 0.f}, acc1 = acc0, acc2 = acc0; float ss = 0.f;
#pragma unroll
        for (int ks = 0; ks < 32; ++ks) { const int ko = ks * 64 + q * 16;
                const bf16x8 h0 = *(const LAS bf16x8*)(L + R_WH + r16 * R_STRIDE + ko), h1 = *(const LAS bf16x8*)(L + R_WH + (16 + r16) * R_STRIDE + ko), h2 = *(const LAS bf16x8*)(L + R_WH + (32 + (r16 & 3)) * R_STRIDE + ko);
                const bf16x8 l0 = *(const LAS bf16x8*)(L + R_WL + r16 * R_STRIDE + ko), l1 = *(const LAS bf16x8*)(L + R_WL + (16 + r16) * R_STRIDE + ko), l2 = *(const LAS bf16x8*)(L + R_WL + (32 + (r16 & 3)) * R_STRIDE + ko);
                acc0 = __builtin_amdgcn_mfma_f32_16x16x32_bf16(h0, xf[ks], acc0, 0, 0, 0); acc1 = __builtin_amdgcn_mfma_f32_16x16x32_bf16(h1, xf[ks], acc1, 0, 0, 0); acc2 = __builtin_amdgcn_mfma_f32_16x16x32_bf16(h2, xf[ks], acc2, 0, 0, 0);
                acc0 = __builtin_amdgcn_mfma_f32_16x16x32_bf16(l0, xf[ks], acc0, 0, 0, 0); acc1 = __builtin_amdgcn_mfma_f32_16x16x32_bf16(l1, xf[ks], acc1, 0, 0, 0); acc2 = __builtin_amdgcn_mfma_f32_16x16x32_bf16(l2, xf[ks], acc2, 0, 0, 0);
                const u32x4 xw = __builtin_bit_cast(u32x4, xf[ks]);
                const float a0 = bflo(xw.x), a1 = bfhi(xw.x), a2 = bflo(xw.y), a3 = bfhi(xw.y), a4 = bflo(xw.z), a5 = bfhi(xw.z), a6 = bflo(xw.w), a7 = bfhi(xw.w);
                ss += ((a0 * a0 + a1 * a1) + (a2 * a2 + a3 * a3)) + ((a4 * a4 + a5 * a5) + (a6 * a6 + a7 * a7));
                __builtin_amdgcn_sched_barrier(0); }
        { const int nb_ = base + NWAVES * 16; if (nb_ < r1 && nb_ - r0 < 128) { base = nb_; R9_LOADROW(); base -= NWAVES * 16; } }
        { auto r_ = __builtin_amdgcn_permlane16_swap(__float_as_uint(ss), __float_as_uint(ss), false, false); ss = __uint_as_float(r_[0]) + __uint_as_float(r_[1]); }
        { auto r_ = __builtin_amdgcn_permlane32_swap(__float_as_uint(ss), __float_as_uint(ss), false, false); ss = __uint_as_float(r_[0]) + __uint_as_float(r_[1]); }
        const float gl0 = __shfl(acc2[0], r16), gl1 = __shfl(acc2[1], r16), gl2 = __shfl(acc2[2], r16), gl3 = __shfl(acc2[3], r16);
        const float rstd = frsq(ss * (1.f / D) + EPS);
        const float g0 = gl0 * rstd + F.in[19][0], g1 = gl1 * rstd + F.in[19][1], g2 = gl2 * rstd + F.in[19][2], g3 = gl3 * rstd + F.in[19][3];
        int gi = 0; float gm = g0; if (g1 > gm) { gm = g1; gi = 1; } if (g2 > gm) { gm = g2; gi = 2; } if (g3 > gm) { gm = g3; gi = 3; }
        const float g_w = __builtin_amdgcn_rcpf(fexp(g0 - gm) + fexp(g1 - gm) + fexp(g2 - gm) + fexp(g3 - gm));
        if ((q >> 1) == (gi & 1)) { const f32x4 a = (gi >> 1) ? acc1 : acc0; const GAS f32x4* bp = (const GAS f32x4*)(F.in[21] + gi * 8 + 4 * (q & 1));
            *(LAS f32x4*)(EL + r16 * 8 + 4 * (q & 1)) = a * rstd + *bp; }
        asm volatile("s_waitcnt lgkmcnt(0)" ::: "memory");
        if (q == 0 && live) { const f32x4 ea = *(const LAS f32x4*)(EL + r16 * 8), eb = *(const LAS f32x4*)(EL + r16 * 8 + 4);
            float el[8] = {ea.x, ea.y, ea.z, ea.w, eb.x, eb.y, eb.z, eb.w};
            int i0 = 0; float m0 = el[0];
#pragma unroll
            for (int n = 1; n < 8; ++n) if (el[n] > m0) { m0 = el[n]; i0 = n; }
            int i1 = (i0 + 1) & 7; float m1 = -INFINITY;
#pragma unroll
            for (int n = 0; n < 8; ++n) if (n != i0 && el[n] > m1) { m1 = el[n]; i1 = n; }
            const float p1r = fexp(m1 - m0); const float w0 = g_w * __builtin_amdgcn_rcpf(1.f + p1r), w1 = w0 * p1r;
            const int e0 = gi * 8 + i0, e1 = gi * 8 + i1; const int lr0 = atomicAdd((int*)&LCNT[e0], 1), lr1 = atomicAdd((int*)&LCNT[e1], 1);
            LAS int* c = CH + (m - r0) * 8; c[0] = e0; c[1] = e1; c[2] = lr0; c[3] = lr1; c[4] = __float_as_int(w0); c[5] = __float_as_int(w1);
            rstd2[m] = rstd; }
        asm volatile("s_waitcnt lgkmcnt(0)" ::: "memory");
    }
    WG_SYNC();
    if (tid < 32) LBASE[tid] = (int)atomicAdd((unsigned*)(F.ctl + CW_CNT + tid), (unsigned)LCNT[tid]);
    WG_SYNC();
    int* tokl = (int*)(F.ws + WS_TOKL); int* asg = (int*)(F.ws + WS_ASG);
    for (int r = tid; r < r1 - r0; r += NWAVES * 64) { const LAS int* c = CH + r * 8; const int m = r0 + r;
        const int e0 = c[0], e1 = c[1], k0 = LBASE[e0] + c[2], k1 = LBASE[e1] + c[3];
        tokl[(size_t)e0 * M + k0] = m; tokl[(size_t)e1 * M + k1] = m;
        asg[m * 8 + 0] = e0; asg[m * 8 + 1] = k0; asg[m * 8 + 2] = e1; asg[m * 8 + 3] = k1; asg[m * 8 + 4] = c[4]; asg[m * 8 + 5] = c[5]; }
}

template <bool GATHER> __device__ __forceinline__ int expert_tables(Frame& F) {
    const int lane = lane_now(), wave = F.wave, tid = wave * 64 + lane; (void)tid; (void)lane; (void)wave;
    LAS int* TS = (LAS int*)(F.lds + XT_TS); LAS int* TOK = (LAS int*)(F.lds + XT_TOK);
    if (tid == 0) { int acc = 0; for (int e = 0; e < 32; ++e) { TS[e] = acc; acc += ((int)F.ctl[CW_CNT + e] + 255) >> 8; } TS[32] = acc; }
    WG_SYNC();
    const int ntiles = TS[32];
    if (GATHER) { const int* tokl = (const int*)(F.ws + WS_TOKL);
        for (int ui = 0; ui < 5; ++ui) { const int L = ui * F.G + (int)blockIdx.x; if (L >= 4 * ntiles) break;
            const int rt = L >> 2; int e = 0; for (int k = 1; k < 32; ++k) e += (TS[k] <= rt) ? 1 : 0;
            const int cnt = (int)F.ctl[CW_CNT + e];
            if (tid < 256) { const int rank = (rt - TS[e]) * 256 + tid; const int tk = (rank < cnt) ? tokl[(size_t)e * M + rank] : 0; TOK[ui * 256 + tid] = tk; ((LAS float*)(F.lds + XT_RS))[ui * 256 + tid] = ((const float*)(F.ws + WS_RSTD2))[tk]; } }
        WG_SYNC(); }
    return ntiles;
}

__device__ __forceinline__ void p12_final(Frame& F) {
    const int lane = lane_now(), wave = F.wave, tid = wave * 64 + lane;
    LAS int* TS = (LAS int*)(F.lds + XT_TS);
    if (tid == 0) { int acc = 0; for (int e = 0; e < 32; ++e) { TS[e] = acc; acc += ((int)F.ctl[CW_CNT + e] + 255) >> 8; } TS[32] = acc; }
    WG_SYNC();
    const int gw = F.vcu * NWAVES + wave, NGW = F.G * NWAVES; const GAS v4u* asg = (const GAS v4u*)(F.ws + WS_ASG); const bf16* YE = (const bf16*)(F.ws + WS_YE); const bf16* XB = (const bf16*)(F.ws + WS_XB);
    const GAS f32x4* gr = (const GAS f32x4*)F.in[25] + 2 * lane; const f32x4 g0 = gr[0], g1 = gr[1], g2 = gr[128], g3 = gr[129];
    v4u a0 = (v4u){0u, 0u, 0u, 0u}, a1 = a0; v4u rx[2], ry0[2], ry1[2]; float cw0 = 0.f, cw1 = 0.f;
#define P12_ROWS(m_, A0, A1) do { const size_t p0_ = (size_t)TS[(A0).x & 31] * 256 + (A0).y, p1_ = (size_t)TS[(A0).z & 31] * 256 + (A0).w; \
        const GAS v4u* xr_ = (const GAS v4u*)(XB + (size_t)(m_) * D) + lane; const GAS v4u* y0_ = (const GAS v4u*)(YE + p0_ * D) + lane; const GAS v4u* y1_ = (const GAS v4u*)(YE + p1_ * D) + lane; \
        rx[0] = __builtin_nontemporal_load(xr_); rx[1] = __builtin_nontemporal_load(xr_ + 64); ry0[0] = __builtin_nontemporal_load(y0_); ry0[1] = __builtin_nontemporal_load(y0_ + 64); ry1[0] = __builtin_nontemporal_load(y1_); ry1[1] = __builtin_nontemporal_load(y1_ + 64); cw0 = __uint_as_float((A1).x); cw1 = __uint_as_float((A1).y); } while (0)
    int m = gw;
    if (m < M) { a0 = asg[2 * m]; a1 = asg[2 * m + 1]; P12_ROWS(m, a0, a1); if (m + NGW < M) { a0 = asg[2 * (m + NGW)]; a1 = asg[2 * (m + NGW) + 1]; } }
    for (; m < M; m += NGW) {
        const float w0 = cw0, w1 = cw1; f32x4 v[4]; float s = 0.f;
#pragma unroll
        for (int hh = 0; hh < 2; ++hh) { const v4u x = rx[hh], a = ry0[hh], c = ry1[hh];
            v[2 * hh] = (f32x4){bflo(x.x) + w0 * bflo(a.x) + w1 * bflo(c.x), bfhi(x.x) + w0 * bfhi(a.x) + w1 * bfhi(c.x), bflo(x.y) + w0 * bflo(a.y) + w1 * bflo(c.y), bfhi(x.y) + w0 * bfhi(a.y) + w1 * bfhi(c.y)};
            v[2 * hh + 1] = (f32x4){bflo(x.z) + w0 * bflo(a.z) + w1 * bflo(c.z), bfhi(x.z) + w0 * bfhi(a.z) + w1 * bfhi(c.z), bflo(x.w) + w0 * bflo(a.w) + w1 * bflo(c.w), bfhi(x.w) + w0 * bfhi(a.w) + w1 * bfhi(c.w)};
            s += dot4(v[2 * hh], v[2 * hh]) + dot4(v[2 * hh + 1], v[2 * hh + 1]); }
        if (m + NGW < M) { P12_ROWS(m + NGW, a0, a1); if (m + 2 * NGW < M) { a0 = asg[2 * (m + 2 * NGW)]; a1 = asg[2 * (m + 2 * NGW) + 1]; } }
        const float rstd = frsq(wave_sum(s) * (1.f / D) + EPS);
        GAS f32x4* orow = (GAS f32x4*)(F.out + (size_t)m * D) + 2 * lane;
        __builtin_nontemporal_store(v[0] * rstd * g0, orow); __builtin_nontemporal_store(v[1] * rstd * g1, orow + 1); __builtin_nontemporal_store(v[2] * rstd * g2, orow + 128); __builtin_nontemporal_store(v[3] * rstd * g3, orow + 129);
    }
#undef P12_ROWS
}

struct Args { const float* in[26]; float* out; unsigned char* ws; int ph_lo, ph_hi, li, sub; };
__global__ void __launch_bounds__(NWAVES * 64, 2) mk_fwd(Args args) {
    extern __shared__ __attribute__((aligned(16))) unsigned char lds[];
    Frame F;
    F.lds = (LAS unsigned char*)lds;
    F.MISC = (volatile LAS unsigned*)(F.lds + MISC_OFF);
    F.wave = __builtin_amdgcn_readfirstlane((int)threadIdx.x >> 6);
    F.G = gridDim.x; { const int bx = blockIdx.x; F.vcu = (F.G % 8 == 0) ? (bx % 8) * (F.G / 8) + bx / 8 : bx; }
    unsigned char* ws = args.ws; F.ws = ws; F.out = args.out;
    F.ctl = (gu32*)(ws + WS_CTL);
#pragma unroll
    for (int i = 0; i < 26; ++i) F.in[i] = args.in[i];
    for (int u = (int)threadIdx.x; u < (LDS_BYTES - LDSCTL_OFF) / 4; u += NWAVES * 64) ((LAS unsigned*)(F.lds + LDSCTL_OFF))[u] = 0u;
    __syncthreads();
    XcdBarrier bar; bar.bar = (unsigned*)(F.ctl + CW_BAR) + args.li * XCD_BAR_WORDS; bar.x = 0; bar.st = nullptr;
    if (N_LAUNCHES != NPHASE) bar = xcd_barrier_post((unsigned*)(F.ctl + CW_BAR) + args.li * XCD_BAR_WORDS, F.MISC + 8);
#define GRID_BAR(seam) do { if (N_LAUNCHES == NPHASE) { if (F.wave == 0 && lane_now() == 0) __hip_atomic_store(F.ctl + CW_TMO, 0xBADBA0u | (unsigned)(seam), RLX_AGENT); } else { xcd_barrier(bar, F.wave); } } while (0)
    const int lo = args.ph_lo, hi = args.ph_hi;
#ifndef PHASE_MASK
#define PHASE_MASK 0x1FFF
#endif
#define IN(k) (((PHASE_MASK >> (k)) & 1) && lo <= (k) && (k) < hi)
#define BOTH(k) (IN(k) && IN((k) + 1))
    bf16* Hb = (bf16*)F.out;
    bf16* PROJ = (bf16*)(ws + WS_PROJ);

    if (IN(0)) { p0_prologue(F); if (BOTH(0)) GRID_BAR(0); }

    if (IN(1)) {
        const int sub = args.sub;
        if (sub & 1) {
        if (blockIdx.x < 32) gate_scan(F, (int)blockIdx.x);
        { pg8::Gemm g{Hb, (const bf16*)(ws + WS_WIN), M, NPROJ, D}; pg8::StaticOrder S; S.init(M, NPROJ, F.G, (int)blockIdx.x);
          pg8::EpiProj E{PROJ, NPROJ, (const float*)(ws + WS_ROPE), attn_body::C2};
          pg8::gemm_phase<pg8::EpiProj, pg8::StaticOrder, PG8_ALIGN, PG8_SP2>(F.lds + RING_OFF, g, S, E, F.wave); }
        { pg8::Gemm g{(const bf16*)(ws + WS_WIN) + (size_t)NPROJ * D, Hb, 512, M, D}; pg8::StaticOrder S; S.init(512, M, F.G, (int)blockIdx.x);
          pg8::EpiBf16<0> E{(bf16*)(ws + WS_MVT), M, nullptr, 0, 0, 1.f};
          pg8::gemm_phase<pg8::EpiBf16<0>, pg8::StaticOrder, PG8_ALIGN, PG8_SP2>(F.lds + RING_OFF, g, S, E, F.wave); } }
        if (BOTH(1)) GRID_BAR(1);
    }

    if (IN(2)) {
        if (args.sub & 4) { stage_convw(F); m1g_phase(F); }
        const float* lv = F.in[5]; const int ln_ = lane_now();
        const float lam = expf(wave_sum(lv[ln_] * lv[64 + ln_])) - expf(wave_sum(lv[128 + ln_] * lv[192 + ln_])) + LAM_INIT;
        const attn_body::AttnTensors AT{(const attn_body::bf16*)(PROJ + C_DQ), (const attn_body::bf16*)(PROJ + C_DK), (const attn_body::bf16*)(PROJ + C_DV), (attn_body::bf16*)(ws + WS_OA), lam, 1.0f - LAM_INIT, EPS, F.in[6]};
        const attn_body::StaticOrder S((int)F.G, F.vcu);
        if (args.sub & 8) attn_body::attn_phase<attn_body::StaticOrder>((char*)lds + RING_OFF, AT, S, F.wave);
        if (BOTH(2)) GRID_BAR(2);
    }

    if (IN(3)) {
        if (args.sub & 2) {
        if (blockIdx.x < 64) { pg8::Gemm g{(const bf16*)(ws + WS_MEMN), (const bf16*)(ws + WS_WKV), MROWS, 2 * D, D}; pg8::StaticOrder S; S.init(MROWS, 2 * D, 64, (int)blockIdx.x);
          pg8::EpiBf16<0> E{(bf16*)(ws + WS_MK), D, nullptr, D, (size_t)MROWS * D, 1.f};
          pg8::gemm_phase<pg8::EpiBf16<0>, pg8::StaticOrder, PG8_ALIGN, PG8_SP2>(F.lds + RING_OFF, g, S, E, F.wave); } }
        if (blockIdx.x >= 64 || F.G < 128) p3_scan_combine(F, args.sub & ~32, (F.G < 128) ? 0 : 64);
        if (F.G >= 128) { if (blockIdx.x >= 64) w2_items(F, (int)blockIdx.x - 64, (int)F.G - 64); } else w2_items(F, (int)blockIdx.x, (int)F.G);
        if (BOTH(3)) GRID_BAR(3); }

    if (IN(4)) { stage_convw(F); m3_phase(F); if (BOTH(4)) GRID_BAR(4); }

    if (IN(5)) {
        pg8::Gemm g{(const bf16*)(ws + WS_OA), (const bf16*)(ws + WS_WOUT), M, D, D};
        pg8::OutFoldOrder S; S.main.init(M, D, F.G, (int)blockIdx.x); S.G = (int)F.G; S.c = (int)blockIdx.x;
        S.fold = pg8::FoldOrder{(int)F.G, (int)blockIdx.x, (const bf16*)(ws + WS_MK), (const bf16*)(ws + WS_MVT2), (const bf16*)(ws + WS_WXQ), (const bf16*)(ws + WS_WXO)};
        pg8::EpiResidFold E{pg8::EpiResid<true, true>{F.in[0], nullptr, (bf16*)(ws + WS_XB), (float*)(F.ctl + CW_ROWSS), D}, pg8::EpiBf16<0>{(bf16*)(ws + WS_FOLD), D, nullptr, 0, 0, 1.f}};
        pg8::gemm_phase<pg8::EpiResidFold, pg8::OutFoldOrder, PG8_ALIGN, PG8_SP2>(F.lds + RING_OFF, g, S, E, F.wave);
        if (BOTH(5)) GRID_BAR(5);
    }

    if (IN(6)) {
        pg8::Gemm g{(const bf16*)(ws + WS_XB), (const bf16*)(ws + WS_FOLD), M, D, D}; pg8::BatchBOrder S; S.init(M, D, F.G, (int)blockIdx.x); S.bstride = (size_t)D * D * 2; S.tpb = SEQ / 256;
        pg8::EpiSoftmaxP E{(bf16*)(ws + WS_XQ), D, (const float*)(F.ctl + CW_ROWSS), EPS, XSCALE, (LAS float*)(F.lds + XT_TS)};
        pg8::gemm_phase<pg8::EpiSoftmaxP, pg8::BatchBOrder, PG8_ALIGN, PG8_SP2>(F.lds + RING_OFF, g, S, E, F.wave);
        if (BOTH(6)) GRID_BAR(6);
    }


    if (IN(8)) {
        pg8::Gemm g{(const bf16*)(ws + WS_XQ), (const bf16*)(ws + WS_FOLD) + (size_t)8192 * D, M, D, D}; pg8::BatchBOrder S; S.init(M, D, F.G, (int)blockIdx.x); S.bstride = (size_t)D * D * 2; S.tpb = SEQ / 256;
        pg8::EpiResid<false, false> E{nullptr, (const bf16*)(ws + WS_XB), (bf16*)(ws + WS_XB), nullptr, D};
        pg8::gemm_phase<pg8::EpiResid<false, false>, pg8::BatchBOrder, PG8_ALIGN, PG8_SP2>(F.lds + RING_OFF, g, S, E, F.wave);
        if (BOTH(8)) GRID_BAR(8);
    }

    if (IN(9)) { p9_router(F); if (BOTH(9)) GRID_BAR(9); }

    if (IN(10) || IN(11)) {
        const int ntiles = IN(10) ? expert_tables<true>(F) : expert_tables<false>(F);
        const int nU = 4 * ntiles, nA = (nU / (int)F.G) * (int)F.G, Lf = nU - nA, c = (int)blockIdx.x;
        const int Nb = (Lf > 0 && IN(10) && IN(11)) ? ((2 * ((int)F.G - Lf) < nA) ? 2 * ((int)F.G - Lf) : nA) : 0;
        const LAS int* TS = (const LAS int*)(F.lds + XT_TS); const LAS int* TOK = (const LAS int*)(F.lds + XT_TOK);
        pg8::Gemm gu{(const bf16*)(ws + WS_XB), (const bf16*)(ws + WS_W13), M, D, D};
        pg8::Gemm gd{(const bf16*)(ws + WS_ACT), (const bf16*)(ws + WS_W2), MAXROWS, D, DEXP};
        pg8::EpiSwiGLU EU{(bf16*)(ws + WS_ACT), DEXP, (const LAS float*)(F.lds + XT_RS)};
        pg8::EpiBf16<0> ED{(bf16*)(ws + WS_YE), D, nullptr, 0, 0, 1.f};
        if (IN(10)) {
            const bool split = IN(11) && Lf > 0;
            pg8::ExpertOrder<true> S{(int)F.G, c, ntiles, TS, TOK, (size_t)D * D * 2, 0, split ? nA : nU, 0};
            pg8::gemm_phase<pg8::EpiSwiGLU, pg8::ExpertOrder<true>, PG8_ALIGN, PG8_SP2>(F.lds + RING_OFF, gu, S, EU, F.wave);
            if (split) { GRID_BAR(10);
                if (c < Lf) { pg8::ExpertOrder<true> S2{(int)F.G, c, ntiles, TS, TOK, (size_t)D * D * 2, 0, nU, nA / (int)F.G};
                    pg8::gemm_phase<pg8::EpiSwiGLU, pg8::ExpertOrder<true>, PG8_ALIGN, PG8_SP2>(F.lds + RING_OFF, gu, S2, EU, F.wave); }
                else { pg8::ExpertOrder<false> S2{(int)F.G - Lf, c - Lf, ntiles, TS, TOK, (size_t)D * DEXP * 2, 0, Nb, 0};
                    pg8::gemm_phase<pg8::EpiBf16<0>, pg8::ExpertOrder<false>, PG8_ALIGN, PG8_SP2>(F.lds + RING_OFF, gd, S2, ED, F.wave); } }
            if (BOTH(10)) GRID_BAR(10);
        }
        if (IN(11)) {
            pg8::ExpertOrder<false> S{(int)F.G, c, ntiles, TS, TOK, (size_t)D * DEXP * 2, Nb, nU, 0};
            pg8::gemm_phase<pg8::EpiBf16<0>, pg8::ExpertOrder<false>, PG8_ALIGN, PG8_SP2>(F.lds + RING_OFF, gd, S, ED, F.wave);
            if (BOTH(11)) GRID_BAR(11);
        }
    }

    if (IN(12)) { p12_final(F); }
#undef IN
#undef BOTH
}

extern "C" void kernel_launch(void* const* d_in, const int* in_sizes, int n_in, void* d_out, int out_size, void* d_ws, size_t ws_size, hipStream_t stream) {
    static int grid = 0;
    if (grid == 0) {
        if (n_in != 26 || in_sizes[0] != M * D || out_size != M * D || ws_size < WS_END) { fprintf(stderr, "kernel_launch: unexpected shapes (n_in %d, in0 %d, out %d, ws %zu); nothing launched\n", n_in, n_in > 0 ? in_sizes[0] : -1, out_size, ws_size); grid = -1; return; }
        int dev = 0, cus = 0, per_cu = 0;
        if (hipGetDevice(&dev) != hipSuccess || hipDeviceGetAttribute(&cus, hipDeviceAttributeMultiprocessorCount, dev) != hipSuccess) { grid = -1; return; }
        if (hipFuncSetAttribute((const void*)mk_fwd, hipFuncAttributeMaxDynamicSharedMemorySize, LDS_BYTES) != hipSuccess) { fprintf(stderr, "kernel_launch: hipFuncSetAttribute failed\n"); grid = -1; return; }
        if (hipOccupancyMaxActiveBlocksPerMultiprocessor(&per_cu, (const void*)mk_fwd, NWAVES * 64, LDS_BYTES) != hipSuccess || per_cu < 1) { fprintf(stderr, "kernel_launch: occupancy query reports %d workgroups per CU\n", per_cu); }
        (void)hipGetLastError();
        grid = cus;
    }
    if (grid < 0) return;
    if (hipMemsetAsync((char*)d_ws + WS_CTL, 0, CTL_ZERO_BYTES, stream) != hipSuccess) return;
    Args a{};
    for (int i = 0; i < 26; ++i) a.in[i] = (const float*)d_in[i];
    a.out = (float*)d_out; a.ws = (unsigned char*)d_ws;
#ifdef PROBE_PRE_MASK
    for (int r = 0; r < PROBE_REP; ++r) for (int k = 0; k < NPHASE; ++k) if ((PROBE_PRE_MASK >> k) & 1) { a.ph_lo = k; a.ph_hi = k + 1; a.li = 1; a.sub = PROBE_SUB;
        hipLaunchKernelGGL(mk_fwd, dim3(grid), dim3(NWAVES * 64), LDS_BYTES, stream, a); }
    if (hipMemsetAsync((char*)d_ws + WS_CTL, 0, CTL_ZERO_BYTES, stream) != hipSuccess) return;
#endif
    for (int li = 0; li < N_LAUNCHES; ++li) {
        a.ph_lo = (N_LAUNCHES == NPHASE) ? li : 0; a.ph_hi = (N_LAUNCHES == NPHASE) ? li + 1 : NPHASE; a.li = 0; a.sub = 0x3F;
        hipLaunchKernelGGL(mk_fwd, dim3(grid), dim3(NWAVES * 64), LDS_BYTES, stream, a);
        if (hipPeekAtLastError() != hipSuccess) break;
    }
#ifdef PROBE_POST_MASK
    for (int r = 0; r < PROBE_REP; ++r) for (int k = 0; k < NPHASE; ++k) if ((PROBE_POST_MASK >> k) & 1) { a.ph_lo = k; a.ph_hi = k + 1; a.li = 1; a.sub = PROBE_SUB;
        hipLaunchKernelGGL(mk_fwd, dim3(grid), dim3(NWAVES * 64), LDS_BYTES, stream, a); }
#endif
}
```

```cpp
#include <hip/hip_runtime.h>
#include <cstdio>
#include <cstdint>
__device__ __forceinline__ int lane_now() { int l; asm volatile("v_mbcnt_lo_u32_b32 %0, -1, 0\n\tv_mbcnt_hi_u32_b32 %0, -1, %0" : "=v"(l)); return l; }
namespace pg8 {
#define PG8_LAS __attribute__((address_space(3)))
typedef unsigned short bf16_t;
typedef short bf16x8 __attribute__((ext_vector_type(8)));
typedef float f32x4 __attribute__((ext_vector_type(4)));
typedef unsigned u32x4 __attribute__((ext_vector_type(4)));
typedef long i64x2_t __attribute__((ext_vector_type(2)));
constexpr int BM = 256, BK = 64, HALF = 128, HTB = HALF * BK * 2  , STAGE_BYTES = 8 * HTB, NXCD = 8, WGM = 8;

__host__ __device__ __forceinline__ int lds_byte(int r, int c) { const int st = (r >> 4) * 2 + (c >> 5), rr = r & 15, cc = c & 31, ob = rr * 64 + cc * 2; return st * 1024 + (ob ^ (((ob >> 9) & 1) << 5)); }
__host__ __device__ __forceinline__ void stage_rc(int b, int& R, int& C) { const int st = b / 1024, sb = b % 1024, swz = sb ^ (((sb >> 9) & 1) << 5); R = (st >> 1) * 16 + swz / 64; C = (st & 1) * 32 + (swz % 64) / 2; }
__host__ __device__ __forceinline__ int perm32(int rho) { const int n = rho >> 4, i = rho & 15; return 8 * (i >> 2) + 4 * n + (i & 3); }

struct Unit { int pm, pn, e, ui; int nt = 0; };
struct Gemm { const bf16_t* A; const bf16_t* Bt; int M, N, K; int kext = 0; };

struct StaticOrder {
    int nM, nN, nwg, G, c;
    __host__ __device__ __forceinline__ void init(int M, int N, int G_, int c_) { nM = M / BM; nN = N / BM; nwg = nM * nN; G = G_; c = c_; }
    __host__ __device__ __forceinline__ bool next(int i, Unit& u) const { const long L = (long)i * G + c; if (L >= nwg) return false; at((int)L, u); u.ui = i; return true; }
    __host__ __device__ __forceinline__ void at(int L, Unit& u) const {
        int wgid = L; { const int q = nwg / NXCD, r = nwg % NXCD, xcd = wgid % NXCD, off = wgid / NXCD; wgid = (xcd < r ? xcd * (q + 1) : r * (q + 1) + (xcd - r) * q) + off; }
        const int nig = WGM * nN, gid = wgid / nig, fm = gid * WGM, gsz = (nM - fm) < WGM ? (nM - fm) : WGM;
        u.pm = fm + ((wgid % nig) % gsz); u.pn = (wgid % nig) / gsz; u.e = 0; u.ui = 0;
    }
    __device__ __forceinline__ const char* aptr(const Gemm& g, const Unit& u, size_t tstep) const { return (const char*)g.A + (size_t)u.pm * tstep; }
    __device__ __forceinline__ const char* bptr(const Gemm& g, const Unit& u, size_t tstep) const { return (const char*)g.Bt + (size_t)u.pn * tstep; }
    __device__ __forceinline__ void avoff(const Unit&, int, const int (&R)[2], const int (&C)[2], int K, unsigned (&vo)[2][2]) const {
#pragma unroll
        for (int h = 0; h < 2; ++h)
#pragma unroll
            for (int i = 0; i < 2; ++i) vo[h][i] = (unsigned)((h * HALF + R[i]) * K + C[i]) * 2u; }
};

__device__ __forceinline__ unsigned cvt_pk_bf16(float lo, float hi) { unsigned r; asm volatile("v_cvt_pk_bf16_f32 %0, %1, %2" : "=v"(r) : "v"(lo), "v"(hi)); return r; }
typedef float f32x2 __attribute__((ext_vector_type(2)));
__device__ __forceinline__ f32x2 gelu_pk(f32x2 v) {
    const f32x2 av = __builtin_elementwise_abs(v), d = av * 0.2316418882f + 1.0f;
    f32x2 t; t.x = __builtin_amdgcn_rcpf(d.x); t.y = __builtin_amdgcn_rcpf(d.y);
    f32x2 q = t * 0.5307027145f + (-0.7265760135f); q = q * t + 0.7107068705f; q = q * t + (-0.142248368f); q = q * t + 0.127414796f; q = q * t;
    const f32x2 s = (v * v) * (-0.72134752044f);
    f32x2 e; e.x = __builtin_amdgcn_exp2f(s.x); e.y = __builtin_amdgcn_exp2f(s.y);
    const f32x2 m = v * (q * e), r = v - m;
    f32x2 o; o.x = v.x < 0.f ? m.x : r.x; o.y = v.y < 0.f ? m.y : r.y; return o;
}

template <int ACT  > struct EpiBf16 {
    static constexpr bool PERM = true, AFTER_DRAIN = false; static constexpr int VM_MIN = 16; static_assert(ACT == 0 || ACT == 1, "EpiBf16: ACT is 0 (none) or 1 (gelu_pk)");
    bf16_t* O; int ldc; const float* bias; int split_cols; size_t split_stride; float scale0; float sall = 1.f;
    __device__ __forceinline__ void operator()(const f32x4 (&acc)[2][2][4][2], const Unit& u, int wr, int wc, int fr, int fq) const {
        const int row0 = u.pm * BM + wr * 64 + fr; int colt = u.pn * BM; bf16_t* base = O;
        float sc = sall; if (split_cols) { const int t = colt / split_cols; base += (size_t)t * split_stride; colt -= t * split_cols; if (t == 0) sc = scale0 * sall; }
        const int col0 = colt + wc * 32 + 8 * fq, bcol0 = u.pn * BM + wc * 32 + 8 * fq;
        f32x4 bv[2][2];
#pragma unroll
        for (int bj = 0; bj < 2; ++bj)
#pragma unroll
            for (int n = 0; n < 2; ++n) bv[bj][n] = bias ? *(const f32x4*)(bias + bcol0 + bj * HALF + 4 * n) : (f32x4){0.f, 0.f, 0.f, 0.f};
#pragma unroll
        for (int ai = 0; ai < 2; ++ai)
#pragma unroll
            for (int m = 0; m < 4; ++m) { bf16_t* rowp = base + (size_t)(row0 + ai * HALF + m * 16) * ldc + col0;
#pragma unroll
                for (int bj = 0; bj < 2; ++bj) { f32x4 v0 = acc[ai][bj][m][0] + bv[bj][0], v1 = acc[ai][bj][m][1] + bv[bj][1];
                    if (ACT == 1) { f32x2 a = gelu_pk((f32x2){v0[0], v0[1]}), b = gelu_pk((f32x2){v0[2], v0[3]}), c = gelu_pk((f32x2){v1[0], v1[1]}), d = gelu_pk((f32x2){v1[2], v1[3]});
                        v0 = (f32x4){a.x, a.y, b.x, b.y}; v1 = (f32x4){c.x, c.y, d.x, d.y}; }
                    v0 = v0 * sc; v1 = v1 * sc; u32x4 w; w.x = cvt_pk_bf16(v0[0], v0[1]); w.y = cvt_pk_bf16(v0[2], v0[3]); w.z = cvt_pk_bf16(v1[0], v1[1]); w.w = cvt_pk_bf16(v1[2], v1[3]);
                    *(u32x4*)(rowp + bj * HALF) = w; } }
    }
};
typedef unsigned u32x2 __attribute__((ext_vector_type(2)));
__device__ __forceinline__ u32x2 pack4(const f32x4 v) { u32x2 w; w.x = cvt_pk_bf16(v[0], v[1]); w.y = cvt_pk_bf16(v[2], v[3]); return w; }
__device__ __forceinline__ unsigned cvt4_fp8(float a, float b, float c, float d) { int w = __builtin_amdgcn_cvt_pk_fp8_f32(a, b, 0, false); w = __builtin_amdgcn_cvt_pk_fp8_f32(c, d, w, true); return (unsigned)w; }

struct EpiProj {
    static constexpr bool PERM = true, AFTER_DRAIN = false; static constexpr int VM_MIN = 16;
    bf16_t* O; int ldc; const float* rope; float qscale; const float* rstd;
    __device__ __forceinline__ void operator()(const f32x4 (&acc)[2][2][4][2], const Unit& u, int wr, int wc, int fr, int fq) const {
        const int row0 = u.pm * BM + wr * 64 + fr;
        if (u.pn < 4) {
            const float sc0 = (u.pn < 2) ? qscale : 1.0f;
#pragma unroll
            for (int ai = 0; ai < 2; ++ai)
#pragma unroll
                for (int m = 0; m < 4; ++m) { const int r = row0 + ai * HALF + m * 16; const int pos = r & 4095; const float* rp = rope + pos * 32 + 8 * fq; const float sc = sc0 * rstd[r];
                    const f32x4 c0 = *(const f32x4*)rp, c1 = *(const f32x4*)(rp + 4), s0 = *(const f32x4*)(rp + 4096 * 32), s1 = *(const f32x4*)(rp + 4096 * 32 + 4);
                    const f32x4 a0 = acc[ai][0][m][0], a1 = acc[ai][0][m][1], b0 = acc[ai][1][m][0], b1 = acc[ai][1][m][1];
                    const f32x4 x0 = (a0 * c0 - b0 * s0) * sc, x1 = (a1 * c1 - b1 * s1) * sc, y0 = (b0 * c0 + a0 * s0) * sc, y1 = (b1 * c1 + a1 * s1) * sc;
                    bf16_t* p = O + (size_t)r * ldc + u.pn * BM + 64 * wc + 8 * fq; u32x4 w;
                    w.x = cvt_pk_bf16(x0[0], x0[1]); w.y = cvt_pk_bf16(x0[2], x0[3]); w.z = cvt_pk_bf16(x1[0], x1[1]); w.w = cvt_pk_bf16(x1[2], x1[3]); *(u32x4*)p = w;
                    w.x = cvt_pk_bf16(y0[0], y0[1]); w.y = cvt_pk_bf16(y0[2], y0[3]); w.z = cvt_pk_bf16(y1[0], y1[1]); w.w = cvt_pk_bf16(y1[2], y1[3]); *(u32x4*)(p + 32) = w; }
        } else {
            const int col0 = u.pn * BM + wc * 32 + 8 * fq;
#pragma unroll
            for (int ai = 0; ai < 2; ++ai)
#pragma unroll
                for (int m = 0; m < 4; ++m) { bf16_t* rowp = O + (size_t)(row0 + ai * HALF + m * 16) * ldc + col0; const float sr = rstd[row0 + ai * HALF + m * 16];
#pragma unroll
                    for (int bj = 0; bj < 2; ++bj) { const f32x4 v0 = acc[ai][bj][m][0] * sr, v1 = acc[ai][bj][m][1] * sr;
                        u32x4 w; w.x = cvt_pk_bf16(v0[0], v0[1]); w.y = cvt_pk_bf16(v0[2], v0[3]); w.z = cvt_pk_bf16(v1[0], v1[1]); w.w = cvt_pk_bf16(v1[2], v1[3]);
                        *(u32x4*)(rowp + bj * HALF) = w; } }
        }
    }
};
struct EpiColScale {
    static constexpr bool PERM = true, AFTER_DRAIN = false; static constexpr int VM_MIN = 16; bf16_t* O; int ldc; const float* cs;
    __device__ __forceinline__ void operator()(const f32x4 (&acc)[2][2][4][2], const Unit& u, int wr, int wc, int fr, int fq) const {
        const int row0 = u.pm * BM + wr * 64 + fr, col0 = u.pn * BM + wc * 32 + 8 * fq;
        f32x4 c[2][2];
#pragma unroll
        for (int bj = 0; bj < 2; ++bj) { c[bj][0] = *(const f32x4*)(cs + col0 + bj * HALF); c[bj][1] = *(const f32x4*)(cs + col0 + bj * HALF + 4); }
#pragma unroll
        for (int ai = 0; ai < 2; ++ai)
#pragma unroll
            for (int m = 0; m < 4; ++m) { bf16_t* rowp = O + (size_t)(row0 + ai * HALF + m * 16) * ldc + col0;
#pragma unroll
                for (int bj = 0; bj < 2; ++bj) { const f32x4 v0 = acc[ai][bj][m][0] * c[bj][0], v1 = acc[ai][bj][m][1] * c[bj][1];
                    u32x4 w; w.x = cvt_pk_bf16(v0[0], v0[1]); w.y = cvt_pk_bf16(v0[2], v0[3]); w.z = cvt_pk_bf16(v1[0], v1[1]); w.w = cvt_pk_bf16(v1[2], v1[3]);
                    *(u32x4*)(rowp + bj * HALF) = w; } }
    }
};
struct InProjOrder { StaticOrder main, tr; int G, c;
    __device__ __forceinline__ bool next(int i, Unit& u) const { const int P = i * G + c; if (P >= main.nwg + tr.nwg) return false;
        const bool mn = P < main.nwg; Unit a, b; main.at(mn ? P : 0, a); tr.at(mn ? 0 : P - main.nwg, b);
        u.pm = mn ? a.pm : b.pm; u.pn = mn ? a.pn : b.pn; u.e = mn ? 0 : 1; u.ui = i; u.nt = 0; return true; }
    __device__ __forceinline__ const char* aptr(const Gemm& g, const Unit& u, size_t tstep) const { return u.e == 0 ? (const char*)g.A + (size_t)u.pm * tstep : (const char*)g.Bt + (size_t)(12 + u.pm) * tstep; }
    __device__ __forceinline__ const char* bptr(const Gemm& g, const Unit& u, size_t tstep) const { return u.e == 0 ? (const char*)g.Bt + (size_t)u.pn * tstep : (const char*)g.A + (size_t)u.pn * tstep; }
    __device__ __forceinline__ void avoff(const Unit& u, int ui, const int (&R)[2], const int (&C)[2], int K, unsigned (&vo)[2][2]) const { main.avoff(u, ui, R, C, K, vo); }
};
struct EpiProjMvt { static constexpr bool PERM = true, AFTER_DRAIN = false; static constexpr int VM_MIN = 16; EpiProj P; EpiColScale B;
    __device__ __forceinline__ void operator()(const f32x4 (&acc)[2][2][4][2], const Unit& u, int wr, int wc, int fr, int fq) const { if (u.e == 0) P(acc, u, wr, wc, fr, fq); else B(acc, u, wr, wc, fr, fq); } };
template <bool BASE_F32, bool WITH_SS> struct EpiResid {
    static constexpr bool PERM = true, AFTER_DRAIN = false; static constexpr int VM_MIN = 16;
    const float* basef; const bf16_t* baseb; bf16_t* xb; float* rowss; int ldc; unsigned char* x8 = nullptr; float accs = 1.f;
    __device__ __forceinline__ void operator()(const f32x4 (&acc)[2][2][4][2], const Unit& u, int wr, int wc, int fr, int fq) const {
        const int row0 = u.pm * BM + wr * 64 + fr, col0 = u.pn * BM + wc * 32 + 8 * fq;
#pragma unroll
        for (int ai = 0; ai < 2; ++ai)
#pragma unroll
            for (int m = 0; m < 4; ++m) { const int r = row0 + ai * HALF + m * 16; const size_t off = (size_t)r * ldc + col0; float ss = 0.f;
#pragma unroll
                for (int bj = 0; bj < 2; ++bj) { f32x4 o0, o1;
                    if (BASE_F32) { o0 = __builtin_nontemporal_load((const f32x4*)(basef + off + bj * HALF)); o1 = __builtin_nontemporal_load((const f32x4*)(basef + off + bj * HALF + 4)); }
                    else { const u32x4 w = *(const u32x4*)(baseb + off + bj * HALF);
                        o0 = (f32x4){__uint_as_float(w.x << 16), __uint_as_float(w.x & 0xffff0000u), __uint_as_float(w.y << 16), __uint_as_float(w.y & 0xffff0000u)};
                        o1 = (f32x4){__uint_as_float(w.z << 16), __uint_as_float(w.z & 0xffff0000u), __uint_as_float(w.w << 16), __uint_as_float(w.w & 0xffff0000u)}; }
                    o0 = o0 + acc[ai][bj][m][0] * accs; o1 = o1 + acc[ai][bj][m][1] * accs;
                    u32x4 w; w.x = cvt_pk_bf16(o0[0], o0[1]); w.y = cvt_pk_bf16(o0[2], o0[3]); w.z = cvt_pk_bf16(o1[0], o1[1]); w.w = cvt_pk_bf16(o1[2], o1[3]);
                    *(u32x4*)(xb + off + bj * HALF) = w;
                    if (x8) { u32x2 w8; w8.x = cvt4_fp8(o0[0], o0[1], o0[2], o0[3]); w8.y = cvt4_fp8(o1[0], o1[1], o1[2], o1[3]); *(u32x2*)(x8 + off + bj * HALF) = w8; }
                    if (WITH_SS) ss += ((o0[0] * o0[0] + o0[1] * o0[1]) + (o0[2] * o0[2] + o0[3] * o0[3])) + ((o1[0] * o1[0] + o1[1] * o1[1]) + (o1[2] * o1[2] + o1[3] * o1[3])); }
                if (WITH_SS) { ss += __shfl_xor(ss, 16); ss += __shfl_xor(ss, 32); if (fq == 0) atomicAdd(rowss + r, ss); } }
    }
};
struct EpiRowScale {
    static constexpr bool PERM = true, AFTER_DRAIN = false; static constexpr int VM_MIN = 16;
    bf16_t* O; int ldc; const float* rowss; float eps, scale;
    __device__ __forceinline__ void operator()(const f32x4 (&acc)[2][2][4][2], const Unit& u, int wr, int wc, int fr, int fq) const {
        const int row0 = u.pm * BM + wr * 64 + fr, col0 = u.pn * BM + wc * 32 + 8 * fq;
#pragma unroll
        for (int ai = 0; ai < 2; ++ai)
#pragma unroll
            for (int m = 0; m < 4; ++m) { const int r = row0 + ai * HALF + m * 16; const float sc = scale / sqrtf(rowss[r] * (1.0f / 1024.0f) + eps); bf16_t* rowp = O + (size_t)r * ldc + col0;
#pragma unroll
                for (int bj = 0; bj < 2; ++bj) { const f32x4 v0 = acc[ai][bj][m][0] * sc, v1 = acc[ai][bj][m][1] * sc;
                    u32x4 w; w.x = cvt_pk_bf16(v0[0], v0[1]); w.y = cvt_pk_bf16(v0[2], v0[3]); w.z = cvt_pk_bf16(v1[0], v1[1]); w.w = cvt_pk_bf16(v1[2], v1[3]);
                    *(u32x4*)(rowp + bj * HALF) = w; } }
    }
};
struct EpiSwiGLU {
    static constexpr bool PERM = true, AFTER_DRAIN = false; static constexpr int VM_MIN = 8;
    bf16_t* O; int ldc; const PG8_LAS float* RS;
    __device__ __forceinline__ void operator()(const f32x4 (&acc)[2][2][4][2], const Unit& u, int wr, int wc, int fr, int fq) const {
        const int row0 = u.pm * BM + wr * 64 + fr, col0 = u.pn * HALF + wc * 32 + 8 * fq;
#pragma unroll
        for (int ai = 0; ai < 2; ++ai)
#pragma unroll
            for (int m = 0; m < 4; ++m) { bf16_t* rowp = O + (size_t)(row0 + ai * HALF + m * 16) * ldc + col0; const float rs = RS[u.ui * 256 + wr * 64 + fr + ai * HALF + m * 16]; u32x4 w;
#pragma unroll
                for (int n = 0; n < 2; ++n) { const f32x4 a = acc[ai][0][m][n] * rs, b = acc[ai][1][m][n] * rs; f32x4 o;
#pragma unroll
                    for (int j = 0; j < 4; ++j) o[j] = a[j] * b[j] * __builtin_amdgcn_rcpf(1.0f + __builtin_amdgcn_exp2f(-1.4426950408889634f * a[j]));
                    const u32x2 p = pack4(o); if (n == 0) { w.x = p.x; w.y = p.y; } else { w.z = p.x; w.w = p.y; } }
                *(u32x4*)rowp = w; }
    }
};
struct EpiSwiGLU8 {
    static constexpr bool PERM = true, AFTER_DRAIN = false; static constexpr int VM_MIN = 8;
    unsigned char* O; int ldc; const PG8_LAS float* RS; static constexpr float inw = 1.f / 32.f, osc = 4.f;
    __device__ __forceinline__ void operator()(const f32x4 (&acc)[2][2][4][2], const Unit& u, int wr, int wc, int fr, int fq) const {
        const int row0 = u.pm * BM + wr * 64 + fr, col0 = u.pn * HALF + wc * 32 + 8 * fq;
#pragma unroll
        for (int ai = 0; ai < 2; ++ai)
#pragma unroll
            for (int m = 0; m < 4; ++m) { unsigned char* rowp = O + (size_t)(row0 + ai * HALF + m * 16) * ldc + col0; u32x2 w; const float rs = RS[u.ui * 256 + wr * 64 + fr + ai * HALF + m * 16] * inw;
#pragma unroll
                for (int n = 0; n < 2; ++n) { const f32x4 a = acc[ai][0][m][n] * rs, b = acc[ai][1][m][n] * rs; f32x4 o;
#pragma unroll
                    for (int j = 0; j < 4; ++j) o[j] = a[j] * b[j] * osc * __builtin_amdgcn_rcpf(1.0f + __builtin_amdgcn_exp2f(-1.4426950408889634f * a[j]));
                    const unsigned p = cvt4_fp8(o[0], o[1], o[2], o[3]); if (n == 0) w.x = p; else w.y = p; }
                *(u32x2*)rowp = w; }
    }
};
struct EpiScaleBf16 {
    static constexpr bool PERM = true, AFTER_DRAIN = false; static constexpr int VM_MIN = 16; bf16_t* O; int ldc; float s;
    __device__ __forceinline__ void operator()(const f32x4 (&acc)[2][2][4][2], const Unit& u, int wr, int wc, int fr, int fq) const {
        const int row0 = u.pm * BM + wr * 64 + fr, col0 = u.pn * BM + wc * 32 + 8 * fq;
#pragma unroll
        for (int ai = 0; ai < 2; ++ai)
#pragma unroll
            for (int m = 0; m < 4; ++m) { bf16_t* rowp = O + (size_t)(row0 + ai * HALF + m * 16) * ldc + col0;
#pragma unroll
                for (int bj = 0; bj < 2; ++bj) { const f32x4 v0 = acc[ai][bj][m][0] * s, v1 = acc[ai][bj][m][1] * s;
                    u32x4 w; w.x = cvt_pk_bf16(v0[0], v0[1]); w.y = cvt_pk_bf16(v0[2], v0[3]); w.z = cvt_pk_bf16(v1[0], v1[1]); w.w = cvt_pk_bf16(v1[2], v1[3]);
                    *(u32x4*)(rowp + bj * HALF) = w; } }
    }
};
struct EpiNull { static constexpr bool PERM = true, AFTER_DRAIN = false; static constexpr int VM_MIN = 0;  float* sink;
    __device__ __forceinline__ void operator()(const f32x4 (&acc)[2][2][4][2], const Unit& u, int wr, int wc, int fr, int fq) const { float s = 0.f;
#pragma unroll
        for (int ai = 0; ai < 2; ++ai)
#pragma unroll
            for (int bj = 0; bj < 2; ++bj)
#pragma unroll
                for (int m = 0; m < 4; ++m)
#pragma unroll
                    for (int n = 0; n < 2; ++n) s += acc[ai][bj][m][n][0] + acc[ai][bj][m][n][1] + acc[ai][bj][m][n][2] + acc[ai][bj][m][n][3];
        if (s == 1.2345e-30f) *sink = s; } };
struct EpiNull2 { static constexpr bool PERM = true, AFTER_DRAIN = false; static constexpr int VM_MIN = 16; bf16_t* O; int ldc;
    __device__ __forceinline__ void operator()(const f32x4 (&acc)[2][2][4][2], const Unit& u, int wr, int wc, int fr, int fq) const {
        const int row0 = u.pm * BM + wr * 64 + fr, col0 = u.pn * BM + wc * 32 + 8 * fq;
#pragma unroll
        for (int ai = 0; ai < 2; ++ai)
#pragma unroll
            for (int m = 0; m < 4; ++m) { const int r = row0 + ai * HALF + m * 16; const float sc = 0.5f; const size_t off = (((size_t)r * ldc + col0) * 2 & 8191) + (size_t)blockIdx.x * 8192;
#pragma unroll
                for (int bj = 0; bj < 2; ++bj) { const f32x4 v0 = acc[ai][bj][m][0] * sc, v1 = acc[ai][bj][m][1] * sc;
                    u32x4 w; w.x = cvt_pk_bf16(v0[0], v0[1]); w.y = cvt_pk_bf16(v0[2], v0[3]); w.z = cvt_pk_bf16(v1[0], v1[1]); w.w = cvt_pk_bf16(v1[2], v1[3]);
                    *(u32x4*)((char*)O + ((off + bj * 256) & ~15)) = w; } }
    } };

struct BatchBOrder : StaticOrder { size_t bstride; int tpb;
    __device__ __forceinline__ const char* bptr(const Gemm& g, const Unit& u, size_t tstep) const { return (const char*)g.Bt + (size_t)(u.pm / tpb) * bstride + (size_t)u.pn * tstep; } };
struct FoldOrder { int G, c; const bf16_t* MK; const bf16_t* MV; const bf16_t* WXQN; const bf16_t* WXOT;
    __device__ __forceinline__ bool next(int i, Unit& u) const { const int L = i * G + c; if (L >= 256) return false;
        const int ty = L >> 7, l = L & 127, b = l >> 4, h = (l >> 2) & 3, j = l & 3; u.e = ty; u.ui = i;
        u.pm = ty == 0 ? b * 4 + h : 32 + b * 4 + j; u.pn = ty == 0 ? j : h; return true; }
    __device__ __forceinline__ const char* aptr(const Gemm&, const Unit& u, size_t) const {
        return u.e == 0 ? (const char*)(MK + ((size_t)(u.pm >> 2) * 256 * 1024 + (u.pm & 3) * 256)) : (const char*)(WXOT + ((size_t)((u.pm - 32) & 3) * 256 * 1024 + u.pn * 256)); }
    __device__ __forceinline__ const char* bptr(const Gemm&, const Unit& u, size_t) const {
        return u.e == 0 ? (const char*)(WXQN + ((size_t)u.pn * 256 * 1024 + (u.pm & 3) * 256)) : (const char*)(MV + ((size_t)((u.pm - 32) >> 2) * 256 * 1024 + u.pn * 256)); }
    __device__ __forceinline__ void avoff(const Unit&, int, const int (&R)[2], const int (&C)[2], int K, unsigned (&vo)[2][2]) const {
#pragma unroll
        for (int h = 0; h < 2; ++h)
#pragma unroll
            for (int i = 0; i < 2; ++i) vo[h][i] = (unsigned)((h * HALF + R[i]) * K + C[i]) * 2u; }
};
struct OutFoldOrder { StaticOrder main; FoldOrder fold; int G, c;
    __device__ __forceinline__ bool next(int i, Unit& u) const { const int P = i * G + c; if (P >= main.nwg + 256) return false;
        const bool mn = P < main.nwg; Unit t; main.at(mn ? P : 0, t);
        const int L = P - main.nwg, ty = L >> 7, l = L & 127, b = l >> 4, h = (l >> 2) & 3, j = l & 3;
        const int fpm = ty == 0 ? b * 4 + h : 32 + b * 4 + j, fpn = ty == 0 ? j : h;
        u.pm = mn ? t.pm : fpm; u.pn = mn ? t.pn : fpn; u.e = mn ? 2 : ty; u.ui = i; u.nt = mn ? 16 : 4; return true; }
    __device__ __forceinline__ const char* aptr(const Gemm& g, const Unit& u, size_t tstep) const { return u.e == 2 ? main.aptr(g, u, tstep) : fold.aptr(g, u, tstep); }
    __device__ __forceinline__ const char* bptr(const Gemm& g, const Unit& u, size_t tstep) const { return u.e == 2 ? main.bptr(g, u, tstep) : fold.bptr(g, u, tstep); }
    __device__ __forceinline__ void avoff(const Unit& u, int ui, const int (&R)[2], const int (&C)[2], int K, unsigned (&vo)[2][2]) const { main.avoff(u, ui, R, C, K, vo); }
};
struct EpiF8Out {
    static constexpr bool PERM = true, AFTER_DRAIN = false; static constexpr int VM_MIN = 16; unsigned char* O; int ldc; float s;
    __device__ __forceinline__ void operator()(const f32x4 (&acc)[2][2][4][2], const Unit& u, int wr, int wc, int fr, int fq) const {
        const int row0 = u.pm * BM + wr * 64 + fr, col0 = u.pn * BM + wc * 32 + 8 * fq;
#pragma unroll
        for (int ai = 0; ai < 2; ++ai)
#pragma unroll
            for (int m = 0; m < 4; ++m) { unsigned char* rowp = O + (size_t)(row0 + ai * HALF + m * 16) * ldc + col0;
#pragma unroll
                for (int bj = 0; bj < 2; ++bj) { const f32x4 v0 = acc[ai][bj][m][0] * s, v1 = acc[ai][bj][m][1] * s;
                    u32x2 w; w.x = cvt4_fp8(v0[0], v0[1], v0[2], v0[3]); w.y = cvt4_fp8(v1[0], v1[1], v1[2], v1[3]); *(u32x2*)(rowp + bj * HALF) = w; } }
    }
};
struct EpiResidFold { static constexpr bool PERM = true, AFTER_DRAIN = false; static constexpr int VM_MIN = 16; EpiResid<false, true> R; EpiF8Out B;
    __device__ __forceinline__ void operator()(const f32x4 (&acc)[2][2][4][2], const Unit& u, int wr, int wc, int fr, int fq) const { if (u.e == 2) R(acc, u, wr, wc, fr, fq); else B(acc, u, wr, wc, fr, fq); } };
struct EpiSoftmaxP {
    static constexpr bool PERM = true, AFTER_DRAIN = false; static constexpr int VM_MIN = 16;
    unsigned char* O; int ldc; const float* rowss; float eps, scale; PG8_LAS float* ex; float psc;
    __device__ __forceinline__ void operator()(f32x4 (&acc)[2][2][4][2], const Unit& u, int wr, int wc, int fr, int fq) const {
        const int rl0 = wr * 64 + fr, row0 = u.pm * BM + rl0, col0 = u.pn * BM + wc * 32 + 8 * fq;
        float mw[2][4];
#pragma unroll
        for (int ai = 0; ai < 2; ++ai)
#pragma unroll
            for (int m = 0; m < 4; ++m) { const int rl = rl0 + ai * HALF + m * 16; const float sc = scale / sqrtf(rowss[u.pm * BM + rl] * (1.0f / 1024.0f) + eps);
                float mx = -INFINITY;
#pragma unroll
                for (int bj = 0; bj < 2; ++bj)
#pragma unroll
                    for (int n = 0; n < 2; ++n) { const f32x4 t = acc[ai][bj][m][n] * sc; acc[ai][bj][m][n] = t; mx = fmaxf(mx, fmaxf(fmaxf(t[0], t[1]), fmaxf(t[2], t[3]))); }
                { auto r = __builtin_amdgcn_permlane16_swap(__float_as_uint(mx), __float_as_uint(mx), false, false); mx = fmaxf(__uint_as_float(r[0]), __uint_as_float(r[1])); }
                { auto r = __builtin_amdgcn_permlane32_swap(__float_as_uint(mx), __float_as_uint(mx), false, false); mx = fmaxf(__uint_as_float(r[0]), __uint_as_float(r[1])); }
                float s = 0.f;
#pragma unroll
                for (int bj = 0; bj < 2; ++bj)
#pragma unroll
                    for (int n = 0; n < 2; ++n) { f32x4 t = acc[ai][bj][m][n];
#pragma unroll
                        for (int j = 0; j < 4; ++j) t[j] = __builtin_amdgcn_exp2f(t[j] - mx);
                        acc[ai][bj][m][n] = t; s += (t[0] + t[1]) + (t[2] + t[3]); }
                { auto r = __builtin_amdgcn_permlane16_swap(__float_as_uint(s), __float_as_uint(s), false, false); s = __uint_as_float(r[0]) + __uint_as_float(r[1]); }
                { auto r = __builtin_amdgcn_permlane32_swap(__float_as_uint(s), __float_as_uint(s), false, false); s = __uint_as_float(r[0]) + __uint_as_float(r[1]); }
                if (fq == 0) { f32x2 ms; ms.x = mx; ms.y = s; *(PG8_LAS f32x2*)(ex + (rl * 4 + wc) * 2) = ms; }
                mw[ai][m] = mx; }
        asm volatile("s_waitcnt lgkmcnt(0)" ::: "memory"); __builtin_amdgcn_s_barrier();
#pragma unroll
        for (int ai = 0; ai < 2; ++ai)
#pragma unroll
            for (int m = 0; m < 4; ++m) { const int rl = rl0 + ai * HALF + m * 16; const PG8_LAS f32x4* e4 = (const PG8_LAS f32x4*)(ex + rl * 8); const f32x4 a = e4[0], b = e4[1];
                const float Mx = fmaxf(fmaxf(a[0], a[2]), fmaxf(b[0], b[2]));
                const float L = (a[1] * __builtin_amdgcn_exp2f(a[0] - Mx) + a[3] * __builtin_amdgcn_exp2f(a[2] - Mx)) + (b[1] * __builtin_amdgcn_exp2f(b[0] - Mx) + b[3] * __builtin_amdgcn_exp2f(b[2] - Mx));
                const float f = __builtin_amdgcn_exp2f(mw[ai][m] - Mx) * __builtin_amdgcn_rcpf(L) * psc;
                unsigned char* rowp = O + (size_t)(row0 + ai * HALF + m * 16) * ldc + col0;
#pragma unroll
                for (int bj = 0; bj < 2; ++bj) { const f32x4 v0 = acc[ai][bj][m][0] * f, v1 = acc[ai][bj][m][1] * f;
                    u32x2 w; w.x = cvt4_fp8(v0[0], v0[1], v0[2], v0[3]); w.y = cvt4_fp8(v1[0], v1[1], v1[2], v1[3]); *(u32x2*)(rowp + bj * HALF) = w; } }
    }
};
__host__ __device__ __forceinline__ int expert_unit_id(int L, int nwg) { const int q = nwg / NXCD, r = nwg % NXCD, xcd = L % NXCD, off = L / NXCD; return (xcd < r ? xcd * (q + 1) : r * (q + 1) + (xcd - r) * q) + off; }
__host__ __device__ __forceinline__ int expert_up_id(int L, int nunits) { const int blk = L & ~31, p = L & 31; return (blk + 32 <= nunits) ? blk + (p & 7) * 4 + (p >> 3) : L; }
template <bool GATHER> struct ExpertOrder {
    int G, c, ntiles; const PG8_LAS int* TS; const PG8_LAS int* TOK; size_t estride;
    int lo = 0, hi = -1, r0 = 0;
    __device__ __forceinline__ bool next(int i, Unit& u) const {
        const int L = lo + (i + r0) * G + c; if (L >= (hi < 0 ? 4 * ntiles : hi)) return false;
        const int id = GATHER ? expert_up_id(L, 4 * ntiles) : L; const int rt = id >> 2; int e = 0;
        for (int k = 1; k < 32; ++k) e += (TS[k] <= rt) ? 1 : 0;
        u.pm = rt; u.pn = id & 3; u.e = e; u.ui = i + r0; return true;
    }
    __device__ __forceinline__ const char* aptr(const Gemm& g, const Unit& u, size_t tstep) const { return GATHER ? (const char*)g.A : (const char*)g.A + (size_t)u.pm * tstep; }
    __device__ __forceinline__ const char* bptr(const Gemm& g, const Unit& u, size_t tstep) const { return (const char*)g.Bt + (size_t)u.e * estride + (size_t)u.pn * tstep; }
    __device__ __forceinline__ void avoff(const Unit& u, int, const int (&R)[2], const int (&C)[2], int K, unsigned (&vo)[2][2]) const {
#pragma unroll
        for (int h = 0; h < 2; ++h)
#pragma unroll
            for (int i = 0; i < 2; ++i) { const int row = GATHER ? TOK[u.ui * 256 + h * HALF + R[i]] : (h * HALF + R[i]); vo[h][i] = (unsigned)(row * K + C[i]) * 2u; } }
};
template <class Epi, class Sched, bool ALIGN_EPI = false, bool SP2 = false, bool FP8 = false>
__device__ __forceinline__ void gemm_phase(PG8_LAS unsigned char* lds, const Gemm g, const Sched& S, const Epi& E, const int wv) {
    const int wid = wv, lane = lane_now(), tid = wid * 64 + lane, wr = wid >> 2, wc = wid & 3, fr = lane & 15, fq = lane >> 4;
    const int K = g.K, nt = (g.kext ? g.kext : K) / BK;
    int R_[2], C_[2]; unsigned voffB[2];
#pragma unroll
    for (int i = 0; i < 2; ++i) { int R, C; stage_rc(tid * 16 + i * 8192, R, C); R_[i] = R; C_[i] = C; const int Rb = Epi::PERM ? ((R & ~31) + perm32(R & 31)) : R;
        voffB[i] = (unsigned)(Rb * K + C) * 2u; }
    const size_t kstep = (size_t)(BK * 2);
    const size_t hstep = (size_t)HALF * K * 2;
    const size_t tstep = 2 * hstep;
    const unsigned ldsw = (unsigned)wid * 1024u;
    const int aoff = lds_byte(wr * 64 + fr, fq * 8), boff = lds_byte(wc * 32 + fr, fq * 8);
#define PG8_SA(b, h) (((b) * 2 + (h)) * HTB)
#define PG8_SB(b, h) ((4 + (b) * 2 + (h)) * HTB)
#define PG8_STAGE(bufoff, gbase, voff) do { _Pragma("unroll") for (int _i = 0; _i < 2; ++_i) \
        __builtin_amdgcn_global_load_lds((const unsigned*)((const char*)(gbase) + (voff)[_i]), (PG8_LAS unsigned*)(lds + (bufoff) + ldsw + _i * 8192), 16, 0, 0); } while (0)
#define PG8_LDA(dst, b, h) do { _Pragma("unroll") for (int m = 0; m < 4; ++m) _Pragma("unroll") for (int k = 0; k < 2; ++k) dst[m][k] = *(const PG8_LAS bf16x8*)(lds + PG8_SA(b, h) + aoff + m * 2048 + k * 1024); } while (0)
#define PG8_LDB(dst, b, h) do { _Pragma("unroll") for (int n = 0; n < 2; ++n) _Pragma("unroll") for (int k = 0; k < 2; ++k) dst[n][k] = *(const PG8_LAS bf16x8*)(lds + PG8_SB(b, h) + boff + n * 2048 + k * 1024); } while (0)
#define PG8_MMA(ai, bj, At, Bt) do { __builtin_amdgcn_s_setprio(1); _Pragma("unroll") for (int m = 0; m < 4; ++m) _Pragma("unroll") for (int n = 0; n < 2; ++n) _Pragma("unroll") for (int k = 0; k < 2; ++k) { \
        if constexpr (FP8) { const i64x2_t b8_ = __builtin_bit_cast(i64x2_t, Bt[n][k]), a8_ = __builtin_bit_cast(i64x2_t, At[m][k]); \
            acc[ai][bj][m][n] = __builtin_amdgcn_mfma_f32_16x16x32_fp8_fp8(b8_[0], a8_[0], acc[ai][bj][m][n], 0, 0, 0); acc[ai][bj][m][n] = __builtin_amdgcn_mfma_f32_16x16x32_fp8_fp8(b8_[1], a8_[1], acc[ai][bj][m][n], 0, 0, 0); } \
        else acc[ai][bj][m][n] = __builtin_amdgcn_mfma_f32_16x16x32_bf16(Bt[n][k], At[m][k], acc[ai][bj][m][n], 0, 0, 0); } __builtin_amdgcn_s_setprio(0); } while (0)
#define PG8_WAIT_V(n) asm volatile("s_waitcnt vmcnt(" #n ")" ::: "memory")
#define PG8_WAIT_L(n) asm volatile("s_waitcnt lgkmcnt(" #n ")" ::: "memory")
#define PG8_BAR __builtin_amdgcn_s_barrier()
#define PG8_SCHED __builtin_amdgcn_sched_barrier(0)
    Unit cur, nxt; int ui = 0;
    if (!S.next(0, cur)) return;
    f32x4 acc[2][2][4][2];
#pragma unroll
    for (int a = 0; a < 2; ++a)
#pragma unroll
        for (int b = 0; b < 2; ++b)
#pragma unroll
            for (int m = 0; m < 4; ++m)
#pragma unroll
                for (int n = 0; n < 2; ++n) acc[a][b][m][n] = (f32x4){0.f, 0.f, 0.f, 0.f};
    bf16x8 At[4][2], B0[2][2], B1[2][2];
    const char* cA = S.aptr(g, cur, tstep); const char* cB = S.bptr(g, cur, tstep);
    unsigned voA[2][2], voN[2][2];
    S.avoff(cur, 0, R_, C_, K, voA);
    if constexpr (SP2) {
        PG8_STAGE(PG8_SB(0, 0), cB, voffB); PG8_STAGE(PG8_SB(0, 1), cB + hstep, voffB); PG8_STAGE(PG8_SA(0, 0), cA, voA[0]); PG8_STAGE(PG8_SA(0, 1), cA, voA[1]);
        if (wr == 1) PG8_BAR;
        PG8_WAIT_V(2); PG8_BAR;
        PG8_STAGE(PG8_SB(1, 0), cB + kstep, voffB); PG8_STAGE(PG8_SA(1, 0), cA + kstep, voA[0]); PG8_STAGE(PG8_SB(1, 1), cB + hstep + kstep, voffB);
        PG8_WAIT_V(6); PG8_BAR;
    } else {
        PG8_STAGE(PG8_SB(0, 0), cB, voffB); PG8_STAGE(PG8_SA(0, 0), cA, voA[0]); PG8_STAGE(PG8_SB(0, 1), cB + hstep, voffB); PG8_STAGE(PG8_SA(0, 1), cA, voA[1]);
        if (wr == 1) PG8_BAR;
        PG8_WAIT_V(4); PG8_BAR;
        PG8_STAGE(PG8_SB(1, 0), cB + kstep, voffB); PG8_STAGE(PG8_SA(1, 0), cA + kstep, voA[0]); PG8_STAGE(PG8_SB(1, 1), cB + hstep + kstep, voffB);
        PG8_WAIT_V(6); PG8_BAR;
    }
    for (;;) {
        const bool has_next = S.next(ui + 1, nxt);
        const char* nA = has_next ? S.aptr(g, nxt, tstep) : cA; const char* nB = has_next ? S.bptr(g, nxt, tstep) : cB;
        if (has_next) S.avoff(nxt, ui + 1, R_, C_, K, voN); else {
#pragma unroll
            for (int h = 0; h < 2; ++h)
#pragma unroll
                for (int i = 0; i < 2; ++i) voN[h][i] = voA[h][i]; }
        int unt = cur.nt ? cur.nt : nt; asm volatile("" : "+s"(unt));
        for (int t = 0; t < unt; t += 2) {
            const bool last = (t == unt - 2);
            const char* a1 = cA + (size_t)(t + 1) * kstep;
            const char* a2 = last ? nA : cA + (size_t)(t + 2) * kstep; const char* b2 = last ? nB : cB + (size_t)(t + 2) * kstep;
            const char* a3 = a2 + kstep; const char* b3 = b2 + kstep;
            unsigned v2[2][2];
#pragma unroll
            for (int h = 0; h < 2; ++h)
#pragma unroll
                for (int i = 0; i < 2; ++i) v2[h][i] = last ? voN[h][i] : voA[h][i];
            if constexpr (SP2) {
            PG8_LDB(B0, 0, 0); PG8_LDB(B1, 0, 1); PG8_SCHED; PG8_LDA(At, 0, 0); PG8_STAGE(PG8_SA(1, 1), a1, voA[1]);
            PG8_WAIT_V(8); PG8_WAIT_L(0); PG8_BAR; PG8_MMA(0, 0, At, B0); PG8_MMA(0, 1, At, B1); PG8_BAR; PG8_SCHED;
            PG8_LDA(At, 0, 1); PG8_STAGE(PG8_SB(0, 0), b2, voffB); PG8_STAGE(PG8_SB(0, 1), b2 + hstep, voffB); PG8_STAGE(PG8_SA(0, 0), a2, v2[0]);
            PG8_WAIT_V(8); PG8_WAIT_L(0); PG8_BAR; PG8_MMA(1, 0, At, B0); PG8_MMA(1, 1, At, B1); PG8_BAR; PG8_SCHED;
            PG8_LDB(B0, 1, 0); PG8_LDB(B1, 1, 1); PG8_SCHED; PG8_LDA(At, 1, 0); PG8_STAGE(PG8_SA(0, 1), a2, v2[1]);
            PG8_WAIT_V(8); PG8_WAIT_L(0); PG8_BAR; PG8_MMA(0, 0, At, B0); PG8_MMA(0, 1, At, B1); PG8_BAR; PG8_SCHED;
            PG8_LDA(At, 1, 1); PG8_STAGE(PG8_SB(1, 0), b3, voffB); PG8_STAGE(PG8_SB(1, 1), b3 + hstep, voffB); PG8_STAGE(PG8_SA(1, 0), a3, v2[0]);
            PG8_WAIT_V(8); PG8_WAIT_L(0); PG8_BAR; PG8_MMA(1, 0, At, B0); PG8_MMA(1, 1, At, B1); PG8_BAR; PG8_SCHED;
            } else {
            PG8_LDB(B0, 0, 0); PG8_SCHED; PG8_LDA(At, 0, 0); PG8_STAGE(PG8_SA(1, 1), a1, voA[1]);
            PG8_WAIT_L(8); PG8_BAR; PG8_WAIT_L(0); PG8_MMA(0, 0, At, B0); PG8_BAR; PG8_SCHED;
            PG8_LDB(B1, 0, 1); PG8_STAGE(PG8_SB(0, 0), b2, voffB);
            PG8_BAR; PG8_WAIT_L(0); PG8_MMA(0, 1, At, B1); PG8_BAR;
            PG8_LDA(At, 0, 1); PG8_STAGE(PG8_SA(0, 0), a2, v2[0]);
            PG8_BAR; PG8_WAIT_L(0); PG8_MMA(1, 0, At, B0); PG8_BAR; PG8_SCHED;
            PG8_STAGE(PG8_SB(0, 1), b2 + hstep, voffB);
            PG8_WAIT_V(6); PG8_BAR; PG8_MMA(1, 1, At, B1); PG8_BAR;
            PG8_LDB(B0, 1, 0); PG8_SCHED; PG8_LDA(At, 1, 0); PG8_STAGE(PG8_SA(0, 1), a2, v2[1]);
            PG8_WAIT_L(8); PG8_BAR; PG8_WAIT_L(0); PG8_MMA(0, 0, At, B0); PG8_BAR; PG8_SCHED;
            PG8_LDB(B1, 1, 1); PG8_STAGE(PG8_SB(1, 0), b3, voffB);
            PG8_BAR; PG8_WAIT_L(0); PG8_MMA(0, 1, At, B1); PG8_BAR;
            PG8_LDA(At, 1, 1); PG8_STAGE(PG8_SA(1, 0), a3, v2[0]);
            PG8_BAR; PG8_WAIT_L(0); PG8_MMA(1, 0, At, B0); PG8_BAR; PG8_SCHED;
            PG8_STAGE(PG8_SB(1, 1), b3 + hstep, voffB);
            PG8_WAIT_V(6); PG8_BAR; PG8_MMA(1, 1, At, B1); PG8_BAR;
            }
        }
        if constexpr (ALIGN_EPI) { if (wr == 0) PG8_BAR; }
        if constexpr (!Epi::AFTER_DRAIN) { E(acc, cur, wr, wc, fr, fq); }
        if (!has_next) break;
#pragma unroll
        for (int a = 0; a < 2; ++a)
#pragma unroll
            for (int b = 0; b < 2; ++b)
#pragma unroll
                for (int m = 0; m < 4; ++m)
#pragma unroll
                    for (int n = 0; n < 2; ++n) acc[a][b][m][n] = (f32x4){0.f, 0.f, 0.f, 0.f};
        cur = nxt; cA = nA; cB = nB; ++ui;
#pragma unroll
        for (int h = 0; h < 2; ++h)
#pragma unroll
            for (int i = 0; i < 2; ++i) voA[h][i] = voN[h][i];
        if constexpr (ALIGN_EPI) { if (wr == 1) PG8_BAR; }
    }
    PG8_WAIT_V(0);
    if constexpr (!ALIGN_EPI) { if (wr == 0) PG8_BAR; }
    PG8_BAR;
    if constexpr (Epi::AFTER_DRAIN) { E.fused(acc, cur, wr, wc, fr, fq, lds, wid, lane); }
#undef PG8_SA
#undef PG8_SB
#undef PG8_STAGE
#undef PG8_LDA
#undef PG8_LDB
#undef PG8_MMA
#undef PG8_WAIT_V
#undef PG8_WAIT_L
#undef PG8_BAR
#undef PG8_SCHED
}
}

#ifndef PG8_SP2
#define PG8_SP2 true
#endif
#ifndef PG8_ALIGN
#define PG8_ALIGN true
#endif
#include <hip/hip_bf16.h>
#include <cmath>
namespace attn_body {
using bf16=__hip_bfloat16;
using bf16x8=__attribute__((ext_vector_type(8)))short;
using s16x4=__attribute__((ext_vector_type(4)))short;
using f32x16=__attribute__((ext_vector_type(16)))float;
using u32x4=__attribute__((ext_vector_type(4)))unsigned;
constexpr int BATCH=8,NHEAD=8,SEQ=4096,D=64,PQ=3072,PO=1024;
constexpr int NW=8,QBLK=32,QB=QBLK*NW,KVBLK=64,NQB=SEQ/QB;
constexpr int ATTN_UNIT_ROWS=QB;
__device__ __forceinline__ int crow(int r,int hi){return (r&3)+8*(r>>2)+4*hi;}
#define SBAR() __builtin_amdgcn_sched_barrier(0)
__device__ __forceinline__ void cmask(f32x16&p0,f32x16&p1,int jb,int qrel,int hi){
  const float NEG=-INFINITY; int kb=64*jb+4*hi;
  #pragma unroll
  for(int r=0;r<16;++r){int kv=kb+(r&3)+8*(r>>2); if(kv>qrel)p0[r]=NEG; if(kv+32>qrel)p1[r]=NEG;}
}

constexpr int NSLOT=3, SLOTB=8192, VSLOTB=2*SLOTB;
constexpr int LDS_K=0, LDS_V=NSLOT*SLOTB, LDS_WS=LDS_V+NSLOT*VSLOTB, LDS_OST=LDS_WS+NW*64*4, LDS_BYTES=LDS_OST+NW*4096;
constexpr float C2=0.125f*1.4426950408889634f;
__device__ __forceinline__ void glds16(const void*gsrc,unsigned lds_dst){unsigned keep;
  asm volatile("s_mov_b32 %0, m0\n\ts_mov_b32 m0, %2\n\ts_nop 0\n\tglobal_load_lds_dwordx4 %1, off\n\ts_mov_b32 m0, %0":"=&s"(keep):"v"(gsrc),"s"(lds_dst):"memory");}
__device__ __forceinline__ float max3f(float a,float b,float c){float r;asm("v_max3_f32 %0, %1, %2, %3":"=v"(r):"v"(a),"v"(b),"v"(c));return r;}
__device__ __forceinline__ float max2f(float a,float b){float r;asm("v_max_f32_e32 %0, %1, %2":"=v"(r):"v"(a),"v"(b));return r;}
__device__ __forceinline__ float fadd_s(float a,float b){float r;asm("v_add_f32_e32 %0, %1, %2":"=v"(r):"v"(a),"v"(b));return r;}
__device__ __forceinline__ float fsub_s(float a,float b){float r;asm("v_sub_f32_e32 %0, %1, %2":"=v"(r):"v"(a),"v"(b));return r;}
typedef float f32x2_t __attribute__((ext_vector_type(2))); typedef __bf16 bf16x2_t __attribute__((ext_vector_type(2)));
__device__ __forceinline__ unsigned cvtpk_s(float lo,float hi){f32x2_t v={lo,hi};bf16x2_t b=__builtin_convertvector(v,bf16x2_t);return __builtin_bit_cast(unsigned,b);}
#define WAIT_BAR(N) asm volatile("s_waitcnt vmcnt(" #N ") lgkmcnt(0)\n\ts_barrier":::"memory")

__device__ __forceinline__ void qkt(f32x16&p0,f32x16&p1,const char*Kslot,const bf16x8*qr,const f32x16&negm,int r32,int hi){
  const char*kb=Kslot+hi*1024+r32*16;
  #pragma unroll
  for(int d0=0;d0<4;++d0){
    const bf16x8 b0=*reinterpret_cast<const bf16x8*>(kb+d0*2048);
    const bf16x8 b1=*reinterpret_cast<const bf16x8*>(kb+d0*2048+512);
    if(d0==0){p0=__builtin_amdgcn_mfma_f32_32x32x16_bf16(b0,qr[0],negm,0,0,0);p1=__builtin_amdgcn_mfma_f32_32x32x16_bf16(b1,qr[0],negm,0,0,0);}
    else{p0=__builtin_amdgcn_mfma_f32_32x32x16_bf16(b0,qr[d0],p0,0,0,0);p1=__builtin_amdgcn_mfma_f32_32x32x16_bf16(b1,qr[d0],p1,0,0,0);}}
}
typedef __attribute__((address_space(3))) const char* lds_cptr;
typedef short v4i16_t __attribute__((ext_vector_type(4)));
__device__ __forceinline__ void kload8(bf16x8*kf,lds_cptr kp){
  kf[0]=*(const __attribute__((address_space(3))) bf16x8*)(kp);      kf[1]=*(const __attribute__((address_space(3))) bf16x8*)(kp+512);
  kf[2]=*(const __attribute__((address_space(3))) bf16x8*)(kp+2048); kf[3]=*(const __attribute__((address_space(3))) bf16x8*)(kp+2560);
  kf[4]=*(const __attribute__((address_space(3))) bf16x8*)(kp+4096); kf[5]=*(const __attribute__((address_space(3))) bf16x8*)(kp+4608);
  kf[6]=*(const __attribute__((address_space(3))) bf16x8*)(kp+6144); kf[7]=*(const __attribute__((address_space(3))) bf16x8*)(kp+6656);
}
__device__ __forceinline__ void kload2(bf16x8*kf,lds_cptr kp,int j){ kf[2*j]=*(const __attribute__((address_space(3))) bf16x8*)(kp+j*2048); kf[2*j+1]=*(const __attribute__((address_space(3))) bf16x8*)(kp+j*2048+512); }
__device__ __forceinline__ s16x4 vtr(lds_cptr p){ return __builtin_bit_cast(s16x4,__builtin_amdgcn_ds_read_tr16_b64_v4i16((__attribute__((address_space(3))) v4i16_t*)p)); }
__device__ __forceinline__ float rowmax(const f32x16&p0,const f32x16&p1){
  float a=max3f(p0[0],p0[1],p1[0]),b=max3f(p0[2],p0[3],p1[1]);a=max3f(a,p1[2],p1[3]);
  #pragma unroll
  for(int r=4;r<16;r+=4){a=max3f(a,p0[r],p0[r+1]);b=max3f(b,p0[r+2],p0[r+3]);a=max3f(a,p1[r],p1[r+1]);b=max3f(b,p1[r+2],p1[r+3]);}
  const float m=max2f(a,b);
  auto rr=__builtin_amdgcn_permlane32_swap(__float_as_uint(m),__float_as_uint(m),false,false);
  return max2f(__uint_as_float(rr[0]),__uint_as_float(rr[1]));
}
__device__ __forceinline__ void pv(f32x16*o,int vb,bf16x8 pa0,bf16x8 pa1,bf16x8 pa2,bf16x8 pa3){
  #pragma unroll
  for(int d0=0;d0<2;++d0){s16x4 lo[4],hi[4];
    #pragma unroll
    for(int ks=0;ks<4;++ks){
      asm volatile("ds_read_b64_tr_b16 %0,%1 offset:%c2":"=&v"(lo[ks]):"v"(vb),"i"(d0*4096+ks*1024):"memory");
      asm volatile("ds_read_b64_tr_b16 %0,%1 offset:%c2":"=&v"(hi[ks]):"v"(vb),"i"(d0*4096+ks*1024+512):"memory");}
    asm volatile("s_waitcnt lgkmcnt(0)":::"memory");SBAR();
    #define PK(k) (bf16x8){lo[k][0],lo[k][1],lo[k][2],lo[k][3],hi[k][0],hi[k][1],hi[k][2],hi[k][3]}
    o[d0]=__builtin_amdgcn_mfma_f32_32x32x16_bf16(pa0,PK(0),o[d0],0,0,0);
    o[d0]=__builtin_amdgcn_mfma_f32_32x32x16_bf16(pa1,PK(1),o[d0],0,0,0);
    o[d0]=__builtin_amdgcn_mfma_f32_32x32x16_bf16(pa2,PK(2),o[d0],0,0,0);
    o[d0]=__builtin_amdgcn_mfma_f32_32x32x16_bf16(pa3,PK(3),o[d0],0,0,0);
    #undef PK
  }
}

__device__ __forceinline__ void pv_pipe(f32x16*o,int vb,bf16x8 pa0,bf16x8 pa1,bf16x8 pa2,bf16x8 pa3){
  s16x4 lo0[4],hi0[4],lo1[4],hi1[4];
  #pragma unroll
  for(int ks=0;ks<4;++ks){
    asm volatile("ds_read_b64_tr_b16 %0,%1 offset:%c2":"=&v"(lo0[ks]):"v"(vb),"i"(ks*1024):"memory");
    asm volatile("ds_read_b64_tr_b16 %0,%1 offset:%c2":"=&v"(hi0[ks]):"v"(vb),"i"(ks*1024+512):"memory");}
  #pragma unroll
  for(int ks=0;ks<4;++ks){
    asm volatile("ds_read_b64_tr_b16 %0,%1 offset:%c2":"=&v"(lo1[ks]):"v"(vb),"i"(4096+ks*1024):"memory");
    asm volatile("ds_read_b64_tr_b16 %0,%1 offset:%c2":"=&v"(hi1[ks]):"v"(vb),"i"(4096+ks*1024+512):"memory");}
  #define PK0(k) (bf16x8){lo0[k][0],lo0[k][1],lo0[k][2],lo0[k][3],hi0[k][0],hi0[k][1],hi0[k][2],hi0[k][3]}
  #define PK1(k) (bf16x8){lo1[k][0],lo1[k][1],lo1[k][2],lo1[k][3],hi1[k][0],hi1[k][1],hi1[k][2],hi1[k][3]}
  asm volatile("s_waitcnt lgkmcnt(8)":::"memory");SBAR();
  o[0]=__builtin_amdgcn_mfma_f32_32x32x16_bf16(pa0,PK0(0),o[0],0,0,0);
  o[0]=__builtin_amdgcn_mfma_f32_32x32x16_bf16(pa1,PK0(1),o[0],0,0,0);
  asm volatile("s_waitcnt lgkmcnt(0)":::"memory");SBAR();
  o[1]=__builtin_amdgcn_mfma_f32_32x32x16_bf16(pa0,PK1(0),o[1],0,0,0);
  o[0]=__builtin_amdgcn_mfma_f32_32x32x16_bf16(pa2,PK0(2),o[0],0,0,0);
  o[1]=__builtin_amdgcn_mfma_f32_32x32x16_bf16(pa1,PK1(1),o[1],0,0,0);
  o[0]=__builtin_amdgcn_mfma_f32_32x32x16_bf16(pa3,PK0(3),o[0],0,0,0);
  o[1]=__builtin_amdgcn_mfma_f32_32x32x16_bf16(pa2,PK1(2),o[1],0,0,0);
  o[1]=__builtin_amdgcn_mfma_f32_32x32x16_bf16(pa3,PK1(3),o[1],0,0,0);
  #undef PK0
  #undef PK1
}
#ifndef ATTN_STORE16
#define ATTN_STORE16(p,v) (*(u32x4*)(p)=(v))
#endif
template<int THRL,int MODE> __device__ __forceinline__ void attn_unit(int b,int qb,const bf16*Q,const bf16*__restrict__ K,const bf16*__restrict__ V,bf16*O,char*shm,const int wv,const float lam,const float oscale,const float eps,const float*sg){
  const int lane=lane_now(),r32=lane&31,hi=lane>>5; const int wid=wv;
  const long rowbase=(long)b*SEQ; const int q0=qb*QB;
  const bf16*Qw=Q+(rowbase+q0+wid*QBLK)*PQ;
  const bf16*Kh=K+rowbase*PQ,*Vh=V+rowbase*PQ;
  const unsigned lds0=(unsigned)(uintptr_t)shm;
  float*wsf=(float*)(shm+LDS_WS)+wid*64;
  const bf16*ksrc=Kh+(long)lane*PQ+wid*8;
  const bf16*vsrc=Vh+(long)(16*(wid&3)+(lane>>2))*PQ+(wid>>2)*32+(lane&3)*8;
  const unsigned kdst=lds0+LDS_K+wid*1024, vdst=lds0+LDS_V+wid*1024;
  #define DMA_K(t,slot) glds16(ksrc+(long)(t)*KVBLK*PQ,(unsigned)__builtin_amdgcn_readfirstlane(kdst+(slot)))
  #define DMA_V(t,slot) do{ glds16(vsrc+(long)(t)*KVBLK*PQ,(unsigned)__builtin_amdgcn_readfirstlane(vdst+2*(slot))); glds16(vsrc+64+(long)(t)*KVBLK*PQ,(unsigned)__builtin_amdgcn_readfirstlane(vdst+2*(slot)+SLOTB)); }while(0)
  const int vb0=(int)(lds0+LDS_V)+((lane>>4)&1)*32+(lane&3)*8+(4*hi+((lane&15)>>2))*64;
  const char*Kbase=shm+LDS_K; bf16x8 kf[8];
  const lds_cptr shm3=(lds_cptr)shm; const lds_cptr kp0=shm3+LDS_K+hi*1024+r32*16; const lds_cptr vp0=shm3+LDS_V+((lane>>4)&1)*32+(lane&3)*8+(4*hi+((lane&15)>>2))*64;
  const int NT=(q0+QB)/KVBLK;
  DMA_K(0,0);DMA_V(0,0);DMA_K(1,SLOTB);
  bf16x8 qr[4];
  #pragma unroll
  for(int d0=0;d0<4;++d0)qr[d0]=*reinterpret_cast<const bf16x8*>(&Qw[(long)r32*PQ+d0*16+hi*8]);
  const lds_cptr qp0=shm3+LDS_OST+wid*4096+hi*512+r32*16;
  #pragma unroll
  for(int d0=0;d0<4;++d0)*(__attribute__((address_space(3))) bf16x8*)(shm3+LDS_OST+wid*4096+hi*512+r32*16+d0*1024)=qr[d0];
  #define QLD(d0) (*(const __attribute__((address_space(3))) bf16x8*)(qp0+(d0)*1024))
  float mhat=0.f,l_reg=0.f;f32x16 o[2],o2[2];o[0]=f32x16{};o[1]=f32x16{};o2[0]=f32x16{};o2[1]=f32x16{};f32x16 negm=f32x16{};asm volatile("":"+v"(negm));
  const int qrel=wid*QBLK+r32;
  #define CMASK(P0,P1,t) do{int jb_=(t)-(NT-4); if(jb_>=0)cmask(P0,P1,jb_,qrel,hi);}while(0)
  bool resc=false;
  #define START(P0,P1) do{ const float rm=rowmax(P0,P1); resc=false; \
    { const float dl=rm; mhat=fadd_s(mhat,dl); \
      _Pragma("unroll") for(int r=0;r<16;++r){P0[r]=fsub_s(P0[r],dl);P1[r]=fsub_s(P1[r],dl);} \
      _Pragma("unroll") for(int r=0;r<16;++r)negm[r]=-mhat; asm volatile("":"+v"(negm)); } \
    _Pragma("unroll") for(int r=0;r<16;++r)P0[r]=__builtin_amdgcn_exp2f(P0[r]); }while(0)
  #define RESC() do{ if(resc){ asm volatile("s_waitcnt lgkmcnt(0)":::"memory"); \
      _Pragma("unroll") for(int d_=0;d_<2;++d_) _Pragma("unroll") for(int r=0;r<16;++r){ const float f_=wsf[crow(r,hi)]; o[d_][r]*=f_; o2[d_][r]*=f_; } } }while(0)
  f32x16 pA0,pA1,pB0,pB1;
  int sl_prev=0,sl_cur=0,sl_next=SLOTB;
  #define ROT() do{sl_prev=sl_cur;sl_cur=sl_next;sl_next=(sl_next==(NSLOT-1)*SLOTB)?0:sl_next+SLOTB;}while(0)
  DMA_K(2,2*SLOTB);
  WAIT_BAR(4);
  qkt(pA0,pA1,Kbase,qr,negm,r32,hi);asm volatile("s_nop 15\n\ts_nop 7":"+v"(pA0),"+v"(pA1));CMASK(pA0,pA1,0);
  START(pA0,pA1);
  _Pragma("unroll") for(int r=0;r<16;++r)pA1[r]=__builtin_amdgcn_exp2f(pA1[r]);
  WAIT_BAR(0);
  DMA_K(3,0);DMA_V(1,SLOTB);
  ROT();
  kload8(kf,kp0+sl_cur);
  WAIT_BAR(3);
  s16x4 vlo[8],vhi[8]; u32x4 pw0,pw1,pw2,pw3;
  #define PKW(P,B) cvtpk_s(P[B],P[B+1])
  #define PAF(k) __builtin_bit_cast(bf16x8,pw##k)
  #define VFR(i) (bf16x8){vlo[i][0],vlo[i][1],vlo[i][2],vlo[i][3],vhi[i][0],vhi[i][1],vhi[i][2],vhi[i][3]}
  #define PKV(L,H,k) (bf16x8){L[k][0],L[k][1],L[k][2],L[k][3],H[k][0],H[k][1],H[k][2],H[k][3]}
  #define PIN(x) asm volatile("":"+v"(x))
  #define MX3(a,b,c) __builtin_fmaxf(__builtin_fmaxf((a),(b)),(c))
  #define GAPA(MF,A0,A1,A2,A3,W0,W1,PW) do{ MF; sacc+=A0; sacc+=A1; sacc+=A2; sacc+=A3; PIN(sacc); W0; W1; PIN(PW); SBAR(); }while(0)
  #define EX(v) __builtin_amdgcn_exp2f(v)
  #define GAPB(MF,X,B) do{ MF; X[B]=EX(X[B]); X[B+1]=EX(X[B+1]); PIN(X); SBAR(); }while(0)
  #define VRD(i) do{ vlo[i]=vtr(vp_+(((i)>>2)*4096+((i)&3)*1024)); vhi[i]=vtr(vp_+(((i)>>2)*4096+((i)&3)*1024+512)); }while(0)
  #define KRD(G,j) do{ if(G){ kload2(kf,kp0+sl_next,j); SBAR(); } }while(0)
  #define STEP(C0,C1,P0,P1,t,GK,GV,GL) do{ SBAR(); \
    const lds_cptr vp_=vp0+2*sl_prev; \
    VRD(0); bf16x8 qa_=QLD(0),qb_=QLD(1); SBAR(); float sacc=(P0[0]+P0[1]); \
    GAPA(C0=__builtin_amdgcn_mfma_f32_32x32x16_bf16(kf[0],qa_,negm,0,0,0), P0[2],P0[3],P0[4],P0[5],     pw0[0]=PKW(P0,0), pw0[1]=PKW(P0,2), pw0); \
    VRD(4); SBAR(); GAPA(C1=__builtin_amdgcn_mfma_f32_32x32x16_bf16(kf[1],qa_,negm,0,0,0), P0[6],P0[7],P0[8],P0[9],     pw0[2]=PKW(P0,4), pw0[3]=PKW(P0,6), pw0); \
    VRD(1); qa_=QLD(2); SBAR(); GAPA(C0=__builtin_amdgcn_mfma_f32_32x32x16_bf16(kf[2],qb_,C0,0,0,0),   P0[10],P0[11],P0[12],P0[13], pw1[0]=PKW(P0,8), pw1[1]=PKW(P0,10), pw1); \
    VRD(5); SBAR(); GAPA(C1=__builtin_amdgcn_mfma_f32_32x32x16_bf16(kf[3],qb_,C1,0,0,0),   P0[14],P0[15],P1[0],P1[1],   pw1[2]=PKW(P0,12),pw1[3]=PKW(P0,14), pw1); \
    VRD(2); qb_=QLD(3); SBAR(); GAPA(C0=__builtin_amdgcn_mfma_f32_32x32x16_bf16(kf[4],qa_,C0,0,0,0),   P1[2],P1[3],P1[4],P1[5],     pw2[0]=PKW(P1,0), pw2[1]=PKW(P1,2), pw2); \
    VRD(6); SBAR(); GAPA(C1=__builtin_amdgcn_mfma_f32_32x32x16_bf16(kf[5],qa_,C1,0,0,0),   P1[6],P1[7],P1[8],P1[9],     pw2[2]=PKW(P1,4), pw2[3]=PKW(P1,6), pw2); \
    VRD(3); SBAR(); GAPA(C0=__builtin_amdgcn_mfma_f32_32x32x16_bf16(kf[6],qb_,C0,0,0,0),   P1[10],P1[11],P1[12],P1[13], pw3[0]=PKW(P1,8), pw3[1]=PKW(P1,10), pw3); \
    VRD(7); SBAR(); GAPA(C1=__builtin_amdgcn_mfma_f32_32x32x16_bf16(kf[7],qb_,C1,0,0,0),   P1[14],P1[15],0.f,0.f,       pw3[2]=PKW(P1,12),pw3[3]=PKW(P1,14), pw3); \
    l_reg+=sacc; \
    if(GK){DMA_K((t)+3,sl_cur);} if(GV){DMA_V((t)+1,sl_next);} \
    CMASK(C0,C1,t); \
    { float a=MX3(C0[0],C0[1],C1[0]),b=MX3(C0[2],C0[3],C1[1]); a=MX3(a,C1[2],C1[3]); \
      _Pragma("unroll") for(int r=4;r<16;r+=4){a=MX3(a,C0[r],C0[r+1]);b=MX3(b,C0[r+2],C0[r+3]);a=MX3(a,C1[r],C1[r+1]);b=MX3(b,C1[r+2],C1[r+3]);} \
      float rm=__builtin_fmaxf(a,b); { auto rr=__builtin_amdgcn_permlane32_swap(__float_as_uint(rm),__float_as_uint(rm),false,false); rm=__builtin_fmaxf(__uint_as_float(rr[0]),__uint_as_float(rr[1])); } \
      resc=false; \
      if(__builtin_expect(__any(rm>(float)THRL),0)){ const float dl=__builtin_fmaxf(rm,0.f); mhat+=dl; \
        _Pragma("unroll") for(int r=0;r<16;++r){C0[r]-=dl;C1[r]-=dl;} \
        _Pragma("unroll") for(int r=0;r<16;++r)negm[r]=-mhat; asm volatile("":"+v"(negm)); \
        const float f=__builtin_amdgcn_exp2f(-dl); l_reg*=f; { const int l2_=lane_now(); if(l2_<32)((__attribute__((address_space(3))) float*)(shm3+LDS_WS))[wid*64+l2_]=f; } resc=true; } } \
    SBAR(); \
    GAPB(o[0]=__builtin_amdgcn_mfma_f32_32x32x16_bf16(PAF(0),VFR(0),o[0],0,0,0), C0,0); \
    GAPB(o[1]=__builtin_amdgcn_mfma_f32_32x32x16_bf16(PAF(0),VFR(4),o[1],0,0,0), C0,2); \
    KRD(GL,0); GAPB(o[0]=__builtin_amdgcn_mfma_f32_32x32x16_bf16(PAF(1),VFR(1),o[0],0,0,0), C0,4); \
    KRD(GL,1); GAPB(o[1]=__builtin_amdgcn_mfma_f32_32x32x16_bf16(PAF(1),VFR(5),o[1],0,0,0), C0,6); \
    KRD(GL,2); GAPB(o[0]=__builtin_amdgcn_mfma_f32_32x32x16_bf16(PAF(2),VFR(2),o[0],0,0,0), C0,8); \
    KRD(GL,3); GAPB(o[1]=__builtin_amdgcn_mfma_f32_32x32x16_bf16(PAF(2),VFR(6),o[1],0,0,0), C0,10); \
    GAPB(o[0]=__builtin_amdgcn_mfma_f32_32x32x16_bf16(PAF(3),VFR(3),o[0],0,0,0), C0,12); \
    GAPB(o[1]=__builtin_amdgcn_mfma_f32_32x32x16_bf16(PAF(3),VFR(7),o[1],0,0,0), C0,14); \
    {   \
      const int vb2_=vb0+2*sl_prev+SLOTB; s16x4 lo0_[4],hi0_[4],lo1_[4],hi1_[4]; \
      _Pragma("unroll") for(int ks=0;ks<4;++ks){ \
        asm volatile("ds_read_b64_tr_b16 %0,%1 offset:%c2":"=&v"(lo0_[ks]):"v"(vb2_),"i"(ks*1024):"memory"); \
        asm volatile("ds_read_b64_tr_b16 %0,%1 offset:%c2":"=&v"(hi0_[ks]):"v"(vb2_),"i"(ks*1024+512):"memory");} \
      _Pragma("unroll") for(int ks=0;ks<4;++ks){ \
        asm volatile("ds_read_b64_tr_b16 %0,%1 offset:%c2":"=&v"(lo1_[ks]):"v"(vb2_),"i"(4096+ks*1024):"memory"); \
        asm volatile("ds_read_b64_tr_b16 %0,%1 offset:%c2":"=&v"(hi1_[ks]):"v"(vb2_),"i"(4096+ks*1024+512):"memory");} \
      asm volatile("s_waitcnt lgkmcnt(8)":::"memory");SBAR(); \
      GAPB(o2[0]=__builtin_amdgcn_mfma_f32_32x32x16_bf16(PAF(0),PKV(lo0_,hi0_,0),o2[0],0,0,0), C1,0); \
      GAPB(o2[0]=__builtin_amdgcn_mfma_f32_32x32x16_bf16(PAF(1),PKV(lo0_,hi0_,1),o2[0],0,0,0), C1,2); \
      asm volatile("s_waitcnt lgkmcnt(0)":::"memory");SBAR(); \
      GAPB(o2[1]=__builtin_amdgcn_mfma_f32_32x32x16_bf16(PAF(0),PKV(lo1_,hi1_,0),o2[1],0,0,0), C1,4); \
      GAPB(o2[0]=__builtin_amdgcn_mfma_f32_32x32x16_bf16(PAF(2),PKV(lo0_,hi0_,2),o2[0],0,0,0), C1,6); \
      GAPB(o2[1]=__builtin_amdgcn_mfma_f32_32x32x16_bf16(PAF(1),PKV(lo1_,hi1_,1),o2[1],0,0,0), C1,8); \
      GAPB(o2[0]=__builtin_amdgcn_mfma_f32_32x32x16_bf16(PAF(3),PKV(lo0_,hi0_,3),o2[0],0,0,0), C1,10); \
      GAPB(o2[1]=__builtin_amdgcn_mfma_f32_32x32x16_bf16(PAF(2),PKV(lo1_,hi1_,2),o2[1],0,0,0), C1,12); \
      GAPB(o2[1]=__builtin_amdgcn_mfma_f32_32x32x16_bf16(PAF(3),PKV(lo1_,hi1_,3),o2[1],0,0,0), C1,14); } \
    }while(0)
  int t=1;
  #undef CMASK
  #define CMASK(P0,P1,t) do{}while(0)
  for(;t+5<NT;t+=2){
    STEP(pB0,pB1,pA0,pA1,t,true,true,true);     WAIT_BAR(3); RESC(); ROT();
    STEP(pA0,pA1,pB0,pB1,t+1,true,true,true);   WAIT_BAR(3); RESC(); ROT();
  }
  #undef CMASK
  int qrelb=qrel; asm volatile("":"+v"(qrelb));
  #define CMASK(P0,P1,t) do{int jb_=(t)-(NT-4); if(jb_>=0)cmask(P0,P1,jb_,qrelb,hi);}while(0)
  #define ENDW(tt) do{ if((tt)+3<NT){WAIT_BAR(3);} else if((tt)+2<NT){WAIT_BAR(2);} else {WAIT_BAR(0);} }while(0)
  for(;t+1<NT;t+=2){
    STEP(pB0,pB1,pA0,pA1,t,(t+3<NT),(t+1<NT),(t+1<NT));       ENDW(t);   RESC(); ROT();
    STEP(pA0,pA1,pB0,pB1,t+1,(t+4<NT),(t+2<NT),(t+2<NT));     ENDW(t+1); RESC(); ROT();
  }
  STEP(pB0,pB1,pA0,pA1,NT-1,false,false,false); RESC();
  { float sacc=pB0[0]+pB0[1]; _Pragma("unroll") for(int r=2;r<16;++r)sacc+=pB0[r]; _Pragma("unroll") for(int r=0;r<16;++r)sacc+=pB1[r]; l_reg+=sacc;
    pw0=(u32x4){PKW(pB0,0),PKW(pB0,2),PKW(pB0,4),PKW(pB0,6)};pw1=(u32x4){PKW(pB0,8),PKW(pB0,10),PKW(pB0,12),PKW(pB0,14)};pw2=(u32x4){PKW(pB1,0),PKW(pB1,2),PKW(pB1,4),PKW(pB1,6)};pw3=(u32x4){PKW(pB1,8),PKW(pB1,10),PKW(pB1,12),PKW(pB1,14)};
    SBAR(); { const int l3_=lane_now(); const int vb3_=(int)(lds0+LDS_V)+((l3_>>4)&1)*32+(l3_&3)*8+(4*(l3_>>5)+((l3_&15)>>2))*64;
      pv(o,vb3_+2*sl_cur,PAF(0),PAF(1),PAF(2),PAF(3)); pv(o2,vb3_+2*sl_cur+SLOTB,PAF(0),PAF(1),PAF(2),PAF(3)); } }
  #undef PKW
  #undef PAF
  #undef VFR
  #undef PIN
  #undef MX3
  #undef GAPA
  #undef GAPB
  #undef EX
  #undef VRD
  #undef KRD
  #undef STEP
  #undef ENDW
  {auto rr=__builtin_amdgcn_permlane32_swap(__float_as_uint(l_reg),__float_as_uint(l_reg),false,false);l_reg=__uint_as_float(rr[0])+__uint_as_float(rr[1]);}
  { const int le=lane_now(),r32e=le&31,hie=le>>5; float*wse=(float*)(shm+LDS_WS)+wid*64;
  if(hie==0)wse[32+r32e]=l_reg;asm volatile("s_waitcnt lgkmcnt(0)":::"memory");
  float rli[16];
  #pragma unroll
  for(int r=0;r<16;++r)rli[r]=__builtin_amdgcn_rcpf(wse[32+crow(r,hie)]);
  bf16*Ow=O+(rowbase+q0+wid*QBLK)*PO;
  { bf16*stg=(bf16*)(shm+LDS_OST)+wid*2048;
    float yv[2][4][8];
    #pragma unroll
    for(int half=0;half<2;++half){
      #pragma unroll
      for(int r=0;r<16;++r){const int orow=crow(r,hie);
        #pragma unroll
        for(int d0=0;d0<2;++d0)stg[orow*64+d0*32+r32e]=__float2bfloat16((half?o2[d0][r]:o[d0][r])*rli[r]);}
      asm volatile("s_waitcnt lgkmcnt(0)":::"memory");
      #pragma unroll
      for(int i=0;i<4;++i){const int row=i*8+(le>>3),ch=le&7; const u32x4 v=*(const u32x4*)(stg+row*64+ch*8);
        if(MODE==0){ ATTN_STORE16(Ow+(long)row*PO+half*64+ch*8,v); }
        else{ const u32x4 w=*(const u32x4*)(Ow+(long)row*PO+half*64+ch*8);
          #pragma unroll
          for(int e=0;e<4;++e){ yv[half][i][2*e]=__uint_as_float(w[e]<<16)-lam*__uint_as_float(v[e]<<16); yv[half][i][2*e+1]=__uint_as_float(w[e]&0xffff0000u)-lam*__uint_as_float(v[e]&0xffff0000u); } } }
      asm volatile("s_waitcnt lgkmcnt(0)":::"memory"); }
    if(MODE==1){ const int ch=le&7; float gg[2][8];
      #pragma unroll
      for(int half=0;half<2;++half)
        #pragma unroll
        for(int e=0;e<8;++e)gg[half][e]=sg[half*64+ch*8+e]*oscale;
      #pragma unroll
      for(int i=0;i<4;++i){ float ss=0.f;
        #pragma unroll
        for(int half=0;half<2;++half)
          #pragma unroll
          for(int e=0;e<8;++e)ss+=yv[half][i][e]*yv[half][i][e];
        ss+=__builtin_bit_cast(float,__builtin_amdgcn_update_dpp(0,__builtin_bit_cast(int,ss),0xB1,0xF,0xF,false));
        ss+=__builtin_bit_cast(float,__builtin_amdgcn_update_dpp(0,__builtin_bit_cast(int,ss),0x4E,0xF,0xF,false));
        ss+=__builtin_bit_cast(float,__builtin_amdgcn_update_dpp(0,__builtin_bit_cast(int,ss),0x141,0xF,0xF,false));
        const float rs=__builtin_amdgcn_rsqf(ss*(1.f/128.f)+eps); const int row=i*8+(le>>3);
        #pragma unroll
        for(int half=0;half<2;++half){ u32x4 ov;
          #pragma unroll
          for(int e=0;e<4;++e)ov[e]=cvtpk_s(yv[half][i][2*e]*rs*gg[half][2*e],yv[half][i][2*e+1]*rs*gg[half][2*e+1]);
          ATTN_STORE16(Ow+(long)row*PO+half*64+ch*8,ov); } } } } }
  asm volatile("s_waitcnt lgkmcnt(0)\n\ts_barrier":::"memory");
  #undef DMA_K
  #undef DMA_V
  #undef QLD
  #undef CMASK
  #undef START
  #undef RESC
  #undef ROT
}
constexpr int ATTN_LDS_BYTES=LDS_BYTES;
struct AttnTensors { const bf16* Q; const bf16* K; const bf16* V; bf16* O; float lam, oscale, eps; const float* sg; };
struct AttnUnit { int b; int h; int qb; };
struct StaticOrder {
  int vcu, G;
  __device__ __forceinline__ StaticOrder(int grid,int vcu_):vcu(vcu_),G(grid){}
  __device__ __forceinline__ bool next(int i,AttnUnit&u)const{
    if(G==256){ if(i>=2)return false; const int s=vcu&7,bv=vcu>>3; u.b=bv>>2; u.h=bv&3; u.qb=(i==0)?s:15-s; return true; }
    const int L=i*G+vcu; if(L>=BATCH*4*NQB)return false; u.b=L/(4*NQB); u.h=(L/NQB)%4; u.qb=L%NQB; return true; }
};
template<class Sched,int THRL=8> __device__ __forceinline__ void attn_phase(char*lds,const AttnTensors&T,const Sched&S,const int wv){
  AttnUnit u;
  for(int i=0;S.next(i,u);++i){ const int h=u.h;
    attn_unit<THRL,0>(u.b,u.qb,T.Q+(2*h)*64,T.K+(2*h)*64,T.V+h*128,T.O+h*128,lds,wv,T.lam,T.oscale,T.eps,T.sg);
    attn_unit<THRL,1>(u.b,u.qb,T.Q+(2*h+1)*64,T.K+(2*h+1)*64,T.V+h*128,T.O+h*128,lds,wv,T.lam,T.oscale,T.eps,T.sg); }
}
#undef SBAR
#undef WAIT_BAR
}

constexpr int NWAVES = 8;
#ifndef MK_N_LAUNCHES
#define MK_N_LAUNCHES 1
#endif
constexpr int NPHASE = 13;
constexpr int N_LAUNCHES = MK_N_LAUNCHES;

constexpr int BATCH = 8, SEQ = 4096, D = 1024, M = BATCH * SEQ;
constexpr int NPROJ = 3072;
constexpr int C_DQ = 0, C_DK = 512, C_DV = 1024, C_MQ = 1536, C_MK = 2048, C_MO = 2560;
constexpr int MEMLEN = 256, MROWS = BATCH * MEMLEN;
constexpr int NEXP = 32, DEXP = 512, MAXROWS = 73728;
constexpr int NCH = 64, CHL = 64, DVX = 144;
constexpr int CS_UNIT = DVX * 128;
constexpr float EPS = 1e-6f;
constexpr float LAM_INIT = 0.2f;
constexpr float FOLD_SCALE = 4.f, P_SCALE = 64.f;
constexpr float W13_SCALE = 32.f, W2_SCALE = 16.f, ACT_SCALE = 4.f, YE_SCALE = 8.f;
constexpr float XSCALE = 0.0625f * 1.4426950408889634f;

constexpr size_t MiB = 1u << 20;
constexpr size_t WS_CTL = 0, CTL_ZERO_BYTES = 1 * MiB;
constexpr size_t WS_GATE = 2 * MiB, WS_ROPE = 3 * MiB, WS_ACUM = 4 * MiB, WS_USUB = 4 * MiB + 512 * 1024, WS_SC = 5 * MiB;
constexpr size_t WS_RSTD0 = 5 * MiB + 128 * 1024;
constexpr size_t WS_RT = 5 * MiB + 768 * 1024;
constexpr size_t WS_RSTD2 = 5 * MiB + 512 * 1024;
constexpr size_t WS_TOKL = 6 * MiB, WS_ASG = 10 * MiB, WS_MEMN = 12 * MiB, WS_MK = 16 * MiB, WS_MVT2 = 20 * MiB;
constexpr size_t WS_WIN = 24 * MiB, WS_WOUT = 31 * MiB, WS_WXQ = 33 * MiB, WS_WKV = 35 * MiB, WS_WXO = 39 * MiB, WS_W13 = 41 * MiB, WS_W2 = 105 * MiB;
constexpr size_t WS_PROJ = 140 * MiB;
constexpr size_t WS_MVT = 332 * MiB;
constexpr size_t WS_XB = 140 * MiB, WS_XQ = 204 * MiB, WS_XO = 268 * MiB;
constexpr size_t WS_H3 = 204 * MiB, WS_ACT = 268 * MiB, WS_YE = 340 * MiB;
constexpr size_t WS_FOLD = 432 * MiB;
constexpr size_t WS_H8 = 448 * MiB;
constexpr size_t WS_OA = 364 * MiB;
constexpr size_t WS_END = 484 * MiB;
static_assert(WS_YE + (size_t)MAXROWS * 1024 * 2 <= WS_END && WS_ACT + (size_t)MAXROWS * 512 * 2 <= WS_YE && WS_PROJ + (size_t)M * NPROJ * 2 <= WS_MVT && WS_MVT + (size_t)512 * M * 2 <= WS_OA, "d_ws map");
constexpr int CW_TMO = 0, CW_CODE = 1, CW_CNT = 1024, CW_ROWSS = 16384, CW_READY = 49152, CW_BAR = 65536;
constexpr int RING_OFF = 0, RING_BYTES = 131072;
constexpr int XT_TS = 131072, XT_TOK = 131072 + 256, XT_RS = XT_TOK + 5 * 1024;
constexpr int LDSCTL_OFF = 158720, MISC_OFF = LDSCTL_OFF + 320;
constexpr int LDS_BYTES = 159744;
static_assert(MISC_OFF + 128 <= LDS_BYTES, "LDS map");

#define GAS __attribute__((address_space(1)))
#define LAS __attribute__((address_space(3)))
typedef unsigned short bf16;
typedef unsigned v4u __attribute__((ext_vector_type(4)));
typedef float f32x4 __attribute__((ext_vector_type(4)));
typedef short bf16x8 __attribute__((ext_vector_type(8)));
typedef GAS unsigned gu32;
typedef GAS unsigned long long gu64;
#define RLX_AGENT __ATOMIC_RELAXED, __HIP_MEMORY_SCOPE_AGENT
#define LDS_WAIT() asm volatile("s_waitcnt lgkmcnt(0)" ::: "memory")
#define VM_WAIT() asm volatile("s_waitcnt vmcnt(0)" ::: "memory")
__device__ __forceinline__ unsigned long long rt() { return __builtin_amdgcn_s_memrealtime(); }
__device__ __forceinline__ unsigned f2bf(float f) { unsigned u = __builtin_bit_cast(unsigned, f); return (u + 0x7fffu + ((u >> 16) & 1u)) >> 16; }
typedef float f32x2_t_ __attribute__((ext_vector_type(2))); typedef __bf16 bf16x2_t_ __attribute__((ext_vector_type(2)));
__device__ __forceinline__ unsigned pk2(float lo, float hi) { f32x2_t_ v = {lo, hi}; bf16x2_t_ b = __builtin_convertvector(v, bf16x2_t_); return __builtin_bit_cast(unsigned, b); }

#define XB_TMO      128
#define XB_XCNT(j)  (256  + 64 * (j))
#define XB_XSUB(j)  (1280 + 64 * (j))
#define XB_XGEN(j)  (2304 + 64 * (j))
#define XB_TOP      3328
#define XB_TOPGEN   3392
#define XCD_BAR_WORDS 3456
#define XB_SPIN_CAP (1u << 18)

__device__ __forceinline__ unsigned xb_ld(unsigned* p)              { return __hip_atomic_load(p, __ATOMIC_RELAXED, __HIP_MEMORY_SCOPE_AGENT); }
__device__ __forceinline__ unsigned xb_add(unsigned* p, unsigned v) { return __hip_atomic_fetch_add(p, v, __ATOMIC_RELAXED, __HIP_MEMORY_SCOPE_AGENT); }
__device__ __forceinline__ unsigned xb_xcc_id() { return (unsigned)__builtin_amdgcn_s_getreg((3 << 11) | 20) & 0xFu; }
#define XB_SPIN(cond, bar) do { unsigned _sp = 0; while (cond) { __builtin_amdgcn_s_sleep(1); \
    if ((++_sp & 255u) == 0u) { if (xb_ld(&(bar)[XB_TMO])) break; if (_sp > XB_SPIN_CAP) { atomicAdd(&(bar)[XB_TMO], 1u); break; } } } } while (0)

struct XcdBarrier {
    unsigned* bar; unsigned x;
    volatile LAS unsigned* st;
};

__device__ __forceinline__ XcdBarrier xcd_barrier_post(unsigned* bar, volatile LAS unsigned* st) {
    XcdBarrier b; b.bar = bar; b.x = xb_xcc_id(); b.st = st;
    if (threadIdx.x == 0) (void)xb_add(&bar[XB_XCNT(b.x)], 1u);
    return b;
}
__device__ __forceinline__ void xcd_barrier_complete(unsigned* bar, unsigned x, unsigned& nloc, unsigned& nx) {
    const unsigned G = gridDim.x * gridDim.y * gridDim.z;
    unsigned sum, cnt, mine, sp = 0u;
    for (;;) {
        sum = 0u; cnt = 0u; mine = 0u;
#pragma unroll
        for (unsigned j = 0; j < 16; ++j) { const unsigned c = xb_ld(&bar[XB_XCNT(j)]); sum += c; cnt += (c > 0u) ? 1u : 0u; mine = (j == x) ? c : mine; }
        if (sum == G) break;
        __builtin_amdgcn_s_sleep(1);
        if ((++sp & 255u) == 0u) { if (xb_ld(&bar[XB_TMO])) break; if (sp > XB_SPIN_CAP) { atomicAdd(&bar[XB_TMO], 1u); break; } }
    }
    nloc = mine > 0u ? mine : 1u; nx = cnt > 0u ? cnt : 1u;
}

__device__ __forceinline__ void xcd_barrier(const XcdBarrier& b, const int wv) {
    asm volatile("s_waitcnt vmcnt(0)" ::: "memory");
    __syncthreads();
    if (wv == 0 && lane_now() == 0) {
        unsigned* bar = b.bar;
        __builtin_amdgcn_s_waitcnt(0);
        unsigned nloc = b.st[0], nx = b.st[1];
        if (nloc == 0u) { xcd_barrier_complete(bar, b.x, nloc, nx); b.st[0] = nloc; b.st[1] = nx; }
        const unsigned old = xb_add(&bar[XB_XSUB(b.x)], 1u);
        const unsigned gen = old / nloc;
        if (old + 1u == (gen + 1u) * nloc) {
            __builtin_amdgcn_fence(__ATOMIC_RELEASE, "agent");
            asm volatile("s_waitcnt vmcnt(0)" ::: "memory");
            const unsigned og = xb_add(&bar[XB_TOP], 1u);
            const unsigned tg = og / nx;
            if (og + 1u == (tg + 1u) * nx) xb_add(&bar[XB_TOPGEN], 1u);
            else XB_SPIN(xb_ld(&bar[XB_TOPGEN]) == tg, bar);
            __builtin_amdgcn_fence(__ATOMIC_ACQUIRE, "agent");
            xb_add(&bar[XB_XGEN(b.x)], 1u);
            asm volatile("s_waitcnt vmcnt(0)" ::: "memory");
        } else {
            XB_SPIN(xb_ld(&bar[XB_XGEN(b.x)]) == gen, bar);
            __builtin_amdgcn_fence(__ATOMIC_ACQUIRE, "agent");
            asm volatile("s_waitcnt vmcnt(0)" ::: "memory");
        }
    }
    __syncthreads();
}


typedef unsigned u32x2 __attribute__((ext_vector_type(2))); typedef unsigned u32x4 __attribute__((ext_vector_type(4)));
struct Frame {
    LAS unsigned char* lds;
    volatile LAS unsigned* MISC;
    gu32* ctl;
    int wave;
    int vcu, G;
    const float* in[26]; float* out; unsigned char* ws;
};
#ifndef PRIM_RED
#define PRIM_RED 1
#define PRIM_ROW 1
#define PRIM_SCAN 1
#define PRIM_MATH 1
#endif
#define DPPF(old_, v_, ctrl, rm) __builtin_bit_cast(float, __builtin_amdgcn_update_dpp(__builtin_bit_cast(int, (float)(old_)), __builtin_bit_cast(int, (float)(v_)), ctrl, rm, 0xF, false))
#if PRIM_RED
__device__ __forceinline__ float wave_sum(float v) {
    v += DPPF(0.f, v, 0xB1, 0xF); v += DPPF(0.f, v, 0x4E, 0xF); v += DPPF(0.f, v, 0x141, 0xF); v += DPPF(0.f, v, 0x140, 0xF);
    { auto r = __builtin_amdgcn_permlane16_swap(__float_as_uint(v), __float_as_uint(v), false, false); v = __uint_as_float(r[0]) + __uint_as_float(r[1]); }
    { auto r = __builtin_amdgcn_permlane32_swap(__float_as_uint(v), __float_as_uint(v), false, false); v = __uint_as_float(r[0]) + __uint_as_float(r[1]); }
    return v;
}
__device__ __forceinline__ float wave_max(float v) {
    v = fmaxf(v, DPPF(v, v, 0xB1, 0xF)); v = fmaxf(v, DPPF(v, v, 0x4E, 0xF)); v = fmaxf(v, DPPF(v, v, 0x141, 0xF)); v = fmaxf(v, DPPF(v, v, 0x140, 0xF));
    { auto r = __builtin_amdgcn_permlane16_swap(__float_as_uint(v), __float_as_uint(v), false, false); v = fmaxf(__uint_as_float(r[0]), __uint_as_float(r[1])); }
    { auto r = __builtin_amdgcn_permlane32_swap(__float_as_uint(v), __float_as_uint(v), false, false); v = fmaxf(__uint_as_float(r[0]), __uint_as_float(r[1])); }
    return v;
}
#else
__device__ __forceinline__ float wave_sum(float v) { for (int o = 1; o < 64; o <<= 1) v += __shfl_xor(v, o); return v; }
__device__ __forceinline__ float wave_max(float v) { for (int o = 1; o < 64; o <<= 1) v = fmaxf(v, __shfl_xor(v, o)); return v; }
#endif
#if PRIM_ROW
__device__ __forceinline__ float row8_sum(float v) { v += DPPF(0.f, v, 0xB1, 0xF); v += DPPF(0.f, v, 0x4E, 0xF); v += DPPF(0.f, v, 0x141, 0xF); return v; }
__device__ __forceinline__ float row16_sum(float v) { v += DPPF(0.f, v, 0xB1, 0xF); v += DPPF(0.f, v, 0x4E, 0xF); v += DPPF(0.f, v, 0x141, 0xF); v += DPPF(0.f, v, 0x140, 0xF); return v; }
#else
__device__ __forceinline__ float row16_sum(float v) { v += __shfl_xor(v, 1); v += __shfl_xor(v, 2); v += __shfl_xor(v, 4); v += __shfl_xor(v, 8); return v; }
__device__ __forceinline__ float row8_sum(float v) { v += __shfl_xor(v, 1); v += __shfl_xor(v, 2); v += __shfl_xor(v, 4); return v; }
#endif
#if PRIM_SCAN
__device__ __forceinline__ float wave_scan_sum(float v) {
    v += DPPF(0.f, v, 0x111, 0xF); v += DPPF(0.f, v, 0x112, 0xF); v += DPPF(0.f, v, 0x114, 0xF); v += DPPF(0.f, v, 0x118, 0xF);
    v += DPPF(0.f, v, 0x142, 0xA); v += DPPF(0.f, v, 0x143, 0xC); return v;
}
__device__ __forceinline__ float wave_scan_max(float v) {
    const float NI = -INFINITY;
    v = fmaxf(v, DPPF(NI, v, 0x111, 0xF)); v = fmaxf(v, DPPF(NI, v, 0x112, 0xF)); v = fmaxf(v, DPPF(NI, v, 0x114, 0xF)); v = fmaxf(v, DPPF(NI, v, 0x118, 0xF));
    v = fmaxf(v, DPPF(NI, v, 0x142, 0xA)); v = fmaxf(v, DPPF(NI, v, 0x143, 0xC)); return v;
}
#else
__device__ __forceinline__ float wave_scan_sum(float v) { const int l = lane_now(); for (int o = 1; o < 64; o <<= 1) { const float t = __shfl_up(v, o); if (l >= o) v += t; } return v; }
__device__ __forceinline__ float wave_scan_max(float v) { const int l = lane_now(); for (int o = 1; o < 64; o <<= 1) { const float t = __shfl_up(v, o); if (l >= o) v = fmaxf(v, t); } return v; }
#endif
#if PRIM_MATH
__device__ __forceinline__ float fexp(float x) { return __builtin_amdgcn_exp2f(x * 1.4426950408889634f); }
__device__ __forceinline__ float fsigmoid(float x) { return __builtin_amdgcn_rcpf(1.f + __builtin_amdgcn_exp2f(-1.4426950408889634f * x)); }
__device__ __forceinline__ float frsq(float x) { return __builtin_amdgcn_rsqf(x); }
#else
__device__ __forceinline__ float fexp(float x) { return expf(x); }
__device__ __forceinline__ float fsigmoid(float x) { return 1.f / (1.f + expf(-x)); }
__device__ __forceinline__ float frsq(float x) { return 1.f / sqrtf(x); }
#endif
__device__ __forceinline__ float bf2f(unsigned short b) { return __uint_as_float((unsigned)b << 16); }
__device__ __forceinline__ float bflo(unsigned w) { return __uint_as_float(w << 16); }
__device__ __forceinline__ float bfhi(unsigned w) { return __uint_as_float(w & 0xffff0000u); }
__device__ __forceinline__ float dot4(f32x4 a, f32x4 b) { return (a.x * b.x + a.y * b.y) + (a.z * b.z + a.w * b.w); }
#define WG_SYNC() __syncthreads()

struct RowMap { int mode, off;
    __device__ __forceinline__ int operator()(int n) const {
        if (mode == 1) return (n < 1024) ? ((n & ~255) | (((n >> 5) & 1) << 7) | (((n >> 6) & 3) << 5) | (n & 31)) : (n < 2560) ? n : (n < 3072) ? n + 512 : n - 512;
        if (mode == 2) return ((n >> 7) << 8) + off + (n & 127);
        return off + n; } };
struct TrItem { const float* W; bf16* WT; const float* ks; int K, ldw, nblk, local; RowMap rm; float f8 = 0.f; };
__device__ __forceinline__ unsigned pk4_fp8(float a, float b, float c, float d) { int w = __builtin_amdgcn_cvt_pk_fp8_f32(a, b, 0, false); w = __builtin_amdgcn_cvt_pk_fp8_f32(c, d, w, true); return (unsigned)w; }
__device__ __forceinline__ void tr_load(const TrItem& t, int lane, f32x4 (&x)[8]) {
    const int kb = t.local / t.nblk, nb = t.local % t.nblk, k0 = 64 * kb, n0 = 32 * nb;
#pragma unroll
    for (int i = 0; i < 8; ++i) x[i] = __builtin_nontemporal_load((const GAS f32x4*)(t.W + (size_t)(k0 + 8 * i + (lane >> 3)) * t.ldw + n0 + 4 * (lane & 7)));
}
__device__ __forceinline__ void tr_finish(const TrItem& t, int lane, const f32x4 (&x)[8], LAS float* scr) {
    const int kb = t.local / t.nblk, nb = t.local % t.nblk, k0 = 64 * kb, n0 = 32 * nb;
#pragma unroll
    for (int i = 0; i < 8; ++i) { LAS float* d = scr + (8 * i + (lane >> 3)) * 33 + 4 * (lane & 7); d[0] = x[i].x; d[1] = x[i].y; d[2] = x[i].z; d[3] = x[i].w; }
    LDS_WAIT(); asm volatile("" ::: "memory");
    const int c = lane & 7;
    f32x4 ks0 = {1.f, 1.f, 1.f, 1.f}, ks1 = ks0;
    if (t.ks) { ks0 = *(const GAS f32x4*)(t.ks + k0 + 8 * c); ks1 = *(const GAS f32x4*)(t.ks + k0 + 8 * c + 4); }
    if (t.f8 != 0.f) { ks0 = ks0 * t.f8; ks1 = ks1 * t.f8;
#pragma unroll
        for (int j = 0; j < 4; ++j) { const int n = (lane >> 3) + 8 * j; const LAS float* s = scr + (8 * c) * 33 + n;
            u32x2 o8; o8.x = pk4_fp8(s[0 * 33] * ks0.x, s[1 * 33] * ks0.y, s[2 * 33] * ks0.z, s[3 * 33] * ks0.w); o8.y = pk4_fp8(s[4 * 33] * ks1.x, s[5 * 33] * ks1.y, s[6 * 33] * ks1.z, s[7 * 33] * ks1.w);
            __builtin_nontemporal_store(o8, (GAS u32x2*)((unsigned char*)t.WT + (size_t)t.rm(n0 + n) * t.K + k0 + 8 * c)); }
        LDS_WAIT(); asm volatile("" ::: "memory"); return; }
#pragma unroll
    for (int j = 0; j < 4; ++j) { const int n = (lane >> 3) + 8 * j; const LAS float* s = scr + (8 * c) * 33 + n;
        v4u o; o.x = pk2(s[0 * 33] * ks0.x, s[1 * 33] * ks0.y); o.y = pk2(s[2 * 33] * ks0.z, s[3 * 33] * ks0.w); o.z = pk2(s[4 * 33] * ks1.x, s[5 * 33] * ks1.y); o.w = pk2(s[6 * 33] * ks1.z, s[7 * 33] * ks1.w);
        GAS v4u* dst_ = (GAS v4u*)(t.WT + (size_t)t.rm(n0 + n) * t.K + k0 + 8 * c);
        if (t.rm.mode == 2) __builtin_nontemporal_store(o, dst_); else *dst_ = o; }
    LDS_WAIT(); asm volatile("" ::: "memory");
}
__device__ __forceinline__ void p0_transpose_item(const float* W, int K, int ldw, int nblk, bf16* WT, const RowMap rm, const float* kscale, LAS float* scr, int item, int lane) {
    TrItem t{W, WT, kscale, K, ldw, nblk, item, rm}; f32x4 x[8]; tr_load(t, lane, x); tr_finish(t, lane, x, scr);
}
__device__ __forceinline__ void rms_row(const int lane, f32x4 (&v)[4], const float* g, bf16* orow, const LAS float* gw, float* gate_out, const float* gate_b, float* rstd_out = nullptr) {
    const GAS f32x4* gr = (const GAS f32x4*)g + 2 * lane;
    float s = 0.f;
#pragma unroll
    for (int j = 0; j < 4; ++j) s += dot4(v[j], v[j]);
    const float rstd = frsq(wave_sum(s) * (1.f / D) + EPS);
    GAS v4u* o16 = (GAS v4u*)orow + lane; v4u o;
    if (rstd_out) {
        o.x = pk2(v[0].x, v[0].y); o.y = pk2(v[0].z, v[0].w); o.z = pk2(v[1].x, v[1].y); o.w = pk2(v[1].z, v[1].w); o16[0] = o;
        o.x = pk2(v[2].x, v[2].y); o.y = pk2(v[2].z, v[2].w); o.z = pk2(v[3].x, v[3].y); o.w = pk2(v[3].z, v[3].w); o16[64] = o;
        if (lane == 0) *rstd_out = rstd; }
    v[0] = v[0] * rstd * gr[0]; v[1] = v[1] * rstd * gr[1]; v[2] = v[2] * rstd * gr[128]; v[3] = v[3] * rstd * gr[129];
    if (!rstd_out && !gw) {
        GAS u32x2* o8 = (GAS u32x2*)orow + lane; u32x2 w8;
        w8.x = pk4_fp8(v[0].x, v[0].y, v[0].z, v[0].w); w8.y = pk4_fp8(v[1].x, v[1].y, v[1].z, v[1].w); o8[0] = w8;
        w8.x = pk4_fp8(v[2].x, v[2].y, v[2].z, v[2].w); w8.y = pk4_fp8(v[3].x, v[3].y, v[3].z, v[3].w); o8[64] = w8; }
    else if (!rstd_out) {
    o.x = pk2(v[0].x, v[0].y); o.y = pk2(v[0].z, v[0].w); o.z = pk2(v[1].x, v[1].y); o.w = pk2(v[1].z, v[1].w); o16[0] = o;
    o.x = pk2(v[2].x, v[2].y); o.y = pk2(v[2].z, v[2].w); o.z = pk2(v[3].x, v[3].y); o.w = pk2(v[3].z, v[3].w); o16[64] = o; }
    if (gw) {
        float mine = 0.f;
#pragma unroll
        for (int q = 0; q < 8; ++q) { const LAS float* wp = gw + q * 1024 + 8 * lane;
            float a = (dot4(v[0], *(const LAS f32x4*)(wp)) + dot4(v[1], *(const LAS f32x4*)(wp + 4))) + (dot4(v[2], *(const LAS f32x4*)(wp + 512)) + dot4(v[3], *(const LAS f32x4*)(wp + 516)));
            a = wave_sum(a); mine = (lane == q) ? a : mine; }
        if (lane < 8) gate_out[lane] = mine + gate_b[lane];
    }
}
__device__ __forceinline__ void sincos_acc(float ang, float& sn, float& cs) {
    const double a = (double)ang; const double q = rint(a * 0.63661977236758134308); const double z = a - q * 1.57079632679489661923;
    const double z2 = z * z;
    const double sp = z * (1.0 + z2 * (-1.0 / 6 + z2 * (1.0 / 120 + z2 * (-1.0 / 5040 + z2 * (1.0 / 362880 + z2 * (-1.0 / 39916800 + z2 * (1.0 / 6227020800.0)))))));
    const double cp = 1.0 + z2 * (-0.5 + z2 * (1.0 / 24 + z2 * (-1.0 / 720 + z2 * (1.0 / 40320 + z2 * (-1.0 / 3628800 + z2 * (1.0 / 479001600.0 + z2 * (-1.0 / 87178291200.0)))))));
    const int qi = ((int)(long long)q) & 3;
    const double s_ = (qi == 0) ? sp : (qi == 1) ? cp : (qi == 2) ? -sp : -cp;
    const double c_ = (qi == 0) ? cp : (qi == 1) ? -sp : (qi == 2) ? -cp : sp;
    sn = (float)s_; cs = (float)c_;
}
__device__ __forceinline__ void p0_prologue(Frame& F) {
    const int lane = lane_now(), wave = F.wave, tid = wave * 64 + lane; (void)tid; (void)lane; (void)wave;
    const int gw = F.vcu * NWAVES + wave, NGW = F.G * NWAVES;
    LAS float* scr = (LAS float*)(F.lds + wave * 8704);
    LAS float* gwt = (LAS float*)(F.lds + 69632);
    for (int i = tid; i < 8192; i += NWAVES * 64) { const int k = i >> 3, q = i & 7; gwt[q * 1024 + k] = F.in[3][(size_t)k * 3592 + 3584 + q]; }
    WG_SYNC();
    bf16* wsb = (bf16*)F.ws;
    constexpr int I_IN = 16 * 112, I_SQ = 16 * 32, I_E = 32 * 256;
    constexpr int NITEMS = I_IN + 4 * I_SQ + 2 * I_E;
    auto decode = [&](int it) -> TrItem { int r = it;
        if (r < I_IN) return TrItem{F.in[3], (bf16*)(F.ws + WS_WIN), F.in[2], D, 3592, 112, r, RowMap{1, 0}}; r -= I_IN;
        if (r < I_SQ) return TrItem{F.in[4], (bf16*)(F.ws + WS_WOUT), nullptr, D, D, 32, r, RowMap{0, 0}}; r -= I_SQ;
        if (r < I_SQ) return TrItem{F.in[14], (bf16*)(F.ws + WS_WKV), nullptr, D, D, 32, r, RowMap{0, 0}, W13_SCALE}; r -= I_SQ;
        if (r < I_SQ) return TrItem{F.in[15], (bf16*)(F.ws + WS_WKV), nullptr, D, D, 32, r, RowMap{0, 1024}, W13_SCALE}; r -= I_SQ;
        if (r < I_SQ) return TrItem{F.in[16], (bf16*)(F.ws + WS_WXO), nullptr, D, D, 32, r, RowMap{0, 0}}; r -= I_SQ;
        if (r < I_E) { const int e = r >> 8; return TrItem{F.in[22] + (size_t)e * D * DEXP, (bf16*)(F.ws + WS_W13 + (size_t)e * D * D), F.in[17], D, DEXP, 16, r & 255, RowMap{2, 0}, W13_SCALE}; } r -= I_E;
        { const int e = r >> 8; return TrItem{F.in[23] + (size_t)e * D * DEXP, (bf16*)(F.ws + WS_W13 + (size_t)e * D * D), F.in[17], D, DEXP, 16, r & 255, RowMap{2, 128}, W13_SCALE}; } };
    { f32x4 xa[8], xb[8];
      int it = gw; if (it < NITEMS) { const TrItem t0 = decode(it); tr_load(t0, lane, xa); }
      for (; it < NITEMS; it += 2 * NGW) {
          const TrItem ta = decode(it); const bool hb = it + NGW < NITEMS; TrItem tb = ta; if (hb) { tb = decode(it + NGW); tr_load(tb, lane, xb); }
          tr_finish(ta, lane, xa, scr);
          if (it + 2 * NGW < NITEMS) { const TrItem tc = decode(it + 2 * NGW); tr_load(tc, lane, xa); }
          if (hb) tr_finish(tb, lane, xb, scr); } }
    (void)wsb;
    { f32x4 nx[4];
#define P0_LOADROW(base, m_) do { const GAS f32x4* xr_ = (const GAS f32x4*)((base) + (size_t)(m_) * D) + 2 * lane; nx[0] = __builtin_nontemporal_load(xr_); nx[1] = __builtin_nontemporal_load(xr_ + 1); nx[2] = __builtin_nontemporal_load(xr_ + 128); nx[3] = __builtin_nontemporal_load(xr_ + 129); } while (0)
      if (gw < M) P0_LOADROW(F.in[0], gw);
      for (int m = gw; m < M; m += NGW) { f32x4 v[4] = {nx[0], nx[1], nx[2], nx[3]}; if (m + NGW < M) P0_LOADROW(F.in[0], m + NGW);
          rms_row(lane, v, F.in[2], (bf16*)F.out + (size_t)m * D, gwt, (float*)(F.ws + WS_GATE) + (size_t)m * 8, F.in[9], (float*)(F.ws + WS_RSTD0) + m); }
      for (int m = gw; m < MROWS; m += NGW) { P0_LOADROW(F.in[1], m); f32x4 v[4] = {nx[0], nx[1], nx[2], nx[3]}; rms_row(lane, v, F.in[12], (bf16*)(F.ws + WS_MEMN + (size_t)m * D), nullptr, nullptr, nullptr); }
#undef P0_LOADROW
    }
    for (int i = F.vcu * (NWAVES * 64) + tid; i < D * D / 8; i += F.G * NWAVES * 64) { const int k = i >> 7, c8 = i & 127; const float gk = F.in[11][k];
        const GAS f32x4* s = (const GAS f32x4*)(F.in[13] + (size_t)k * D + c8 * 8); const f32x4 a = __builtin_nontemporal_load(s), b = __builtin_nontemporal_load(s + 1);
        v4u o; o.x = pk2(a.x * gk, a.y * gk); o.y = pk2(a.z * gk, a.w * gk); o.z = pk2(b.x * gk, b.y * gk); o.w = pk2(b.z * gk, b.w * gk); *(GAS v4u*)((bf16*)(F.ws + WS_WXQ) + (size_t)k * D + c8 * 8) = o; }
    for (int i = F.vcu * (NWAVES * 64) + tid; i < 36 * 1024; i += F.G * NWAVES * 64) { const int n = i >> 10, k = i & 1023;
        const float v = ((n < 32) ? F.in[20][k * 32 + n] : F.in[18][k * 4 + (n - 32)]) * F.in[17][k]; const unsigned hi = f2bf(v); const float rem = v - __uint_as_float(hi << 16);
        bf16* rt_ = (bf16*)(F.ws + WS_RT); rt_[n * 1024 + k] = (bf16)hi; rt_[(36 + n) * 1024 + k] = (bf16)f2bf(rem); }
    float* rope = (float*)(F.ws + WS_ROPE);
    for (int i = F.vcu * (NWAVES * 64) + tid; i < SEQ * 32; i += F.G * NWAVES * 64) { const int pos = i >> 5, fi = i & 31;
        const float invf = (float)exp2(-(double)fi * (13.287712379549449 / 32.0));
        const float ang = (float)pos * invf; float sn, cs; sincos_acc(ang, sn, cs); rope[i] = cs; rope[SEQ * 32 + i] = sn; }
}


__device__ __forceinline__ void w2_items(Frame& F, int rank, int nidle) {
    const int lane = lane_now(), wave = F.wave;
    LAS float* scr = (LAS float*)(F.lds + wave * 8704);
    if (rank < 0) return;
    const int first = rank * NWAVES + wave, step = nidle * NWAVES, NIT = 32 * 256;
    auto item = [&](int r) -> TrItem { const int e = r >> 8; return TrItem{F.in[24] + (size_t)e * DEXP * D, (bf16*)(F.ws + WS_W2 + (size_t)e * D * DEXP), nullptr, DEXP, D, 32, r & 255, RowMap{0, 0}, W2_SCALE}; };
    f32x4 xa[8], xb[8];
    int r = first; if (r < NIT) { const TrItem t0 = item(r); tr_load(t0, lane, xa); }
    for (; r < NIT; r += 2 * step) {
        const TrItem ta = item(r); const bool hb = r + step < NIT; TrItem tb = ta; if (hb) { tb = item(r + step); tr_load(tb, lane, xb); }
        tr_finish(ta, lane, xa, scr);
        if (r + 2 * step < NIT) { const TrItem tc = item(r + 2 * step); tr_load(tc, lane, xa); }
        if (hb) tr_finish(tb, lane, xb, scr); }
}
__device__ __forceinline__ void gate_scan(Frame& F, int bh) {
    const int lane = lane_now(), wave = F.wave;
    const int b = bh >> 2, h = bh & 3; const float* gate = (const float*)(F.ws + WS_GATE);
    float* acum = (float*)(F.ws + WS_ACUM) + (size_t)bh * SEQ; float* usub = (float*)(F.ws + WS_USUB) + (size_t)bh * SEQ; float* sc = (float*)(F.ws + WS_SC) + (size_t)bh * NCH * 4;
    LAS float* GB = (LAS float*)F.lds;
    float gi_[8], gf_[8];
#pragma unroll
    for (int jj = 0; jj < 8; ++jj) { const size_t row = (size_t)b * SEQ + (wave * 8 + jj) * CHL + lane; gi_[jj] = gate[row * 8 + h]; gf_[jj] = gate[row * 8 + 4 + h]; }
#pragma unroll
    for (int jj = 0; jj < 8; ++jj) { const int j = wave * 8 + jj; const int t = j * CHL + lane;
        const float gi = gi_[jj], gf = gf_[jj];
        const float e = fexp(-fabsf(gf));
        const float l1p = (e < 0.0078125f) ? e * (1.f - e * (0.5f - e * 0.33333334f)) : __builtin_amdgcn_logf(1.f + e) * 0.6931471805599453f;
        const float a = wave_scan_sum(fminf(gf, 0.f) - l1p);
        const float g = __builtin_bit_cast(float, __builtin_amdgcn_readlane(__builtin_bit_cast(int, a), 63)); const float u = gi - a;
        const float bm = wave_max(g + u);
        acum[t] = a; usub[t] = u;
        if (lane == 0) { GB[j] = g; GB[64 + j] = bm; } }
    WG_SYNC();
    if (wave == 0) { float G = GB[lane], B = GB[64 + lane]; const float g = G;
#pragma unroll
        for (int o = 1; o < 64; o <<= 1) { const float Gp = __shfl_up(G, o), Bp = __shfl_up(B, o); if (lane >= o) { B = fmaxf(Bp + G, B); G = Gp + G; } }
        const float mnew = fmaxf(G, B);
        float mprev = __shfl_up(mnew, 1); if (lane == 0) mprev = 0.f;
        sc[lane * 4 + 0] = mprev; sc[lane * 4 + 1] = mnew; sc[lane * 4 + 2] = g; sc[lane * 4 + 3] = expf(g + mprev - mnew); }
    WG_SYNC();
}

constexpr int TS64 = 144;
constexpr int TS128 = 272;
constexpr int ML_CW = 135168;
__device__ __forceinline__ void stage_convw(Frame& F) {
    const int tid = F.wave * 64 + lane_now(); LAS float* cwl = (LAS float*)(F.lds + ML_CW);
    for (int i = tid; i < 5632; i += NWAVES * 64) cwl[i] = (i < 4096) ? F.in[7][i] : (i < 5120) ? F.in[8][i - 4096] : F.in[10][i - 5120];
    WG_SYNC();
}
__device__ __forceinline__ void conv2_silu8(const bf16* src, int t, const LAS float* cwl, int ch0, float (&y0)[8], float (&y1)[8]) {
    v4u x[5];
#pragma unroll
    for (int i = 0; i < 5; ++i) { const int tt = t - 3 + i; x[i] = (tt >= 0) ? *(const GAS v4u*)(src + (size_t)tt * NPROJ) : (v4u){0u, 0u, 0u, 0u}; }
#pragma unroll
    for (int hh = 0; hh < 2; ++hh) {
        const f32x4 bb = *(const LAS f32x4*)(cwl + 4096 + ch0 + 4 * hh); f32x4 a0 = bb, a1 = bb;
#pragma unroll
        for (int tau = 0; tau < 4; ++tau) { const f32x4 w = *(const LAS f32x4*)(cwl + tau * 1024 + ch0 + 4 * hh);
            const unsigned p0 = hh ? x[tau].z : x[tau].x, p1 = hh ? x[tau].w : x[tau].y, q0 = hh ? x[tau + 1].z : x[tau + 1].x, q1 = hh ? x[tau + 1].w : x[tau + 1].y;
            a0 += w * (f32x4){bflo(p0), bfhi(p0), bflo(p1), bfhi(p1)}; a1 += w * (f32x4){bflo(q0), bfhi(q0), bflo(q1), bfhi(q1)}; }
#pragma unroll
        for (int e = 0; e < 4; ++e) { y0[4 * hh + e] = a0[e] * fsigmoid(a0[e]); y1[4 * hh + e] = a1[e] * fsigmoid(a1[e]); } }
}
__device__ __forceinline__ void stage_vt(Frame& F, int tid, int b, int t0, int h, LAS unsigned char* VT) {
    const bf16* mvt = (const bf16*)(F.ws + WS_MVT);
#pragma unroll
    for (int i = 0; i < 2; ++i) { const int id = tid + 512 * i, r = id >> 3, c = id & 7;
        *(LAS v4u*)(VT + r * TS64 + c * 16) = *(const GAS v4u*)(mvt + (size_t)(h * 128 + r) * M + (size_t)b * SEQ + t0 + c * 8); }
    if (tid < 128) { const int r = 128 + (tid >> 3), c = tid & 7; const unsigned one2 = (r == 128) ? 0x3F803F80u : 0u; *(LAS v4u*)(VT + r * TS64 + c * 16) = (v4u){one2, one2, one2, one2}; }
}

#define LDS_BARRIER() asm volatile("s_waitcnt lgkmcnt(0)\n\ts_barrier" ::: "memory")
__device__ __forceinline__ void conv2_math(const v4u (&x)[5], const LAS float* cwl, int ch0, float (&y0)[8], float (&y1)[8]) {
#pragma unroll
    for (int hh = 0; hh < 2; ++hh) {
        const f32x4 bb = *(const LAS f32x4*)(cwl + 4096 + ch0 + 4 * hh); f32x4 a0 = bb, a1 = bb;
#pragma unroll
        for (int tau = 0; tau < 4; ++tau) { const f32x4 w = *(const LAS f32x4*)(cwl + tau * 1024 + ch0 + 4 * hh);
            const unsigned p0 = hh ? x[tau].z : x[tau].x, p1 = hh ? x[tau].w : x[tau].y, q0 = hh ? x[tau + 1].z : x[tau + 1].x, q1 = hh ? x[tau + 1].w : x[tau + 1].y;
            a0 += w * (f32x4){bflo(p0), bfhi(p0), bflo(p1), bfhi(p1)}; a1 += w * (f32x4){bflo(q0), bfhi(q0), bflo(q1), bfhi(q1)}; }
#pragma unroll
        for (int e = 0; e < 4; ++e) { y0[4 * hh + e] = a0[e] * fsigmoid(a0[e]); y1[4 * hh + e] = a1[e] * fsigmoid(a1[e]); } }
}
struct M1Pre { v4u xk[5], vt[2]; float u0, u1; };
__device__ __forceinline__ void m1_load(Frame& F, int bh, int j, int lane, int wave, int tid, M1Pre& p) {
    const int b = bh >> 2, h = bh & 3, t0 = j * CHL; const bf16* proj = (const bf16*)(F.ws + WS_PROJ);
    const int c8 = (lane & 7) + 8 * (wave & 1), r0 = 2 * ((wave >> 1) * 8 + (lane >> 3));
    const bf16* sk = proj + (size_t)b * SEQ * NPROJ + C_MK + h * 128 + c8 * 8;
#pragma unroll
    for (int i = 0; i < 5; ++i) { const int tt = t0 + r0 - 3 + i, tc = tt < 0 ? 0 : tt; p.xk[i] = *(const GAS v4u*)(sk + (size_t)tc * NPROJ); }
    const bf16* mvt = (const bf16*)(F.ws + WS_MVT);
#pragma unroll
    for (int i = 0; i < 2; ++i) { const int id = tid + 512 * i, r = id >> 3, c = id & 7; p.vt[i] = *(const GAS v4u*)(mvt + (size_t)(h * 128 + r) * M + (size_t)b * SEQ + t0 + c * 8); }
    const float* usub = (const float*)(F.ws + WS_USUB) + (size_t)bh * SEQ + t0; p.u0 = usub[r0]; p.u1 = usub[r0 + 1];
}
constexpr int NGRP = 8, GCH = NCH / NGRP, ST_V4 = 9 * NWAVES * 64;
__device__ __forceinline__ void m1g_phase(Frame& F) {
    const int lane = lane_now(), wave = F.wave, tid = wave * 64 + lane;
    LAS unsigned char* KWT = F.lds; LAS unsigned char* VT = F.lds + 128 * TS64; const LAS float* cwl = (const LAS float*)(F.lds + ML_CW);
    const int r16 = lane & 15, q = lane >> 4, w = wave;
    for (int u = F.vcu; u < 32 * NGRP; u += F.G) { const int bh = u / NGRP, g = u % NGRP, h = bh & 3;
        M1Pre p; m1_load(F, bh, g * GCH, lane, wave, tid, p);
        f32x4 acc[9];
#pragma unroll
        for (int nt = 0; nt < 9; ++nt) acc[nt] = (f32x4){0.f, 0.f, 0.f, 0.f};
        for (int jj = 0; jj < GCH; ++jj) { const int j = g * GCH + jj, t0 = j * CHL;
            const float* sc = (const float*)(F.ws + WS_SC) + ((size_t)bh * NCH + j) * 4; const float mnew = sc[1], gj = sc[2], dec = sc[3];
            { const int c8 = (lane & 7) + 8 * (wave & 1), r0 = 2 * ((wave >> 1) * 8 + (lane >> 3)); float y0[8], y1[8];
#pragma unroll
                for (int i = 0; i < 3; ++i) { if (t0 + r0 - 3 + i < 0) p.xk[i] = (v4u){0u, 0u, 0u, 0u}; }
                conv2_math(p.xk, cwl, 512 + h * 128 + c8 * 8, y0, y1);
                { bf16* kc = (bf16*)F.out + (size_t)48 * 1024 * 1024 + ((size_t)(bh >> 2) * SEQ + t0 + r0) * 512 + h * 128 + c8 * 8; v4u o;
                  o.x = pk2(y0[0], y0[1]); o.y = pk2(y0[2], y0[3]); o.z = pk2(y0[4], y0[5]); o.w = pk2(y0[6], y0[7]); *(GAS v4u*)kc = o;
                  o.x = pk2(y1[0], y1[1]); o.y = pk2(y1[2], y1[3]); o.z = pk2(y1[4], y1[5]); o.w = pk2(y1[6], y1[7]); *(GAS v4u*)(kc + 512) = o; }
                const float w0 = 0.08838834764831845f * fexp(gj + p.u0 - mnew), w1 = 0.08838834764831845f * fexp(gj + p.u1 - mnew);
#pragma unroll
                for (int e = 0; e < 8; ++e) *(LAS unsigned*)(KWT + (c8 * 8 + e) * TS64 + r0 * 2) = pk2(y0[e] * w0, y1[e] * w1); }
#pragma unroll
            for (int i = 0; i < 2; ++i) { const int id = tid + 512 * i, r = id >> 3, c = id & 7; *(LAS v4u*)(VT + r * TS64 + c * 16) = p.vt[i]; }
            if (tid < 128) { const int r = 128 + (tid >> 3), c = tid & 7; const unsigned one2 = (r == 128) ? 0x3F803F80u : 0u; *(LAS v4u*)(VT + r * TS64 + c * 16) = (v4u){one2, one2, one2, one2}; }
            LDS_BARRIER();
            if (jj + 1 < GCH) m1_load(F, bh, j + 1, lane, wave, tid, p);
            bf16x8 xa[2];
#pragma unroll
            for (int ks = 0; ks < 2; ++ks) xa[ks] = *(const LAS bf16x8*)(KWT + (16 * w + r16) * TS64 + ks * 64 + q * 16);
#pragma unroll
            for (int nt = 0; nt < 9; ++nt) { acc[nt] = acc[nt] * dec;
#pragma unroll
                for (int ks = 0; ks < 2; ++ks) { const bf16x8 yb = *(const LAS bf16x8*)(VT + (16 * nt + r16) * TS64 + ks * 64 + q * 16); acc[nt] = __builtin_amdgcn_mfma_f32_16x16x32_bf16(xa[ks], yb, acc[nt], 0, 0, 0); } }
            LDS_BARRIER();
        }
        GAS f32x4* tg = (GAS f32x4*)F.out + (size_t)4 * 1024 * 1024 + (size_t)u * ST_V4 + tid;
#pragma unroll
        for (int nt = 0; nt < 9; ++nt) tg[nt * 512] = acc[nt];
    }
    WG_SYNC();
}

__device__ __forceinline__ void p3_scan_combine(Frame& F, const int sub, const int blk0) {
    const int lane = lane_now(), wave = F.wave, tid = wave * 64 + lane;
    const int vb = (int)blockIdx.x - blk0, nb = F.G - blk0;
    if (sub & 16) { const GAS f32x4* TG = (const GAS f32x4*)F.out + (size_t)4 * 1024 * 1024; GAS f32x4* CIN = (GAS f32x4*)F.out + (size_t)4 * 1024 * 1024;
        for (int ch = vb * (NWAVES * 64) + tid; ch < 32 * ST_V4; ch += nb * NWAVES * 64) { const int bh = ch / ST_V4, e = ch % ST_V4;
            const float* sc = (const float*)(F.ws + WS_SC) + (size_t)bh * NCH * 4; f32x4 t[NGRP];
#pragma unroll
            for (int g = 0; g < NGRP; ++g) t[g] = TG[((size_t)bh * NGRP + g) * ST_V4 + e];
            f32x4 run = {0.f, 0.f, 0.f, 0.f};
#pragma unroll
            for (int g = 0; g < NGRP; ++g) { CIN[((size_t)bh * NGRP + g) * ST_V4 + e] = run; float dg = 1.f;
#pragma unroll
                for (int jj = 0; jj < GCH; ++jj) dg *= sc[(g * GCH + jj) * 4 + 3];
                run = run * dg + t[g]; } } }
    const float* lv = F.in[5];
    const float lam = expf(wave_sum(lv[lane] * lv[64 + lane])) - expf(wave_sum(lv[128 + lane] * lv[192 + lane])) + LAM_INIT;
    const int gw = vb * NWAVES + wave, NGW = nb * NWAVES; bf16* oa = (bf16*)(F.ws + WS_OA);
    float gs[8];
#pragma unroll
    for (int e = 0; e < 8; ++e) gs[e] = F.in[6][((lane * 8) & 127) + e] * (1.0f - LAM_INIT);
    if (sub & 32) for (int m = gw; m < M; m += NGW) { GAS v4u* r = (GAS v4u*)(oa + (size_t)m * 1024) + lane; const v4u a = r[0], c = r[64];
        float y[8]; y[0] = bflo(a.x) - lam * bflo(c.x); y[1] = bfhi(a.x) - lam * bfhi(c.x); y[2] = bflo(a.y) - lam * bflo(c.y); y[3] = bfhi(a.y) - lam * bfhi(c.y);
        y[4] = bflo(a.z) - lam * bflo(c.z); y[5] = bfhi(a.z) - lam * bfhi(c.z); y[6] = bflo(a.w) - lam * bflo(c.w); y[7] = bfhi(a.w) - lam * bfhi(c.w);
        float ss = 0.f;
#pragma unroll
        for (int e = 0; e < 8; ++e) ss += y[e] * y[e];
        ss = row16_sum(ss);
        const float rs = frsq(ss * (1.f / 128.f) + EPS); v4u o;
        o.x = pk2(y[0] * rs * gs[0], y[1] * rs * gs[1]); o.y = pk2(y[2] * rs * gs[2], y[3] * rs * gs[3]); o.z = pk2(y[4] * rs * gs[4], y[5] * rs * gs[5]); o.w = pk2(y[6] * rs * gs[6], y[7] * rs * gs[7]);
        r[0] = o; }
}

struct M3Pre { v4u xq[5], kc[2], vt[2], ow[2]; float u, a, u0, u1; };
__device__ __forceinline__ void m3_load(Frame& F, int bh, int j, int lane, int wave, int tid, M3Pre& p) {
    const int b = bh >> 2, h = bh & 3, t0 = j * CHL; const bf16* proj = (const bf16*)(F.ws + WS_PROJ);
    const int c8 = (lane & 7) + 8 * (wave & 1), r0 = 2 * ((wave >> 1) * 8 + (lane >> 3));
    const bf16* sq = proj + (size_t)b * SEQ * NPROJ + C_MQ + h * 128 + c8 * 8;
    const bf16* kc = (const bf16*)F.out + (size_t)48 * 1024 * 1024 + ((size_t)b * SEQ + t0 + r0) * 512 + h * 128 + c8 * 8;
#pragma unroll
    for (int i = 0; i < 5; ++i) { const int tt = t0 + r0 - 3 + i, tc = tt < 0 ? 0 : tt;
        p.xq[i] = *(const GAS v4u*)(sq + (size_t)tc * NPROJ); }
    p.kc[0] = *(const GAS v4u*)kc; p.kc[1] = *(const GAS v4u*)(kc + 512);
    const bf16* mvt = (const bf16*)(F.ws + WS_MVT);
#pragma unroll
    for (int i = 0; i < 2; ++i) { const int id = tid + 512 * i, r = id >> 3, c = id & 7; p.vt[i] = *(const GAS v4u*)(mvt + (size_t)(h * 128 + r) * M + (size_t)b * SEQ + t0 + c * 8); }
    { const GAS v4u* op = (const GAS v4u*)(proj + ((size_t)b * SEQ + t0 + (tid >> 3)) * NPROJ + C_MO + h * 128 + 16 * (tid & 7)); p.ow[0] = op[0]; p.ow[1] = op[1]; }
    p.u = ((const float*)(F.ws + WS_USUB))[(size_t)bh * SEQ + t0 + lane]; p.a = ((const float*)(F.ws + WS_ACUM))[(size_t)bh * SEQ + t0 + lane];
    p.u0 = ((const float*)(F.ws + WS_USUB))[(size_t)bh * SEQ + t0 + r0]; p.u1 = ((const float*)(F.ws + WS_USUB))[(size_t)bh * SEQ + t0 + r0 + 1];
}
__device__ __forceinline__ void m3_phase(Frame& F) {
    const int lane = lane_now(), wave = F.wave, tid = wave * 64 + lane;
    const bf16* proj = (const bf16*)(F.ws + WS_PROJ);
    LAS unsigned char* Qs = F.lds; LAS unsigned char* Ks = F.lds + 64 * TS128; LAS unsigned char* VT = F.lds + 128 * TS128; LAS unsigned char* CT = VT + DVX * TS64;
    LAS unsigned char* SD = CT + DVX * TS128; LAS float* sv = (LAS float*)(SD + 64 * TS64);
    LAS unsigned char* KWT = SD + 64 * TS64 + 1024;
    LAS float* HB = (LAS float*)F.lds;
    const LAS float* cwl = (const LAS float*)(F.lds + ML_CW);
    static_assert(128 * TS128 + DVX * TS64 + DVX * TS128 + 64 * TS64 + 4 * 64 * 4 + 128 * TS64 <= ML_CW && 64 * 132 * 4 <= 128 * TS128 && ML_CW + 5632 * 4 <= LDSCTL_OFF, "m3 LDS");
    M3Pre p;
    for (int ug = F.vcu; ug < 32 * NGRP; ug += F.G) {
    const int bh = ug / NGRP, g = ug % NGRP;
    f32x4 cst[9];
    { const GAS f32x4* cin = (const GAS f32x4*)F.out + (size_t)4 * 1024 * 1024 + (size_t)ug * ST_V4 + tid;
#pragma unroll
      for (int nt = 0; nt < 9; ++nt) cst[nt] = cin[nt * 512]; }
    m3_load(F, bh, g * GCH, lane, wave, tid, p);
    for (int jj = 0; jj < GCH; ++jj) {
        const int j = g * GCH + jj, b = bh >> 2, h = bh & 3, t0 = j * CHL;
        const float* sc = (const float*)(F.ws + WS_SC) + ((size_t)bh * NCH + j) * 4; const float mprev = sc[0], mnew = sc[1], gj = sc[2], dec = sc[3];
        { const int c8 = (lane & 7) + 8 * (wave & 1), r0 = 2 * ((wave >> 1) * 8 + (lane >> 3)); float y0[8], y1[8]; v4u o;
#pragma unroll
            for (int i = 0; i < 3; ++i) { const bool z = t0 + r0 - 3 + i < 0; if (z) p.xq[i] = (v4u){0u, 0u, 0u, 0u}; }
            conv2_math(p.xq, cwl, h * 128 + c8 * 8, y0, y1);
            o.x = pk2(y0[0], y0[1]); o.y = pk2(y0[2], y0[3]); o.z = pk2(y0[4], y0[5]); o.w = pk2(y0[6], y0[7]); *(LAS v4u*)(Qs + r0 * TS128 + c8 * 16) = o;
            o.x = pk2(y1[0], y1[1]); o.y = pk2(y1[2], y1[3]); o.z = pk2(y1[4], y1[5]); o.w = pk2(y1[6], y1[7]); *(LAS v4u*)(Qs + (r0 + 1) * TS128 + c8 * 16) = o;
            y0[0] = bflo(p.kc[0].x); y0[1] = bfhi(p.kc[0].x); y0[2] = bflo(p.kc[0].y); y0[3] = bfhi(p.kc[0].y); y0[4] = bflo(p.kc[0].z); y0[5] = bfhi(p.kc[0].z); y0[6] = bflo(p.kc[0].w); y0[7] = bfhi(p.kc[0].w);
            y1[0] = bflo(p.kc[1].x); y1[1] = bfhi(p.kc[1].x); y1[2] = bflo(p.kc[1].y); y1[3] = bfhi(p.kc[1].y); y1[4] = bflo(p.kc[1].z); y1[5] = bfhi(p.kc[1].z); y1[6] = bflo(p.kc[1].w); y1[7] = bfhi(p.kc[1].w);
            const float ksc = 0.08838834764831845f;
            o.x = pk2(y0[0] * ksc, y0[1] * ksc); o.y = pk2(y0[2] * ksc, y0[3] * ksc); o.z = pk2(y0[4] * ksc, y0[5] * ksc); o.w = pk2(y0[6] * ksc, y0[7] * ksc); *(LAS v4u*)(Ks + r0 * TS128 + c8 * 16) = o;
            o.x = pk2(y1[0] * ksc, y1[1] * ksc); o.y = pk2(y1[2] * ksc, y1[3] * ksc); o.z = pk2(y1[4] * ksc, y1[5] * ksc); o.w = pk2(y1[6] * ksc, y1[7] * ksc); *(LAS v4u*)(Ks + (r0 + 1) * TS128 + c8 * 16) = o;
            const float w0 = ksc * fexp(gj + p.u0 - mnew), w1 = ksc * fexp(gj + p.u1 - mnew);
#pragma unroll
            for (int e = 0; e < 8; ++e) *(LAS unsigned*)(KWT + (c8 * 8 + e) * TS64 + r0 * 2) = pk2(y0[e] * w0, y1[e] * w1); }
#pragma unroll
        for (int i = 0; i < 2; ++i) { const int id = tid + 512 * i, r = id >> 3, c = id & 7; *(LAS v4u*)(VT + r * TS64 + c * 16) = p.vt[i]; }
        if (tid < 128) { const int r = 128 + (tid >> 3), c = tid & 7; const unsigned one2 = (r == 128) ? 0x3F803F80u : 0u; *(LAS v4u*)(VT + r * TS64 + c * 16) = (v4u){one2, one2, one2, one2}; }
        { const int r16s = lane & 15, qs = lane >> 4;
#pragma unroll
          for (int nt = 0; nt < 9; ++nt) { u32x2 o2; o2.x = pk2(cst[nt][0], cst[nt][1]); o2.y = pk2(cst[nt][2], cst[nt][3]); *(LAS u32x2*)(CT + (16 * nt + r16s) * TS128 + (16 * wave + 4 * qs) * 2) = o2; } }
        if (wave == 0) { const float um = fmaxf(mprev, wave_scan_max(p.u));
            sv[lane] = p.u; sv[64 + lane] = um; sv[128 + lane] = fexp(mprev - um); sv[192 + lane] = fexp(-(p.a + um)); }
        const v4u ow0 = p.ow[0], ow1 = p.ow[1];
        LDS_BARRIER();
        if (jj + 1 < GCH) m3_load(F, bh, j + 1, lane, wave, tid, p);
        const int tr = tid >> 3, part = tid & 7; const size_t orow = (size_t)b * SEQ + t0 + tr;
        const int r16 = lane & 15, q = lane >> 4, tt = wave & 3, hf = wave >> 2; const int t = 16 * tt + r16;
        bf16x8 qf[4];
#pragma unroll
        for (int ks = 0; ks < 4; ++ks) qf[ks] = *(const LAS bf16x8*)(Qs + t * TS128 + ks * 64 + q * 16);
        { const float umt = sv[64 + t];
#pragma unroll
            for (int k = 0; k < 2; ++k) { const int st = 2 * hf + k; f32x4 acc = {0.f, 0.f, 0.f, 0.f};
#pragma unroll
                for (int ks = 0; ks < 4; ++ks) { const bf16x8 kf = *(const LAS bf16x8*)(Ks + (16 * st + r16) * TS128 + ks * 64 + q * 16); acc = __builtin_amdgcn_mfma_f32_16x16x32_bf16(kf, qf[ks], acc, 0, 0, 0); }
                float o[4];
#pragma unroll
                for (int i = 0; i < 4; ++i) { const int s = 16 * st + 4 * q + i; o[i] = (s <= t) ? acc[i] * fexp(sv[s] - umt) : 0.f; }
                u32x2 w; w.x = pk2(o[0], o[1]); w.y = pk2(o[2], o[3]); *(LAS u32x2*)(SD + t * TS64 + (16 * st + 4 * q) * 2) = w; } }
        f32x4 acc[5];
#pragma unroll
        for (int k = 0; k < 5; ++k) acc[k] = (f32x4){0.f, 0.f, 0.f, 0.f};
        { bf16x8 cf[3];
#pragma unroll
          for (int i = 0; i < 22; ++i) {
              if (i < 20) { const int k = i >> 2, ks = i & 3; const int mt = (k < 4) ? 4 * hf + k : 8; cf[i % 3] = *(const LAS bf16x8*)(CT + (16 * mt + r16) * TS128 + ks * 64 + q * 16); }
              __builtin_amdgcn_sched_barrier(0);
              if (i >= 2) { const int j = i - 2; acc[j >> 2] = __builtin_amdgcn_mfma_f32_16x16x32_bf16(cf[j % 3], qf[j & 3], acc[j >> 2], 0, 0, 0); }
              __builtin_amdgcn_sched_barrier(0); } }
        { bf16x8 xa[2];
#pragma unroll
          for (int ks = 0; ks < 2; ++ks) xa[ks] = *(const LAS bf16x8*)(KWT + (16 * wave + r16) * TS64 + ks * 64 + q * 16);
#pragma unroll
          for (int nt = 0; nt < 9; ++nt) { cst[nt] = cst[nt] * dec;
#pragma unroll
              for (int ks = 0; ks < 2; ++ks) { const bf16x8 yb = *(const LAS bf16x8*)(VT + (16 * nt + r16) * TS64 + ks * 64 + q * 16); cst[nt] = __builtin_amdgcn_mfma_f32_16x16x32_bf16(xa[ks], yb, cst[nt], 0, 0, 0); } } }
        LDS_BARRIER();
        { const float wi = sv[128 + t];
            bf16x8 sf[2];
#pragma unroll
            for (int ks = 0; ks < 2; ++ks) sf[ks] = *(const LAS bf16x8*)(SD + t * TS64 + ks * 64 + q * 16);
#pragma unroll
            for (int k = 0; k < 5; ++k) acc[k] = acc[k] * wi;
            { bf16x8 vf[3];
#pragma unroll
              for (int i = 0; i < 12; ++i) {
                  if (i < 10) { const int k = i >> 1, ks = i & 1; const int mt = (k < 4) ? 4 * hf + k : 8; vf[i % 3] = *(const LAS bf16x8*)(VT + (16 * mt + r16) * TS64 + ks * 64 + q * 16); }
                  __builtin_amdgcn_sched_barrier(0);
                  if (i >= 2) { const int j = i - 2; acc[j >> 1] = __builtin_amdgcn_mfma_f32_16x16x32_bf16(vf[j % 3], sf[j & 1], acc[j >> 1], 0, 0, 0); }
                  __builtin_amdgcn_sched_barrier(0); } }
            const float den = __shfl(acc[4][0], r16);
            const float inv = __builtin_amdgcn_rcpf(fmaxf(fabsf(den), sv[192 + t]));
#pragma unroll
            for (int k = 0; k < 4; ++k) *(LAS f32x4*)(HB + t * 132 + 16 * (4 * hf + k) + 4 * q) = acc[k] * inv; }
        LDS_BARRIER();
        { bf16* Y = (bf16*)(F.ws + WS_OA);
            f32x4 x[4]; float s = 0.f;
#pragma unroll
            for (int i = 0; i < 4; ++i) { x[i] = *(const LAS f32x4*)(HB + tr * 132 + 16 * part + 4 * i); s += (x[i][0] + x[i][1]) + (x[i][2] + x[i][3]); }
            s = row8_sum(s);
            const float mu = s * (1.f / 128.f); float v = 0.f;
#pragma unroll
            for (int i = 0; i < 4; ++i) { x[i] = x[i] - mu; v += dot4(x[i], x[i]); }
            v = row8_sum(v);
            const float rs = frsq(v * (1.f / 128.f) + EPS);
            const LAS f32x4* gp = (const LAS f32x4*)(cwl + 5120 + h * 128 + 16 * part);
#pragma unroll
            for (int hh = 0; hh < 2; ++hh) { const v4u ow = hh ? ow1 : ow0; const f32x4 g0 = gp[2 * hh], g1 = gp[2 * hh + 1]; const f32x4 a0 = x[2 * hh] * rs * g0, a1 = x[2 * hh + 1] * rs * g1; v4u o;
                o.x = pk2(a0[0] * fsigmoid(bflo(ow.x)), a0[1] * fsigmoid(bfhi(ow.x))); o.y = pk2(a0[2] * fsigmoid(bflo(ow.y)), a0[3] * fsigmoid(bfhi(ow.y)));
                o.z = pk2(a1[0] * fsigmoid(bflo(ow.z)), a1[1] * fsigmoid(bfhi(ow.z))); o.w = pk2(a1[2] * fsigmoid(bflo(ow.w)), a1[3] * fsigmoid(bfhi(ow.w)));
                *(GAS v4u*)(Y + orow * 1024 + 512 + h * 128 + 16 * part + 8 * hh) = o; } }
        LDS_BARRIER();
    }
    }
    WG_SYNC();
}

typedef float f32x16 __attribute__((ext_vector_type(16)));
__device__ __forceinline__ void xattn_unit(Frame& F, int rt, int h) {
    const int lane = lane_now(), wave = F.wave;
    const bf16* XQ = (const bf16*)(F.ws + WS_XQ); bf16* XO = (bf16*)(F.ws + WS_XO);
    const int r32 = lane & 31, hi = lane >> 5; const int b = (rt * 256) / SEQ; const size_t row0 = (size_t)rt * 256 + wave * 32;
    const bf16* qrow = XQ + (row0 + r32) * D + h * 256 + hi * 8;
    const bf16* Kg = (const bf16*)(F.ws + WS_MK) + (size_t)(b * MEMLEN) * D + h * 256;
    const bf16* Vg = (const bf16*)(F.ws + WS_MVT2) + (size_t)(h * 256) * MROWS + b * MEMLEN;
    LAS unsigned char* KB = F.lds; LAS unsigned char* VB = F.lds + 65536;
#define XA_KSRC(i) (Kg + (size_t)(2 * (4 * wave + (i)) + (lane >> 5)) * D + (((lane & 31) ^ ((2 * (4 * wave + (i)) + (lane >> 5)) & 15)) * 8))
#define XA_VSRC(i) (Vg + (size_t)(8 * (2 * wave + (i)) + (lane >> 3)) * MROWS + (((lane & 7) ^ (((8 * (2 * wave + (i)) + (lane >> 3)) >> 1) & 7)) * 8))
    const bf16* ks0 = XA_KSRC(0); const bf16* ks1 = XA_KSRC(1); const bf16* ks2 = XA_KSRC(2); const bf16* ks3 = XA_KSRC(3); const bf16* vs0 = XA_VSRC(0); const bf16* vs1 = XA_VSRC(1);
#define XA_ISSUE(step) do { const int kt_ = (step) & 3, hv_ = (step) >> 2, bf_ = (step) & 1, vf_ = (step) % 3; const size_t ko_ = (size_t)kt_ * 64 * D, vo_ = (size_t)hv_ * 128 * MROWS + kt_ * 64; \
        __builtin_amdgcn_global_load_lds((const unsigned*)(ks0 + ko_), (LAS unsigned*)(KB + bf_ * 32768 + (4 * wave + 0) * 1024), 16, 0, 0); \
        __builtin_amdgcn_global_load_lds((const unsigned*)(ks1 + ko_), (LAS unsigned*)(KB + bf_ * 32768 + (4 * wave + 1) * 1024), 16, 0, 0); \
        __builtin_amdgcn_global_load_lds((const unsigned*)(ks2 + ko_), (LAS unsigned*)(KB + bf_ * 32768 + (4 * wave + 2) * 1024), 16, 0, 0); \
        __builtin_amdgcn_global_load_lds((const unsigned*)(ks3 + ko_), (LAS unsigned*)(KB + bf_ * 32768 + (4 * wave + 3) * 1024), 16, 0, 0); \
        __builtin_amdgcn_global_load_lds((const unsigned*)(vs0 + vo_), (LAS unsigned*)(VB + vf_ * 16384 + (2 * wave + 0) * 1024), 16, 0, 0); \
        __builtin_amdgcn_global_load_lds((const unsigned*)(vs1 + vo_), (LAS unsigned*)(VB + vf_ * 16384 + (2 * wave + 1) * 1024), 16, 0, 0); } while (0)
#define XA_PV(step_) do { const unsigned vbase_ = (unsigned)(uintptr_t)(VB + ((step_) % 3) * 16384) + 8 * hi; u32x2 vf[3][2]; \
        _Pragma("unroll") for (int i = 0; i < 18; ++i) { \
            if (i < 16) { const int mt = i >> 2, st = i & 3; const int dv = 32 * mt + r32; const unsigned vr = vbase_ + dv * 128; const int sw = (dv >> 1) & 7; \
                asm volatile("ds_read_b64 %0, %1" : "=v"(vf[i % 3][0]) : "v"(vr + (((2 * st) ^ sw) * 16)) : "memory"); asm volatile("ds_read_b64 %0, %1" : "=v"(vf[i % 3][1]) : "v"(vr + (((2 * st + 1) ^ sw) * 16)) : "memory"); } \
            if (i >= 2) { if (i < 16) asm volatile("s_waitcnt lgkmcnt(4)" ::: "memory"); else if (i == 16) asm volatile("s_waitcnt lgkmcnt(2)" ::: "memory"); else asm volatile("s_waitcnt lgkmcnt(0)" ::: "memory"); } \
            __builtin_amdgcn_sched_barrier(0); \
            if (i >= 2) { const int j = i - 2; u32x4 w; w.x = vf[j % 3][0].x; w.y = vf[j % 3][0].y; w.z = vf[j % 3][1].x; w.w = vf[j % 3][1].y; \
                o[j >> 2] = __builtin_amdgcn_mfma_f32_32x32x16_bf16(__builtin_bit_cast(bf16x8, w), pf[j & 3], o[j >> 2], 0, 0, 0); } \
            __builtin_amdgcn_sched_barrier(0); } } while (0)
#define XA_FINISH(hv_) do { { auto rr = __builtin_amdgcn_permlane32_swap(__float_as_uint(l), __float_as_uint(l), false, false); l = __uint_as_float(rr[0]) + __uint_as_float(rr[1]); } \
        const float inv = __builtin_amdgcn_rcpf(l); bf16* orow = XO + (row0 + r32) * D + h * 256 + (hv_) * 128; \
        _Pragma("unroll") for (int mt = 0; mt < 4; ++mt) _Pragma("unroll") for (int a = 0; a < 2; ++a) { const int b2 = a + 2; \
            const unsigned x0 = pk2(o[mt][4 * a] * inv, o[mt][4 * a + 1] * inv), x1 = pk2(o[mt][4 * a + 2] * inv, o[mt][4 * a + 3] * inv); \
            const unsigned y0 = pk2(o[mt][4 * b2] * inv, o[mt][4 * b2 + 1] * inv), y1 = pk2(o[mt][4 * b2 + 2] * inv, o[mt][4 * b2 + 3] * inv); \
            auto s0_ = __builtin_amdgcn_permlane32_swap(y0, x0, false, false); auto s1_ = __builtin_amdgcn_permlane32_swap(y1, x1, false, false); \
            u32x4 w; w.x = s0_[0]; w.y = s1_[0]; w.z = s0_[1]; w.w = s1_[1]; *(GAS u32x4*)(orow + 32 * mt + 8 * (hi ? a : b2)) = w; } \
        _Pragma("unroll") for (int i = 0; i < 4; ++i) o[i] = (f32x16){}; l = 0.f; mx = -INFINITY; } while (0)
    XA_ISSUE(0);
    bf16x8 qf[16];
#pragma unroll
    for (int ks = 0; ks < 16; ++ks) qf[ks] = __builtin_nontemporal_load((const GAS bf16x8*)(qrow + ks * 16));
    const bool lag = wave >= 4;
    f32x16 o[4];
#pragma unroll
    for (int i = 0; i < 4; ++i) o[i] = (f32x16){};
    float mx = -INFINITY, l = 0.f; bf16x8 pf[4];
#pragma unroll
    for (int i = 0; i < 4; ++i) pf[i] = (bf16x8){};
    for (int step = 0; step < 8; ++step) {
        asm volatile("s_waitcnt vmcnt(0)" ::: "memory"); WG_SYNC();
        if (step < 7) XA_ISSUE(step + 1);
        if (lag && step > 0) { XA_PV(step - 1); if (step == 4) XA_FINISH(0); }
        const LAS unsigned char* kb = KB + (step & 1) * 32768;
        f32x16 s0 = (f32x16){}, s1 = (f32x16){};
        { bf16x8 kf[2][2];
          const unsigned kaddr0 = (unsigned)(uintptr_t)(kb + r32 * 512), kaddr1 = kaddr0 + 32 * 512;
#define XA_KRD(ks_) do { const unsigned pos_ = (unsigned)(((2 * (ks_) + hi) ^ (r32 & 15)) * 16); \
              asm volatile("ds_read_b128 %0, %1" : "=v"(kf[(ks_) & 1][0]) : "v"(kaddr0 + pos_) : "memory"); asm volatile("ds_read_b128 %0, %1" : "=v"(kf[(ks_) & 1][1]) : "v"(kaddr1 + pos_) : "memory"); } while (0)
          XA_KRD(0);
#pragma unroll
          for (int ks = 0; ks < 16; ++ks) {
              if (ks < 15) { XA_KRD(ks + 1); asm volatile("s_waitcnt lgkmcnt(2)" ::: "memory"); } else asm volatile("s_waitcnt lgkmcnt(0)" ::: "memory");
              __builtin_amdgcn_sched_barrier(0);
              s0 = __builtin_amdgcn_mfma_f32_32x32x16_bf16(kf[ks & 1][0], qf[ks], s0, 0, 0, 0); s1 = __builtin_amdgcn_mfma_f32_32x32x16_bf16(kf[ks & 1][1], qf[ks], s1, 0, 0, 0);
              __builtin_amdgcn_sched_barrier(0); }
#undef XA_KRD
        }
        float tm = fmaxf(s0[0], s1[0]);
#pragma unroll
        for (int r = 1; r < 16; ++r) tm = fmaxf(tm, fmaxf(s0[r], s1[r]));
        { auto rr = __builtin_amdgcn_permlane32_swap(__float_as_uint(tm), __float_as_uint(tm), false, false); tm = fmaxf(__uint_as_float(rr[0]), __uint_as_float(rr[1])); }
        float mn = mx;
        if (__any(tm > mx + 8.0f)) { mn = fmaxf(mx, tm); const float alpha = __builtin_amdgcn_exp2f(mx - mn); l *= alpha;
#pragma unroll
            for (int i = 0; i < 4; ++i) o[i] = o[i] * alpha; }
        mx = mn;
        float ps = 0.f;
#pragma unroll
        for (int r = 0; r < 16; ++r) { s0[r] = __builtin_amdgcn_exp2f(s0[r] - mn); s1[r] = __builtin_amdgcn_exp2f(s1[r] - mn); ps += s0[r] + s1[r]; }
        l += ps;
#pragma unroll
        for (int kk = 0; kk < 2; ++kk) { u32x4 w0, w1;
            w0.x = pk2(s0[8 * kk + 0], s0[8 * kk + 1]); w0.y = pk2(s0[8 * kk + 2], s0[8 * kk + 3]); w0.z = pk2(s0[8 * kk + 4], s0[8 * kk + 5]); w0.w = pk2(s0[8 * kk + 6], s0[8 * kk + 7]);
            w1.x = pk2(s1[8 * kk + 0], s1[8 * kk + 1]); w1.y = pk2(s1[8 * kk + 2], s1[8 * kk + 3]); w1.z = pk2(s1[8 * kk + 4], s1[8 * kk + 5]); w1.w = pk2(s1[8 * kk + 6], s1[8 * kk + 7]);
            pf[kk] = __builtin_bit_cast(bf16x8, w0); pf[2 + kk] = __builtin_bit_cast(bf16x8, w1); }
        if (!lag) { XA_PV(step); if (step == 3) XA_FINISH(0); }
    }
    if (lag) XA_PV(7);
    XA_FINISH(1);
#undef XA_ISSUE
#undef XA_KSRC
#undef XA_VSRC
#undef XA_PV
#undef XA_FINISH
    WG_SYNC();
}

constexpr int R_WH = 0, R_STRIDE = 2064, R_WL = 36 * R_STRIDE, R_CH = 72 * R_STRIDE, R_LCNT = R_CH + 4096, R_LBASE = R_LCNT + 128, R_EL = R_LBASE + 128;
static_assert(R_EL + 4096 <= LDSCTL_OFF, "router LDS");
__device__ __forceinline__ void p9_router(Frame& F) {
    const int lane = lane_now(), wave = F.wave, tid = wave * 64 + lane;
    LAS unsigned char* L = F.lds;
    LAS int* CH = (LAS int*)(L + R_CH); LAS int* LCNT = (LAS int*)(L + R_LCNT); LAS int* LBASE = (LAS int*)(L + R_LBASE); LAS float* EL = (LAS float*)(L + R_EL) + wave * 128;
    const bf16* x2 = (const bf16*)(F.ws + WS_XB); float* rstd2 = (float*)(F.ws + WS_RSTD2);
    const int rpb = (M + F.G - 1) / F.G; const int r0 = F.vcu * rpb; const int r1 = (r0 + rpb < M) ? r0 + rpb : M;
    const int r16 = lane & 15, q = lane >> 4;
    int base = r0 + wave * 16;
    bf16x8 xf[32];
#define R9_LOADROW() do { const int m_ = base + r16; const bf16* xr_ = x2 + (size_t)((m_ < r1) ? m_ : r0) * D + 8 * q; _Pragma("unroll") for (int j = 0; j < 32; ++j) xf[j] = __builtin_nontemporal_load((const GAS bf16x8*)(xr_ + j * 32)); } while (0)
    if (base < r1 && base - r0 < 128) R9_LOADROW();
    { const GAS v4u* rtg = (const GAS v4u*)(F.ws + WS_RT);
#pragma unroll
      for (int i = 0; i < 18; ++i) { const int id = tid + 512 * i, row = id >> 7, c = id & 127; *(LAS v4u*)(L + row * R_STRIDE + c * 16) = rtg[id]; } }
    if (tid < 32) LCNT[tid] = 0;
    WG_SYNC();
    for (; base < r1 && base - r0 < 128; base += NWAVES * 16) {
        const int m = base + r16; const bool live = m < r1;
        f32x4 acc0 = {0.f, 0.f, 0.f, 0.f}, acc1 = acc0, acc2 = acc0; float ss = 0.f;
#pragma unroll
        for (int ks = 0; ks < 32; ++ks) { const int ko = ks * 64 + q * 16;
                const bf16x8 h0 = *(const LAS bf16x8*)(L + R_WH + r16 * R_STRIDE + ko), h1 = *(const LAS bf16x8*)(L + R_WH + (16 + r16) * R_STRIDE + ko), h2 = *(const LAS bf16x8*)(L + R_WH + (32 + (r16 & 3)) * R_STRIDE + ko);
                const bf16x8 l0 = *(const LAS bf16x8*)(L + R_WL + r16 * R_STRIDE + ko), l1 = *(const LAS bf16x8*)(L + R_WL + (16 + r16) * R_STRIDE + ko), l2 = *(const LAS bf16x8*)(L + R_WL + (32 + (r16 & 3)) * R_STRIDE + ko);
                acc0 = __builtin_amdgcn_mfma_f32_16x16x32_bf16(h0, xf[ks], acc0, 0, 0, 0); acc1 = __builtin_amdgcn_mfma_f32_16x16x32_bf16(h1, xf[ks], acc1, 0, 0, 0); acc2 = __builtin_amdgcn_mfma_f32_16x16x32_bf16(h2, xf[ks], acc2, 0, 0, 0);
                acc0 = __builtin_amdgcn_mfma_f32_16x16x32_bf16(l0, xf[ks], acc0, 0, 0, 0); acc1 = __builtin_amdgcn_mfma_f32_16x16x32_bf16(l1, xf[ks], acc1, 0, 0, 0); acc2 = __builtin_amdgcn_mfma_f32_16x16x32_bf16(l2, xf[ks], acc2, 0, 0, 0);
                const u32x4 xw = __builtin_bit_cast(u32x4, xf[ks]);
                const float a0 = bflo(xw.x), a1 = bfhi(xw.x), a2 = bflo(xw.y), a3 = bfhi(xw.y), a4 = bflo(xw.z), a5 = bfhi(xw.z), a6 = bflo(xw.w), a7 = bfhi(xw.w);
                ss += ((a0 * a0 + a1 * a1) + (a2 * a2 + a3 * a3)) + ((a4 * a4 + a5 * a5) + (a6 * a6 + a7 * a7));
                __builtin_amdgcn_sched_barrier(0); }
        { auto r_ = __builtin_amdgcn_permlane16_swap(__float_as_uint(ss), __float_as_uint(ss), false, false); ss = __uint_as_float(r_[0]) + __uint_as_float(r_[1]); }
        { auto r_ = __builtin_amdgcn_permlane32_swap(__float_as_uint(ss), __float_as_uint(ss), false, false); ss = __uint_as_float(r_[0]) + __uint_as_float(r_[1]); }
        const float rstd = frsq(ss * (1.f / D) + EPS);
        { const int nb_ = base + NWAVES * 16; if (nb_ < r1 && nb_ - r0 < 128) { base = nb_; R9_LOADROW(); base -= NWAVES * 16; } }
        const float gl0 = __shfl(acc2[0], r16), gl1 = __shfl(acc2[1], r16), gl2 = __shfl(acc2[2], r16), gl3 = __shfl(acc2[3], r16);
        const float g0 = gl0 * rstd + F.in[19][0], g1 = gl1 * rstd + F.in[19][1], g2 = gl2 * rstd + F.in[19][2], g3 = gl3 * rstd + F.in[19][3];
        int gi = 0; float gm = g0; if (g1 > gm) { gm = g1; gi = 1; } if (g2 > gm) { gm = g2; gi = 2; } if (g3 > gm) { gm = g3; gi = 3; }
        const float g_w = __builtin_amdgcn_rcpf(fexp(g0 - gm) + fexp(g1 - gm) + fexp(g2 - gm) + fexp(g3 - gm));
        if ((q >> 1) == (gi & 1)) { const f32x4 a = (gi >> 1) ? acc1 : acc0; const GAS f32x4* bp = (const GAS f32x4*)(F.in[21] + gi * 8 + 4 * (q & 1));
            *(LAS f32x4*)(EL + r16 * 8 + 4 * (q & 1)) = a * rstd + *bp; }
        asm volatile("s_waitcnt lgkmcnt(0)" ::: "memory");
        if (q == 0 && live) { const f32x4 ea = *(const LAS f32x4*)(EL + r16 * 8), eb = *(const LAS f32x4*)(EL + r16 * 8 + 4);
            float el[8] = {ea.x, ea.y, ea.z, ea.w, eb.x, eb.y, eb.z, eb.w};
            int i0 = 0; float m0 = el[0];
#pragma unroll
            for (int n = 1; n < 8; ++n) if (el[n] > m0) { m0 = el[n]; i0 = n; }
            int i1 = (i0 + 1) & 7; float m1 = -INFINITY;
#pragma unroll
            for (int n = 0; n < 8; ++n) if (n != i0 && el[n] > m1) { m1 = el[n]; i1 = n; }
            const float p1r = fexp(m1 - m0); const float w0 = g_w * __builtin_amdgcn_rcpf(1.f + p1r), w1 = w0 * p1r;
            const int e0 = gi * 8 + i0, e1 = gi * 8 + i1; const int lr0 = atomicAdd((int*)&LCNT[e0], 1), lr1 = atomicAdd((int*)&LCNT[e1], 1);
            LAS int* c = CH + (m - r0) * 8; c[0] = e0; c[1] = e1; c[2] = lr0; c[3] = lr1; c[4] = __float_as_int(w0); c[5] = __float_as_int(w1);
            rstd2[m] = rstd; }
        asm volatile("s_waitcnt lgkmcnt(0)" ::: "memory");
    }
    WG_SYNC();
    if (tid < 32) LBASE[tid] = (int)atomicAdd((unsigned*)(F.ctl + CW_CNT + tid), (unsigned)LCNT[tid]);
    WG_SYNC();
    int* tokl = (int*)(F.ws + WS_TOKL); int* asg = (int*)(F.ws + WS_ASG);
    for (int r = tid; r < r1 - r0; r += NWAVES * 64) { const LAS int* c = CH + r * 8; const int m = r0 + r;
        const int e0 = c[0], e1 = c[1], k0 = LBASE[e0] + c[2], k1 = LBASE[e1] + c[3];
        tokl[(size_t)e0 * M + k0] = m; tokl[(size_t)e1 * M + k1] = m;
        asg[m * 8 + 0] = e0; asg[m * 8 + 1] = k0; asg[m * 8 + 2] = e1; asg[m * 8 + 3] = k1; asg[m * 8 + 4] = c[4]; asg[m * 8 + 5] = c[5]; }
}

template <bool GATHER> __device__ __forceinline__ int expert_tables(Frame& F) {
    const int lane = lane_now(), wave = F.wave, tid = wave * 64 + lane; (void)tid; (void)lane; (void)wave;
    LAS int* TS = (LAS int*)(F.lds + XT_TS); LAS int* TOK = (LAS int*)(F.lds + XT_TOK);
    if (tid == 0) { int acc = 0; for (int e = 0; e < 32; ++e) { TS[e] = acc; acc += ((int)F.ctl[CW_CNT + e] + 255) >> 8; } TS[32] = acc; }
    WG_SYNC();
    const int ntiles = TS[32];
    if (GATHER) { const int* tokl = (const int*)(F.ws + WS_TOKL);
        int e_[5], base_[5], cnt_[5]; bool ok_[5];
#pragma unroll
        for (int ui = 0; ui < 5; ++ui) { const int L = ui * F.G + (int)blockIdx.x; ok_[ui] = L < 4 * ntiles; const int rt = pg8::expert_up_id(ok_[ui] ? L : 0, 4 * ntiles) >> 2; int e = 0;
            for (int k = 1; k < 32; ++k) e += (TS[k] <= rt) ? 1 : 0;
            e_[ui] = e; base_[ui] = (rt - TS[e]) * 256; cnt_[ui] = (int)F.ctl[CW_CNT + e]; }
        if (tid < 256) { int tk_[5]; float rs_[5];
#pragma unroll
            for (int ui = 0; ui < 5; ++ui) { const int rank = base_[ui] + tid; const int v = tokl[(size_t)e_[ui] * M + (rank < cnt_[ui] ? rank : 0)]; tk_[ui] = (rank < cnt_[ui]) ? v : 0; }
#pragma unroll
            for (int ui = 0; ui < 5; ++ui) rs_[ui] = ((const float*)(F.ws + WS_RSTD2))[tk_[ui]];
#pragma unroll
            for (int ui = 0; ui < 5; ++ui) if (ok_[ui]) { TOK[ui * 256 + tid] = tk_[ui]; ((LAS float*)(F.lds + XT_RS))[ui * 256 + tid] = rs_[ui]; } }
        WG_SYNC(); }
    return ntiles;
}

__device__ __forceinline__ void p12_final(Frame& F) {
    const int lane = lane_now(), wave = F.wave, tid = wave * 64 + lane;
    LAS int* TS = (LAS int*)(F.lds + XT_TS);
    if (tid == 0) { int acc = 0; for (int e = 0; e < 32; ++e) { TS[e] = acc; acc += ((int)F.ctl[CW_CNT + e] + 255) >> 8; } TS[32] = acc; }
    WG_SYNC();
    const int gw = F.vcu * NWAVES + wave, NGW = F.G * NWAVES; const GAS v4u* asg = (const GAS v4u*)(F.ws + WS_ASG); const unsigned char* YE = (const unsigned char*)(F.ws + WS_YE); const bf16* XB = (const bf16*)(F.ws + WS_XB);
    const GAS f32x4* gr = (const GAS f32x4*)F.in[25] + 2 * lane; const f32x4 g0 = gr[0], g1 = gr[1], g2 = gr[128], g3 = gr[129];
    v4u a0, a1, rx[2]; u32x2 ry0[2], ry1[2]; float cw0, cw1;
#define P12_REC(m_) do { const int mc_ = (m_) < M ? (m_) : M - 1; a0 = asg[2 * mc_]; a1 = asg[2 * mc_ + 1]; } while (0)
#define P12_ROWS(m_) do { const int mc_ = (m_) < M ? (m_) : M - 1; const size_t p0_ = (size_t)TS[a0.x & 31] * 256 + a0.y, p1_ = (size_t)TS[a0.z & 31] * 256 + a0.w; \
        const GAS v4u* xr_ = (const GAS v4u*)(XB + (size_t)mc_ * D) + lane; const GAS u32x2* y0_ = (const GAS u32x2*)(YE + p0_ * D) + lane; const GAS u32x2* y1_ = (const GAS u32x2*)(YE + p1_ * D) + lane; \
        rx[0] = __builtin_nontemporal_load(xr_); rx[1] = __builtin_nontemporal_load(xr_ + 64); ry0[0] = __builtin_nontemporal_load(y0_); ry0[1] = __builtin_nontemporal_load(y0_ + 64); ry1[0] = __builtin_nontemporal_load(y1_); ry1[1] = __builtin_nontemporal_load(y1_ + 64); \
        cw0 = __uint_as_float(a1.x) * (1.f / YE_SCALE); cw1 = __uint_as_float(a1.y) * (1.f / YE_SCALE); } while (0)
    P12_REC(gw); P12_ROWS(gw); P12_REC(gw + NGW);
    for (int m = gw; m < M; m += NGW) {
        const v4u x0 = rx[0], x1 = rx[1]; const u32x2 ya0 = ry0[0], ya1 = ry0[1], yb0 = ry1[0], yb1 = ry1[1]; const float w0 = cw0, w1 = cw1;
        P12_ROWS(m + NGW); P12_REC(m + 2 * NGW);
        f32x4 v[4]; float s = 0.f;
#pragma unroll
        for (int hh = 0; hh < 2; ++hh) { const v4u x = hh ? x1 : x0; const u32x2 a = hh ? ya1 : ya0, c = hh ? yb1 : yb0;
            const f32x2_t_ a01 = __builtin_amdgcn_cvt_pk_f32_fp8((int)a.x, false), a23 = __builtin_amdgcn_cvt_pk_f32_fp8((int)a.x, true), a45 = __builtin_amdgcn_cvt_pk_f32_fp8((int)a.y, false), a67 = __builtin_amdgcn_cvt_pk_f32_fp8((int)a.y, true);
            const f32x2_t_ c01 = __builtin_amdgcn_cvt_pk_f32_fp8((int)c.x, false), c23 = __builtin_amdgcn_cvt_pk_f32_fp8((int)c.x, true), c45 = __builtin_amdgcn_cvt_pk_f32_fp8((int)c.y, false), c67 = __builtin_amdgcn_cvt_pk_f32_fp8((int)c.y, true);
            v[2 * hh] = (f32x4){bflo(x.x) + w0 * a01.x + w1 * c01.x, bfhi(x.x) + w0 * a01.y + w1 * c01.y, bflo(x.y) + w0 * a23.x + w1 * c23.x, bfhi(x.y) + w0 * a23.y + w1 * c23.y};
            v[2 * hh + 1] = (f32x4){bflo(x.z) + w0 * a45.x + w1 * c45.x, bfhi(x.z) + w0 * a45.y + w1 * c45.y, bflo(x.w) + w0 * a67.x + w1 * c67.x, bfhi(x.w) + w0 * a67.y + w1 * c67.y};
            s += dot4(v[2 * hh], v[2 * hh]) + dot4(v[2 * hh + 1], v[2 * hh + 1]); }
        const float rstd = frsq(wave_sum(s) * (1.f / D) + EPS);
        GAS f32x4* orow = (GAS f32x4*)(F.out + (size_t)m * D) + 2 * lane;
        __builtin_nontemporal_store(v[0] * rstd * g0, orow); __builtin_nontemporal_store(v[1] * rstd * g1, orow + 1); __builtin_nontemporal_store(v[2] * rstd * g2, orow + 128); __builtin_nontemporal_store(v[3] * rstd * g3, orow + 129);
    }
#undef P12_ROWS
#undef P12_REC
}

struct Args { const float* in[26]; float* out; unsigned char* ws; int ph_lo, ph_hi, li, sub; };
__global__ void __launch_bounds__(NWAVES * 64, 2) mk_fwd(Args args) {
    extern __shared__ __attribute__((aligned(16))) unsigned char lds[];
    Frame F;
    F.lds = (LAS unsigned char*)lds;
    F.MISC = (volatile LAS unsigned*)(F.lds + MISC_OFF);
    F.wave = __builtin_amdgcn_readfirstlane((int)threadIdx.x >> 6);
    F.G = gridDim.x; { const int bx = blockIdx.x; F.vcu = (F.G % 8 == 0) ? (bx % 8) * (F.G / 8) + bx / 8 : bx; }
    unsigned char* ws = args.ws; F.ws = ws; F.out = args.out;
    F.ctl = (gu32*)(ws + WS_CTL);
#pragma unroll
    for (int i = 0; i < 26; ++i) F.in[i] = args.in[i];
    for (int u = (int)threadIdx.x; u < (LDS_BYTES - LDSCTL_OFF) / 4; u += NWAVES * 64) ((LAS unsigned*)(F.lds + LDSCTL_OFF))[u] = 0u;
    __syncthreads();
    XcdBarrier bar; bar.bar = (unsigned*)(F.ctl + CW_BAR) + args.li * XCD_BAR_WORDS; bar.x = 0; bar.st = nullptr;
    if (N_LAUNCHES != NPHASE) bar = xcd_barrier_post((unsigned*)(F.ctl + CW_BAR) + args.li * XCD_BAR_WORDS, F.MISC + 8);
#ifdef TPROBE
#ifndef TPA
#define TPA 100
#endif
#ifndef TPBLK
#define TPBLK 0
#endif
#define TP_MARK(id) do { if (blockIdx.x == TPBLK && F.wave == 0) { if ((id) == TPA && F.MISC[12] == 0u) F.MISC[12] = (unsigned)(rt() - tp_t0) | 1u; if ((id) == TPROBE && F.MISC[14] == 0u) F.MISC[14] = ((unsigned)(rt() - tp_t0) - (TPA == 100 ? 0u : F.MISC[12])) | 1u; } } while (0)
#define GRID_BAR(seam) do { xcd_barrier(bar, F.wave); TP_MARK(seam); } while (0)
    const unsigned long long tp_t0 = rt();
#else
#define GRID_BAR(seam) do { if (N_LAUNCHES == NPHASE) { if (F.wave == 0 && lane_now() == 0) __hip_atomic_store(F.ctl + CW_TMO, 0xBADBA0u | (unsigned)(seam), RLX_AGENT); } else { xcd_barrier(bar, F.wave); } } while (0)
#endif
    const int lo = args.ph_lo, hi = args.ph_hi;
#ifndef PHASE_MASK
#define PHASE_MASK 0x1FFF
#endif
#define IN(k) (((PHASE_MASK >> (k)) & 1) && lo <= (k) && (k) < hi)
#define BOTH(k) (IN(k) && IN((k) + 1))
    bf16* Hb = (bf16*)F.out;
    bf16* PROJ = (bf16*)(ws + WS_PROJ);

    if (IN(0)) { p0_prologue(F); if (BOTH(0)) GRID_BAR(0); }

    if (IN(1)) {
        const int sub = args.sub;
        if (sub & 1) {
        if (blockIdx.x < 32) gate_scan(F, (int)blockIdx.x);
        { pg8::Gemm g{Hb, (const bf16*)(ws + WS_WIN), M, NPROJ, D}; pg8::InProjOrder S; S.main.init(M, NPROJ, F.G, (int)blockIdx.x); S.tr.init(512, M, F.G, (int)blockIdx.x); S.G = (int)F.G; S.c = (int)blockIdx.x;
          pg8::EpiProjMvt E{pg8::EpiProj{PROJ, NPROJ, (const float*)(ws + WS_ROPE), attn_body::C2, (const float*)(ws + WS_RSTD0)}, pg8::EpiColScale{(bf16*)(ws + WS_MVT), M, (const float*)(ws + WS_RSTD0)}};
          pg8::gemm_phase<pg8::EpiProjMvt, pg8::InProjOrder, PG8_ALIGN, PG8_SP2>(F.lds + RING_OFF, g, S, E, F.wave); } }
        if (BOTH(1)) GRID_BAR(1);
    }

    if (IN(2)) {
        if (args.sub & 4) { stage_convw(F); m1g_phase(F); }
#ifdef TPROBE
        TP_MARK(20);
#endif
        const float* lv = F.in[5]; const int ln_ = lane_now();
        const float lam = expf(wave_sum(lv[ln_] * lv[64 + ln_])) - expf(wave_sum(lv[128 + ln_] * lv[192 + ln_])) + LAM_INIT;
        const attn_body::AttnTensors AT{(const attn_body::bf16*)(PROJ + C_DQ), (const attn_body::bf16*)(PROJ + C_DK), (const attn_body::bf16*)(PROJ + C_DV), (attn_body::bf16*)(ws + WS_OA), lam, 1.0f - LAM_INIT, EPS, F.in[6]};
        const attn_body::StaticOrder S((int)F.G, F.vcu);
        if (args.sub & 8) attn_body::attn_phase<attn_body::StaticOrder>((char*)lds + RING_OFF, AT, S, F.wave);
#ifdef TPROBE
        TP_MARK(21);
#endif
        if (BOTH(2)) GRID_BAR(2);
    }

    if (IN(3)) {
        if (args.sub & 2) {
        if (blockIdx.x < 64) { pg8::Gemm g{(const bf16*)(ws + WS_MEMN), (const bf16*)(ws + WS_WKV), MROWS, 2 * D, D / 2}; pg8::StaticOrder S; S.init(MROWS, 2 * D, 64, (int)blockIdx.x);
          pg8::EpiBf16<0> E{(bf16*)(ws + WS_MK), D, nullptr, D, (size_t)MROWS * D, 1.f, 1.f / W13_SCALE};
          pg8::gemm_phase<pg8::EpiBf16<0>, pg8::StaticOrder, PG8_ALIGN, PG8_SP2, true>(F.lds + RING_OFF, g, S, E, F.wave); } }
        if (blockIdx.x >= 64 || F.G < 128) p3_scan_combine(F, args.sub & ~32, (F.G < 128) ? 0 : 64);
        if (F.G >= 128) { if (blockIdx.x >= 64) w2_items(F, (int)blockIdx.x - 64, (int)F.G - 64); } else w2_items(F, (int)blockIdx.x, (int)F.G);
#ifdef TPROBE
        __syncthreads(); TP_MARK(23);
#endif
        if (BOTH(3)) GRID_BAR(3); }

    if (IN(4)) { stage_convw(F); m3_phase(F); if (BOTH(4)) GRID_BAR(4); }

    if (IN(5)) {
        pg8::Gemm g{(const bf16*)(ws + WS_OA), (const bf16*)(ws + WS_WOUT), M, D, D};
        pg8::OutFoldOrder S; S.main.init(M, D, F.G, (int)blockIdx.x); S.G = (int)F.G; S.c = (int)blockIdx.x;
        S.fold = pg8::FoldOrder{(int)F.G, (int)blockIdx.x, (const bf16*)(ws + WS_MK), (const bf16*)(ws + WS_MVT2), (const bf16*)(ws + WS_WXQ), (const bf16*)(ws + WS_WXO)};
        pg8::EpiResidFold E{pg8::EpiResid<false, true>{nullptr, (const bf16*)F.out, (bf16*)(ws + WS_XB), (float*)(F.ctl + CW_ROWSS), D, (unsigned char*)(ws + WS_XO), 1.f}, pg8::EpiF8Out{(unsigned char*)(ws + WS_FOLD), D, FOLD_SCALE}};
        pg8::gemm_phase<pg8::EpiResidFold, pg8::OutFoldOrder, PG8_ALIGN, PG8_SP2>(F.lds + RING_OFF, g, S, E, F.wave);
        if (BOTH(5)) GRID_BAR(5);
    }

    if (IN(6)) {
        pg8::Gemm g{(const bf16*)(ws + WS_XO), (const bf16*)(ws + WS_FOLD), M, D, D / 2}; pg8::BatchBOrder S; S.init(M, D, F.G, (int)blockIdx.x); S.bstride = (size_t)D * D; S.tpb = SEQ / 256;
        pg8::EpiSoftmaxP E{(unsigned char*)(ws + WS_XQ), D, (const float*)(F.ctl + CW_ROWSS), EPS, XSCALE / FOLD_SCALE, (LAS float*)(F.lds + XT_TS), P_SCALE};
        pg8::gemm_phase<pg8::EpiSoftmaxP, pg8::BatchBOrder, PG8_ALIGN, PG8_SP2, true>(F.lds + RING_OFF, g, S, E, F.wave);
        if (BOTH(6)) GRID_BAR(6);
    }


    if (IN(8)) {
        pg8::Gemm g{(const bf16*)(ws + WS_XQ), (const bf16*)(ws + WS_FOLD + (size_t)8192 * D), M, D, D / 2}; pg8::BatchBOrder S; S.init(M, D, F.G, (int)blockIdx.x); S.bstride = (size_t)D * D; S.tpb = SEQ / 256;
        pg8::EpiResid<false, false> E{nullptr, (const bf16*)(ws + WS_XB), (bf16*)(ws + WS_XB), nullptr, D, (unsigned char*)(ws + WS_H8), 1.f / (P_SCALE * FOLD_SCALE)};
        pg8::gemm_phase<pg8::EpiResid<false, false>, pg8::BatchBOrder, PG8_ALIGN, PG8_SP2, true>(F.lds + RING_OFF, g, S, E, F.wave);
        if (BOTH(8)) GRID_BAR(8);
    }

    if (IN(9)) { p9_router(F); if (BOTH(9)) GRID_BAR(9); }

    if (IN(10) || IN(11)) {
        const int ntiles = IN(10) ? expert_tables<true>(F) : expert_tables<false>(F);
#ifdef TPROBE
        TP_MARK(30);
#endif
        const int nU = 4 * ntiles, nA = (nU / (int)F.G) * (int)F.G, Lf = nU - nA, c = (int)blockIdx.x;
        const int Nb = (Lf > 0 && IN(10) && IN(11)) ? ((2 * ((int)F.G - Lf) < nA) ? 2 * ((int)F.G - Lf) : nA) : 0;
        const LAS int* TS = (const LAS int*)(F.lds + XT_TS); const LAS int* TOK = (const LAS int*)(F.lds + XT_TOK);
        pg8::Gemm gu{(const bf16*)(ws + WS_H8), (const bf16*)(ws + WS_W13), M, D, D / 2};
        pg8::Gemm gd{(const bf16*)(ws + WS_ACT), (const bf16*)(ws + WS_W2), MAXROWS, D, DEXP / 2};
        static_assert(W13_SCALE == 32.f && ACT_SCALE == 4.f, "EpiSwiGLU8 constants"); pg8::EpiSwiGLU8 EU{(unsigned char*)(ws + WS_ACT), DEXP, (const LAS float*)(F.lds + XT_RS)};
        pg8::EpiF8Out ED{(unsigned char*)(ws + WS_YE), D, YE_SCALE / (ACT_SCALE * W2_SCALE)};
        if (IN(10)) {
            const bool split = IN(11) && Lf > 0;
            pg8::ExpertOrder<true> S{(int)F.G, c, ntiles, TS, TOK, (size_t)D * D, 0, split ? nA : nU, 0};
            pg8::gemm_phase<pg8::EpiSwiGLU8, pg8::ExpertOrder<true>, PG8_ALIGN, PG8_SP2, true>(F.lds + RING_OFF, gu, S, EU, F.wave);
            if (split) { GRID_BAR(10);
                if (c < Lf) { pg8::ExpertOrder<true> S2{(int)F.G, c, ntiles, TS, TOK, (size_t)D * D, 0, nU, nA / (int)F.G};
                    pg8::gemm_phase<pg8::EpiSwiGLU8, pg8::ExpertOrder<true>, PG8_ALIGN, PG8_SP2, true>(F.lds + RING_OFF, gu, S2, EU, F.wave); }
                else { pg8::ExpertOrder<false> S2{(int)F.G - Lf, c - Lf, ntiles, TS, TOK, (size_t)D * DEXP, 0, Nb, 0};
                    pg8::gemm_phase<pg8::EpiF8Out, pg8::ExpertOrder<false>, PG8_ALIGN, PG8_SP2, true>(F.lds + RING_OFF, gd, S2, ED, F.wave); } }
            if (BOTH(10)) GRID_BAR(10);
        }
        if (IN(11)) {
            pg8::ExpertOrder<false> S{(int)F.G, c, ntiles, TS, TOK, (size_t)D * DEXP, Nb, nU, 0};
            pg8::gemm_phase<pg8::EpiF8Out, pg8::ExpertOrder<false>, PG8_ALIGN, PG8_SP2, true>(F.lds + RING_OFF, gd, S, ED, F.wave);
            if (BOTH(11)) GRID_BAR(11);
        }
    }

#ifdef TPROBE
    const unsigned long long tp_t12 = rt();
#endif
    if (IN(12)) { p12_final(F); }
#ifdef TPROBE
    if (TPROBE == 12) { __syncthreads(); if (blockIdx.x == TPBLK && F.wave == 0) F.MISC[14] = (unsigned)(rt() - tp_t12) | 1u; }
    if (blockIdx.x == TPBLK && F.wave == 0) { const unsigned long long te = rt(); const unsigned long long d = (unsigned long long)F.MISC[14] * TMUL; while (rt() - te < d) __builtin_amdgcn_s_sleep(8); }
#endif
#undef IN
#undef BOTH
}

extern "C" void kernel_launch(void* const* d_in, const int* in_sizes, int n_in, void* d_out, int out_size, void* d_ws, size_t ws_size, hipStream_t stream) {
    static int grid = 0;
    if (grid == 0) {
        if (n_in != 26 || in_sizes[0] != M * D || out_size != M * D || ws_size < WS_END) { fprintf(stderr, "kernel_launch: unexpected shapes (n_in %d, in0 %d, out %d, ws %zu); nothing launched\n", n_in, n_in > 0 ? in_sizes[0] : -1, out_size, ws_size); grid = -1; return; }
        int dev = 0, cus = 0, per_cu = 0;
        if (hipGetDevice(&dev) != hipSuccess || hipDeviceGetAttribute(&cus, hipDeviceAttributeMultiprocessorCount, dev) != hipSuccess) { grid = -1; return; }
        if (hipFuncSetAttribute((const void*)mk_fwd, hipFuncAttributeMaxDynamicSharedMemorySize, LDS_BYTES) != hipSuccess) { fprintf(stderr, "kernel_launch: hipFuncSetAttribute failed\n"); grid = -1; return; }
        if (hipOccupancyMaxActiveBlocksPerMultiprocessor(&per_cu, (const void*)mk_fwd, NWAVES * 64, LDS_BYTES) != hipSuccess || per_cu < 1) { fprintf(stderr, "kernel_launch: occupancy query reports %d workgroups per CU\n", per_cu); }
        (void)hipGetLastError();
        grid = cus;
    }
    if (grid < 0) return;
    if (hipMemsetAsync((char*)d_ws + WS_CTL, 0, CTL_ZERO_BYTES, stream) != hipSuccess) return;
    Args a{};
    for (int i = 0; i < 26; ++i) a.in[i] = (const float*)d_in[i];
    a.out = (float*)d_out; a.ws = (unsigned char*)d_ws;
#ifdef PROBE_PRE_MASK
    for (int r = 0; r < PROBE_REP; ++r) for (int k = 0; k < NPHASE; ++k) if ((PROBE_PRE_MASK >> k) & 1) { a.ph_lo = k; a.ph_hi = k + 1; a.li = 1; a.sub = PROBE_SUB;
        hipLaunchKernelGGL(mk_fwd, dim3(grid), dim3(NWAVES * 64), LDS_BYTES, stream, a); }
    if (hipMemsetAsync((char*)d_ws + WS_CTL, 0, CTL_ZERO_BYTES, stream) != hipSuccess) return;
#endif
    for (int li = 0; li < N_LAUNCHES; ++li) {
        a.ph_lo = (N_LAUNCHES == NPHASE) ? li : 0; a.ph_hi = (N_LAUNCHES == NPHASE) ? li + 1 : NPHASE; a.li = 0; a.sub = 0x3F;
        hipLaunchKernelGGL(mk_fwd, dim3(grid), dim3(NWAVES * 64), LDS_BYTES, stream, a);
        if (hipPeekAtLastError() != hipSuccess) break;
    }
#ifdef PROBE_POST_MASK
    for (int r = 0; r < PROBE_REP; ++r) for (int k = 0; k < NPHASE; ++k) if ((PROBE_POST_MASK >> k) & 1) { a.ph_lo = k; a.ph_hi = k + 1; a.li = 1; a.sub = PROBE_SUB;
        hipLaunchKernelGGL(mk_fwd, dim3(grid), dim3(NWAVES * 64), LDS_BYTES, stream, a); }
#endif
}
```
